# Optimizing an MI355X kernel written in HIP

```python
import math
import jax, jax.numpy as jnp
from jax import lax
import numpy as np

D_MODEL = 2048
BATCH = 4
SEQ = 4096
DEPTH = 2

GRID_W = 64
CTX_LEN = 256
N_EVEN = (DEPTH + 1) // 2
N_ODD = DEPTH // 2
NORM_EPS = 1e-6
Q_HEADS = 16
KV_HEADS = 4
GQA_GROUP = Q_HEADS // KV_HEADS
ATTN_HDIM = 64
ATTN_BLOCK = 128
WINDOW = 128
ROPE_PAIRS = ATTN_HDIM // 4
ROPE_BASE = 10000.0
NEG_INF = -1e30
LRU_WIDTH = D_MODEL // 2
LRU_HEADS = 16
LRU_HDIM = LRU_WIDTH // LRU_HEADS
LRU_C = 8.0
CONV_W = 4
CONV_LEFT = 2
Q_W = Q_HEADS * ATTN_HDIM
KV_W = KV_HEADS * ATTN_HDIM
EVEN_IN = Q_W + 2 * KV_W + 2 * LRU_WIDTH
EVEN_MIX = Q_W + LRU_WIDTH
S5_WIDTH = D_MODEL // 2
S5_CH = 16
S5_GROUPS = S5_WIDTH // S5_CH
S5_STATE = 64
N_EXPERTS = 16
N_EXPERT_GROUPS = 4
EXPERTS_PER_GROUP = N_EXPERTS // N_EXPERT_GROUPS
TOP_K = 2
EXPERT_FF = D_MODEL // 2
MOE_BLOCK = 256

kernel_name = 'hybrid_prefix_dit_swa_rglru_s5_moe'


def rmsnorm(x, g):
    xf = x.astype(jnp.float32)
    y = xf * lax.rsqrt(jnp.mean(xf * xf, axis=-1, keepdims=True) + NORM_EPS)
    return (y * g.astype(jnp.float32)).astype(x.dtype)


def modulate(x, g, shift, scale):
    return rmsnorm(x, g) * (1 + scale) + shift


def axial_rope_angles(n):
    rows = n // GRID_W
    row = jnp.repeat(jnp.arange(rows), GRID_W).astype(jnp.float32)
    col = jnp.tile(jnp.arange(GRID_W), rows).astype(jnp.float32)
    inv_freq = ROPE_BASE ** (-jnp.arange(ROPE_PAIRS, dtype=jnp.float32) / ROPE_PAIRS)
    return row[:, None] * inv_freq, col[:, None] * inv_freq


def apply_axial_rope(x, ang_row, ang_col):
    xf = x.astype(jnp.float32)
    x_row, x_col = jnp.split(xf, 2, axis=-1)

    def rot(t, ang):
        t1, t2 = jnp.split(t, 2, axis=-1)
        cos, sin = jnp.cos(ang)[:, None, :], jnp.sin(ang)[:, None, :]
        return jnp.concatenate([t1 * cos - t2 * sin, t2 * cos + t1 * sin], axis=-1)

    return jnp.concatenate([rot(x_row, ang_row), rot(x_col, ang_col)], axis=-1).astype(x.dtype)


def band_blocks(t, nb):
    bsz, _, h, d = t.shape
    tp = jnp.pad(t, ((0, 0), (ATTN_BLOCK, ATTN_BLOCK), (0, 0), (0, 0))).reshape(bsz, nb + 2, ATTN_BLOCK, h, d)
    return jnp.concatenate([tp[:, :-2], tp[:, 1:-1], tp[:, 2:]], axis=2)


def windowed_gqa(q, k, v, qc, kc, vc, sink, with_ctx_out):
    bsz, n = q.shape[0], q.shape[1]
    nb = n // ATTN_BLOCK
    scale = ATTN_HDIM ** -0.5
    qb = q.reshape(bsz, nb, ATTN_BLOCK, KV_HEADS, GQA_GROUP, ATTN_HDIM)
    kb, vb = band_blocks(k, nb), band_blocks(v, nb)
    s_loc = jnp.einsum('bnqhgd,bnkhd->bnhgqk', qb, kb).astype(jnp.float32) * scale
    s_ctx = jnp.einsum('bnqhgd,bchd->bnhgqc', qb, kc).astype(jnp.float32) * scale
    qi = jnp.arange(ATTN_BLOCK)[:, None]
    kj = jnp.arange(3 * ATTN_BLOCK)[None, :]
    rel = kj - ATTN_BLOCK - qi
    kpos = jnp.arange(nb)[:, None, None] * ATTN_BLOCK - ATTN_BLOCK + kj[None]
    mask = (jnp.abs(rel) <= WINDOW)[None] & (kpos >= 0) & (kpos < n)
    s_loc = jnp.where(mask[None, :, None, None], s_loc, NEG_INF)
    sk = sink.astype(jnp.float32).reshape(KV_HEADS, GQA_GROUP)[:, :, None, None]
    m = jnp.maximum(jnp.maximum(s_loc.max(-1, keepdims=True), s_ctx.max(-1, keepdims=True)), sk)
    p_loc = jnp.exp(s_loc - m)
    p_ctx = jnp.exp(s_ctx - m)
    denom = p_loc.sum(-1, keepdims=True) + p_ctx.sum(-1, keepdims=True) + jnp.exp(sk - m)
    o = (jnp.einsum('bnhgqk,bnkhd->bnqhgd', (p_loc / denom).astype(v.dtype), vb)
         + jnp.einsum('bnhgqc,bchd->bnqhgd', (p_ctx / denom).astype(v.dtype), vc))
    y_lat = o.reshape(bsz, n, Q_W)
    y_ctx = None
    if with_ctx_out:
        cl = qc.shape[1]
        qcb = qc.reshape(bsz, cl, KV_HEADS, GQA_GROUP, ATTN_HDIM)
        s_cc = jnp.einsum('bqhgd,bkhd->bhgqk', qcb, kc).astype(jnp.float32) * scale
        sink_col = jnp.broadcast_to(sk, s_cc.shape[:-1] + (1,))
        p = jax.nn.softmax(jnp.concatenate([s_cc, sink_col], axis=-1), axis=-1)[..., :-1]
        y_ctx = jnp.einsum('bhgqk,bkhd->bqhgd', p.astype(vc.dtype), vc).reshape(bsz, cl, Q_W)
    return y_lat, y_ctx


def centred_dwconv(u, w, b):
    n = u.shape[1]
    up = jnp.pad(u, ((0, 0), (CONV_LEFT, CONV_W - 1 - CONV_LEFT), (0, 0)))
    out = b
    for tap in range(CONV_W):
        out = out + up[:, tap:tap + n] * w[tap]
    return out


def linear_scan(a, b, h0, reverse):
    def combine(e1, e2):
        a1, b1 = e1
        a2, b2 = e2
        return a1 * a2, a2 * b1 + b2

    a_cum, b_cum = lax.associative_scan(combine, (a, b), axis=1, reverse=reverse)
    if h0 is None:
        return b_cum
    return a_cum * h0[:, None] + b_cum


def rglru_gates(u, lam, wa, ba, wi, bi):
    bsz, n, w = u.shape
    ub = u.reshape(bsz, n, LRU_HEADS, LRU_HDIM)
    r = jax.nn.sigmoid(jnp.einsum('bnhi,hij->bnhj', ub, wa.astype(jnp.float32)).reshape(bsz, n, w) + ba.astype(jnp.float32))
    i = jax.nn.sigmoid(jnp.einsum('bnhi,hij->bnhj', ub, wi.astype(jnp.float32)).reshape(bsz, n, w) + bi.astype(jnp.float32))
    log_a = -LRU_C * r * jax.nn.softplus(-lam.astype(jnp.float32))
    a = jnp.exp(log_a)
    mult = jnp.sqrt(-jnp.expm1(2.0 * log_a))
    return a, mult * (i * u)


def rglru_mixer(xr, gr, xrc, grc, conv_w, conv_b, lam, wa, ba, wi, bi, with_ctx_out):
    u_lat = centred_dwconv(xr, conv_w, conv_b).astype(jnp.float32)
    u_ctx = centred_dwconv(xrc, conv_w, conv_b).astype(jnp.float32)
    h_lat = jnp.zeros_like(u_lat)
    h_ctx = jnp.zeros_like(u_ctx) if with_ctx_out else None
    for d, rev in enumerate((False, True)):
        prm = (lam[d], wa[d], ba[d], wi[d], bi[d])
        a_c, b_c = rglru_gates(u_ctx, *prm)
        hc = linear_scan(a_c, b_c, None, rev)
        h0 = hc[:, 0] if rev else hc[:, -1]
        a_l, b_l = rglru_gates(u_lat, *prm)
        h_lat = h_lat + linear_scan(a_l, b_l, h0, rev)
        if with_ctx_out:
            h_ctx = h_ctx + hc
    y_lat = (h_lat * jax.nn.gelu(gr.astype(jnp.float32))).astype(xr.dtype)
    y_ctx = (h_ctx * jax.nn.gelu(grc.astype(jnp.float32))).astype(xrc.dtype) if with_ctx_out else None
    return y_lat, y_ctx


def even_mixer(h_lat, h_ctx, ang_row, ang_col, w_in, w_out, sink, conv_w, conv_b, lam, wa, ba, wi, bi, with_ctx_out):
    splits = [Q_W, Q_W + KV_W, Q_W + 2 * KV_W, Q_W + 2 * KV_W + LRU_WIDTH]
    q, k, v, xr, gr = jnp.split(h_lat @ w_in, splits, axis=-1)
    qc, kc, vc, xrc, grc = jnp.split(h_ctx @ w_in, splits, axis=-1)

    def heads(t, nh):
        return t.reshape(t.shape[0], t.shape[1], nh, ATTN_HDIM)

    q = apply_axial_rope(heads(q, Q_HEADS), ang_row, ang_col)
    k = apply_axial_rope(heads(k, KV_HEADS), ang_row, ang_col)
    a_lat, a_ctx = windowed_gqa(q, k, heads(v, KV_HEADS), heads(qc, Q_HEADS), heads(kc, KV_HEADS),
                                heads(vc, KV_HEADS), sink, with_ctx_out)
    r_lat, r_ctx = rglru_mixer(xr, gr, xrc, grc, conv_w, conv_b, lam, wa, ba, wi, bi, with_ctx_out)
    y_lat = jnp.concatenate([a_lat, r_lat], axis=-1) @ w_out
    y_ctx = jnp.concatenate([a_ctx, r_ctx], axis=-1) @ w_out if with_ctx_out else None
    return y_lat, y_ctx


def s5_mixer(u_lat, u_ctx, lam_re, lam_im, log_step, b_re, b_im, c_re, c_im, d_skip, glu_w, glu_b, with_ctx_out):
    bsz, n, _ = u_lat.shape
    cl = u_ctx.shape[1]
    ul = u_lat.astype(jnp.float32)
    uc = u_ctx.astype(jnp.float32)
    ulg = ul.reshape(bsz, n, S5_GROUPS, S5_CH)
    ucg = uc.reshape(bsz, cl, S5_GROUPS, S5_CH)
    d32 = d_skip.astype(jnp.float32)
    y_lat = d32 * ul
    y_ctx = d32 * uc if with_ctx_out else None
    for d, rev in enumerate((False, True)):
        lam = lax.complex(lam_re[d].astype(jnp.float32), lam_im[d].astype(jnp.float32))
        step = jnp.exp(log_step[d].astype(jnp.float32))[:, None]
        lam_bar = jnp.exp(lam * step)
        b_bar = ((lam_bar - 1) / lam)[..., None] * lax.complex(b_re[d].astype(jnp.float32), b_im[d].astype(jnp.float32))
        c_mat = lax.complex(c_re[d].astype(jnp.float32), c_im[d].astype(jnp.float32))
        bu_c = jnp.einsum('bngc,gsc->bngs', ucg, b_bar)
        xc = linear_scan(jnp.broadcast_to(lam_bar, (1, cl) + lam_bar.shape), bu_c, None, rev)
        x0 = xc[:, 0] if rev else xc[:, -1]
        bu_l = jnp.einsum('bngc,gsc->bngs', ulg, b_bar)
        xl = linear_scan(jnp.broadcast_to(lam_bar, (1, n) + lam_bar.shape), bu_l, x0, rev)
        y_lat = y_lat + jnp.real(jnp.einsum('bngs,gcs->bngc', xl, c_mat)).reshape(bsz, n, S5_WIDTH)
        if with_ctx_out:
            y_ctx = y_ctx + jnp.real(jnp.einsum('bngs,gcs->bngc', xc, c_mat)).reshape(bsz, cl, S5_WIDTH)

    def glu(y):
        z = jax.nn.gelu(y)
        return (z * jax.nn.sigmoid(z @ glu_w.astype(jnp.float32) + glu_b.astype(jnp.float32))).astype(u_lat.dtype)

    return glu(y_lat), (glu(y_ctx) if with_ctx_out else None)


def odd_mixer(h_lat, h_ctx, w_in, w_out, lam_re, lam_im, log_step, b_re, b_im, c_re, c_im, d_skip, glu_w, glu_b, with_ctx_out):
    y_lat, y_ctx = s5_mixer(h_lat @ w_in, h_ctx @ w_in, lam_re, lam_im, log_step, b_re, b_im, c_re, c_im,
                            d_skip, glu_w, glu_b, with_ctx_out)
    return y_lat @ w_out, (y_ctx @ w_out if with_ctx_out else None)


def moe_ffn(h, router_w, router_b, w_gate, w_up, w_down):
    shp = h.shape
    t = h.reshape(-1, shp[-1])
    n_tok = t.shape[0]
    logits = t.astype(jnp.float32) @ router_w.astype(jnp.float32) + router_b.astype(jnp.float32)
    probs = jax.nn.softmax(logits, axis=-1).reshape(n_tok, N_EXPERT_GROUPS, EXPERTS_PER_GROUP)
    group_score = lax.top_k(probs, TOP_K)[0].sum(-1)
    g_sel = jnp.argmax(group_score, axis=-1)
    in_group = jnp.take_along_axis(probs, g_sel[:, None, None], axis=1)[:, 0]
    top_w, top_local = lax.top_k(in_group, TOP_K)
    top_w = top_w / top_w.sum(-1, keepdims=True)
    top_e = g_sel[:, None] * EXPERTS_PER_GROUP + top_local
    n_assign = n_tok * TOP_K
    n_blocks = -(-n_assign // MOE_BLOCK) + N_EXPERTS
    e_flat = top_e.reshape(-1)
    order = jnp.argsort(e_flat)
    e_sorted = e_flat[order]
    tok_sorted = order // TOP_K
    w_sorted = top_w.reshape(-1)[order]
    counts = jnp.bincount(e_flat, length=N_EXPERTS)
    start = jnp.cumsum(counts) - counts
    padded = (counts + MOE_BLOCK - 1) // MOE_BLOCK * MOE_BLOCK
    pad_end = jnp.cumsum(padded)
    pad_start = pad_end - padded
    dest = pad_start[e_sorted] + jnp.arange(n_assign) - start[e_sorted]
    buf = jnp.zeros((n_blocks * MOE_BLOCK, shp[-1]), t.dtype).at[dest].set(t[tok_sorted])
    block_e = jnp.minimum(jnp.searchsorted(pad_end, jnp.arange(n_blocks) * MOE_BLOCK, side='right'), N_EXPERTS - 1)

    def expert_block(args):
        xb, e = args
        return (jax.nn.silu(xb @ w_gate[e]) * (xb @ w_up[e])) @ w_down[e]

    y_buf = lax.map(expert_block, (buf.reshape(n_blocks, MOE_BLOCK, shp[-1]), block_e)).reshape(-1, shp[-1])
    y = jnp.zeros_like(t).at[tok_sorted].add((y_buf[dest] * w_sorted[:, None]).astype(t.dtype))
    return y.reshape(shp)


def setup_inputs(seed: int = 0) -> dict:
    key = jax.random.key(seed)
    ks = iter(jax.random.split(key, 40))
    f32 = jnp.float32

    def nrm(shape, s):
        return jax.random.normal(next(ks), shape, f32) * s

    def uni(shape, lo, hi):
        return jax.random.uniform(next(ks), shape, f32, lo, hi)

    a0 = uni((N_EVEN, 2, LRU_WIDTH), 0.9, 0.999) ** (1.0 / LRU_C)
    n_idx = jnp.arange(S5_STATE, dtype=f32)
    return {
        'x': nrm((BATCH, SEQ, D_MODEL), 1.0),
        'c': nrm((BATCH, D_MODEL), 1.0),
        'ctx': nrm((BATCH, CTX_LEN, D_MODEL), 1.0),
        'c_ctx': nrm((D_MODEL,), 1.0),
        'ada_w': nrm((DEPTH, D_MODEL, 6 * D_MODEL), 0.5 * D_MODEL ** -0.5),
        'ada_b': nrm((DEPTH, 6 * D_MODEL), 0.02),
        'norm_mix': 1.0 + nrm((DEPTH, D_MODEL), 0.02),
        'norm_ffn': 1.0 + nrm((DEPTH, D_MODEL), 0.02),
        'norm_final': 1.0 + nrm((D_MODEL,), 0.02),
        'ev_w_in': nrm((N_EVEN, D_MODEL, EVEN_IN), D_MODEL ** -0.5),
        'ev_w_out': nrm((N_EVEN, EVEN_MIX, D_MODEL), EVEN_MIX ** -0.5),
        'attn_sink': nrm((N_EVEN, Q_HEADS), 1.0),
        'lru_conv_w': nrm((N_EVEN, CONV_W, LRU_WIDTH), CONV_W ** -0.5),
        'lru_conv_b': nrm((N_EVEN, LRU_WIDTH), 0.02),
        'lru_lam': jnp.log(a0) - jnp.log1p(-a0),
        'lru_wa': nrm((N_EVEN, 2, LRU_HEADS, LRU_HDIM, LRU_HDIM), LRU_HDIM ** -0.5),
        'lru_ba': nrm((N_EVEN, 2, LRU_WIDTH), 0.02),
        'lru_wi': nrm((N_EVEN, 2, LRU_HEADS, LRU_HDIM, LRU_HDIM), LRU_HDIM ** -0.5),
        'lru_bi': nrm((N_EVEN, 2, LRU_WIDTH), 0.02),
        'od_w_in': nrm((N_ODD, D_MODEL, S5_WIDTH), D_MODEL ** -0.5),
        's5_lam_re': -0.5 + nrm((N_ODD, 2, S5_GROUPS, S5_STATE), 0.01),
        's5_lam_im': math.pi * n_idx + nrm((N_ODD, 2, S5_GROUPS, S5_STATE), 0.01),
        's5_log_step': uni((N_ODD, 2, S5_GROUPS), math.log(1e-3), math.log(1e-1)),
        's5_b_re': nrm((N_ODD, 2, S5_GROUPS, S5_STATE, S5_CH), (2 * S5_CH) ** -0.5),
        's5_b_im': nrm((N_ODD, 2, S5_GROUPS, S5_STATE, S5_CH), (2 * S5_CH) ** -0.5),
        's5_c_re': nrm((N_ODD, 2, S5_GROUPS, S5_CH, S5_STATE), S5_STATE ** -0.5),
        's5_c_im': nrm((N_ODD, 2, S5_GROUPS, S5_CH, S5_STATE), S5_STATE ** -0.5),
        's5_d': nrm((N_ODD, S5_WIDTH), 0.5),
        's5_glu_w': nrm((N_ODD, S5_WIDTH, S5_WIDTH), S5_WIDTH ** -0.5),
        's5_glu_b': nrm((N_ODD, S5_WIDTH), 0.02),
        'od_w_out': nrm((N_ODD, S5_WIDTH, D_MODEL), S5_WIDTH ** -0.5),
        'router_w': nrm((D_MODEL, N_EXPERTS), D_MODEL ** -0.5),
        'router_b': nrm((N_EXPERTS,), 0.01),
        'moe_w_gate': nrm((DEPTH, N_EXPERTS, D_MODEL, EXPERT_FF), D_MODEL ** -0.5),
        'moe_w_up': nrm((DEPTH, N_EXPERTS, D_MODEL, EXPERT_FF), D_MODEL ** -0.5),
        'moe_w_down': nrm((DEPTH, N_EXPERTS, EXPERT_FF, D_MODEL), EXPERT_FF ** -0.5),
    }


def reference(x, c, ctx, c_ctx, ada_w, ada_b, norm_mix, norm_ffn, norm_final,
              ev_w_in, ev_w_out, attn_sink, lru_conv_w, lru_conv_b, lru_lam, lru_wa, lru_ba, lru_wi, lru_bi,
              od_w_in, s5_lam_re, s5_lam_im, s5_log_step, s5_b_re, s5_b_im, s5_c_re, s5_c_im, s5_d,
              s5_glu_w, s5_glu_b, od_w_out, router_w, router_b, moe_w_gate, moe_w_up, moe_w_down):
    n = x.shape[1]
    ang_row, ang_col = axial_rope_angles(n)
    silu_c = jax.nn.silu(c)
    silu_cc = jax.nn.silu(c_ctx)
    for l in range(DEPTH):
        last = l == DEPTH - 1
        ada_lat = (silu_c @ ada_w[l] + ada_b[l])[:, None, :]
        ada_ctx = silu_cc @ ada_w[l] + ada_b[l]
        sh1, sc1, g1, sh2, sc2, g2 = jnp.split(ada_lat, 6, axis=-1)
        sh1c, sc1c, g1c, sh2c, sc2c, g2c = jnp.split(ada_ctx, 6, axis=-1)
        h_lat = modulate(x, norm_mix[l], sh1, sc1)
        h_ctx = modulate(ctx, norm_mix[l], sh1c, sc1c)
        if l % 2 == 0:
            e = l // 2
            y_lat, y_ctx = even_mixer(h_lat, h_ctx, ang_row, ang_col, ev_w_in[e], ev_w_out[e], attn_sink[e],
                                      lru_conv_w[e], lru_conv_b[e], lru_lam[e], lru_wa[e], lru_ba[e],
                                      lru_wi[e], lru_bi[e], not last)
        else:
            o = l // 2
            y_lat, y_ctx = odd_mixer(h_lat, h_ctx, od_w_in[o], od_w_out[o], s5_lam_re[o], s5_lam_im[o],
                                     s5_log_step[o], s5_b_re[o], s5_b_im[o], s5_c_re[o], s5_c_im[o], s5_d[o],
                                     s5_glu_w[o], s5_glu_b[o], not last)
        x = x + g1 * y_lat
        x = x + g2 * moe_ffn(modulate(x, norm_ffn[l], sh2, sc2), router_w, router_b,
                             moe_w_gate[l], moe_w_up[l], moe_w_down[l])
        if not last:
            ctx = ctx + g1c * y_ctx
            ctx = ctx + g2c * moe_ffn(modulate(ctx, norm_ffn[l], sh2c, sc2c), router_w, router_b,
                                      moe_w_gate[l], moe_w_up[l], moe_w_down[l])
    return rmsnorm(x, norm_final)
```

```cpp
#ifndef CPU_EMU
#include <hip/hip_runtime.h>
#include <cstdio>
#include <cstdint>
#endif

#ifndef BATCH
#define BATCH 4
#endif
#ifndef SEQ
#define SEQ 4096
#endif
#ifndef CTX_LEN
#define CTX_LEN 256
#endif
constexpr int D = 2048, NB = BATCH, NSEQ = SEQ, NCTX = CTX_LEN;
constexpr int ML = NB * NSEQ, MC = NB * NCTX, MT = ML + MC;
constexpr int NADA = NB + 1;
constexpr int QW = 1024, KVW = 256, LW = 1024, EVIN = 3584;
constexpr int COL_Q = 0, COL_K = 1024, COL_V = 1280, COL_XR = 1536, COL_GR = 2560;
constexpr int S5W = 1024, S5G = 64, S5C = 16, S5S = 64;
constexpr int NE = 16, FF = 1024;
constexpr int NBLK = (2 * MT + 255) / 256 + NE;
constexpr int ADA6 = 6 * D;
static_assert(ML % 256 == 0 && MC % 256 == 0 && NSEQ % 256 == 0 && NCTX % 256 == 0, "tiles must not straddle sequences");

typedef unsigned short bf16_t;
#ifndef CPU_EMU
#define LAS __attribute__((address_space(3)))
__device__ __forceinline__ int tid_of(int wv) { int l; asm volatile("v_mbcnt_lo_u32_b32 %0, -1, 0\n\tv_mbcnt_hi_u32_b32 %0, -1, %0" : "=v"(l)); return wv * 64 + l; }
#endif

#ifdef CPU_EMU
constexpr bool MOE1_FP8 = false, MOE0_FP8 = false, DENSE1_FP8 = false, IN0_FP8 = false, IN0QKV_FP8 = false, OUT0_FP8 = false, RES_BF16 = false, Y8 = false;
#else
constexpr bool Y8 = true;
constexpr bool RES_BF16 = true; constexpr bool IN0_FP8 = false, IN0QKV_FP8 = true, OUT0_FP8 = true;
constexpr bool DENSE1_FP8 = true;
constexpr bool MOE0_FP8 = true;
constexpr bool MOE1_FP8 = true;
#endif
constexpr float W8_SCALE = 64.0f, ACT8_SCALE = 4.0f;
constexpr int W8_E8M0 = 127 - 6, ACT8_E8M0 = 127 - 2, ONE_E8M0 = 127;
constexpr float Z8_SCALE = 8.0f, S8_SCALE = 16.0f, MIX8_SCALE = 16.0f, Y8_SCALE = 16.0f; constexpr int Z8_E8M0 = 127 - 3, S8_E8M0 = 127 - 4, MIX8_E8M0 = 127 - 4;

constexpr size_t al256(size_t x) { return (x + 255) & ~(size_t)255; }
constexpr size_t WS_BAR = 0;
constexpr size_t WS_CNT = 16384;
constexpr size_t WS_ADA = 32768;
constexpr size_t CTL_BYTES = al256(WS_ADA + (size_t)2 * NADA * ADA6 * 4);
constexpr size_t WS_ROPE = CTL_BYTES;
constexpr size_t WS_S5LAM = WS_ROPE + 64 * 16 * 8;
constexpr size_t WS_S5BB = WS_S5LAM + (size_t)2 * S5G * S5S * 8;
constexpr size_t WS_S5LAMT = WS_S5BB + (size_t)2 * S5G * S5S * S5C * 8;
constexpr size_t WS_S5BF = WS_S5LAMT + (size_t)2 * S5G * S5S * 8;
constexpr size_t WS_S5CF = WS_S5BF + (size_t)2 * S5G * 4 * 64 * 16;
constexpr size_t WS_LRUBF = WS_S5CF + (size_t)2 * S5G * 4 * 64 * 16;
constexpr size_t WS_RWF = WS_LRUBF + (size_t)2 * 16 * 2 * 2 * 4 * 64 * 16;
constexpr size_t WS_WT_IN0 = al256(WS_RWF + (size_t)2 * 64 * 64 * 16);
constexpr size_t WS_WT_OUT0 = WS_WT_IN0 + (size_t)EVIN * D * 2;
constexpr size_t WS_WT_IN1 = WS_WT_OUT0 + (size_t)D * D * 2;
constexpr size_t WS_WT_GLU = WS_WT_IN1 + (size_t)S5W * D * 2;
constexpr size_t WS_WT_OUT1 = WS_WT_GLU + (size_t)S5W * S5W * 2;
constexpr size_t WS_WT_GU = WS_WT_OUT1 + (size_t)D * S5W * 2;
constexpr size_t WS_WT_DN = WS_WT_GU + (size_t)2 * NE * 2 * FF * D * 2;
constexpr size_t WS_W8_GU = WS_WT_GU + (size_t)NE * 2 * FF * D * 2;
constexpr size_t WS_W8_DN = WS_WT_DN + (size_t)NE * D * FF * 2;
constexpr size_t WS_XRES = WS_WT_DN + (size_t)2 * NE * D * FF * 2;
constexpr size_t WS_H8 = WS_XRES + (size_t)MT * D * 2;
constexpr size_t WS_H = WS_XRES + (size_t)MT * D * 4;
constexpr size_t WS_TOK = WS_H + (size_t)MT * D * 2;
constexpr size_t WS_ROWIDX = WS_TOK + (size_t)4 * MT * 2 * 4;
constexpr size_t WS_RA = al256(WS_ROWIDX + (size_t)NBLK * 256 * 4);
constexpr size_t WS_QKV = WS_RA;
constexpr size_t WS_MIX = WS_QKV + (size_t)MT * EVIN * 2;
constexpr size_t WS_U1 = WS_RA;
constexpr size_t WS_YS5 = WS_U1 + (size_t)MT * S5W * 2;
constexpr size_t WS_Z = WS_YS5 + (size_t)ML * S5W * 4;
constexpr size_t WS_S = WS_Z + (size_t)ML * S5W * 2;
constexpr int S5_CHUNK = 128, S5_NCC = NCTX / S5_CHUNK, S5_NLC = NSEQ / S5_CHUNK, S5_NCH = S5_NCC + S5_NLC;
static_assert(S5_NCC % 2 == 0 && S5_NLC % 2 == 0, "chunks are processed in pairs");
constexpr size_t WS_S5E = WS_S + (size_t)ML * S5W * 2;
constexpr size_t RA_BYTES = (size_t)MT * EVIN * 2 + (size_t)MT * D * 2;
static_assert(WS_S5E + (size_t)NB * S5G * 2 * S5_NCH * S5S * 8 <= WS_RA + RA_BYTES, "L1 overlay (E)");
static_assert((size_t)MT * S5W * 2 + (size_t)ML * S5W * 4 + 2 * (size_t)ML * S5W * 2 <= RA_BYTES, "L1 overlay");
constexpr size_t WS_RB = al256(WS_RA + RA_BYTES);
constexpr size_t WS_ACT = WS_RB;
constexpr size_t WS_YBUF = WS_ACT + (size_t)NBLK * 256 * FF * 2;
constexpr size_t WS_UCONV = WS_RB;
constexpr size_t WS_HSUM = WS_UCONV + (size_t)MT * LW * 4;
constexpr size_t RB_BYTES = (size_t)NBLK * 256 * FF * 2 + (size_t)NBLK * 256 * D * 2;
static_assert(2 * (size_t)MT * LW * 4 <= RB_BYTES, "LRU overlay");
constexpr size_t WS_UBF = WS_RB;
constexpr int VT_T = 128 + NSEQ + 128 + NCTX;
constexpr size_t WS_VT = WS_UBF + (size_t)MT * LW * 2;
constexpr size_t WS_LRUAGG = al256(WS_VT + (size_t)NB * 4 * 64 * VT_T * 2);
constexpr int LRU_CH = 64, LRU_NCC = NCTX / LRU_CH, LRU_NLC = NSEQ / LRU_CH, LRU_NCH = LRU_NCC + LRU_NLC;
static_assert(LRU_NCC % 2 == 0 && LRU_NLC % 2 == 0, "chunks are processed in pairs");
static_assert(WS_LRUAGG + (size_t)NB * 2 * LRU_NCH * LW * 8 <= WS_RB + RB_BYTES, "RB overlay");
constexpr int MAXG = 256;
constexpr int HIST_LD = 32;
constexpr size_t WS_HIST = al256(WS_RB + RB_BYTES);
constexpr size_t WS_END = WS_HIST + (size_t)2 * MAXG * HIST_LD * 4;

struct Params {
    const float *x, *c, *ctx, *c_ctx, *ada_w, *ada_b, *norm_mix, *norm_ffn, *norm_final;
    const float *ev_w_in, *ev_w_out, *attn_sink, *lru_conv_w, *lru_conv_b, *lru_lam, *lru_wa, *lru_ba, *lru_wi, *lru_bi;
    const float *od_w_in, *s5_lam_re, *s5_lam_im, *s5_log_step, *s5_b_re, *s5_b_im, *s5_c_re, *s5_c_im, *s5_d, *s5_glu_w, *s5_glu_b, *od_w_out;
    const float *router_w, *router_b, *moe_w_gate, *moe_w_up, *moe_w_down;
    float* out;
    unsigned char* ws;
};

#ifdef CPU_EMU
typedef float f32x4 __attribute__((vector_size(16)));
#else
typedef float f32x4 __attribute__((ext_vector_type(4)));
#endif
struct u32x2_t { unsigned x, y; };
struct u32x4_t { unsigned x, y, z, w; };
#ifdef CPU_EMU
__device__ __forceinline__ void st_coh(int* p, int v) { *p = v; }
__device__ __forceinline__ int ld_coh(const int* p) { return *p; }
#else
__device__ __forceinline__ void st_coh(int* p, int v) { __hip_atomic_store(p, v, __ATOMIC_RELAXED, __HIP_MEMORY_SCOPE_AGENT); }
__device__ __forceinline__ int ld_coh(const int* p) { return __hip_atomic_load(p, __ATOMIC_RELAXED, __HIP_MEMORY_SCOPE_AGENT); }
#endif
__device__ __forceinline__ f32x4 unpack4bf(unsigned lo, unsigned hi) { return (f32x4){__uint_as_float(lo << 16), __uint_as_float(lo & 0xffff0000u), __uint_as_float(hi << 16), __uint_as_float(hi & 0xffff0000u)}; }
__device__ __forceinline__ float bf2f(bf16_t b) { return __uint_as_float(((unsigned)b) << 16); }
__device__ __forceinline__ bf16_t f2bf(float f) { unsigned u = __float_as_uint(f); u += 0x7FFFu + ((u >> 16) & 1u); return (bf16_t)(u >> 16); }
#ifdef CPU_EMU
__device__ __forceinline__ unsigned pack2bf(float lo, float hi) { return (unsigned)f2bf(lo) | ((unsigned)f2bf(hi) << 16); }
#else
typedef short s5_bf16x8 __attribute__((ext_vector_type(8)));
typedef unsigned u4v_t __attribute__((ext_vector_type(4)));
__device__ __forceinline__ int deal_item(int round, int gwave, int nwaves, int items, int grp = 2) {
    const int full = items / nwaves; if (round < full) return round * nwaves + gwave; if (round > full) return -1;
    const int rem = items - full * nwaves, blk = gwave >> 3, wv = gwave & 7; if (wv >= grp) return -1; const int j = blk * grp + wv; return j < rem ? full * nwaves + j : -1; }
#ifndef CPU_EMU
__device__ __forceinline__ float clamp_e4m3(float x) { return fminf(fmaxf(x, -448.0f), 448.0f); }
__device__ __forceinline__ unsigned pack4_fp8(float a, float b, float c, float d) { int w = 0; w = __builtin_amdgcn_cvt_pk_fp8_f32(clamp_e4m3(a), clamp_e4m3(b), w, false); w = __builtin_amdgcn_cvt_pk_fp8_f32(clamp_e4m3(c), clamp_e4m3(d), w, true); return (unsigned)w; }
#endif
__device__ __forceinline__ float opaque_zero() { float z = 0.f; asm volatile("" : "+v"(z)); return z; }
#define MFMA_KEEP(acc, x) asm volatile("" : "+v"(acc) : "v"(x))
typedef __bf16 bf16x2_hw __attribute__((ext_vector_type(2)));
typedef float f32x2_hw __attribute__((ext_vector_type(2)));
__device__ __forceinline__ unsigned pack2bf(float lo, float hi) { const f32x2_hw v = {lo, hi}; const bf16x2_hw b = __builtin_convertvector(v, bf16x2_hw); return __builtin_bit_cast(unsigned, b); }
#endif
#ifdef CPU_EMU
__device__ __forceinline__ float sigmoidf_(float x) { return 1.0f / (1.0f + __expf(-x)); }
__device__ __forceinline__ float fast_rcp(float x) { return 1.0f / x; }
__device__ __forceinline__ float fast_sqrt(float x) { return sqrtf(x); }
#else
__device__ __forceinline__ float fast_rcp(float x) { return __builtin_amdgcn_rcpf(x); }
__device__ __forceinline__ float fast_sqrt(float x) { return __builtin_amdgcn_sqrtf(x); }
__device__ __forceinline__ float sigmoidf_(float x) { return __builtin_amdgcn_rcpf(1.0f + __builtin_amdgcn_exp2f(-1.44269504089f * x)); }
#endif
__device__ __forceinline__ float siluf_(float x) { return x * sigmoidf_(x); }
#ifdef CPU_EMU
__device__ __forceinline__ float geluf_(float x) { const float u = 0.7978845608028654f * (x + 0.044715f * x * x * x); return 0.5f * x * (1.0f + tanhf(u)); }
#else
__device__ __forceinline__ float geluf_(float x) { const float t = x * x, e = __builtin_amdgcn_exp2f(x * __builtin_fmaf(t, -0.102943215f, -2.302208198f)); return x * __builtin_amdgcn_rcpf(1.0f + e); }
#endif
__device__ __forceinline__ float softplusf_(float x) { return x > 20.f ? x : log1pf(__expf(x)); }
__device__ __forceinline__ int ada_row(int r) { return r < ML ? r / NSEQ : NB; }
__device__ __forceinline__ const float* ada_ptr(const Params& p, int l, int arow, int which) { return (const float*)(p.ws + WS_ADA) + ((size_t)l * NADA + arow) * ADA6 + (size_t)which * D; }
__device__ __forceinline__ const float* xin_row(const Params& p, int l, int r) {
    if (l == 0) return r < ML ? p.x + (size_t)r * D : p.ctx + (size_t)(r - ML) * D;
    return (const float*)(p.ws + WS_XRES) + (size_t)r * D;
}

#ifndef CPU_EMU
constexpr int ADA_ITEMS = 2 * (ADA6 / 128), ADA_LDS_BYTES = (NADA * D + 16 * NADA * 128) * 4;
__device__ __forceinline__ void ph_ada(const Params& p, float* sil, int bid, int nblocks, int wv_) {
    const int tid = tid_of(wv_), w = wv_, lane = tid & 63, kh = lane >> 5, cq = lane & 31;
    float* ada = (float*)(p.ws + WS_ADA); float* red = sil + NADA * D;
    if (bid < ADA_ITEMS) { for (int i = tid; i < NADA * D; i += 512) { const int r = i / D, k = i % D; sil[i] = siluf_(r < NB ? p.c[(size_t)r * D + k] : p.c_ctx[k]); } }
    __syncthreads();
    for (int item = bid; item < ADA_ITEMS; item += nblocks) {
        const int l = item / (ADA6 / 128), cb = (item % (ADA6 / 128)) * 128, c0 = cb + cq * 4;
        f32x4 acc[NADA];
#pragma unroll
        for (int r = 0; r < NADA; ++r) acc[r] = (f32x4){0.f, 0.f, 0.f, 0.f};
        const float* wp = p.ada_w + (size_t)l * D * ADA6 + c0; const int k0 = w * 256 + kh * 128;
#pragma unroll 16
        for (int k = k0; k < k0 + 128; ++k) {
            const f32x4 wv = *(const f32x4*)(wp + (size_t)k * ADA6);
#pragma unroll
            for (int r = 0; r < NADA; ++r) acc[r] += wv * sil[r * D + k];
        }
        __syncthreads();
#pragma unroll
        for (int r = 0; r < NADA; ++r) *(f32x4*)(red + ((size_t)((w * 2 + kh) * NADA + r) * 128) + cq * 4) = acc[r];
        __syncthreads();
        for (int i = tid; i < NADA * 128; i += 512) { const int r = i / 128, cc = i % 128; float sacc = p.ada_b[(size_t)l * ADA6 + cb + cc];
#pragma unroll
            for (int ww = 0; ww < 16; ++ww) sacc += red[(size_t)(ww * NADA + r) * 128 + cc];
            ada[((size_t)l * NADA + r) * ADA6 + cb + cc] = sacc; }
    }
}
#else
void ph_ada_emu(const Params& p) {
    float* ada = (float*)(p.ws + WS_ADA);
    for (int l = 0; l < 2; ++l) for (int r = 0; r < NADA; ++r) { std::vector<double> acc(ADA6, 0.0);
        for (int k = 0; k < D; ++k) { const float cv = r < NB ? p.c[(size_t)r * D + k] : p.c_ctx[k]; const double sv = siluf_(cv); const float* wr = p.ada_w + ((size_t)l * D + k) * ADA6; for (int j = 0; j < ADA6; ++j) acc[j] += sv * wr[j]; }
        for (int j = 0; j < ADA6; ++j) ada[((size_t)l * NADA + r) * ADA6 + j] = (float)acc[j] + p.ada_b[(size_t)l * ADA6 + j]; }
}
#endif
__device__ __forceinline__ void ph_tables(const Params& p, long gtid, long gthreads) {
    float* rope = (float*)(p.ws + WS_ROPE);
    for (long it = gtid; it < 64 * 16; it += gthreads) {
        const int pos = (int)(it / 16), i = (int)(it % 16);
        const double inv = pow(10000.0, -(double)i / 16.0); const double a = (double)pos * (double)(float)inv;
        rope[it * 2] = (float)cos(a); rope[it * 2 + 1] = (float)sin(a);
    }
    float* lamb = (float*)(p.ws + WS_S5LAM); float* bb = (float*)(p.ws + WS_S5BB);
    for (long it = gtid; it < 2L * S5G * S5S; it += gthreads) {
        const int g = (int)((it / S5S) % S5G), d = (int)(it / (S5S * S5G));
        const double lr = p.s5_lam_re[it], li = p.s5_lam_im[it], step = exp((double)p.s5_log_step[d * S5G + g]);
        const double mag = exp(lr * step), br = mag * cos(li * step), bi = mag * sin(li * step);
        lamb[it * 2] = (float)br; lamb[it * 2 + 1] = (float)bi;
        const double nr = br - 1.0, ni = bi, den = lr * lr + li * li;
        const double cr = (nr * lr + ni * li) / den, ci = (ni * lr - nr * li) / den;
        for (int c = 0; c < S5C; ++c) { const double b_r = p.s5_b_re[it * S5C + c], b_i = p.s5_b_im[it * S5C + c];
            bb[(it * S5C + c) * 2] = (float)(cr * b_r - ci * b_i); bb[(it * S5C + c) * 2 + 1] = (float)(cr * b_i + ci * b_r); }
        const double magT = exp(lr * step * S5_CHUNK); float* lt = (float*)(p.ws + WS_S5LAMT);
        lt[it * 2] = (float)(magT * cos(li * step * S5_CHUNK)); lt[it * 2 + 1] = (float)(magT * sin(li * step * S5_CHUNK));
    }
    { bf16_t* rw = (bf16_t*)(p.ws + WS_RWF);
      for (long it = gtid; it < 64L * 64 * 8; it += gthreads) { const int j = (int)(it & 7), lane = (int)((it >> 3) & 63), st = (int)(it >> 9);
          const float wv = p.router_w[(size_t)(32 * st + 8 * (lane >> 4) + j) * NE + (lane & 15)]; const bf16_t hi = f2bf(wv); rw[it] = hi; rw[64L * 64 * 8 + it] = f2bf(wv - bf2f(hi)); } }
    bf16_t* lb = (bf16_t*)(p.ws + WS_LRUBF);
    for (long it = gtid; it < 2L * 16 * 2 * 2 * 4 * 64 * 8; it += gthreads) {
        const int j = (int)(it & 7), lane = (int)((it >> 3) & 63), ks = (int)((it >> 9) & 3), cs = (int)((it >> 11) & 1), gate = (int)((it >> 12) & 1); const long dh = it >> 13;
        const float* w = gate ? p.lru_wi : p.lru_wa;
        lb[it] = f2bf(w[((size_t)dh * 64 + 16 * ks + 8 * (lane >> 5) + j) * 64 + 32 * cs + (lane & 31)]);
    }
    bf16_t* bf = (bf16_t*)(p.ws + WS_S5BF); bf16_t* cf = (bf16_t*)(p.ws + WS_S5CF);
    for (long it = gtid; it < 2L * S5G * 4 * 64 * 8; it += gthreads) {
        const int j = (int)(it & 7), lane = (int)((it >> 3) & 63), ct = (int)((it >> 9) & 3); const long dg = it >> 11;
        { const int st = (lane & 31) + 32 * (ct >> 1), ch = 8 * (lane >> 5) + j; const size_t gi = (size_t)dg * S5S + st;
          const double lr = p.s5_lam_re[gi], li = p.s5_lam_im[gi], step = exp((double)p.s5_log_step[dg]);
          const double mag = exp(lr * step), br = mag * cos(li * step), bi = mag * sin(li * step), nr = br - 1.0, ni = bi, den = lr * lr + li * li;
          const double cr = (nr * lr + ni * li) / den, ci = (ni * lr - nr * li) / den, b_r = p.s5_b_re[gi * S5C + ch], b_i = p.s5_b_im[gi * S5C + ch];
          bf[it] = f2bf((float)((ct & 1) ? (cr * b_i + ci * b_r) : (cr * b_r - ci * b_i))); }
        { const int ks = ct, q = 32 * ks + 8 * (lane >> 4) + j, st = q >> 1, ch = lane & 15; const size_t ci_ = ((size_t)dg * S5C + ch) * S5S + st;
          cf[it] = f2bf((q & 1) ? -p.s5_c_im[ci_] : p.s5_c_re[ci_]); }
    }
}
__device__ __forceinline__ void ph_norm(const Params& p, int l, int rows, long gtid, long gthreads) {
    bf16_t* h = (bf16_t*)(p.ws + WS_H);
    for (long r = gtid; r < rows; r += gthreads) {
        const float* xr = xin_row(p, l, (int)r); const int ar = ada_row((int)r);
        const float* sh = ada_ptr(p, l, ar, 0); const float* sc = ada_ptr(p, l, ar, 1); const float* g = p.norm_mix + (size_t)l * D;
        float ss = 0.f; for (int k = 0; k < D; ++k) ss += xr[k] * xr[k];
        const float rstd = 1.0f / sqrtf(ss / D + 1e-6f);
        for (int k = 0; k < D; ++k) h[(size_t)r * D + k] = f2bf(xr[k] * rstd * g[k] * (1.0f + sc[k]) + sh[k]);
    }
}
__device__ __forceinline__ void ph_conv(const Params& p, long gtid, long gthreads) {
    const bf16_t* qkv = (const bf16_t*)(p.ws + WS_QKV); float* u = (float*)(p.ws + WS_UCONV);
    for (long it = gtid; it < (long)MT * LW; it += gthreads) {
        const int r = (int)(it / LW), ch = (int)(it % LW);
        int base, t, n; if (r < ML) { base = (r / NSEQ) * NSEQ; t = r % NSEQ; n = NSEQ; } else { const int rc = r - ML; base = ML + (rc / NCTX) * NCTX; t = rc % NCTX; n = NCTX; }
        float acc = p.lru_conv_b[ch];
        for (int tap = 0; tap < 4; ++tap) { const int tt = t + tap - 2; if (tt >= 0 && tt < n) acc += p.lru_conv_w[tap * LW + ch] * bf2f(qkv[(size_t)(base + tt) * EVIN + COL_XR + ch]); }
        u[it] = acc;
    }
}
__device__ __forceinline__ void ph_lru(const Params& p, long gtid, long gthreads) {
    const bf16_t* qkv = (const bf16_t*)(p.ws + WS_QKV); const float* u = (const float*)(p.ws + WS_UCONV); float* hs = (float*)(p.ws + WS_HSUM); bf16_t* mix = (bf16_t*)(p.ws + WS_MIX);
    for (long it = gtid; it < (long)NB * LW; it += gthreads) {
        const int b = (int)(it / LW), ch = (int)(it % LW), hh = ch / 64, j = ch % 64;
        for (int d = 0; d < 2; ++d) {
            const float lamv = softplusf_(-p.lru_lam[d * LW + ch]), ba = p.lru_ba[d * LW + ch], bi = p.lru_bi[d * LW + ch];
            const float* wa = p.lru_wa + ((size_t)(d * 16 + hh) * 64) * 64 + j; const float* wi = p.lru_wi + ((size_t)(d * 16 + hh) * 64) * 64 + j;
            float state = 0.f;
            for (int seg = 0; seg < 2; ++seg) {
                const int n = seg ? NSEQ : NCTX, base = seg ? b * NSEQ : ML + b * NCTX;
                for (int stp = 0; stp < n; ++stp) {
                    const int row = base + (d ? n - 1 - stp : stp); const float* ur = u + (size_t)row * LW + hh * 64;
                    float ra = ba, ia = bi;
                    for (int i = 0; i < 64; ++i) { ra += ur[i] * wa[(size_t)i * 64]; ia += ur[i] * wi[(size_t)i * 64]; }
                    const float rg = sigmoidf_(ra), ig = sigmoidf_(ia), log_a = -8.0f * rg * lamv, a = __expf(log_a), mult = sqrtf(-expm1f(2.0f * log_a));
                    state = a * state + mult * (ig * ur[j]);
                    if (d == 0) hs[(size_t)row * LW + ch] = state;
                    else { const float tot = hs[(size_t)row * LW + ch] + state; mix[(size_t)row * D + QW + ch] = f2bf(tot * geluf_(bf2f(qkv[(size_t)row * EVIN + COL_GR + ch]))); }
                }
            }
        }
    }
}
__device__ __forceinline__ void ph_attn(const Params& p, long gtid, long gthreads) {
    const bf16_t* qkv = (const bf16_t*)(p.ws + WS_QKV); bf16_t* mix = (bf16_t*)(p.ws + WS_MIX);
    for (long it = gtid; it < (long)MT * 16; it += gthreads) {
        const int r = (int)(it / 16), hd = (int)(it % 16), kvh = hd / 4;
        float q[64], o[64];
        for (int d = 0; d < 64; ++d) { q[d] = bf2f(qkv[(size_t)r * EVIN + COL_Q + hd * 64 + d]); o[d] = 0.f; }
        float m = p.attn_sink[hd], lsum = 1.0f;
        const int b = r < ML ? r / NSEQ : (r - ML) / NCTX;
        for (int seg = 0; seg < 2; ++seg) {
            int k0, k1;
            if (seg == 0) { if (r >= ML) continue; const int t = r % NSEQ; const int lo = t - 128 < 0 ? 0 : t - 128, hi = t + 128 > NSEQ - 1 ? NSEQ - 1 : t + 128; k0 = b * NSEQ + lo; k1 = b * NSEQ + hi + 1; }
            else { k0 = ML + b * NCTX; k1 = k0 + NCTX; }
            for (int kr = k0; kr < k1; ++kr) {
                const bf16_t* kp = qkv + (size_t)kr * EVIN + COL_K + kvh * 64; const bf16_t* vp = qkv + (size_t)kr * EVIN + COL_V + kvh * 64;
                float s = 0.f; for (int d = 0; d < 64; ++d) s += q[d] * bf2f(kp[d]);
                if (s > m) { const float f = __expf(m - s); lsum *= f; for (int d = 0; d < 64; ++d) o[d] *= f; m = s; }
                const float pe = __expf(s - m); lsum += pe;
                for (int d = 0; d < 64; ++d) o[d] += pe * bf2f(vp[d]);
            }
        }
        const float inv = 1.0f / lsum;
        for (int d = 0; d < 64; ++d) mix[(size_t)r * D + hd * 64 + d] = f2bf(o[d] * inv);
    }
}
__device__ __forceinline__ void ph_router(const Params& p, int l, int rows, long gtid, long gthreads) {
    bf16_t* h = (bf16_t*)(p.ws + WS_H); const float* xres = (const float*)(p.ws + WS_XRES);
    int* tok_e = (int*)(p.ws + WS_TOK); float* tok_w = (float*)(p.ws + WS_TOK) + (size_t)MT * 2; int* tok_slot = (int*)(p.ws + WS_TOK) + (size_t)MT * 4;
    int* cnt = (int*)(p.ws + WS_CNT) + l * 64;
    for (long r = gtid; r < rows; r += gthreads) {
        const float* xr = xres + (size_t)r * D; const int ar = ada_row((int)r);
        const float* sh = ada_ptr(p, l, ar, 3); const float* sc = ada_ptr(p, l, ar, 4); const float* g = p.norm_ffn + (size_t)l * D;
        float ss = 0.f; for (int k = 0; k < D; ++k) ss += xr[k] * xr[k];
        const float rstd = 1.0f / sqrtf(ss / D + 1e-6f);
        float lg[NE];
#pragma unroll
        for (int e = 0; e < NE; ++e) lg[e] = p.router_b[e];
        for (int k = 0; k < D; ++k) { const float hv = xr[k] * rstd * g[k] * (1.0f + sc[k]) + sh[k]; h[(size_t)r * D + k] = f2bf(hv);
#pragma unroll
            for (int e = 0; e < NE; ++e) lg[e] += hv * p.router_w[(size_t)k * NE + e]; }
        float mx = lg[0];
#pragma unroll
        for (int e = 1; e < NE; ++e) mx = lg[e] > mx ? lg[e] : mx;
        float pr[NE], sum = 0.f;
#pragma unroll
        for (int e = 0; e < NE; ++e) { pr[e] = __expf(lg[e] - mx); sum += pr[e]; }
#pragma unroll
        for (int e = 0; e < NE; ++e) pr[e] /= sum;
        float best = -1.f, w1 = 0.f, w2 = 0.f; int e1 = 0, e2 = 0;
#pragma unroll
        for (int gi = 0; gi < 4; ++gi) { float a1 = -1.f, a2 = -1.f; int j1 = 0, j2 = 0;
#pragma unroll
            for (int j = 0; j < 4; ++j) { const float v = pr[gi * 4 + j]; if (v > a1) { a2 = a1; j2 = j1; a1 = v; j1 = j; } else if (v > a2) { a2 = v; j2 = j; } }
            if (a1 + a2 > best) { best = a1 + a2; e1 = gi * 4 + j1; e2 = gi * 4 + j2; w1 = a1; w2 = a2; } }
        const float ws = w1 + w2;
        tok_e[r * 2] = e1; tok_e[r * 2 + 1] = e2; tok_w[r * 2] = w1 / ws; tok_w[r * 2 + 1] = w2 / ws;
        tok_slot[r * 2] = atomicAdd(cnt + e1, 1); tok_slot[r * 2 + 1] = atomicAdd(cnt + e2, 1);
    }
}
__device__ __forceinline__ int moe_pad_start(const int* cnt, int e) { int acc = 0;
#pragma unroll
    for (int j = 0; j < NE; ++j) { const int pj = (cnt[j] + 255) / 256 * 256; acc += (j < e) ? pj : 0; } return acc; }
__device__ __forceinline__ void ph_dispatch(const Params& p, int l, int rows, long gtid, long gthreads) {
    const int* tok_e = (const int*)(p.ws + WS_TOK); const int* tok_slot = (const int*)(p.ws + WS_TOK) + (size_t)MT * 4; int* tok_dest = (int*)(p.ws + WS_TOK) + (size_t)MT * 6;
    int* rowidx = (int*)(p.ws + WS_ROWIDX); const int* cnt = (const int*)(p.ws + WS_CNT) + l * 64;
    for (long it = gtid; it < (long)rows * 2; it += gthreads) { const int e = tok_e[it], dest = moe_pad_start(cnt, e) + tok_slot[it]; tok_dest[it] = dest; st_coh(rowidx + dest, (int)(it / 2)); }
    const int total = moe_pad_start(cnt, NE);
    for (long it = gtid; it < total; it += gthreads) { int acc = 0, st = 0, ce = 0;
#pragma unroll
        for (int j = 0; j < NE; ++j) { const int pj = (cnt[j] + 255) / 256 * 256; if (it >= acc && it < acc + pj) { st = acc; ce = cnt[j]; } acc += pj; }
        if (it - st >= ce) st_coh(rowidx + it, 0); }
}
__device__ __forceinline__ void ph_combine(const Params& p, int l, int rows, long gtid, long gthreads) {
    float* xres = (float*)(p.ws + WS_XRES); const bf16_t* yb = (const bf16_t*)(p.ws + WS_YBUF);
    const float* tok_w = (const float*)(p.ws + WS_TOK) + (size_t)MT * 2; const int* tok_dest = (const int*)(p.ws + WS_TOK) + (size_t)MT * 6;
    for (long it = gtid; it < (long)rows * (D / 4); it += gthreads) {
        const int r = (int)(it / (D / 4)), c = (int)(it % (D / 4)) * 4; const float* g2 = ada_ptr(p, l, ada_row(r), 5);
        const int d0 = tok_dest[r * 2], d1 = tok_dest[r * 2 + 1]; const float w0 = tok_w[r * 2], w1 = tok_w[r * 2 + 1];
        for (int j = 0; j < 4; ++j) xres[(size_t)r * D + c + j] += g2[c + j] * (w0 * bf2f(yb[(size_t)d0 * D + c + j]) + w1 * bf2f(yb[(size_t)d1 * D + c + j]));
    }
}
__device__ __forceinline__ void ph_s5(const Params& p, long gtid, long gthreads) {
    const bf16_t* u1 = (const bf16_t*)(p.ws + WS_U1); float* ys = (float*)(p.ws + WS_YS5); bf16_t* z = (bf16_t*)(p.ws + WS_Z);
    const float* lamb = (const float*)(p.ws + WS_S5LAM); const float* bb = (const float*)(p.ws + WS_S5BB);
    for (long it = gtid; it < (long)NB * S5W; it += gthreads) {
        const int b = (int)(it / S5W), col = (int)(it % S5W), g = col / S5C, c = col % S5C;
        for (int t = 0; t < NSEQ; ++t) { const size_t row = (size_t)b * NSEQ + t; ys[row * S5W + col] = p.s5_d[col] * bf2f(u1[row * S5W + col]); }
        for (int d = 0; d < 2; ++d)
            for (int s = 0; s < S5S; ++s) {
                const size_t gi = ((size_t)d * S5G + g) * S5S + s;
                const float lr = lamb[gi * 2], li = lamb[gi * 2 + 1];
                const float cr = p.s5_c_re[(((size_t)d * S5G + g) * S5C + c) * S5S + s], ci = p.s5_c_im[(((size_t)d * S5G + g) * S5C + c) * S5S + s];
                float br[S5C], bi[S5C]; for (int cc = 0; cc < S5C; ++cc) { br[cc] = bb[(gi * S5C + cc) * 2]; bi[cc] = bb[(gi * S5C + cc) * 2 + 1]; }
                float xr = 0.f, xi = 0.f;
                for (int seg = 0; seg < 2; ++seg) {
                    const int n = seg ? NSEQ : NCTX, base = seg ? b * NSEQ : ML + b * NCTX;
                    for (int stp = 0; stp < n; ++stp) {
                        const size_t row = (size_t)base + (d ? n - 1 - stp : stp); const bf16_t* ur = u1 + row * S5W + g * S5C;
                        float bur = 0.f, bui = 0.f; for (int cc = 0; cc < S5C; ++cc) { const float uv = bf2f(ur[cc]); bur += br[cc] * uv; bui += bi[cc] * uv; }
                        const float nr = lr * xr - li * xi + bur, ni = lr * xi + li * xr + bui; xr = nr; xi = ni;
                        if (seg) ys[row * S5W + col] += cr * xr - ci * xi;
                    }
                }
            }
        for (int t = 0; t < NSEQ; ++t) { const size_t row = (size_t)b * NSEQ + t; z[row * S5W + col] = f2bf(geluf_(ys[row * S5W + col])); }
    }
}
#ifndef CPU_EMU
typedef float s5_f32x16 __attribute__((ext_vector_type(16)));
constexpr int S5_XPITCH = 272, S5_XBYTES = 32 * S5_XPITCH, S5_ABYTES = 0, S5_WAVE_LDS = S5_XBYTES + S5_ABYTES + 8 * 2 * 64 * 8;
static_assert(8 * S5_WAVE_LDS <= 147456 - 64, "S5 LDS");
__device__ __forceinline__ int s5_chunk_row0(int b, int k) { return k < S5_NCC ? ML + b * NCTX + k * S5_CHUNK : b * NSEQ + (k - S5_NCC) * S5_CHUNK; }
__device__ __forceinline__ int s5_order(int d, int k) { return d == 0 ? k : (k < S5_NCC ? S5_NCC - 1 - k : S5_NCC + (S5_NLC - 1 - (k - S5_NCC))); }
template <int PASS> __device__ __forceinline__ void ph_s5_fast(const Params& p, LAS unsigned char* lds, int gwave, int nwaves, int wv_) {
    const int lane = tid_of(wv_) & 63, wv = wv_;
    LAS unsigned char* xl = lds + wv * S5_WAVE_LDS;
    const int r = lane & 31, hh = lane >> 5, a_half = (r >> 2) & 1, a_n = (r & 3) + 4 * (r >> 3), tk = lane & 15, q4 = lane >> 4;
    const bf16_t* u1 = (const bf16_t*)(p.ws + WS_U1); bf16_t* z = (bf16_t*)(p.ws + WS_Z); float* ys = (float*)(p.ws + WS_YS5);
    const float* lamb = (const float*)(p.ws + WS_S5LAM); const float* lamt = (const float*)(p.ws + WS_S5LAMT);
    const s5_bf16x8* BF = (const s5_bf16x8*)(p.ws + WS_S5BF); const s5_bf16x8* CF = (const s5_bf16x8*)(p.ws + WS_S5CF);
    float* E = (float*)(p.ws + WS_S5E);
    constexpr int P0 = PASS == 2 ? S5_NCC / 2 : 0, NPAIR = S5_NCH / 2 - P0;
    for (int rd = 0; rd <= (NB * S5G * NPAIR) / nwaves; ++rd) {
        const int it = deal_item(rd, gwave, nwaves, NB * S5G * NPAIR); if (it < 0) continue;
        const int g = it % S5G, pr = P0 + (it / S5G) % NPAIR, b = it / (NPAIR * S5G);
        const int k_s = 2 * pr + hh, k_a = 2 * pr + a_half;
        const int rb_a = s5_chunk_row0(b, k_a);
#pragma unroll
        for (int d = 0; d < 2; ++d) {
            const size_t dg = (size_t)d * S5G + g;
            s5_bf16x8 bfr[4], cfr[4];
#pragma unroll
            for (int ct = 0; ct < 4; ++ct) { bfr[ct] = BF[(dg * 4 + ct) * 64 + lane]; if (PASS == 2) cfr[ct] = CF[(dg * 4 + ct) * 64 + lane]; }
            const float l0r = lamb[(dg * S5S + r) * 2], l0i = lamb[(dg * S5S + r) * 2 + 1], l1r = lamb[(dg * S5S + r + 32) * 2], l1i = lamb[(dg * S5S + r + 32) * 2 + 1];
            float x0r = 0.f, x0i = 0.f, x1r = 0.f, x1i = 0.f;
            float* Eb = E + (((size_t)(b * S5G + g) * 2 + d) * S5_NCH) * S5S * 2;
            if (PASS == 2) {
                const float t0r = lamt[(dg * S5S + r) * 2], t0i = lamt[(dg * S5S + r) * 2 + 1], t1r = lamt[(dg * S5S + r + 32) * 2], t1i = lamt[(dg * S5S + r + 32) * 2 + 1];
                const int oi = s5_order(d, k_s);
                const int oa = s5_order(d, 2 * pr), ob = s5_order(d, 2 * pr + 1), oimax = oa > ob ? oa : ob;
#pragma unroll 8
                for (int j = 0; j < oimax; ++j) { const float e0r = Eb[(j * S5S + r) * 2], e0i = Eb[(j * S5S + r) * 2 + 1], e1r = Eb[(j * S5S + r + 32) * 2], e1i = Eb[(j * S5S + r + 32) * 2 + 1];
                    const float n0r = t0r * x0r - t0i * x0i + e0r, n0i = t0r * x0i + t0i * x0r + e0i, n1r = t1r * x1r - t1i * x1i + e1r, n1i = t1r * x1i + t1i * x1r + e1i;
                    if (j < oi) { x0r = n0r; x0i = n0i; x1r = n1r; x1i = n1i; } }
            }
#pragma unroll 1
            for (int i = 0; i < 8; ++i) {
                const int tile = d ? 7 - i : i;
                const s5_bf16x8 a = *(const s5_bf16x8*)(u1 + (size_t)(rb_a + tile * 16 + a_n) * S5W + g * S5C + 8 * hh);
                s5_f32x16 acc[4];
#pragma unroll
                for (int ct = 0; ct < 4; ++ct) { const float z0 = opaque_zero(); s5_f32x16 zz;
#pragma unroll
                    for (int e = 0; e < 16; ++e) zz[e] = z0;
                    acc[ct] = __builtin_amdgcn_mfma_f32_32x32x16_bf16(a, bfr[ct], zz, 0, 0, 0); }
                MFMA_KEEP(acc[3], a);
#pragma unroll
                for (int nn = 0; nn < 16; ++nn) {
                    const int n = d ? 15 - nn : nn;
                    float n0r = __builtin_fmaf(l0r, x0r, __builtin_fmaf(-l0i, x0i, acc[0][n])), n0i = __builtin_fmaf(l0r, x0i, __builtin_fmaf(l0i, x0r, acc[1][n])), n1r = __builtin_fmaf(l1r, x1r, __builtin_fmaf(-l1i, x1i, acc[2][n])), n1i = __builtin_fmaf(l1r, x1i, __builtin_fmaf(l1i, x1r, acc[3][n]));
                    asm volatile("" : "+v"(n0r), "+v"(n0i), "+v"(n1r), "+v"(n1i));
                    x0r = n0r; x0i = n0i; x1r = n1r; x1i = n1i;
                    if (PASS == 2) { *(LAS unsigned*)(xl + (hh * 16 + n) * S5_XPITCH + 4 * r) = pack2bf(x0r, x0i); *(LAS unsigned*)(xl + (hh * 16 + n) * S5_XPITCH + 4 * (r + 32)) = pack2bf(x1r, x1i); }
                }
                if (PASS == 2) asm volatile("" ::: "memory");
                if (PASS == 2) {
#pragma unroll
                    for (int rg = 0; rg < 2; ++rg) {
                        const size_t row = (size_t)s5_chunk_row0(b, 2 * pr + rg) + tile * 16 + tk; const size_t off = row * S5W + g * S5C + 4 * q4;
                        f32x4 yv; LAS u32x2_t* ypark = (LAS u32x2_t*)(xl + S5_XBYTES + S5_ABYTES) + (tile * 2 + rg) * 64 + lane;
                        if (d == 0) { const f32x4 dsk = *(const f32x4*)(p.s5_d + g * S5C + 4 * q4); const u32x2_t uu = *(const u32x2_t*)(u1 + off);
                            yv = (f32x4){dsk[0] * __uint_as_float(uu.x << 16), dsk[1] * __uint_as_float(uu.x & 0xffff0000u), dsk[2] * __uint_as_float(uu.y << 16), dsk[3] * __uint_as_float(uu.y & 0xffff0000u)}; }
                        else { const unsigned y01 = ypark->x, y23 = ypark->y; yv = (f32x4){__uint_as_float(y01 << 16), __uint_as_float(y01 & 0xffff0000u), __uint_as_float(y23 << 16), __uint_as_float(y23 & 0xffff0000u)}; }
#pragma unroll
                        for (int ks = 0; ks < 4; ++ks) { const s5_bf16x8 xb = *(const LAS s5_bf16x8*)(xl + (rg * 16 + tk) * S5_XPITCH + (32 * ks + 8 * q4) * 2);
                            yv = __builtin_amdgcn_mfma_f32_16x16x32_bf16(cfr[ks], xb, yv, 0, 0, 0); MFMA_KEEP(yv, xb); }
                        if (d == 0) { ypark->x = pack2bf(yv[0], yv[1]); ypark->y = pack2bf(yv[2], yv[3]); }
                        else if (DENSE1_FP8) *(unsigned*)((unsigned char*)z + off) = pack4_fp8(geluf_(yv[0]) * Z8_SCALE, geluf_(yv[1]) * Z8_SCALE, geluf_(yv[2]) * Z8_SCALE, geluf_(yv[3]) * Z8_SCALE);
                        else { u32x2_t w; w.x = pack2bf(geluf_(yv[0]), geluf_(yv[1])); w.y = pack2bf(geluf_(yv[2]), geluf_(yv[3])); *(u32x2_t*)(z + off) = w; }
                    }
                    asm volatile("" ::: "memory");
                }
            }
            if (PASS == 1) { const int oi = s5_order(d, k_s); float* ep = Eb + (size_t)oi * S5S * 2;
                ep[r * 2] = x0r; ep[r * 2 + 1] = x0i; ep[(r + 32) * 2] = x1r; ep[(r + 32) * 2 + 1] = x1i; }
        }
    }
}
#endif
#ifndef CPU_EMU
__device__ __forceinline__ void ph_conv_fast(const Params& p, long gtid, long gthreads) {
    const bf16_t* qkv = (const bf16_t*)(p.ws + WS_QKV); bf16_t* ub = (bf16_t*)(p.ws + WS_UBF);
    for (long it = gtid; it < (long)MT * (LW / 8); it += gthreads) {
        const int rr = (int)(it / (LW / 8)), ch = (int)(it % (LW / 8)) * 8;
        int base, t, n; if (rr < ML) { base = (rr / NSEQ) * NSEQ; t = rr % NSEQ; n = NSEQ; } else { const int rc = rr - ML; base = ML + (rc / NCTX) * NCTX; t = rc % NCTX; n = NCTX; }
        float acc[8];
#pragma unroll
        for (int j = 0; j < 8; ++j) acc[j] = p.lru_conv_b[ch + j];
#pragma unroll
        for (int tap = 0; tap < 4; ++tap) { const int tt = t + tap - 2; if (tt >= 0 && tt < n) { const u32x4_t v = *(const u32x4_t*)(qkv + (size_t)(base + tt) * EVIN + COL_XR + ch); const unsigned vw[4] = {v.x, v.y, v.z, v.w};
#pragma unroll
                for (int j = 0; j < 8; ++j) acc[j] += p.lru_conv_w[tap * LW + ch + j] * __uint_as_float((j & 1) ? (vw[j >> 1] & 0xffff0000u) : (vw[j >> 1] << 16)); } }
        u32x4_t w; w.x = pack2bf(acc[0], acc[1]); w.y = pack2bf(acc[2], acc[3]); w.z = pack2bf(acc[4], acc[5]); w.w = pack2bf(acc[6], acc[7]);
        *(u32x4_t*)(ub + (size_t)rr * LW + ch) = w;
    }
}
__device__ __forceinline__ int lru_chunk_row0(int b, int k) { return k < LRU_NCC ? ML + b * NCTX + k * LRU_CH : b * NSEQ + (k - LRU_NCC) * LRU_CH; }
__device__ __forceinline__ int lru_order(int d, int k) { return d == 0 ? k : (k < LRU_NCC ? LRU_NCC - 1 - k : LRU_NCC + (LRU_NLC - 1 - (k - LRU_NCC))); }
#define LRU_ZERO16(v) do { const float z0_ = opaque_zero(); _Pragma("unroll") for (int e_ = 0; e_ < 16; ++e_) v[e_] = z0_; } while (0)
template <int PASS> __device__ __forceinline__ void ph_lru_fast(const Params& p, LAS unsigned char* lds, int gwave, int nwaves, int wv_) {
    const int lane = tid_of(wv_) & 63; LAS float* hfl = (LAS float*)(lds + wv_ * (LRU_CH * 64 * 4)) + lane;
    const int r = lane & 31, hh = lane >> 5, a_half = (r >> 2) & 1, a_n = (r & 3) + 4 * (r >> 3);
    const bf16_t* ub = (const bf16_t*)(p.ws + WS_UBF); const bf16_t* qkv = (const bf16_t*)(p.ws + WS_QKV); bf16_t* mix = (bf16_t*)(p.ws + WS_MIX);
    const s5_bf16x8* LB = (const s5_bf16x8*)(p.ws + WS_LRUBF); float* AGG = (float*)(p.ws + WS_LRUAGG);
    constexpr int NPAIR = LRU_NCH / 2, NT = LRU_CH / 16;
    s5_bf16x8 idf[2];
#pragma unroll
    for (int kk = 0; kk < 2; ++kk) { const int jj = r - 16 * kk - 8 * hh;
#pragma unroll
        for (int e = 0; e < 8; ++e) idf[kk][e] = (e == jj) ? (short)0x3F80 : (short)0; }
    for (int rd = 0; rd <= (NB * 16 * 2 * NPAIR) / nwaves; ++rd) {
        const int it = deal_item(rd, gwave, nwaves, NB * 16 * 2 * NPAIR, OUT0_FP8 ? 4 : 2); if (it < 0) continue;
        const int cs = it & 1, pr = OUT0_FP8 ? (it >> 2) % NPAIR : (it >> 1) % NPAIR, h = OUT0_FP8 ? 2 * ((it / (4 * NPAIR)) % 8) + ((it >> 1) & 1) : (it / (2 * NPAIR)) % 16, b = it / (32 * NPAIR);
        const int k_s = 2 * pr + hh, k_a = 2 * pr + a_half, rb_a = lru_chunk_row0(b, k_a), rb_s = lru_chunk_row0(b, k_s);
        const int ch = h * 64 + 32 * cs + r;
#pragma unroll
        for (int d = 0; d < 2; ++d) {
            const int oi = lru_order(d, k_s);
            s5_bf16x8 br[4], bi[4];
#pragma unroll
            for (int ks = 0; ks < 4; ++ks) { br[ks] = LB[(((size_t)(d * 16 + h) * 2 + 0) * 2 + cs) * 4 * 64 + ks * 64 + lane]; bi[ks] = LB[(((size_t)(d * 16 + h) * 2 + 1) * 2 + cs) * 4 * 64 + ks * 64 + lane]; }
            const float lamv = softplusf_(-p.lru_lam[d * LW + ch]), bav = p.lru_ba[d * LW + ch], biv = p.lru_bi[d * LW + ch];
            const float nba = -1.44269504089f * bav, nbi = -1.44269504089f * biv, c2 = -8.0f * 1.44269504089f * lamv;
            float state = 0.f, aprod = 1.f;
            float* ag = AGG + (((size_t)b * 2 + d) * LRU_NCH) * LW * 2;
            if (PASS == 2) { const int oa = lru_order(d, 2 * pr), ob = lru_order(d, 2 * pr + 1), oimax = oa > ob ? oa : ob;
#pragma unroll 16
                for (int j = 0; j < oimax; ++j) { const float aj = ag[((size_t)j * LW + ch) * 2], bj = ag[((size_t)j * LW + ch) * 2 + 1]; if (j < oi) state = aj * state + bj; } }
            s5_bf16x8 an[4], gn0, gn1;
            { const int tile0 = d ? NT - 1 : 0; const bf16_t* up = ub + (size_t)(rb_a + tile0 * 16 + a_n) * LW + h * 64 + 8 * hh;
#pragma unroll
              for (int ks = 0; ks < 4; ++ks) an[ks] = *(const s5_bf16x8*)(up + 16 * ks);
              if (PASS == 2 && d == 1) { const bf16_t* gp = qkv + (size_t)(rb_a + tile0 * 16 + a_n) * EVIN + COL_GR + h * 64 + 32 * cs + 8 * hh; gn0 = *(const s5_bf16x8*)gp; gn1 = *(const s5_bf16x8*)(gp + 16); } }
#pragma unroll 1
            for (int i = 0; i < NT; ++i) {
                const int tile = d ? NT - 1 - i : i;
                s5_bf16x8 a[4], g0, g1;
#pragma unroll
                for (int ks = 0; ks < 4; ++ks) a[ks] = an[ks];
                if (PASS == 2 && d == 1) { g0 = gn0; g1 = gn1; }
                if (i + 1 < NT) { const int tl = d ? tile - 1 : tile + 1; const bf16_t* up = ub + (size_t)(rb_a + tl * 16 + a_n) * LW + h * 64 + 8 * hh;
#pragma unroll
                    for (int ks = 0; ks < 4; ++ks) an[ks] = *(const s5_bf16x8*)(up + 16 * ks);
                    if (PASS == 2 && d == 1) { const bf16_t* gp = qkv + (size_t)(rb_a + tl * 16 + a_n) * EVIN + COL_GR + h * 64 + 32 * cs + 8 * hh; gn0 = *(const s5_bf16x8*)gp; gn1 = *(const s5_bf16x8*)(gp + 16); } }
                s5_f32x16 ar, ai, au, agr; LRU_ZERO16(ar); LRU_ZERO16(ai); LRU_ZERO16(au); LRU_ZERO16(agr);
#pragma unroll
                for (int ks = 0; ks < 4; ++ks) { ar = __builtin_amdgcn_mfma_f32_32x32x16_bf16(a[ks], br[ks], ar, 0, 0, 0); ai = __builtin_amdgcn_mfma_f32_32x32x16_bf16(a[ks], bi[ks], ai, 0, 0, 0); }
                au = __builtin_amdgcn_mfma_f32_32x32x16_bf16(cs ? a[2] : a[0], idf[0], au, 0, 0, 0); au = __builtin_amdgcn_mfma_f32_32x32x16_bf16(cs ? a[3] : a[1], idf[1], au, 0, 0, 0);
                if (PASS == 2 && d == 1) { agr = __builtin_amdgcn_mfma_f32_32x32x16_bf16(g0, idf[0], agr, 0, 0, 0); agr = __builtin_amdgcn_mfma_f32_32x32x16_bf16(g1, idf[1], agr, 0, 0, 0); }
                MFMA_KEEP(au, a[0]); MFMA_KEEP(au, a[1]); MFMA_KEEP(au, a[2]); MFMA_KEEP(au, a[3]); MFMA_KEEP(ai, a[3]); if (PASS == 2 && d == 1) { MFMA_KEEP(agr, g0); MFMA_KEEP(agr, g1); }
#pragma unroll
                for (int nn = 0; nn < 16; ++nn) {
                    const int n = d ? 15 - nn : nn;
                    const float rg = fast_rcp(1.0f + __builtin_amdgcn_exp2f(__builtin_fmaf(ar[n], -1.44269504089f, nba))), ig = fast_rcp(1.0f + __builtin_amdgcn_exp2f(__builtin_fmaf(ai[n], -1.44269504089f, nbi))), av = __builtin_amdgcn_exp2f(rg * c2), mult = fast_sqrt(__builtin_fmaf(-av, av, 1.0f));
                    state = av * state + mult * (ig * au[n]);
                    if (PASS == 1) aprod *= av;
                    if (PASS == 2) { if (d == 0) hfl[(tile * 16 + n) * 64] = state; else { const float mv = (hfl[(tile * 16 + n) * 64] + state) * geluf_(agr[n]);
                        if (OUT0_FP8) ((unsigned char*)mix)[(size_t)(rb_s + tile * 16 + n) * D + QW + ch] = (unsigned char)(pack4_fp8(mv, 0.f, 0.f, 0.f) & 0xffu); else mix[(size_t)(rb_s + tile * 16 + n) * D + QW + ch] = f2bf(mv); } }
                }
            }
            if (PASS == 1) { ag[((size_t)oi * LW + ch) * 2] = aprod; ag[((size_t)oi * LW + ch) * 2 + 1] = state; }
        }
    }
}
#endif
#ifndef CPU_EMU
constexpr int AT_KROWS = 320, AT_LDS_K = 0, AT_LDS_V = AT_KROWS * 128, AT_LDS_BYTES = 2 * AT_KROWS * 128;
static_assert(NCTX == 256, "attention key halves assume 256 context keys");
__device__ __forceinline__ void ph_attn_fast(const Params& p, LAS unsigned char* lds, int bid, int nblocks, int wv_) {
    const int tid = tid_of(wv_), lane = tid & 63, w = wv_, r = lane & 31, hh = lane >> 5;
    const bf16_t* qkv = (const bf16_t*)(p.ws + WS_QKV); const bf16_t* vt = (const bf16_t*)(p.ws + WS_VT); bf16_t* mix = (bf16_t*)(p.ws + WS_MIX);
    constexpr int NQB = NSEQ / 128, NCB = NCTX / 128, UNITS = NB * 4 * (NQB + NCB);
    for (int un = bid; un < UNITS; un += nblocks) {
        const int kvh = un & 3, rest = un >> 2; int b, qb; if (rest < NB * NQB) { b = rest / NQB; qb = rest % NQB; } else { b = (rest - NB * NQB) / NCB; qb = NQB + (rest - NB * NQB) % NCB; }
        const bool isc = qb >= NQB;
        const int q0 = isc ? (qb - NQB) * 128 : qb * 128, qrow0 = isc ? ML + b * NCTX + q0 : b * NSEQ + q0, head = 4 * kvh + (w >> 1);
        s5_bf16x8 qf[2][4];
#pragma unroll
        for (int qt = 0; qt < 2; ++qt)
#pragma unroll
            for (int ds = 0; ds < 4; ++ds) qf[qt][ds] = *(const s5_bf16x8*)(qkv + (size_t)(qrow0 + 64 * (w & 1) + 32 * qt + r) * EVIN + COL_Q + head * 64 + 16 * ds + 8 * hh);
        s5_f32x16 oacc[2][2];
#pragma unroll
        for (int qt = 0; qt < 2; ++qt)
#pragma unroll
            for (int dt = 0; dt < 2; ++dt)
#pragma unroll
                for (int e = 0; e < 16; ++e) oacc[qt][dt][e] = 0.f;
        const float sk = p.attn_sink[head];
        float mrun[2] = {sk, sk}, lrun[2] = {hh == 0 ? 1.0f : 0.f, hh == 0 ? 1.0f : 0.f};
#pragma unroll 1
        for (int half = isc ? 1 : 0; half < 2; ++half) {
            __syncthreads();
            static_assert(AT_KROWS * 8 == 5 * 512 && 64 * 40 == 5 * 512, "staging: five 16-byte pieces per thread and operand");
            u4v_t stK[5], stV[5];
#pragma unroll
            for (int k5 = 0; k5 < 5; ++k5) {
                const int i = tid + 512 * k5, row = i >> 3, cc = i & 7; int grow;
                if (half == 1 && row >= 64) grow = ML + b * NCTX + (row - 64);
                else { int kpos = q0 - 128 + 320 * half + row; kpos = kpos < 0 ? 0 : (kpos > NSEQ - 1 ? NSEQ - 1 : kpos); grow = b * NSEQ + kpos; }
                stK[k5] = *(const u4v_t*)(qkv + (size_t)grow * EVIN + COL_K + kvh * 64 + cc * 8);
            }
#pragma unroll
            for (int k5 = 0; k5 < 5; ++k5) {
                const int i = tid + 512 * k5, d = i / 40, pc = i % 40;
                const int pos = (half == 0) ? q0 + pc * 8 : (pc < 8 ? q0 + 320 + pc * 8 : 128 + NSEQ + 128 + (pc - 8) * 8);
                stV[k5] = *(const u4v_t*)(vt + ((size_t)(b * 4 + kvh) * 64 + d) * VT_T + pos);
            }
#pragma unroll
            for (int k5 = 0; k5 < 5; ++k5) { const int i = tid + 512 * k5, row = i >> 3, cc = i & 7; *(LAS u4v_t*)(lds + AT_LDS_K + row * 128 + ((cc ^ (row & 7)) << 4)) = stK[k5]; }
#pragma unroll
            for (int k5 = 0; k5 < 5; ++k5) { const int i = tid + 512 * k5, d = i / 40, pc = i % 40, kt = pc >> 2, cc = pc & 3; *(LAS u4v_t*)(lds + AT_LDS_V + kt * 4096 + d * 64 + ((cc ^ ((d >> 2) & 3)) << 4)) = stV[k5]; }
            __syncthreads();
#pragma unroll 1
            for (int kt = (isc ? 2 : 0); kt < 10; ++kt) {
                const bool local = !(half == 1 && kt >= 2);
                const int Kb = q0 - 128 + 320 * half + 32 * kt;
                s5_bf16x8 kf[4], vf[2][2];
#pragma unroll
                for (int ds = 0; ds < 4; ++ds) kf[ds] = *(const LAS s5_bf16x8*)(lds + AT_LDS_K + (32 * kt + r) * 128 + (((2 * ds + hh) ^ (r & 7)) << 4));
#pragma unroll
                for (int dt = 0; dt < 2; ++dt)
#pragma unroll
                    for (int s2 = 0; s2 < 2; ++s2) vf[dt][s2] = *(const LAS s5_bf16x8*)(lds + AT_LDS_V + kt * 4096 + (32 * dt + r) * 64 + (((2 * s2 + hh) ^ (((32 * dt + r) >> 2) & 3)) << 4));
#pragma unroll
                for (int qt = 0; qt < 2; ++qt) {
                    const int Qb = q0 + 64 * (w & 1) + 32 * qt;
                    bool need_mask = false;
                    if (local) {
                        if (Kb - (Qb + 31) > 128 || Qb - (Kb + 31) > 128 || Kb + 31 < 0 || Kb >= NSEQ) continue;
                        need_mask = !(Kb + 31 - Qb <= 128 && Qb + 31 - Kb <= 128 && Kb >= 0 && Kb + 31 < NSEQ);
                    }
                    s5_f32x16 sc; const float z0 = opaque_zero();
#pragma unroll
                    for (int e = 0; e < 16; ++e) sc[e] = z0;
#pragma unroll
                    for (int ds = 0; ds < 4; ++ds) sc = __builtin_amdgcn_mfma_f32_32x32x16_bf16(kf[ds], qf[qt][ds], sc, 0, 0, 0);
                    MFMA_KEEP(sc, kf[0]); MFMA_KEEP(sc, kf[1]); MFMA_KEEP(sc, kf[2]); MFMA_KEEP(sc, kf[3]);
                    if (need_mask) {
                        const int qpos = Qb + r;
#pragma unroll
                        for (int e = 0; e < 16; ++e) { const int kpos = Kb + (e & 3) + 8 * (e >> 2) + 4 * hh, rel = kpos - qpos; if (rel > 128 || rel < -128 || kpos < 0 || kpos >= NSEQ) sc[e] = -1e30f; }
                    }
                    float tmax = sc[0];
#pragma unroll
                    for (int e = 1; e < 16; ++e) tmax = fmaxf(tmax, sc[e]);
                    tmax = fmaxf(tmax, __shfl_xor(tmax, 32));
                    const float mnew = fmaxf(mrun[qt], tmax), scl = __expf(mrun[qt] - mnew), mneg = -mnew * 1.44269504089f; mrun[qt] = mnew;
                    float psum = 0.f; float pv[16];
#pragma unroll
                    for (int e = 0; e < 16; ++e) { pv[e] = __builtin_amdgcn_exp2f(__builtin_fmaf(sc[e], 1.44269504089f, mneg)); psum += pv[e]; }
                    lrun[qt] = lrun[qt] * scl + psum;
                    if (__ballot(scl != 1.0f) != 0ull) {
#pragma unroll
                    for (int dt = 0; dt < 2; ++dt)
#pragma unroll
                        for (int e = 0; e < 16; ++e) oacc[qt][dt][e] *= scl; }
                    s5_bf16x8 pf[2];
#pragma unroll
                    for (int s2 = 0; s2 < 2; ++s2) { unsigned w0 = pack2bf(pv[8 * s2], pv[8 * s2 + 1]), w1 = pack2bf(pv[8 * s2 + 2], pv[8 * s2 + 3]), w2 = pack2bf(pv[8 * s2 + 4], pv[8 * s2 + 5]), w3 = pack2bf(pv[8 * s2 + 6], pv[8 * s2 + 7]);
                        u4v_t t4 = {w0, w1, w2, w3}; pf[s2] = __builtin_bit_cast(s5_bf16x8, t4); }
#pragma unroll
                    for (int dt = 0; dt < 2; ++dt)
#pragma unroll
                        for (int s2 = 0; s2 < 2; ++s2) oacc[qt][dt] = __builtin_amdgcn_mfma_f32_32x32x16_bf16(vf[dt][s2], pf[s2], oacc[qt][dt], 0, 0, 0);
                    MFMA_KEEP(oacc[qt][1], pf[0]); MFMA_KEEP(oacc[qt][1], pf[1]);
                }
            }
        }
#pragma unroll
        for (int qt = 0; qt < 2; ++qt) {
            const float ltot = lrun[qt] + __shfl_xor(lrun[qt], 32), inv = 1.0f / ltot;
            bf16_t* op = mix + (size_t)(qrow0 + 64 * (w & 1) + 32 * qt + r) * D + head * 64; unsigned char* op8 = (unsigned char*)mix + (size_t)(qrow0 + 64 * (w & 1) + 32 * qt + r) * D + head * 64; const float inv8 = inv * MIX8_SCALE;
#pragma unroll
            for (int dt = 0; dt < 2; ++dt)
#pragma unroll
                for (int g4 = 0; g4 < 4; ++g4) {
                    if (OUT0_FP8) { *(unsigned*)(op8 + 32 * dt + 8 * g4 + 4 * hh) = pack4_fp8(oacc[qt][dt][4 * g4] * inv8, oacc[qt][dt][4 * g4 + 1] * inv8, oacc[qt][dt][4 * g4 + 2] * inv8, oacc[qt][dt][4 * g4 + 3] * inv8); continue; }
                    u32x2_t wv2; wv2.x = pack2bf(oacc[qt][dt][4 * g4] * inv, oacc[qt][dt][4 * g4 + 1] * inv); wv2.y = pack2bf(oacc[qt][dt][4 * g4 + 2] * inv, oacc[qt][dt][4 * g4 + 3] * inv);
                    *(u32x2_t*)(op + 32 * dt + 8 * g4 + 4 * hh) = wv2; }
        }
    }
}
#endif
#ifndef CPU_EMU
__device__ __forceinline__ float wave_sum(float v) {
#pragma unroll
    for (int o = 32; o >= 1; o >>= 1) v += __shfl_xor(v, o);
    return v; }
template <int MODE> __device__ __forceinline__ void ph_norm_fast(const Params& p, int l, int rows, int gwave, int nwaves, int wv_) {
    const int lane = tid_of(wv_) & 63;
    bf16_t* h = (bf16_t*)(p.ws + WS_H); float* xres = (float*)(p.ws + WS_XRES); const bf16_t* yb = (const bf16_t*)(p.ws + WS_YBUF);
    const float* tok_w = (const float*)(p.ws + WS_TOK) + (size_t)MT * 2; const int* tok_dest = (const int*)(p.ws + WS_TOK) + (size_t)MT * 6;
    for (int r = gwave; r < rows; r += nwaves) {
        const int ar = ada_row(r);
        f32x4 xv[8];
        f32x4 cg[8], cs[8], ch[8];
        if (MODE == 2) {
#pragma unroll
            for (int i = 0; i < 8; ++i) cg[i] = *(const f32x4*)(p.norm_final + 4 * lane + 256 * i);
        } else { const float* sh = ada_ptr(p, l, ar, 0); const float* sc = ada_ptr(p, l, ar, 1); const float* g = p.norm_mix + (size_t)l * D;
#pragma unroll
            for (int i = 0; i < 8; ++i) { const int c = 4 * lane + 256 * i; cg[i] = *(const f32x4*)(g + c); cs[i] = *(const f32x4*)(sc + c); ch[i] = *(const f32x4*)(sh + c); } }
        if (MODE == 0) { const float* xr = xin_row(p, l, r);
#pragma unroll
            for (int i = 0; i < 8; ++i) xv[i] = *(const f32x4*)(xr + 4 * lane + 256 * i); }
        else { const int lm = (MODE == 1) ? l - 1 : 1; const float* g2 = ada_ptr(p, lm, ar, 5); float* xr = xres + (size_t)r * D;
            const int d0 = tok_dest[r * 2], d1 = tok_dest[r * 2 + 1]; const float w0 = tok_w[r * 2], w1 = tok_w[r * 2 + 1];
            f32x4 xo[8], gg[8]; unsigned ya8[8], yc8[8]; u32x2_t ya16[8], yc16[8];
#pragma unroll
            for (int i = 0; i < 8; ++i) { const int c = 4 * lane + 256 * i;
                if (RES_BF16) { const u32x2_t t = *(const u32x2_t*)((const bf16_t*)xres + (size_t)r * D + c); xo[i] = unpack4bf(t.x, t.y); } else xo[i] = *(const f32x4*)(xr + c);
                gg[i] = *(const f32x4*)(g2 + c);
                if (Y8) { ya8[i] = *(const unsigned*)((const unsigned char*)yb + (size_t)d0 * D + c); yc8[i] = *(const unsigned*)((const unsigned char*)yb + (size_t)d1 * D + c); }
                else { ya16[i] = *(const u32x2_t*)(yb + (size_t)d0 * D + c); yc16[i] = *(const u32x2_t*)(yb + (size_t)d1 * D + c); } }
#pragma unroll
            for (int i = 0; i < 8; ++i) { f32x4 m;
                if (Y8) { const unsigned ya = ya8[i], yc = yc8[i]; const float u0 = w0 * (1.0f / Y8_SCALE), u1 = w1 * (1.0f / Y8_SCALE);
                    m[0] = u0 * __builtin_amdgcn_cvt_f32_fp8(ya, 0) + u1 * __builtin_amdgcn_cvt_f32_fp8(yc, 0); m[1] = u0 * __builtin_amdgcn_cvt_f32_fp8(ya, 1) + u1 * __builtin_amdgcn_cvt_f32_fp8(yc, 1);
                    m[2] = u0 * __builtin_amdgcn_cvt_f32_fp8(ya, 2) + u1 * __builtin_amdgcn_cvt_f32_fp8(yc, 2); m[3] = u0 * __builtin_amdgcn_cvt_f32_fp8(ya, 3) + u1 * __builtin_amdgcn_cvt_f32_fp8(yc, 3); }
                else { const u32x2_t ya = ya16[i], yc = yc16[i];
                    m[0] = w0 * __uint_as_float(ya.x << 16) + w1 * __uint_as_float(yc.x << 16); m[1] = w0 * __uint_as_float(ya.x & 0xffff0000u) + w1 * __uint_as_float(yc.x & 0xffff0000u);
                    m[2] = w0 * __uint_as_float(ya.y << 16) + w1 * __uint_as_float(yc.y << 16); m[3] = w0 * __uint_as_float(ya.y & 0xffff0000u) + w1 * __uint_as_float(yc.y & 0xffff0000u); }
                xv[i] = xo[i] + gg[i] * m; } }
        float ss = 0.f;
#pragma unroll
        for (int i = 0; i < 8; ++i) ss += (xv[i][0] * xv[i][0] + xv[i][1] * xv[i][1]) + (xv[i][2] * xv[i][2] + xv[i][3] * xv[i][3]);
        ss = wave_sum(ss);
        const float rstd = 1.0f / sqrtf(ss * (1.0f / D) + 1e-6f);
#ifndef CPU_EMU
        asm volatile("" ::: "memory");
#endif
        if (MODE == 2) {
#pragma unroll
            for (int i = 0; i < 8; ++i) { const int c = 4 * lane + 256 * i; *(f32x4*)(p.out + (size_t)r * D + c) = xv[i] * rstd * cg[i]; }
        } else {
#pragma unroll
            for (int i = 0; i < 8; ++i) { const int c = 4 * lane + 256 * i;
                if (MODE == 1) { if (RES_BF16) { u32x2_t t; t.x = pack2bf(xv[i][0], xv[i][1]); t.y = pack2bf(xv[i][2], xv[i][3]); *(u32x2_t*)((bf16_t*)xres + (size_t)r * D + c) = t; } else *(f32x4*)(xres + (size_t)r * D + c) = xv[i]; }
                const f32x4 hv = xv[i] * rstd * cg[i] * (cs[i] + 1.0f) + ch[i];
                if ((MODE == 1 && DENSE1_FP8) || (MODE == 0 && IN0_FP8)) *(unsigned*)((unsigned char*)h + (size_t)r * D + c) = pack4_fp8(hv[0], hv[1], hv[2], hv[3]);
                else { if (MODE == 0 && IN0QKV_FP8) *(unsigned*)(p.ws + WS_H8 + (size_t)r * D + c) = pack4_fp8(hv[0], hv[1], hv[2], hv[3]);
                    u32x2_t w; w.x = pack2bf(hv[0], hv[1]); w.y = pack2bf(hv[2], hv[3]); *(u32x2_t*)(h + (size_t)r * D + c) = w; } } }
    }
}
template <bool H8> __device__ __forceinline__ void ph_router_fast(const Params& p, int l, int rows, LAS unsigned char* lds, int bid, int nblocks, int wv_) {
    const int lane = tid_of(wv_) & 63, rr = lane & 15, q = lane >> 4, w = wv_;
    bf16_t* h = (bf16_t*)(p.ws + WS_H); const float* xres = (const float*)(p.ws + WS_XRES); const s5_bf16x8* RWF = (const s5_bf16x8*)(p.ws + WS_RWF);
    int* tok_e = (int*)(p.ws + WS_TOK); float* tok_w = (float*)(p.ws + WS_TOK) + (size_t)MT * 2; int* tok_slot = (int*)(p.ws + WS_TOK) + (size_t)MT * 4;
    int* hist = (int*)(p.ws + WS_HIST) + (size_t)l * MAXG * HIST_LD;
    int run = 0;
    LAS float* ssq = (LAS float*)lds;
    LAS f32x4* red = (LAS f32x4*)(lds + 1024);
    LAS float* cfA = (LAS float*)(lds + 16384); LAS float* cfB = cfA + D;
    const int tid = w * 64 + lane, ntl = rows / 16, TPW = (ntl + nblocks - 1) / nblocks, t_lo = bid * TPW, t_hi = (t_lo + TPW < ntl) ? t_lo + TPW : ntl;
    s5_bf16x8 rwh[8], rwl[8];
#pragma unroll
    for (int st = 0; st < 8; ++st) { rwh[st] = RWF[(8 * w + st) * 64 + lane]; rwl[st] = RWF[(64 + 8 * w + st) * 64 + lane]; }
    int ar_cur = -1;
    u4v_t nx[8];
    if (RES_BF16 && t_lo < t_hi) { const bf16_t* xr = (const bf16_t*)xres + (size_t)(t_lo * 16 + rr) * D + 256 * w + 8 * q;
#pragma unroll
        for (int st = 0; st < 8; ++st) nx[st] = *(const u4v_t*)(xr + 32 * st); }
    for (int t16 = t_lo; t16 < t_hi; ++t16) {
        const int r = t16 * 16 + rr, ar = ada_row(t16 * 16);
        if (ar != ar_cur) { ar_cur = ar;
            const f32x4 gv = *(const f32x4*)(p.norm_ffn + (size_t)l * D + 4 * tid), sv = *(const f32x4*)(ada_ptr(p, l, ar, 4) + 4 * tid), hv = *(const f32x4*)(ada_ptr(p, l, ar, 3) + 4 * tid);
            *(LAS f32x4*)(cfA + 4 * tid) = gv * (sv + 1.0f); *(LAS f32x4*)(cfB + 4 * tid) = hv; }
        f32x4 xa[8], xb[8];
        if (RES_BF16) {
#pragma unroll
            for (int st = 0; st < 8; ++st) { xa[st] = unpack4bf(nx[st][0], nx[st][1]); xb[st] = unpack4bf(nx[st][2], nx[st][3]); }
            if (t16 + 1 < t_hi) { const bf16_t* xr = (const bf16_t*)xres + (size_t)((t16 + 1) * 16 + rr) * D + 256 * w + 8 * q;
#pragma unroll
                for (int st = 0; st < 8; ++st) nx[st] = *(const u4v_t*)(xr + 32 * st); } }
        else { const float* xr = xres + (size_t)r * D + 256 * w + 8 * q;
#pragma unroll
            for (int st = 0; st < 8; ++st) { xa[st] = *(const f32x4*)(xr + 32 * st); xb[st] = *(const f32x4*)(xr + 32 * st + 4); } }
        float ss = 0.f;
#pragma unroll
        for (int st = 0; st < 8; ++st) ss += (xa[st][0] * xa[st][0] + xa[st][1] * xa[st][1]) + (xa[st][2] * xa[st][2] + xa[st][3] * xa[st][3]) + (xb[st][0] * xb[st][0] + xb[st][1] * xb[st][1]) + (xb[st][2] * xb[st][2] + xb[st][3] * xb[st][3]);
        ss += __shfl_xor(ss, 16); ss += __shfl_xor(ss, 32);
        if (q == 0) ssq[w * 16 + rr] = ss;
        __syncthreads();
        float tot = 0.f;
#pragma unroll
        for (int ww = 0; ww < 8; ++ww) tot += ssq[ww * 16 + rr];
        const float rstd = 1.0f / sqrtf(tot * (1.0f / D) + 1e-6f);
        const LAS float* cA = cfA + 256 * w + 8 * q; const LAS float* cB = cfB + 256 * w + 8 * q;
        f32x4 lhi, llo; { const float z0 = opaque_zero(); lhi = (f32x4){z0, z0, z0, z0}; llo = lhi; }
#pragma unroll
        for (int st = 0; st < 8; ++st) {
            const f32x4 ga = *(const LAS f32x4*)(cA + 32 * st), gb = *(const LAS f32x4*)(cA + 32 * st + 4), ha = *(const LAS f32x4*)(cB + 32 * st), hb = *(const LAS f32x4*)(cB + 32 * st + 4);
            const f32x4 va = xa[st] * rstd * ga + ha, vb = xb[st] * rstd * gb + hb;
            u4v_t wv4 = {pack2bf(va[0], va[1]), pack2bf(va[2], va[3]), pack2bf(vb[0], vb[1]), pack2bf(vb[2], vb[3])};
            if (H8) { u32x2_t w8; w8.x = pack4_fp8(va[0], va[1], va[2], va[3]); w8.y = pack4_fp8(vb[0], vb[1], vb[2], vb[3]); *(u32x2_t*)((unsigned char*)h + (size_t)r * D + 256 * w + 32 * st + 8 * q) = w8; }
            else *(u4v_t*)(h + (size_t)r * D + 256 * w + 32 * st + 8 * q) = wv4;
            const s5_bf16x8 hf = __builtin_bit_cast(s5_bf16x8, wv4);
            lhi = __builtin_amdgcn_mfma_f32_16x16x32_bf16(rwh[st], hf, lhi, 0, 0, 0); MFMA_KEEP(lhi, rwh[st]);
            llo = __builtin_amdgcn_mfma_f32_16x16x32_bf16(rwl[st], hf, llo, 0, 0, 0); MFMA_KEEP(llo, rwl[st]); MFMA_KEEP(llo, hf);
        }
        red[w * 64 + lane] = lhi + llo;
        __syncthreads();
        if (w == 0) {
            f32x4 lsum = red[lane];
#pragma unroll
            for (int ww = 1; ww < 8; ++ww) lsum += red[ww * 64 + lane];
            float lg[4];
#pragma unroll
            for (int i = 0; i < 4; ++i) lg[i] = lsum[i] + p.router_b[4 * q + i];
            float mx = fmaxf(fmaxf(lg[0], lg[1]), fmaxf(lg[2], lg[3])); mx = fmaxf(mx, __shfl_xor(mx, 16)); mx = fmaxf(mx, __shfl_xor(mx, 32));
            float pr[4], sum = 0.f;
#pragma unroll
            for (int i = 0; i < 4; ++i) { pr[i] = __expf(lg[i] - mx); sum += pr[i]; }
            sum += __shfl_xor(sum, 16); sum += __shfl_xor(sum, 32);
            float a1 = -1.f, a2 = -1.f; int j1 = 0, j2 = 0;
#pragma unroll
            for (int i = 0; i < 4; ++i) { const float v = pr[i] / sum; if (v > a1) { a2 = a1; j2 = j1; a1 = v; j1 = i; } else if (v > a2) { a2 = v; j2 = i; } }
            float best = a1 + a2; int bq = q; float w1 = a1, w2 = a2; int e1 = 4 * q + j1, e2 = 4 * q + j2;
#pragma unroll
            for (int o = 16; o <= 32; o <<= 1) {
                const float ob = __shfl_xor(best, o), ow1 = __shfl_xor(w1, o), ow2 = __shfl_xor(w2, o); const int oq = __shfl_xor(bq, o), oe1 = __shfl_xor(e1, o), oe2 = __shfl_xor(e2, o);
                if (ob > best || (ob == best && oq < bq)) { best = ob; bq = oq; w1 = ow1; w2 = ow2; e1 = oe1; e2 = oe2; } }
            int rk1 = 0, rk2 = 0, mine = 0; const unsigned long long below = (1ull << rr) - 1ull;
#pragma unroll
            for (int e = 0; e < NE; ++e) { const unsigned long long m = __ballot(q == 0 && (e1 == e || e2 == e)); const int pc = __popcll(m & below); if (e1 == e) rk1 = pc; if (e2 == e) rk2 = pc; if (rr == e) mine = __popcll(m); }
            const int b1 = __shfl(run, e1), b2 = __shfl(run, e2);
            if (q == 0) { const float ws = w1 + w2; tok_e[r * 2] = e1; tok_e[r * 2 + 1] = e2; tok_w[r * 2] = w1 / ws; tok_w[r * 2 + 1] = w2 / ws;
                tok_slot[r * 2] = b1 + rk1; tok_slot[r * 2 + 1] = b2 + rk2; }
            run += mine;
        }
    }
    if (w == 0 && lane < HIST_LD) hist[bid * HIST_LD + lane] = lane < NE ? run : 0;
}
__device__ __forceinline__ void ph_dispatch_fast(const Params& p, int l, int rows, LAS unsigned char* lds, int bid, int nblocks, int wv_) {
    const int tid = tid_of(wv_); const int* hist = (const int*)(p.ws + WS_HIST) + (size_t)l * MAXG * HIST_LD;
    const int* tok_e = (const int*)(p.ws + WS_TOK); const int* tok_slot = (const int*)(p.ws + WS_TOK) + (size_t)MT * 4; int* tok_dest = (int*)(p.ws + WS_TOK) + (size_t)MT * 6;
    int* rowidx = (int*)(p.ws + WS_ROWIDX); int* cnt = (int*)(p.ws + WS_CNT) + l * 64;
    LAS int* pre = (LAS int*)lds; LAS int* seg = pre + MAXG * NE; LAS int* tot = seg + 32 * NE; LAS int* pst = tot + NE;
    { const int e = tid & 15, sg = tid >> 4; int v[8], sum = 0;
#pragma unroll
        for (int i = 0; i < 8; ++i) { const int wg = 8 * sg + i; v[i] = wg < nblocks ? hist[wg * HIST_LD + e] : 0; sum += v[i]; }
        seg[sg * NE + e] = sum;
        __syncthreads();
        int base = 0; for (int s2 = 0; s2 < sg; ++s2) base += seg[s2 * NE + e];
#pragma unroll
        for (int i = 0; i < 8; ++i) { pre[(8 * sg + i) * NE + e] = base; base += v[i]; }
        if (sg == 31) tot[e] = base;
        __syncthreads();
        if (tid <= NE) { int acc = 0; for (int j = 0; j < tid; ++j) acc += (tot[j] + 255) / 256 * 256; pst[tid] = acc; }
        if (bid == 0 && tid < NE) cnt[tid] = tot[tid];
        __syncthreads(); }
    const long gtid = (long)bid * 512 + tid, gthreads = (long)nblocks * 512; const int tpw = (rows / 16 + nblocks - 1) / nblocks;
    for (long it = gtid; it < (long)rows * 2; it += gthreads) { const int e = tok_e[it], wg = (int)((it >> 5) / tpw), dest = pst[e] + pre[wg * NE + e] + tok_slot[it]; tok_dest[it] = dest; st_coh(rowidx + dest, (int)(it / 2)); }
    const int total = pst[NE];
    for (long it = gtid; it < total; it += gthreads) { int st = 0, ce = 0;
#pragma unroll
        for (int j = 0; j < NE; ++j) { if (it >= pst[j] && it < pst[j + 1]) { st = pst[j]; ce = tot[j]; } }
        if (it - st >= ce) st_coh(rowidx + it, 0); }
}
#endif
__device__ __forceinline__ void ph_final(const Params& p, long gtid, long gthreads) {
    const float* xres = (const float*)(p.ws + WS_XRES);
    for (long r = gtid; r < ML; r += gthreads) {
        const float* xr = xres + (size_t)r * D; float ss = 0.f; for (int k = 0; k < D; ++k) ss += xr[k] * xr[k];
        const float rstd = 1.0f / sqrtf(ss / D + 1e-6f);
        for (int k = 0; k < D; ++k) p.out[(size_t)r * D + k] = xr[k] * rstd * p.norm_final[k];
    }
}

struct CvtJob { const float* src; bf16_t* dst; int K, N, mode, fp8, ld; };
constexpr int NJOBS = 6 + 2 * NE * 3;
constexpr int IN0_NQ = QW + 2 * KVW;
__device__ __forceinline__ CvtJob cvt_job(const Params& p, int j) {
    CvtJob J; unsigned char* ws = p.ws; J.fp8 = 0;
    if (j == 0) { J.src = p.ev_w_in; J.dst = (bf16_t*)(ws + WS_WT_IN0); J.K = D; J.N = IN0_NQ; J.mode = 0; }
    else if (j == 5) { J.src = p.ev_w_in + IN0_NQ; J.dst = (bf16_t*)(ws + WS_WT_IN0) + (size_t)IN0_NQ * D; J.K = D; J.N = EVIN - IN0_NQ; J.mode = 0; }
    else if (j == 1) { J.src = p.ev_w_out; J.dst = (bf16_t*)(ws + WS_WT_OUT0); J.K = D; J.N = D; J.mode = 0; }
    else if (j == 2) { J.src = p.od_w_in; J.dst = (bf16_t*)(ws + WS_WT_IN1); J.K = D; J.N = S5W; J.mode = 0; }
    else if (j == 3) { J.src = p.s5_glu_w; J.dst = (bf16_t*)(ws + WS_WT_GLU); J.K = S5W; J.N = S5W; J.mode = 0; }
    else if (j == 4) { J.src = p.od_w_out; J.dst = (bf16_t*)(ws + WS_WT_OUT1); J.K = S5W; J.N = D; J.mode = 0; }
    else { const int q = j - 6, le = q / 3, kind = q % 3;
        if (kind == 0) { J.src = p.moe_w_gate + (size_t)le * D * FF; J.dst = (bf16_t*)(ws + WS_WT_GU) + (size_t)le * 2 * FF * D; J.K = D; J.N = FF; J.mode = 1; }
        else if (kind == 1) { J.src = p.moe_w_up + (size_t)le * D * FF; J.dst = (bf16_t*)(ws + WS_WT_GU) + (size_t)le * 2 * FF * D; J.K = D; J.N = FF; J.mode = 2; }
        else { J.src = p.moe_w_down + (size_t)le * FF * D; J.dst = (bf16_t*)(ws + WS_WT_DN) + (size_t)le * D * FF; J.K = FF; J.N = D; J.mode = 0; }
        if (le >= NE ? MOE1_FP8 : MOE0_FP8) { const int l8 = le / NE, e = le % NE; J.fp8 = 1;
            J.dst = kind == 2 ? (bf16_t*)(ws + WS_WT_DN + (size_t)l8 * NE * D * FF * 2 + (size_t)e * D * FF) : (bf16_t*)(ws + WS_WT_GU + (size_t)l8 * NE * 2 * FF * D * 2 + (size_t)e * 2 * FF * D); } }
    if (((IN0_FP8 || IN0QKV_FP8) && j == 0) || (IN0_FP8 && j == 5) || (OUT0_FP8 && j == 1)) J.fp8 = 1;
    J.ld = (j == 0 || j == 5) ? EVIN : J.N;
    if (DENSE1_FP8 && j >= 2 && j <= 4) J.fp8 = 1;
    return J;
}
__device__ __forceinline__ int cvt_rowmap(int mode, int n) { return mode == 0 ? n : (n / 128) * 256 + (mode == 2 ? 128 : 0) + n % 128; }
constexpr long cvt_tiles_of(int K, int N) { return (long)(K / 64) * (N / 256); }
constexpr long CVT_TILES = cvt_tiles_of(D, IN0_NQ) + cvt_tiles_of(D, EVIN - IN0_NQ) + cvt_tiles_of(D, D) + cvt_tiles_of(D, S5W) + cvt_tiles_of(S5W, S5W) + cvt_tiles_of(S5W, D) + (long)2 * NE * 3 * cvt_tiles_of(D, FF);
__device__ __forceinline__ void cvt_find(long tile, int& j, long& local) {
    const long t0 = cvt_tiles_of(D, IN0_NQ), t1 = t0 + cvt_tiles_of(D, D), t2 = t1 + cvt_tiles_of(D, S5W), t3 = t2 + cvt_tiles_of(S5W, S5W), t4 = t3 + cvt_tiles_of(S5W, D), t5 = t4 + cvt_tiles_of(D, EVIN - IN0_NQ);
    if (tile < t0) { j = 0; local = tile; } else if (tile < t1) { j = 1; local = tile - t0; } else if (tile < t2) { j = 2; local = tile - t1; } else if (tile < t3) { j = 3; local = tile - t2; }
    else if (tile < t4) { j = 4; local = tile - t3; } else if (tile < t5) { j = 5; local = tile - t4; } else { const long q = tile - t5, per = cvt_tiles_of(D, FF); j = 6 + (int)(q / per); local = q % per; }
}
#ifndef CPU_EMU
constexpr int CVT_PITCH = 257, CVT_LDS_BYTES = 128 * 129 * 4;
struct CvtSrc { const float* src; int N, fp8; };
__device__ __forceinline__ CvtSrc cvt_src(const Params& p, long t) { int j; long loc; cvt_find(t, j, loc); const CvtJob L = cvt_job(p, j); CvtSrc S; S.N = L.ld; S.fp8 = L.fp8;
    if (L.fp8) { const int tn8 = L.N / 128, k0 = (int)(loc / tn8) * 128, n0 = (int)(loc % tn8) * 128; S.src = L.src + (size_t)k0 * L.ld + n0; }
    else { const int tn = L.N / 256, k0 = (int)(loc / tn) * 64, n0 = (int)(loc % tn) * 256; S.src = L.src + (size_t)k0 * L.ld + n0; }
    return S; }
__device__ __forceinline__ f32x4 cvt_load(const CvtSrc& S, int tid, int i) { const int q = tid + 512 * i, kk = S.fp8 ? q >> 5 : q >> 6, n4 = S.fp8 ? (q & 31) * 4 : (q & 63) * 4; return *(const f32x4*)(S.src + (size_t)kk * S.N + n4); }
__device__ __forceinline__ void ph_convert(const Params& p, float* tile, long t_end, int max_tiles, int wv_) {
    const int tid = tid_of(wv_); int* ctr = (int*)(p.ws + WS_CNT) + 128; LAS int* tsh = (LAS int*)((LAS unsigned char*)tile + CVT_LDS_BYTES);
    (void)max_tiles;
    int pend = 0, par = 0;
    __syncthreads();
    if (tid == 0) { const int a0 = atomicAdd(ctr, 1), a1 = atomicAdd(ctr, 1); pend = atomicAdd(ctr, 1); tsh[0] = a0; tsh[1] = a1; }
    __syncthreads();
    long t = tsh[0], tn = tsh[1];
    f32x4 R[8];
    if (t < t_end) { const CvtSrc S = cvt_src(p, t);
#pragma unroll
        for (int i = 0; i < 8; ++i) R[i] = cvt_load(S, tid, i); }
    while (t < t_end) {
        int j; long local; cvt_find(t, j, local); const CvtJob J = cvt_job(p, j);
        const bool more = tn < t_end; const CvtSrc SN = cvt_src(p, more ? tn : t);
#pragma unroll
        for (int i = 0; i < 8; ++i) {
            if (J.fp8) { const int q = tid + 512 * i, kk = q >> 5, n4 = (q & 31) * 4; *(f32x4*)(tile + kk * 128 + (n4 ^ (((kk >> 4) & 3) << 4))) = R[i]; }
            else { const int q = tid + 512 * i, kk = q >> 6, n4 = (q & 63) * 4; tile[kk * CVT_PITCH + n4] = R[i][0]; tile[kk * CVT_PITCH + n4 + 1] = R[i][1]; tile[kk * CVT_PITCH + n4 + 2] = R[i][2]; tile[kk * CVT_PITCH + n4 + 3] = R[i][3]; }
        }
        if (tid == 0) { tsh[2 + par] = pend; pend = atomicAdd(ctr, 1); }
        __syncthreads();
        const long tnn = tsh[2 + par]; par ^= 1;
        if (more) {
#pragma unroll
            for (int i = 0; i < 8; ++i) R[i] = cvt_load(SN, tid, i); }
        if (J.fp8) {
            const int tn8 = J.N / 128, k0 = (int)(local / tn8) * 128, n0 = (int)(local % tn8) * 128;
            const float wsc = (OUT0_FP8 && j == 1 && k0 < QW) ? W8_SCALE / MIX8_SCALE : W8_SCALE;
#pragma unroll
            for (int i = 0; i < 2; ++i) { const int lane = tid & 63, nn = 64 * i + 8 * (tid >> 6) + (lane & 7), kg = lane >> 3, kgl = kg & 3; const float* tp = tile + (16 * kg) * 128 + (nn ^ (kgl << 4)); u4v_t w;
#pragma unroll
                for (int d4 = 0; d4 < 4; ++d4) { int pk = 0; pk = __builtin_amdgcn_cvt_pk_fp8_f32(tp[(4 * d4) * 128] * wsc, tp[(4 * d4 + 1) * 128] * wsc, pk, false);
                    pk = __builtin_amdgcn_cvt_pk_fp8_f32(tp[(4 * d4 + 2) * 128] * wsc, tp[(4 * d4 + 3) * 128] * wsc, pk, true); w[d4] = (unsigned)pk; }
                *(u4v_t*)((unsigned char*)J.dst + (size_t)cvt_rowmap(J.mode, n0 + nn) * J.K + k0 + 16 * kg) = w; }
        } else {
            const int tnn_ = J.N / 256, k0 = (int)(local / tnn_) * 64, n0 = (int)(local % tnn_) * 256;
#pragma unroll
            for (int i = 0; i < 4; ++i) { const int q = tid + 512 * i, nn = q >> 3, k8 = (q & 7) * 8; const float* tp = tile + k8 * CVT_PITCH + nn;
                u4v_t w = {pack2bf(tp[0], tp[CVT_PITCH]), pack2bf(tp[2 * CVT_PITCH], tp[3 * CVT_PITCH]), pack2bf(tp[4 * CVT_PITCH], tp[5 * CVT_PITCH]), pack2bf(tp[6 * CVT_PITCH], tp[7 * CVT_PITCH])};
                *(u4v_t*)(J.dst + (size_t)cvt_rowmap(J.mode, n0 + nn) * J.K + k0 + k8) = w; }
        }
        __syncthreads();
        t = tn; tn = tnn;
    }
}
#else
void ph_convert_emu(const Params& p) {
    for (int j = 0; j < NJOBS; ++j) { const CvtJob J = cvt_job(p, j);
        for (int n = 0; n < J.N; ++n) { bf16_t* dr = J.dst + (size_t)cvt_rowmap(J.mode, n) * J.K; for (int k = 0; k < J.K; ++k) dr[k] = f2bf(J.src[(size_t)k * J.ld + n]); } }
}
#endif

namespace pg8 {
constexpr int BM = 256, BK = 64, HALF = 128, HTB = HALF * BK * 2  , STAGE_BYTES = 8 * HTB, NXCD = 8, WGM = 8;
struct Unit { int pm, pn, e; };
struct Gemm { const bf16_t* A; const bf16_t* Bt; int M, N, K; int sc_w = 0, sc_a = 0; };
__host__ __device__ __forceinline__ int lds_byte(int r, int c) { const int st = (r >> 4) * 2 + (c >> 5), rr = r & 15, cc = c & 31, ob = rr * 64 + cc * 2; return st * 1024 + (ob ^ (((ob >> 9) & 1) << 5)); }
__host__ __device__ __forceinline__ void stage_rc(int b, int& R, int& C) { const int st = b / 1024, sb = b % 1024, swz = sb ^ (((sb >> 9) & 1) << 5); R = (st >> 1) * 16 + swz / 64; C = (st & 1) * 32 + (swz % 64) / 2; }
__host__ __device__ __forceinline__ int perm32(int rho) { const int n = rho >> 4, i = rho & 15; return 8 * (i >> 2) + 4 * n + (i & 3); }

struct StaticOrder {
    static constexpr bool GATHER = false;
    int nM, nN, nwg, G, c;
    __host__ __device__ void init(int M, int N, int G_, int c_) { nM = M / BM; nN = N / BM; nwg = nM * nN; G = G_; c = c_; }
    __host__ __device__ bool next(int i, Unit& u) const {
        const long L = (long)i * G + c; if (L >= nwg) return false;
        int wgid = (int)L; { const int q = nwg / NXCD, r = nwg % NXCD, xcd = wgid % NXCD, off = wgid / NXCD; wgid = (xcd < r ? xcd * (q + 1) : r * (q + 1) + (xcd - r) * q) + off; }
        const int nig = WGM * nN, gid = wgid / nig, fm = gid * WGM, gsz = (nM - fm) < WGM ? (nM - fm) : WGM;
        u.pm = fm + ((wgid % nig) % gsz); u.pn = (wgid % nig) / gsz; u.e = 0; return true;
    }
    __device__ __forceinline__ const char* b_base(const Gemm& g, const Unit& u) const { return (const char*)g.Bt + (size_t)u.pn * ((size_t)BM * g.K * 2); }
    __device__ __forceinline__ int a_row(const Unit& u, int rr) const { return u.pm * BM + rr; }
};
template <bool ROWS> struct MoeOrder {
    static constexpr bool GATHER = ROWS;
    int nN, nwg, G, c; const int* cnt; const int* rowidx; size_t estride;
    __device__ void init(const int* cnt_, int N, int G_, int c_, const int* rowidx_, size_t estride_) { int acc = 0; cnt = cnt_;
#pragma unroll
        for (int e = 0; e < NE; ++e) acc += (cnt[e] + 255) / 256 * 256;
        nN = N / BM; nwg = (acc / 256) * nN; G = G_; c = c_; rowidx = rowidx_; estride = estride_; }
    __device__ bool next(int i, Unit& u) const { const long L = (long)i * G + c; if (L >= nwg) return false; u.pm = (int)(L / nN); u.pn = (int)(L % nN); int e = 0, acc = 0;
#pragma unroll
        for (int j = 0; j < NE - 1; ++j) { acc += (cnt[j] + 255) / 256 * 256; e += (u.pm * 256 >= acc) ? 1 : 0; }
        u.e = e; return true; }
    __device__ __forceinline__ const char* b_base(const Gemm& g, const Unit& u) const { return (const char*)g.Bt + (size_t)u.e * estride + (size_t)u.pn * ((size_t)BM * g.K * 2); }
    __device__ __forceinline__ int a_row(const Unit& u, int rr) const { return ROWS ? ld_coh(rowidx + u.pm * BM + rr) : u.pm * BM + rr; }
};

#ifdef CPU_EMU
typedef unsigned char* LdsPtr;
#else
#define PG8_LAS __attribute__((address_space(3)))
typedef PG8_LAS unsigned char* LdsPtr;
typedef short bf16x8 __attribute__((ext_vector_type(8)));
typedef unsigned u32x4 __attribute__((ext_vector_type(4)));
typedef int pg8_v4i __attribute__((ext_vector_type(4)));
typedef int pg8_v8i __attribute__((ext_vector_type(8)));
template <class Epi, class Sched, bool F8 = false>
__device__ __forceinline__ void gemm_phase(LdsPtr lds, const Gemm g, const Sched& S, const Epi& E, int wv_) {
    const int tid = tid_of(wv_), wid = wv_, lane = tid & 63, wr = wid >> 2, wc = wid & 3, fr = lane & 15, fq = lane >> 4;
    const int K = g.K, nt = K / BK;
    unsigned voffB[2]; int RA[2], CA[2];
#pragma unroll
    for (int i = 0; i < 2; ++i) { int R, C; stage_rc(tid * 16 + i * 8192, R, C); const int Rb = Epi::PERM ? ((R & ~31) + perm32(R & 31)) : R;
        RA[i] = R; CA[i] = C; voffB[i] = (unsigned)(Rb * K + C) * 2u; }
    const size_t kstep = (size_t)(BK * 2);
    const size_t hstep = (size_t)HALF * K * 2;
    const unsigned ldsw = (unsigned)wid * 1024u;
    const int aoff = F8 ? lds_byte(wr * 64 + fr, fq * 16) + ((fq & 1) << 4) : lds_byte(wr * 64 + fr, fq * 8), boff = F8 ? lds_byte(wc * 32 + fr, fq * 16) + ((fq & 1) << 4) : lds_byte(wc * 32 + fr, fq * 8);
    const int sc_both = (g.sc_w & 0xff) | ((g.sc_a & 0xff) << 8);
    const int koff = F8 ? (16 - ((fq & 1) << 5)) : 1024;
#define PG8_SA(b, h) (((b) * 2 + (h)) * HTB)
#define PG8_SB(b, h) ((4 + (b) * 2 + (h)) * HTB)
#define PG8_STAGE(bufoff, gbase, voff) do { _Pragma("unroll") for (int _i = 0; _i < 2; ++_i) \
        __builtin_amdgcn_global_load_lds((const unsigned*)((const char*)(gbase) + (voff)[_i]), (PG8_LAS unsigned*)(lds + (bufoff) + ldsw + _i * 8192), 16, 0, 0); } while (0)
#define PG8_LD8(dst, addr) do { const pg8_v4i lo_ = *(const PG8_LAS pg8_v4i*)(addr), hi_ = *(const PG8_LAS pg8_v4i*)((addr) + koff); dst = __builtin_shufflevector(lo_, hi_, 0, 1, 2, 3, 4, 5, 6, 7); } while (0)
#define PG8_LDA(dst, b, h) do { if constexpr (F8) { _Pragma("unroll") for (int m = 0; m < 4; ++m) PG8_LD8(dst##8[m], lds + PG8_SA(b, h) + aoff + m * 2048); } \
        else { _Pragma("unroll") for (int m = 0; m < 4; ++m) _Pragma("unroll") for (int k = 0; k < 2; ++k) dst[m][k] = *(const PG8_LAS bf16x8*)(lds + PG8_SA(b, h) + aoff + m * 2048 + k * koff); } } while (0)
#define PG8_LDB(dst, b, h) do { if constexpr (F8) { _Pragma("unroll") for (int n = 0; n < 2; ++n) PG8_LD8(dst##8[n], lds + PG8_SB(b, h) + boff + n * 2048); } \
        else { _Pragma("unroll") for (int n = 0; n < 2; ++n) _Pragma("unroll") for (int k = 0; k < 2; ++k) dst[n][k] = *(const PG8_LAS bf16x8*)(lds + PG8_SB(b, h) + boff + n * 2048 + k * koff); } } while (0)
#define PG8_MMA(ai, bj, At, Bt) do { __builtin_amdgcn_s_setprio(1); \
        if constexpr (F8) { _Pragma("unroll") for (int m = 0; m < 4; ++m) _Pragma("unroll") for (int n = 0; n < 2; ++n) \
            acc[ai][bj][m][n] = __builtin_amdgcn_mfma_scale_f32_16x16x128_f8f6f4(Bt##8[n], At##8[m], acc[ai][bj][m][n], 0, 0, 0, sc_both, 1, sc_both); } \
        else { _Pragma("unroll") for (int m = 0; m < 4; ++m) _Pragma("unroll") for (int n = 0; n < 2; ++n) _Pragma("unroll") for (int k = 0; k < 2; ++k) \
            acc[ai][bj][m][n] = __builtin_amdgcn_mfma_f32_16x16x32_bf16(Bt[n][k], At[m][k], acc[ai][bj][m][n], 0, 0, 0); } \
        __builtin_amdgcn_s_setprio(0); } while (0)
#define PG8_WAIT_V(n) asm volatile("s_waitcnt vmcnt(" #n ")" ::: "memory")
#define PG8_WAIT_L(n) asm volatile("s_waitcnt lgkmcnt(" #n ")" ::: "memory")
#define PG8_BAR __builtin_amdgcn_s_barrier()
#define PG8_SCHED __builtin_amdgcn_sched_barrier(0)
#define PG8_VOFFA(dst, U) do { _Pragma("unroll") for (int _h = 0; _h < 2; ++_h) _Pragma("unroll") for (int _i = 0; _i < 2; ++_i) \
        dst[_h][_i] = (unsigned)((size_t)S.a_row(U, _h * HALF + RA[_i]) * K + CA[_i]) * 2u; } while (0)
    Unit cur, nxt; int ui = 0;
    if (!S.next(0, cur)) return;
    f32x4 acc[2][2][4][2];
#pragma unroll
    for (int a = 0; a < 2; ++a)
#pragma unroll
        for (int b = 0; b < 2; ++b)
#pragma unroll
            for (int m = 0; m < 4; ++m)
#pragma unroll
                for (int n = 0; n < 2; ++n) acc[a][b][m][n] = (f32x4){0.f, 0.f, 0.f, 0.f};
    bf16x8 At[4][2], B0[2][2], B1[2][2];
    pg8_v8i At8[4], B08[2], B18[2];
    unsigned vA[2][2];
    PG8_VOFFA(vA, cur);
    const char* cA = (const char*)g.A; const char* cB = S.b_base(g, cur);
    PG8_STAGE(PG8_SB(0, 0), cB, voffB); PG8_STAGE(PG8_SB(0, 1), cB + hstep, voffB); PG8_STAGE(PG8_SA(0, 0), cA, vA[0]); PG8_STAGE(PG8_SA(0, 1), cA, vA[1]);
    if (wr == 1) PG8_BAR;
    PG8_WAIT_V(2); PG8_BAR;
    PG8_STAGE(PG8_SB(1, 0), cB + kstep, voffB); PG8_STAGE(PG8_SA(1, 0), cA + kstep, vA[0]); PG8_STAGE(PG8_SB(1, 1), cB + hstep + kstep, voffB);
    PG8_WAIT_V(6); PG8_BAR;
    for (;;) {
        const bool has_next = S.next(ui + 1, nxt);
        const char* nB = has_next ? S.b_base(g, nxt) : cB;
        for (int t = 0; t < nt; t += 2) {
            const bool last = (t == nt - 2);
            const char* a1 = cA + (size_t)(t + 1) * kstep;
            const char* a2 = last ? cA : cA + (size_t)(t + 2) * kstep; const char* b2 = last ? nB : cB + (size_t)(t + 2) * kstep;
            const char* a3 = a2 + kstep; const char* b3 = b2 + kstep;
            PG8_LDB(B0, 0, 0); PG8_LDB(B1, 0, 1); PG8_SCHED; PG8_LDA(At, 0, 0); PG8_STAGE(PG8_SA(1, 1), a1, vA[1]);
            if (last && has_next) { PG8_VOFFA(vA, nxt); }
            PG8_WAIT_V(8); PG8_WAIT_L(0); PG8_BAR; PG8_MMA(0, 0, At, B0); PG8_MMA(0, 1, At, B1); PG8_BAR; PG8_SCHED;
            PG8_LDA(At, 0, 1); PG8_STAGE(PG8_SB(0, 0), b2, voffB); PG8_STAGE(PG8_SB(0, 1), b2 + hstep, voffB); PG8_STAGE(PG8_SA(0, 0), a2, vA[0]);
            PG8_WAIT_V(8); PG8_WAIT_L(0); PG8_BAR; PG8_MMA(1, 0, At, B0); PG8_MMA(1, 1, At, B1); PG8_BAR; PG8_SCHED;
            PG8_LDB(B0, 1, 0); PG8_LDB(B1, 1, 1); PG8_SCHED; PG8_LDA(At, 1, 0); PG8_STAGE(PG8_SA(0, 1), a2, vA[1]);
            PG8_WAIT_V(8); PG8_WAIT_L(0); PG8_BAR; PG8_MMA(0, 0, At, B0); PG8_MMA(0, 1, At, B1); PG8_BAR; PG8_SCHED;
            PG8_LDA(At, 1, 1); PG8_STAGE(PG8_SB(1, 0), b3, voffB); PG8_STAGE(PG8_SB(1, 1), b3 + hstep, voffB); PG8_STAGE(PG8_SA(1, 0), a3, vA[0]);
            PG8_WAIT_V(8); PG8_WAIT_L(0); PG8_BAR; PG8_MMA(1, 0, At, B0); PG8_MMA(1, 1, At, B1); PG8_BAR; PG8_SCHED;
        }
        if (wr == 0) PG8_BAR;
        E(acc, cur, wr, wc, fr, fq);
        if (!has_next) break;
#pragma unroll
        for (int a = 0; a < 2; ++a)
#pragma unroll
            for (int b = 0; b < 2; ++b)
#pragma unroll
                for (int m = 0; m < 4; ++m)
#pragma unroll
                    for (int n = 0; n < 2; ++n) acc[a][b][m][n] = (f32x4){0.f, 0.f, 0.f, 0.f};
        cur = nxt; cB = nB; ++ui;
        if (wr == 1) PG8_BAR;
    }
    PG8_WAIT_V(0);
    PG8_BAR;
#undef PG8_SA
#undef PG8_SB
#undef PG8_STAGE
#undef PG8_LDA
#undef PG8_LDB
#undef PG8_MMA
#undef PG8_LD8
#undef PG8_WAIT_V
#undef PG8_WAIT_L
#undef PG8_BAR
#undef PG8_SCHED
#undef PG8_VOFFA
}
#endif
}

typedef f32x4 AccT[2][2][4][2];

struct EpiQKV {
    static constexpr bool PERM = false;
    bf16_t* O; const float* rope; bf16_t* VT; int pn0 = 0;
    __device__ __forceinline__ void operator()(const AccT& acc, const pg8::Unit& u, int wr, int wc, int fr, int fq) const {
        const int colt = (u.pn + pn0) * 256; const bool is_q = colt < COL_K, is_k = colt >= COL_K && colt < COL_V, is_v = colt >= COL_V && colt < COL_XR;
#pragma unroll
        for (int ai = 0; ai < 2; ++ai) {
            f32x4 rp[4][2];
            if (is_q || is_k) {
#pragma unroll
                for (int m = 0; m < 4; ++m) { const int r = u.pm * 256 + ai * 128 + wr * 64 + m * 16 + fr, t = r % NSEQ, pos = (wc & 1) ? (t % 64) : (t / 64);
                    rp[m][0] = *(const f32x4*)(rope + (pos * 16 + 4 * fq) * 2); rp[m][1] = *(const f32x4*)(rope + (pos * 16 + 4 * fq) * 2 + 4); }
#ifndef CPU_EMU
                asm volatile("" ::: "memory");
#endif
            }
#pragma unroll
            for (int m = 0; m < 4; ++m) {
                const int r = u.pm * 256 + ai * 128 + wr * 64 + m * 16 + fr; const bool lat = r < ML; const int t = r % NSEQ;
#pragma unroll
                for (int bj = 0; bj < 2; ++bj) {
                    const int cg = colt + bj * 128 + wc * 32;
                    f32x4 v0 = acc[ai][bj][m][0], v1 = acc[ai][bj][m][1];
                    if ((is_q || is_k) && lat) {
#pragma unroll
                        for (int j = 0; j < 4; ++j) { const float cs = rp[m][j >> 1][(j & 1) * 2], sn = rp[m][j >> 1][(j & 1) * 2 + 1]; const float a = v0[j], b = v1[j]; v0[j] = a * cs - b * sn; v1[j] = b * cs + a * sn; }
                    }
                    if (is_q) { v0 *= 0.125f; v1 *= 0.125f; }
                    bf16_t* rowp = O + (size_t)r * EVIN + cg + 4 * fq;
                    u32x2_t w0, w1; w0.x = pack2bf(v0[0], v0[1]); w0.y = pack2bf(v0[2], v0[3]); w1.x = pack2bf(v1[0], v1[1]); w1.y = pack2bf(v1[2], v1[3]);
                    *(u32x2_t*)rowp = w0; *(u32x2_t*)(rowp + 16) = w1;
                    if (is_v) {
                        const int bb = lat ? r / NSEQ : (r - ML) / NCTX, tt = lat ? t : (r - ML) % NCTX, k16 = tt & 15, kp = (k16 & 3) | ((k16 & 4) << 1) | ((k16 & 8) >> 1);
                        const int pos = (lat ? 128 : 128 + NSEQ + 128) + (tt & ~15) + kp, vc = cg - COL_V + 4 * fq;
                        bf16_t* vp = VT + ((size_t)bb * 256 + vc) * VT_T + pos;
#pragma unroll
                        for (int j = 0; j < 4; ++j) { vp[(size_t)j * VT_T] = f2bf(v0[j]); vp[(size_t)(16 + j) * VT_T] = f2bf(v1[j]); }
                    }
                }
            }
        }
    }
};
template <bool IN16, bool OUT16> struct EpiResidT {
    static constexpr bool PERM = false;
    const float* xin_lat; const float* xin_ctx; float* xout; const float* gate;
    __device__ __forceinline__ void operator()(const AccT& acc, const pg8::Unit& u, int wr, int wc, int fr, int fq) const {
        const int row0 = u.pm * 256, arow = row0 < ML ? row0 / NSEQ : NB; const float* gp = gate + (size_t)arow * ADA6;
        const int col0 = u.pn * 256 + wc * 32 + 4 * fq;
        f32x4 gv[2][2];
#pragma unroll
        for (int bj = 0; bj < 2; ++bj)
#pragma unroll
            for (int n = 0; n < 2; ++n) gv[bj][n] = *(const f32x4*)(gp + col0 + bj * 128 + n * 16);
#pragma unroll
        for (int ai = 0; ai < 2; ++ai) {
            f32x4 xi[4][2][2];
#pragma unroll
            for (int m = 0; m < 4; ++m) { const int r = row0 + ai * 128 + wr * 64 + m * 16 + fr;
                const size_t io = (r < ML ? (size_t)r * D : (size_t)(r - ML) * D) + col0; const float* ib = r < ML ? xin_lat : xin_ctx;
#pragma unroll
                for (int bj = 0; bj < 2; ++bj)
#pragma unroll
                    for (int n = 0; n < 2; ++n) {
                        if (IN16) { const u32x2_t t = *(const u32x2_t*)((const bf16_t*)ib + io + bj * 128 + n * 16); xi[m][bj][n] = unpack4bf(t.x, t.y); } else xi[m][bj][n] = *(const f32x4*)(ib + io + bj * 128 + n * 16); } }
#ifndef CPU_EMU
            asm volatile("" ::: "memory");
#endif
#pragma unroll
            for (int m = 0; m < 4; ++m) { const int r = row0 + ai * 128 + wr * 64 + m * 16 + fr; const size_t oo = (size_t)r * D + col0;
#pragma unroll
                for (int bj = 0; bj < 2; ++bj)
#pragma unroll
                    for (int n = 0; n < 2; ++n) { const f32x4 xo = xi[m][bj][n] + gv[bj][n] * acc[ai][bj][m][n];
                        if (OUT16) { u32x2_t t; t.x = pack2bf(xo[0], xo[1]); t.y = pack2bf(xo[2], xo[3]); *(u32x2_t*)((bf16_t*)xout + oo + bj * 128 + n * 16) = t; } else *(f32x4*)(xout + oo + bj * 128 + n * 16) = xo; } }
        }
    }
};
typedef EpiResidT<false, RES_BF16> EpiResid0;
typedef EpiResidT<RES_BF16, RES_BF16> EpiResid;
struct EpiBf16 {
    static constexpr bool PERM = true;
    bf16_t* O; int ldc;
    __device__ __forceinline__ void operator()(const AccT& acc, const pg8::Unit& u, int wr, int wc, int fr, int fq) const {
        const int col0 = u.pn * 256 + wc * 32 + 8 * fq;
#pragma unroll
        for (int ai = 0; ai < 2; ++ai)
#pragma unroll
            for (int m = 0; m < 4; ++m) { bf16_t* rowp = O + (size_t)(u.pm * 256 + ai * 128 + wr * 64 + m * 16 + fr) * ldc + col0;
#pragma unroll
                for (int bj = 0; bj < 2; ++bj) { const f32x4 v0 = acc[ai][bj][m][0], v1 = acc[ai][bj][m][1];
                    u32x4_t w; w.x = pack2bf(v0[0], v0[1]); w.y = pack2bf(v0[2], v0[3]); w.z = pack2bf(v1[0], v1[1]); w.w = pack2bf(v1[2], v1[3]);
                    *(u32x4_t*)(rowp + bj * 128) = w; } }
    }
};
#ifndef CPU_EMU
struct EpiY8 {
    static constexpr bool PERM = true;
    unsigned char* O; int ldc;
    __device__ __forceinline__ void operator()(const AccT& acc, const pg8::Unit& u, int wr, int wc, int fr, int fq) const {
        const int col0 = u.pn * 256 + wc * 32 + 8 * fq;
#pragma unroll
        for (int ai = 0; ai < 2; ++ai)
#pragma unroll
            for (int m = 0; m < 4; ++m) { unsigned char* rowp = O + (size_t)(u.pm * 256 + ai * 128 + wr * 64 + m * 16 + fr) * ldc + col0;
#pragma unroll
                for (int bj = 0; bj < 2; ++bj) { const f32x4 v0 = acc[ai][bj][m][0] * Y8_SCALE, v1 = acc[ai][bj][m][1] * Y8_SCALE;
                    u32x2_t w; w.x = pack4_fp8(v0[0], v0[1], v0[2], v0[3]); w.y = pack4_fp8(v1[0], v1[1], v1[2], v1[3]);
                    *(u32x2_t*)(rowp + bj * 128) = w; } }
    }
};
#endif
struct EpiGU {
    static constexpr bool PERM = true;
    bf16_t* O;
    __device__ __forceinline__ void operator()(const AccT& acc, const pg8::Unit& u, int wr, int wc, int fr, int fq) const {
        const int col0 = u.pn * 128 + wc * 32 + 8 * fq;
#pragma unroll
        for (int ai = 0; ai < 2; ++ai)
#pragma unroll
            for (int m = 0; m < 4; ++m) { bf16_t* rowp = O + (size_t)(u.pm * 256 + ai * 128 + wr * 64 + m * 16 + fr) * FF + col0;
                float o[8];
#pragma unroll
                for (int n = 0; n < 2; ++n)
#pragma unroll
                    for (int j = 0; j < 4; ++j) { const float gt = acc[ai][0][m][n][j], up = acc[ai][1][m][n][j]; o[n * 4 + j] = siluf_(gt) * up; }
                u32x4_t w; w.x = pack2bf(o[0], o[1]); w.y = pack2bf(o[2], o[3]); w.z = pack2bf(o[4], o[5]); w.w = pack2bf(o[6], o[7]);
                *(u32x4_t*)rowp = w; }
    }
};
#ifndef CPU_EMU
struct EpiGU8 {
    static constexpr bool PERM = true;
    unsigned char* O;
    __device__ __forceinline__ void operator()(const AccT& acc, const pg8::Unit& u, int wr, int wc, int fr, int fq) const {
        const int col0 = u.pn * 128 + wc * 32 + 8 * fq;
#pragma unroll
        for (int ai = 0; ai < 2; ++ai)
#pragma unroll
            for (int m = 0; m < 4; ++m) { unsigned char* rowp = O + (size_t)(u.pm * 256 + ai * 128 + wr * 64 + m * 16 + fr) * FF + col0;
                float o[8];
#pragma unroll
                for (int n = 0; n < 2; ++n)
#pragma unroll
                    for (int j = 0; j < 4; ++j) { const float gt = acc[ai][0][m][n][j], up = acc[ai][1][m][n][j]; o[n * 4 + j] = siluf_(gt) * up * ACT8_SCALE; }
                u32x2_t w; w.x = pack4_fp8(o[0], o[1], o[2], o[3]); w.y = pack4_fp8(o[4], o[5], o[6], o[7]);
                *(u32x2_t*)rowp = w; }
    }
};
#endif
struct EpiGLU {
    static constexpr bool PERM = true;
    const bf16_t* Z; bf16_t* O; const float* bias;
    __device__ __forceinline__ void operator()(const AccT& acc, const pg8::Unit& u, int wr, int wc, int fr, int fq) const {
        const int col0 = u.pn * 256 + wc * 32 + 8 * fq;
#pragma unroll
        for (int ai = 0; ai < 2; ++ai)
#pragma unroll
            for (int m = 0; m < 4; ++m) { const size_t ro = (size_t)(u.pm * 256 + ai * 128 + wr * 64 + m * 16 + fr) * S5W + col0;
#pragma unroll
                for (int bj = 0; bj < 2; ++bj) { const u32x4_t zz = *(const u32x4_t*)(Z + ro + bj * 128); const unsigned zw[4] = {zz.x, zz.y, zz.z, zz.w}; float o[8];
#pragma unroll
                    for (int n = 0; n < 2; ++n)
#pragma unroll
                        for (int j = 0; j < 4; ++j) { const int q = n * 4 + j; const float zv = __uint_as_float((q & 1) ? (zw[q >> 1] & 0xffff0000u) : (zw[q >> 1] << 16));
                            o[q] = zv * sigmoidf_(acc[ai][bj][m][n][j] + bias[col0 + bj * 128 + q]); }
                    u32x4_t w; w.x = pack2bf(o[0], o[1]); w.y = pack2bf(o[2], o[3]); w.z = pack2bf(o[4], o[5]); w.w = pack2bf(o[6], o[7]);
                    *(u32x4_t*)(O + ro + bj * 128) = w; } }
    }
};

#ifndef CPU_EMU
struct EpiGLU8 {
    static constexpr bool PERM = true;
    const unsigned char* Z; unsigned char* O; const float* bias;
    __device__ __forceinline__ void operator()(const AccT& acc, const pg8::Unit& u, int wr, int wc, int fr, int fq) const {
        const int col0 = u.pn * 256 + wc * 32 + 8 * fq;
        u32x2_t zall[2][4][2]; f32x4 bv[2][2];
#pragma unroll
        for (int bj = 0; bj < 2; ++bj)
#pragma unroll
            for (int n = 0; n < 2; ++n) bv[bj][n] = *(const f32x4*)(bias + col0 + bj * 128 + n * 4);
#pragma unroll
        for (int ai = 0; ai < 2; ++ai)
#pragma unroll
            for (int m = 0; m < 4; ++m) { const size_t ro = (size_t)(u.pm * 256 + ai * 128 + wr * 64 + m * 16 + fr) * S5W + col0;
#pragma unroll
                for (int bj = 0; bj < 2; ++bj) zall[ai][m][bj] = *(const u32x2_t*)(Z + ro + bj * 128); }
        asm volatile("" ::: "memory");
#pragma unroll
        for (int ai = 0; ai < 2; ++ai)
#pragma unroll
            for (int m = 0; m < 4; ++m) { const size_t ro = (size_t)(u.pm * 256 + ai * 128 + wr * 64 + m * 16 + fr) * S5W + col0;
#pragma unroll
                for (int bj = 0; bj < 2; ++bj) { const u32x2_t zz = zall[ai][m][bj]; float o[8];
#pragma unroll
                    for (int n = 0; n < 2; ++n) { const int zw = (int)(n ? zz.y : zz.x);
                        const float z0 = __builtin_amdgcn_cvt_f32_fp8(zw, 0), z1 = __builtin_amdgcn_cvt_f32_fp8(zw, 1), z2 = __builtin_amdgcn_cvt_f32_fp8(zw, 2), z3 = __builtin_amdgcn_cvt_f32_fp8(zw, 3); const float zv[4] = {z0, z1, z2, z3};
#pragma unroll
                        for (int j = 0; j < 4; ++j) { const int q = n * 4 + j; o[q] = zv[j] * (S8_SCALE / Z8_SCALE) * sigmoidf_(acc[ai][bj][m][n][j] + bv[bj][n][j]); } }
                    u32x2_t w; w.x = pack4_fp8(o[0], o[1], o[2], o[3]); w.y = pack4_fp8(o[4], o[5], o[6], o[7]);
                    *(u32x2_t*)(O + ro + bj * 128) = w; } }
    }
};
#endif

enum { G_IN0 = 0, G_OUT0, G_GU, G_DN, G_IN1, G_GLU, G_OUT1, G_GU8, G_DN8, G_IN18, G_GLU8, G_OUT18, G_IN08, G_OUT08, G_IN0SPLIT };
#ifdef CPU_EMU
namespace pg8 {
template <class Epi, class Sched> void gemm_phase(LdsPtr, const Gemm g, const Sched& S, const Epi& E, int) {
    Unit u; std::vector<float> C(256 * 256), af(g.K), bfv((size_t)256 * g.K);
    for (int i = 0; S.next(i, u); ++i) {
        const bf16_t* Bb = (const bf16_t*)S.b_base(g, u);
        for (size_t q = 0; q < (size_t)256 * g.K; ++q) bfv[q] = bf2f(Bb[q]);
        for (int r = 0; r < 256; ++r) { const bf16_t* a = g.A + (size_t)S.a_row(u, r) * g.K; for (int k = 0; k < g.K; ++k) af[k] = bf2f(a[k]);
            for (int cc = 0; cc < 256; ++cc) { const float* bp = &bfv[(size_t)cc * g.K]; float s = 0.f; for (int k = 0; k < g.K; ++k) s += af[k] * bp[k]; C[r * 256 + cc] = s; } }
        for (int tid = 0; tid < 512; ++tid) { const int wid = tid >> 6, lane = tid & 63, wr = wid >> 2, wc = wid & 3, fr = lane & 15, fq = lane >> 4;
            f32x4 acc[2][2][4][2];
            for (int ai = 0; ai < 2; ++ai) for (int bj = 0; bj < 2; ++bj) for (int m = 0; m < 4; ++m) for (int n = 0; n < 2; ++n) for (int j = 0; j < 4; ++j) {
                const int r = 128 * ai + 64 * wr + 16 * m + fr, cc = Epi::PERM ? 128 * bj + 32 * wc + 8 * fq + 4 * n + j : 128 * bj + 32 * wc + 16 * n + 4 * fq + j;
                acc[ai][bj][m][n][j] = C[r * 256 + cc]; }
            E(acc, u, wr, wc, fr, fq); }
    }
}
}
#endif
#ifndef CPU_EMU
template <class Sched> __device__ __forceinline__ void gemm_stagger(const Sched& S, int tile_us) {
    const int rem = S.nwg % S.G; if (rem == 0 || S.c < rem) return;
    const int units = (int)((long)(S.c - rem) * tile_us * 4 / (5 * (S.G - rem)));
    for (int i = 0; i < units; ++i) __builtin_amdgcn_s_sleep(32);
}
#else
template <class Sched> void gemm_stagger(const Sched&, int) {}
#endif
template <int WHICH> __device__ __forceinline__ void run_gemm(const Params& p, int l, pg8::LdsPtr lds, int G, int c, int wv_ = 0) {
    unsigned char* ws = p.ws; pg8::Gemm g;
    if constexpr (WHICH == G_IN0) { g.A = (const bf16_t*)(ws + WS_H); g.Bt = (const bf16_t*)(ws + WS_WT_IN0); g.M = MT; g.N = EVIN; g.K = D;
        pg8::StaticOrder S; S.init(g.M, g.N, G, c); EpiQKV E; E.O = (bf16_t*)(ws + WS_QKV); E.rope = (const float*)(ws + WS_ROPE); E.VT = (bf16_t*)(ws + WS_VT); pg8::gemm_phase(lds, g, S, E, wv_); }
    else if constexpr (WHICH == G_OUT0) { g.A = (const bf16_t*)(ws + WS_MIX); g.Bt = (const bf16_t*)(ws + WS_WT_OUT0); g.M = MT; g.N = D; g.K = D;
        pg8::StaticOrder S; S.init(g.M, g.N, G, c); EpiResid0 E; E.xin_lat = p.x; E.xin_ctx = p.ctx; E.xout = (float*)(ws + WS_XRES); E.gate = (const float*)(ws + WS_ADA) + 2 * D; pg8::gemm_phase(lds, g, S, E, wv_); }
    else if constexpr (WHICH == G_GU) { g.A = (const bf16_t*)(ws + WS_H); g.Bt = (const bf16_t*)(ws + WS_WT_GU) + (size_t)l * NE * 2 * FF * D; g.M = NBLK * 256; g.N = 2 * FF; g.K = D;
        pg8::MoeOrder<true> S; S.init((const int*)(ws + WS_CNT) + l * 64, g.N, G, c, (const int*)(ws + WS_ROWIDX), (size_t)2 * FF * D * 2); EpiGU E; E.O = (bf16_t*)(ws + WS_ACT); pg8::gemm_phase(lds, g, S, E, wv_); }
    else if constexpr (WHICH == G_DN) { g.A = (const bf16_t*)(ws + WS_ACT); g.Bt = (const bf16_t*)(ws + WS_WT_DN) + (size_t)l * NE * D * FF; g.M = NBLK * 256; g.N = D; g.K = FF;
        pg8::MoeOrder<false> S; S.init((const int*)(ws + WS_CNT) + l * 64, g.N, G, c, nullptr, (size_t)D * FF * 2); EpiBf16 E; E.O = (bf16_t*)(ws + WS_YBUF); E.ldc = D; pg8::gemm_phase(lds, g, S, E, wv_); }
#ifndef CPU_EMU
    else if constexpr (WHICH == G_IN0SPLIT) {
        { g.A = (const bf16_t*)(ws + WS_H); g.Bt = (const bf16_t*)(ws + WS_WT_IN0) + (size_t)IN0_NQ * D; g.M = MT; g.N = EVIN - IN0_NQ; g.K = D;
          pg8::StaticOrder S; S.init(g.M, g.N, G, c); EpiBf16 E; E.O = (bf16_t*)(ws + WS_QKV) + IN0_NQ; E.ldc = EVIN; pg8::gemm_phase(lds, g, S, E, wv_); }
        const int extra = ((MT / 256) * ((EVIN - IN0_NQ) / 256)) % G, G2 = G - extra;
        if (c >= extra) { pg8::Gemm g2; g2.A = (const bf16_t*)(ws + WS_H8); g2.Bt = (const bf16_t*)(ws + WS_WT_IN0); g2.M = MT; g2.N = IN0_NQ; g2.K = D / 2; g2.sc_w = W8_E8M0; g2.sc_a = ONE_E8M0;
          pg8::StaticOrder S; S.init(g2.M, g2.N, G2, c - extra); EpiQKV E; E.O = (bf16_t*)(ws + WS_QKV); E.rope = (const float*)(ws + WS_ROPE); E.VT = (bf16_t*)(ws + WS_VT); pg8::gemm_phase<EpiQKV, pg8::StaticOrder, true>(lds, g2, S, E, wv_); } }
    else if constexpr (WHICH == G_IN08) { g.A = (const bf16_t*)(ws + WS_H); g.Bt = (const bf16_t*)(ws + WS_WT_IN0); g.M = MT; g.N = EVIN; g.K = D / 2; g.sc_w = W8_E8M0; g.sc_a = ONE_E8M0;
        pg8::StaticOrder S; S.init(g.M, g.N, G, c); EpiQKV E; E.O = (bf16_t*)(ws + WS_QKV); E.rope = (const float*)(ws + WS_ROPE); E.VT = (bf16_t*)(ws + WS_VT); pg8::gemm_phase<EpiQKV, pg8::StaticOrder, true>(lds, g, S, E, wv_); }
    else if constexpr (WHICH == G_OUT08) { g.A = (const bf16_t*)(ws + WS_MIX); g.Bt = (const bf16_t*)(ws + WS_WT_OUT0); g.M = MT; g.N = D; g.K = D / 2; g.sc_w = W8_E8M0; g.sc_a = ONE_E8M0;
        pg8::StaticOrder S; S.init(g.M, g.N, G, c); gemm_stagger(S, 30); EpiResid0 E; E.xin_lat = p.x; E.xin_ctx = p.ctx; E.xout = (float*)(ws + WS_XRES); E.gate = (const float*)(ws + WS_ADA) + 2 * D; pg8::gemm_phase<EpiResid0, pg8::StaticOrder, true>(lds, g, S, E, wv_); }
    else if constexpr (WHICH == G_IN18) { g.A = (const bf16_t*)(ws + WS_H); g.Bt = (const bf16_t*)(ws + WS_WT_IN1); g.M = MT; g.N = S5W; g.K = D / 2; g.sc_w = W8_E8M0; g.sc_a = ONE_E8M0;
        pg8::StaticOrder S; S.init(g.M, g.N, G, c); gemm_stagger(S, 16); EpiBf16 E; E.O = (bf16_t*)(ws + WS_U1); E.ldc = S5W; pg8::gemm_phase<EpiBf16, pg8::StaticOrder, true>(lds, g, S, E, wv_); }
    else if constexpr (WHICH == G_GLU8) { g.A = (const bf16_t*)(ws + WS_Z); g.Bt = (const bf16_t*)(ws + WS_WT_GLU); g.M = ML; g.N = S5W; g.K = S5W / 2; g.sc_w = W8_E8M0; g.sc_a = Z8_E8M0;
        pg8::StaticOrder S; S.init(g.M, g.N, G, c); EpiGLU8 E; E.Z = ws + WS_Z; E.O = ws + WS_S; E.bias = p.s5_glu_b; pg8::gemm_phase<EpiGLU8, pg8::StaticOrder, true>(lds, g, S, E, wv_); }
    else if constexpr (WHICH == G_OUT18) { g.A = (const bf16_t*)(ws + WS_S); g.Bt = (const bf16_t*)(ws + WS_WT_OUT1); g.M = ML; g.N = D; g.K = S5W / 2; g.sc_w = W8_E8M0; g.sc_a = S8_E8M0;
        pg8::StaticOrder S; S.init(g.M, g.N, G, c); EpiResid E; E.xin_lat = (const float*)(ws + WS_XRES); E.xin_ctx = (const float*)(ws + WS_XRES + (size_t)ML * D * (RES_BF16 ? 2 : 4)); E.xout = (float*)(ws + WS_XRES);
        E.gate = (const float*)(ws + WS_ADA) + (size_t)NADA * ADA6 + 2 * D; pg8::gemm_phase<EpiResid, pg8::StaticOrder, true>(lds, g, S, E, wv_); }
    else if constexpr (WHICH == G_GU8) { g.A = (const bf16_t*)(ws + WS_H); g.Bt = (const bf16_t*)(ws + WS_WT_GU + (size_t)l * NE * 2 * FF * D * 2); g.M = NBLK * 256; g.N = 2 * FF; g.K = D / 2; g.sc_w = W8_E8M0; g.sc_a = ONE_E8M0;
        pg8::MoeOrder<true> S; S.init((const int*)(ws + WS_CNT) + l * 64, g.N, G, c, (const int*)(ws + WS_ROWIDX), (size_t)2 * FF * D); gemm_stagger(S, 20); EpiGU8 E; E.O = ws + WS_ACT; pg8::gemm_phase<EpiGU8, pg8::MoeOrder<true>, true>(lds, g, S, E, wv_); }
    else if constexpr (WHICH == G_DN8) { g.A = (const bf16_t*)(ws + WS_ACT); g.Bt = (const bf16_t*)(ws + WS_WT_DN + (size_t)l * NE * D * FF * 2); g.M = NBLK * 256; g.N = D; g.K = FF / 2; g.sc_w = W8_E8M0; g.sc_a = ACT8_E8M0;
        pg8::MoeOrder<false> S; S.init((const int*)(ws + WS_CNT) + l * 64, g.N, G, c, nullptr, (size_t)D * FF); gemm_stagger(S, 13);
        if constexpr (Y8) { EpiY8 E; E.O = ws + WS_YBUF; E.ldc = D; pg8::gemm_phase<EpiY8, pg8::MoeOrder<false>, true>(lds, g, S, E, wv_); }
        else { EpiBf16 E; E.O = (bf16_t*)(ws + WS_YBUF); E.ldc = D; pg8::gemm_phase<EpiBf16, pg8::MoeOrder<false>, true>(lds, g, S, E, wv_); } }
#endif
    else if constexpr (WHICH == G_IN1) { g.A = (const bf16_t*)(ws + WS_H); g.Bt = (const bf16_t*)(ws + WS_WT_IN1); g.M = MT; g.N = S5W; g.K = D;
        pg8::StaticOrder S; S.init(g.M, g.N, G, c); EpiBf16 E; E.O = (bf16_t*)(ws + WS_U1); E.ldc = S5W; pg8::gemm_phase(lds, g, S, E, wv_); }
    else if constexpr (WHICH == G_GLU) { g.A = (const bf16_t*)(ws + WS_Z); g.Bt = (const bf16_t*)(ws + WS_WT_GLU); g.M = ML; g.N = S5W; g.K = S5W;
        pg8::StaticOrder S; S.init(g.M, g.N, G, c); EpiGLU E; E.Z = (const bf16_t*)(ws + WS_Z); E.O = (bf16_t*)(ws + WS_S); E.bias = p.s5_glu_b; pg8::gemm_phase(lds, g, S, E, wv_); }
    else { g.A = (const bf16_t*)(ws + WS_S); g.Bt = (const bf16_t*)(ws + WS_WT_OUT1); g.M = ML; g.N = D; g.K = S5W;
        pg8::StaticOrder S; S.init(g.M, g.N, G, c); EpiResid E; E.xin_lat = (const float*)(ws + WS_XRES); E.xin_ctx = (const float*)(ws + WS_XRES + (size_t)ML * D * (RES_BF16 ? 2 : 4)); E.xout = (float*)(ws + WS_XRES);
        E.gate = (const float*)(ws + WS_ADA) + (size_t)NADA * ADA6 + 2 * D; pg8::gemm_phase(lds, g, S, E, wv_); }
}
#ifndef CPU_EMU

#define XB_TMO      128
#define XB_XCNT(j)  (256  + 64 * (j))
#define XB_XSUB(j)  (1280 + 64 * (j))
#define XB_XGEN(j)  (2304 + 64 * (j))
#define XB_TOP      3328
#define XB_TOPGEN   3392
#define XCD_BAR_WORDS 3456
#define XB_SPIN_CAP (1u << 24)

__device__ __forceinline__ unsigned xb_ld(unsigned* p)              { return __hip_atomic_load(p, __ATOMIC_RELAXED, __HIP_MEMORY_SCOPE_AGENT); }
__device__ __forceinline__ unsigned xb_add(unsigned* p, unsigned v) { return __hip_atomic_fetch_add(p, v, __ATOMIC_RELAXED, __HIP_MEMORY_SCOPE_AGENT); }
__device__ __forceinline__ unsigned xb_xcc_id() { return (unsigned)__builtin_amdgcn_s_getreg((3 << 11) | 20) & 0xFu; }
#define XB_SPIN(cond, bar) do { unsigned _sp = 0; while (cond) { __builtin_amdgcn_s_sleep(1); \
    if ((++_sp & 255u) == 0u) { if (xb_ld(&(bar)[XB_TMO])) break; if (_sp > XB_SPIN_CAP) { atomicAdd(&(bar)[XB_TMO], 1u); break; } } } } while (0)

struct XcdBarrier {
    unsigned* bar; unsigned x;
    volatile LAS unsigned* st;
};

__device__ __forceinline__ XcdBarrier xcd_barrier_post(unsigned* bar, volatile LAS unsigned* st, int wv_) {
    XcdBarrier b; b.bar = bar; b.x = xb_xcc_id(); b.st = st;
    if (tid_of(wv_) == 0) (void)xb_add(&bar[XB_XCNT(b.x)], 1u);
    return b;
}
__device__ __forceinline__ void xcd_barrier_complete(unsigned* bar, unsigned x, unsigned& nloc, unsigned& nx) {
    const unsigned G = gridDim.x * gridDim.y * gridDim.z;
    unsigned sum, cnt, mine, sp = 0u;
    for (;;) {
        sum = 0u; cnt = 0u; mine = 0u;
#pragma unroll
        for (unsigned j = 0; j < 16; ++j) { const unsigned c = xb_ld(&bar[XB_XCNT(j)]); sum += c; cnt += (c > 0u) ? 1u : 0u; mine = (j == x) ? c : mine; }
        if (sum == G) break;
        __builtin_amdgcn_s_sleep(1);
        if ((++sp & 255u) == 0u) { if (xb_ld(&bar[XB_TMO])) break; if (sp > XB_SPIN_CAP) { atomicAdd(&bar[XB_TMO], 1u); break; } }
    }
    nloc = mine > 0u ? mine : 1u; nx = cnt > 0u ? cnt : 1u;
}

__device__ __forceinline__ void xcd_barrier(const XcdBarrier& b, int wv_) {
    asm volatile("s_waitcnt vmcnt(0)" ::: "memory");
    __syncthreads();
    if (tid_of(wv_) == 0) {
        unsigned* bar = b.bar;
        __builtin_amdgcn_s_waitcnt(0);
        unsigned nloc = b.st[0], nx = b.st[1];
        if (nloc == 0u) { xcd_barrier_complete(bar, b.x, nloc, nx); b.st[0] = nloc; b.st[1] = nx; }
        const unsigned old = xb_add(&bar[XB_XSUB(b.x)], 1u);
        const unsigned gen = old / nloc;
        if (old + 1u == (gen + 1u) * nloc) {
            __builtin_amdgcn_fence(__ATOMIC_RELEASE, "agent");
            asm volatile("s_waitcnt vmcnt(0)" ::: "memory");
            const unsigned og = xb_add(&bar[XB_TOP], 1u);
            const unsigned tg = og / nx;
            if (og + 1u == (tg + 1u) * nx) xb_add(&bar[XB_TOPGEN], 1u);
            else XB_SPIN(xb_ld(&bar[XB_TOPGEN]) == tg, bar);
            __builtin_amdgcn_fence(__ATOMIC_ACQUIRE, "agent");
            xb_add(&bar[XB_XGEN(b.x)], 1u);
            asm volatile("s_waitcnt vmcnt(0)" ::: "memory");
        } else {
            XB_SPIN(xb_ld(&bar[XB_XGEN(b.x)]) == gen, bar);
            __builtin_amdgcn_fence(__ATOMIC_ACQUIRE, "agent");
            asm volatile("s_waitcnt vmcnt(0)" ::: "memory");
        }
    }
    __syncthreads();
}


#define GT ((long)blockIdx.x * blockDim.x + threadIdx.x)
#define GN ((long)gridDim.x * blockDim.x)
constexpr int MEGA_LDS = 147456;
__device__ __forceinline__ long gt_of(int wv) { return (long)blockIdx.x * 512 + tid_of(wv); }
__global__ void __launch_bounds__(512, 2) k_mega(Params p) {
    extern __shared__ __attribute__((aligned(16))) unsigned char shm[];
    volatile LAS unsigned* st = (volatile LAS unsigned*)(shm + MEGA_LDS - 64);
    const int WV = __builtin_amdgcn_readfirstlane((int)threadIdx.x >> 6);
    if (tid_of(WV) == 0) { st[0] = 0u; st[1] = 0u; st[2] = 0u; st[3] = 0u; }
    __syncthreads();
    const XcdBarrier bar = xcd_barrier_post((unsigned*)(p.ws + WS_BAR), st, WV);
    const long gn = (long)gridDim.x * 512; const int G = (int)gridDim.x, c = (int)blockIdx.x; const pg8::LdsPtr lds = (pg8::LdsPtr)shm;
#define gt gt_of(WV)
    ph_ada(p, (float*)shm, c, G, WV); ph_tables(p, gt, gn); ph_convert(p, (float*)shm, CVT_TILES, -1, WV);
    xcd_barrier(bar, WV);
    ph_norm_fast<0>(p, 0, MT, c * 8 + WV, G * 8, WV);
    xcd_barrier(bar, WV);
    run_gemm<IN0_FP8 ? G_IN08 : (IN0QKV_FP8 ? G_IN0SPLIT : G_IN0)>(p, 0, lds, G, c, WV);
    xcd_barrier(bar, WV);
    ph_attn_fast(p, (LAS unsigned char*)shm, c, G, WV);
    { constexpr int ATT_UNITS = NB * 4 * (NSEQ / 128 + NCTX / 128); const int extra = ATT_UNITS % G;
      if (extra * 2 < G) { if (c >= extra) ph_conv_fast(p, (long)(c - extra) * 512 + tid_of(WV), (long)(G - extra) * 512); } else ph_conv_fast(p, gt, gn); }
    xcd_barrier(bar, WV);
    ph_lru_fast<1>(p, (LAS unsigned char*)shm, c * 8 + WV, G * 8, WV);
    xcd_barrier(bar, WV);
    ph_lru_fast<2>(p, (LAS unsigned char*)shm, c * 8 + WV, G * 8, WV);
    xcd_barrier(bar, WV);
    run_gemm<OUT0_FP8 ? G_OUT08 : G_OUT0>(p, 0, lds, G, c, WV);
    xcd_barrier(bar, WV);
    ph_router_fast<MOE0_FP8>(p, 0, MT, (LAS unsigned char*)shm, c, G, WV);
    xcd_barrier(bar, WV);
    ph_dispatch_fast(p, 0, MT, (LAS unsigned char*)shm, c, G, WV);
    xcd_barrier(bar, WV);
    run_gemm<MOE0_FP8 ? G_GU8 : G_GU>(p, 0, lds, G, c, WV);
    xcd_barrier(bar, WV);
    run_gemm<MOE0_FP8 ? G_DN8 : G_DN>(p, 0, lds, G, c, WV);
    xcd_barrier(bar, WV);
    ph_norm_fast<1>(p, 1, MT, c * 8 + WV, G * 8, WV);
    xcd_barrier(bar, WV);
    run_gemm<DENSE1_FP8 ? G_IN18 : G_IN1>(p, 1, lds, G, c, WV);
    xcd_barrier(bar, WV);
    ph_s5_fast<1>(p, (LAS unsigned char*)shm, c * 8 + WV, G * 8, WV);
    xcd_barrier(bar, WV);
    ph_s5_fast<2>(p, (LAS unsigned char*)shm, c * 8 + WV, G * 8, WV);
    xcd_barrier(bar, WV);
    run_gemm<DENSE1_FP8 ? G_GLU8 : G_GLU>(p, 1, lds, G, c, WV);
    xcd_barrier(bar, WV);
    run_gemm<DENSE1_FP8 ? G_OUT18 : G_OUT1>(p, 1, lds, G, c, WV);
    xcd_barrier(bar, WV);
    ph_router_fast<MOE1_FP8>(p, 1, ML, (LAS unsigned char*)shm, c, G, WV);
    xcd_barrier(bar, WV);
    ph_dispatch_fast(p, 1, ML, (LAS unsigned char*)shm, c, G, WV);
    xcd_barrier(bar, WV);
    run_gemm<MOE1_FP8 ? G_GU8 : G_GU>(p, 1, lds, G, c, WV);
    xcd_barrier(bar, WV);
    run_gemm<MOE1_FP8 ? G_DN8 : G_DN>(p, 1, lds, G, c, WV);
    xcd_barrier(bar, WV);
    ph_norm_fast<2>(p, 1, ML, c * 8 + WV, G * 8, WV);
#undef gt
}

#ifdef MK_MULTI
__global__ void __launch_bounds__(512, 2) k_prologue(Params p) {
    extern __shared__ __attribute__((aligned(16))) unsigned char shm[];
    ph_ada(p, (float*)shm, blockIdx.x, gridDim.x, (int)threadIdx.x >> 6); ph_tables(p, GT, GN); ph_convert(p, (float*)shm, CVT_TILES, -1, (int)threadIdx.x >> 6);
}
template <int WHICH> __global__ void __launch_bounds__(512, 2) k_gemm(Params p, int l) {
    extern __shared__ __attribute__((aligned(16))) unsigned char shm[];
    run_gemm<WHICH>(p, l, (pg8::LdsPtr)shm, (int)gridDim.x, (int)blockIdx.x, __builtin_amdgcn_readfirstlane((int)threadIdx.x >> 6));
}
__global__ void __launch_bounds__(512, 2) k_norm(Params p, int l, int rows) { ph_norm(p, l, rows, GT, GN); }
__global__ void __launch_bounds__(512, 2) k_conv(Params p) { ph_conv(p, GT, GN); }
__global__ void __launch_bounds__(512, 2) k_lru(Params p) { ph_lru(p, GT, GN); }
__global__ void __launch_bounds__(512, 2) k_attn(Params p) { ph_attn(p, GT, GN); }
__global__ void __launch_bounds__(512, 2) k_router(Params p, int l, int rows) { ph_router(p, l, rows, GT, GN); }
__global__ void __launch_bounds__(512, 2) k_dispatch(Params p, int l, int rows) { ph_dispatch(p, l, rows, GT, GN); }
__global__ void __launch_bounds__(512, 2) k_combine(Params p, int l, int rows) { ph_combine(p, l, rows, GT, GN); }
__global__ void __launch_bounds__(512, 2) k_s5(Params p) { ph_s5(p, GT, GN); }
__global__ void __launch_bounds__(512, 2) k_final(Params p) { ph_final(p, GT, GN); }

#endif
static Params make_params(void* const* d_in, void* d_out, void* d_ws) {
    Params p{}; const float* const* in = (const float* const*)d_in;
    p.x = in[0]; p.c = in[1]; p.ctx = in[2]; p.c_ctx = in[3]; p.ada_w = in[4]; p.ada_b = in[5]; p.norm_mix = in[6]; p.norm_ffn = in[7]; p.norm_final = in[8];
    p.ev_w_in = in[9]; p.ev_w_out = in[10]; p.attn_sink = in[11]; p.lru_conv_w = in[12]; p.lru_conv_b = in[13]; p.lru_lam = in[14]; p.lru_wa = in[15]; p.lru_ba = in[16]; p.lru_wi = in[17]; p.lru_bi = in[18];
    p.od_w_in = in[19]; p.s5_lam_re = in[20]; p.s5_lam_im = in[21]; p.s5_log_step = in[22]; p.s5_b_re = in[23]; p.s5_b_im = in[24]; p.s5_c_re = in[25]; p.s5_c_im = in[26]; p.s5_d = in[27];
    p.s5_glu_w = in[28]; p.s5_glu_b = in[29]; p.od_w_out = in[30]; p.router_w = in[31]; p.router_b = in[32]; p.moe_w_gate = in[33]; p.moe_w_up = in[34]; p.moe_w_down = in[35];
    p.out = (float*)d_out; p.ws = (unsigned char*)d_ws; return p;
}

extern "C" void kernel_launch(void* const* d_in, const int* in_sizes, int n_in, void* d_out, int out_size, void* d_ws, size_t ws_size, hipStream_t stream) {
    if (n_in != 36 || ws_size < WS_END || out_size != ML * D) { fprintf(stderr, "kernel_launch: unexpected shapes (n_in %d, out %d, ws %zu < %zu)\n", n_in, out_size, ws_size, (size_t)WS_END); return; }
#ifdef MK_MULTI
    static bool attr_done = false;
    constexpr int GLDS = pg8::STAGE_BYTES;
    if (!attr_done) {
        (void)hipFuncSetAttribute((const void*)k_gemm<G_IN0>, hipFuncAttributeMaxDynamicSharedMemorySize, GLDS); (void)hipFuncSetAttribute((const void*)k_gemm<G_OUT0>, hipFuncAttributeMaxDynamicSharedMemorySize, GLDS);
        (void)hipFuncSetAttribute((const void*)k_gemm<G_GU>, hipFuncAttributeMaxDynamicSharedMemorySize, GLDS); (void)hipFuncSetAttribute((const void*)k_gemm<G_DN>, hipFuncAttributeMaxDynamicSharedMemorySize, GLDS);
        (void)hipFuncSetAttribute((const void*)k_gemm<G_IN1>, hipFuncAttributeMaxDynamicSharedMemorySize, GLDS); (void)hipFuncSetAttribute((const void*)k_gemm<G_GLU>, hipFuncAttributeMaxDynamicSharedMemorySize, GLDS);
        (void)hipFuncSetAttribute((const void*)k_gemm<G_OUT1>, hipFuncAttributeMaxDynamicSharedMemorySize, GLDS);
        attr_done = true;
    }
    const Params p = make_params(d_in, d_out, d_ws);
    (void)hipMemsetAsync(d_ws, 0, CTL_BYTES, stream);
    const dim3 blk(512); const int NG = 256, NW = 1024;
    k_prologue<<<NW, blk, (ADA_LDS_BYTES > CVT_LDS_BYTES + 16 ? ADA_LDS_BYTES : CVT_LDS_BYTES + 16), stream>>>(p);
    k_norm<<<NW, blk, 0, stream>>>(p, 0, MT);
    k_gemm<G_IN0><<<NG, blk, GLDS, stream>>>(p, 0);
    k_attn<<<NW, blk, 0, stream>>>(p);
    k_conv<<<NW, blk, 0, stream>>>(p);
    k_lru<<<NW, blk, 0, stream>>>(p);
    k_gemm<G_OUT0><<<NG, blk, GLDS, stream>>>(p, 0);
    k_router<<<NW, blk, 0, stream>>>(p, 0, MT);
    k_dispatch<<<NW, blk, 0, stream>>>(p, 0, MT);
    k_gemm<G_GU><<<NG, blk, GLDS, stream>>>(p, 0);
    k_gemm<G_DN><<<NG, blk, GLDS, stream>>>(p, 0);
    k_combine<<<NW, blk, 0, stream>>>(p, 0, MT);
    k_norm<<<NW, blk, 0, stream>>>(p, 1, MT);
    k_gemm<G_IN1><<<NG, blk, GLDS, stream>>>(p, 1);
    k_s5<<<NW, blk, 0, stream>>>(p);
    k_gemm<G_GLU><<<NG, blk, GLDS, stream>>>(p, 1);
    k_gemm<G_OUT1><<<NG, blk, GLDS, stream>>>(p, 1);
    k_router<<<NW, blk, 0, stream>>>(p, 1, ML);
    k_dispatch<<<NW, blk, 0, stream>>>(p, 1, ML);
    k_gemm<G_GU><<<NG, blk, GLDS, stream>>>(p, 1);
    k_gemm<G_DN><<<NG, blk, GLDS, stream>>>(p, 1);
    k_combine<<<NW, blk, 0, stream>>>(p, 1, ML);
    k_final<<<NW, blk, 0, stream>>>(p);
#else
    static int grid = 0;
    if (!grid) {
        int dev = 0, cus = 0, per_cu = 0;
        if (hipGetDevice(&dev) != hipSuccess || hipDeviceGetAttribute(&cus, hipDeviceAttributeMultiprocessorCount, dev) != hipSuccess) { fprintf(stderr, "kernel_launch: device query failed\n"); return; }
        if (hipFuncSetAttribute((const void*)k_mega, hipFuncAttributeMaxDynamicSharedMemorySize, MEGA_LDS) != hipSuccess) { fprintf(stderr, "kernel_launch: hipFuncSetAttribute failed\n"); return; }
        if (hipOccupancyMaxActiveBlocksPerMultiprocessor(&per_cu, (const void*)k_mega, 512, MEGA_LDS) != hipSuccess || per_cu < 1) { fprintf(stderr, "kernel_launch: occupancy query says %d\n", per_cu); return; }
        grid = cus < MAXG ? cus : MAXG;
    }
    const Params p = make_params(d_in, d_out, d_ws);
    (void)hipMemsetAsync(d_ws, 0, WS_ADA, stream);
    hipLaunchKernelGGL(k_mega, dim3(grid), dim3(512), MEGA_LDS, stream, p);
#endif
}
#endif
```

```cpp
#ifndef CPU_EMU
#include <hip/hip_runtime.h>
#include <cstdio>
#include <cstdint>
#endif

#ifndef BATCH
#define BATCH 4
#endif
#ifndef SEQ
#define SEQ 4096
#endif
#ifndef CTX_LEN
#define CTX_LEN 256
#endif
constexpr int D = 2048, NB = BATCH, NSEQ = SEQ, NCTX = CTX_LEN;
constexpr int ML = NB * NSEQ, MC = NB * NCTX, MT = ML + MC;
constexpr int NADA = NB + 1;
constexpr int QW = 1024, KVW = 256, LW = 1024, EVIN = 3584;
constexpr int COL_Q = 0, COL_K = 1024, COL_V = 1280, COL_XR = 1536, COL_GR = 2560;
constexpr int S5W = 1024, S5G = 64, S5C = 16, S5S = 64;
constexpr int NE = 16, FF = 1024;
constexpr int NBLK = (2 * MT + 255) / 256 + NE;
constexpr int ADA6 = 6 * D;
static_assert(ML % 256 == 0 && MC % 256 == 0 && NSEQ % 256 == 0 && NCTX % 256 == 0, "tiles must not straddle sequences");

typedef unsigned short bf16_t;
#ifndef CPU_EMU
#define LAS __attribute__((address_space(3)))
__device__ __forceinline__ int tid_of(int wv) { int l; asm volatile("v_mbcnt_lo_u32_b32 %0, -1, 0\n\tv_mbcnt_hi_u32_b32 %0, -1, %0" : "=v"(l)); return wv * 64 + l; }
#endif

#ifdef CPU_EMU
constexpr bool MOE1_FP8 = false, MOE0_FP8 = false, DENSE1_FP8 = false, IN0_FP8 = false, IN0QKV_FP8 = false, OUT0_FP8 = false, RES_BF16 = false, Y8 = false;
#else
constexpr bool Y8 = true;
constexpr bool RES_BF16 = true; constexpr bool IN0_FP8 = false, IN0QKV_FP8 = true, OUT0_FP8 = true;
constexpr bool DENSE1_FP8 = true;
constexpr bool MOE0_FP8 = true;
constexpr bool MOE1_FP8 = true;
#endif
constexpr float W8_SCALE = 64.0f, ACT8_SCALE = 4.0f;
constexpr int W8_E8M0 = 127 - 6, ACT8_E8M0 = 127 - 2, ONE_E8M0 = 127;
constexpr float Z8_SCALE = 8.0f, S8_SCALE = 16.0f, MIX8_SCALE = 16.0f, Y8_SCALE = 16.0f; constexpr int Z8_E8M0 = 127 - 3, S8_E8M0 = 127 - 4, MIX8_E8M0 = 127 - 4;

constexpr size_t al256(size_t x) { return (x + 255) & ~(size_t)255; }
constexpr size_t WS_BAR = 0;
constexpr size_t WS_CNT = 16384;
constexpr size_t WS_ADA = 32768;
constexpr size_t CTL_BYTES = al256(WS_ADA + (size_t)2 * NADA * ADA6 * 4);
constexpr size_t WS_ROPE = CTL_BYTES;
constexpr size_t WS_S5LAM = WS_ROPE + 64 * 16 * 8;
constexpr size_t WS_S5BB = WS_S5LAM + (size_t)2 * S5G * S5S * 8;
constexpr size_t WS_S5LAMT = WS_S5BB + (size_t)2 * S5G * S5S * S5C * 8;
constexpr size_t WS_S5BF = WS_S5LAMT + (size_t)2 * S5G * S5S * 8;
constexpr size_t WS_S5CF = WS_S5BF + (size_t)2 * S5G * 4 * 64 * 16;
constexpr size_t WS_LRUBF = WS_S5CF + (size_t)2 * S5G * 4 * 64 * 16;
constexpr size_t WS_RWF = WS_LRUBF + (size_t)2 * 16 * 2 * 2 * 4 * 64 * 16;
constexpr size_t WS_WT_IN0 = al256(WS_RWF + (size_t)2 * 64 * 64 * 16);
constexpr size_t WS_WT_OUT0 = WS_WT_IN0 + (size_t)EVIN * D * 2;
constexpr size_t WS_WT_IN1 = WS_WT_OUT0 + (size_t)D * D * 2;
constexpr size_t WS_WT_GLU = WS_WT_IN1 + (size_t)S5W * D * 2;
constexpr size_t WS_WT_OUT1 = WS_WT_GLU + (size_t)S5W * S5W * 2;
constexpr size_t WS_WT_GU = WS_WT_OUT1 + (size_t)D * S5W * 2;
constexpr size_t WS_WT_DN = WS_WT_GU + (size_t)2 * NE * 2 * FF * D * 2;
constexpr size_t WS_W8_GU = WS_WT_GU + (size_t)NE * 2 * FF * D * 2;
constexpr size_t WS_W8_DN = WS_WT_DN + (size_t)NE * D * FF * 2;
constexpr size_t WS_XRES = WS_WT_DN + (size_t)2 * NE * D * FF * 2;
constexpr size_t WS_H8 = WS_XRES + (size_t)MT * D * 2;
constexpr size_t WS_H = WS_XRES + (size_t)MT * D * 4;
constexpr size_t WS_TOK = WS_H + (size_t)MT * D * 2;
constexpr size_t WS_ROWIDX = WS_TOK + (size_t)4 * MT * 2 * 4;
constexpr size_t WS_RA = al256(WS_ROWIDX + (size_t)NBLK * 256 * 4);
constexpr size_t WS_QKV = WS_RA;
constexpr size_t WS_MIX = WS_QKV + (size_t)MT * EVIN * 2;
constexpr size_t WS_U1 = WS_RA;
constexpr size_t WS_YS5 = WS_U1 + (size_t)MT * S5W * 2;
constexpr size_t WS_Z = WS_YS5 + (size_t)ML * S5W * 4;
constexpr size_t WS_S = WS_Z + (size_t)ML * S5W * 2;
constexpr int S5_CHUNK = 128, S5_NCC = NCTX / S5_CHUNK, S5_NLC = NSEQ / S5_CHUNK, S5_NCH = S5_NCC + S5_NLC;
static_assert(S5_NCC % 2 == 0 && S5_NLC % 2 == 0, "chunks are processed in pairs");
constexpr size_t WS_S5E = WS_S + (size_t)ML * S5W * 2;
constexpr size_t RA_BYTES = (size_t)MT * EVIN * 2 + (size_t)MT * D * 2;
static_assert(WS_S5E + (size_t)NB * S5G * 2 * S5_NCH * S5S * 8 <= WS_RA + RA_BYTES, "L1 overlay (E)");
static_assert((size_t)MT * S5W * 2 + (size_t)ML * S5W * 4 + 2 * (size_t)ML * S5W * 2 <= RA_BYTES, "L1 overlay");
constexpr size_t WS_RB = al256(WS_RA + RA_BYTES);
constexpr size_t WS_ACT = WS_RB;
constexpr size_t WS_YBUF = WS_ACT + (size_t)NBLK * 256 * FF * 2;
constexpr size_t WS_UCONV = WS_RB;
constexpr size_t WS_HSUM = WS_UCONV + (size_t)MT * LW * 4;
constexpr size_t RB_BYTES = (size_t)NBLK * 256 * FF * 2 + (size_t)NBLK * 256 * D * 2;
static_assert(2 * (size_t)MT * LW * 4 <= RB_BYTES, "LRU overlay");
constexpr size_t WS_UBF = WS_RB;
constexpr int VT_T = 128 + NSEQ + 128 + NCTX;
constexpr size_t WS_VT = WS_UBF + (size_t)MT * LW * 2;
constexpr size_t WS_LRUAGG = al256(WS_VT + (size_t)NB * 4 * 64 * VT_T * 2);
constexpr int LRU_CH = 64, LRU_NCC = NCTX / LRU_CH, LRU_NLC = NSEQ / LRU_CH, LRU_NCH = LRU_NCC + LRU_NLC;
static_assert(LRU_NCC % 2 == 0 && LRU_NLC % 2 == 0, "chunks are processed in pairs");
static_assert(WS_LRUAGG + (size_t)NB * 2 * LRU_NCH * LW * 8 <= WS_RB + RB_BYTES, "RB overlay");
constexpr int MAXG = 256;
constexpr int HIST_LD = 32;
constexpr size_t WS_HIST = al256(WS_RB + RB_BYTES);
constexpr size_t WS_END = WS_HIST + (size_t)2 * MAXG * HIST_LD * 4;

struct Params {
    const float *x, *c, *ctx, *c_ctx, *ada_w, *ada_b, *norm_mix, *norm_ffn, *norm_final;
    const float *ev_w_in, *ev_w_out, *attn_sink, *lru_conv_w, *lru_conv_b, *lru_lam, *lru_wa, *lru_ba, *lru_wi, *lru_bi;
    const float *od_w_in, *s5_lam_re, *s5_lam_im, *s5_log_step, *s5_b_re, *s5_b_im, *s5_c_re, *s5_c_im, *s5_d, *s5_glu_w, *s5_glu_b, *od_w_out;
    const float *router_w, *router_b, *moe_w_gate, *moe_w_up, *moe_w_down;
    float* out;
    unsigned char* ws;
};

#ifdef CPU_EMU
typedef float f32x4 __attribute__((vector_size(16)));
#else
typedef float f32x4 __attribute__((ext_vector_type(4)));
#endif
struct u32x2_t { unsigned x, y; };
struct u32x4_t { unsigned x, y, z, w; };
#ifdef CPU_EMU
__device__ __forceinline__ void st_coh(int* p, int v) { *p = v; }
__device__ __forceinline__ int ld_coh(const int* p) { return *p; }
#else
__device__ __forceinline__ void st_coh(int* p, int v) { __hip_atomic_store(p, v, __ATOMIC_RELAXED, __HIP_MEMORY_SCOPE_AGENT); }
__device__ __forceinline__ int ld_coh(const int* p) { return __hip_atomic_load(p, __ATOMIC_RELAXED, __HIP_MEMORY_SCOPE_AGENT); }
#endif
__device__ __forceinline__ f32x4 unpack4bf(unsigned lo, unsigned hi) { return (f32x4){__uint_as_float(lo << 16), __uint_as_float(lo & 0xffff0000u), __uint_as_float(hi << 16), __uint_as_float(hi & 0xffff0000u)}; }
__device__ __forceinline__ float bf2f(bf16_t b) { return __uint_as_float(((unsigned)b) << 16); }
__device__ __forceinline__ bf16_t f2bf(float f) { unsigned u = __float_as_uint(f); u += 0x7FFFu + ((u >> 16) & 1u); return (bf16_t)(u >> 16); }
#ifdef CPU_EMU
__device__ __forceinline__ unsigned pack2bf(float lo, float hi) { return (unsigned)f2bf(lo) | ((unsigned)f2bf(hi) << 16); }
#else
typedef short s5_bf16x8 __attribute__((ext_vector_type(8)));
typedef unsigned u4v_t __attribute__((ext_vector_type(4)));
__device__ __forceinline__ int deal_item(int round, int gwave, int nwaves, int items, int grp = 2) {
    const int full = items / nwaves; if (round < full) return round * nwaves + gwave; if (round > full) return -1;
    const int rem = items - full * nwaves, blk = gwave >> 3, wv = gwave & 7; if (wv >= grp) return -1; const int j = blk * grp + wv; return j < rem ? full * nwaves + j : -1; }
#ifndef CPU_EMU
__device__ __forceinline__ float clamp_e4m3(float x) { return fminf(fmaxf(x, -448.0f), 448.0f); }
__device__ __forceinline__ unsigned pack4_fp8(float a, float b, float c, float d) { int w = 0; w = __builtin_amdgcn_cvt_pk_fp8_f32(clamp_e4m3(a), clamp_e4m3(b), w, false); w = __builtin_amdgcn_cvt_pk_fp8_f32(clamp_e4m3(c), clamp_e4m3(d), w, true); return (unsigned)w; }
#endif
__device__ __forceinline__ float opaque_zero() { float z = 0.f; asm volatile("" : "+v"(z)); return z; }
#define MFMA_KEEP(acc, x) asm volatile("" : "+v"(acc) : "v"(x))
typedef __bf16 bf16x2_hw __attribute__((ext_vector_type(2)));
typedef float f32x2_hw __attribute__((ext_vector_type(2)));
__device__ __forceinline__ unsigned pack2bf(float lo, float hi) { const f32x2_hw v = {lo, hi}; const bf16x2_hw b = __builtin_convertvector(v, bf16x2_hw); return __builtin_bit_cast(unsigned, b); }
#endif
#ifdef CPU_EMU
__device__ __forceinline__ float sigmoidf_(float x) { return 1.0f / (1.0f + __expf(-x)); }
__device__ __forceinline__ float fast_rcp(float x) { return 1.0f / x; }
__device__ __forceinline__ float fast_sqrt(float x) { return sqrtf(x); }
#else
__device__ __forceinline__ float fast_rcp(float x) { return __builtin_amdgcn_rcpf(x); }
__device__ __forceinline__ float fast_sqrt(float x) { return __builtin_amdgcn_sqrtf(x); }
__device__ __forceinline__ float sigmoidf_(float x) { return __builtin_amdgcn_rcpf(1.0f + __builtin_amdgcn_exp2f(-1.44269504089f * x)); }
#endif
__device__ __forceinline__ float siluf_(float x) { return x * sigmoidf_(x); }
#ifdef CPU_EMU
__device__ __forceinline__ float geluf_(float x) { const float u = 0.7978845608028654f * (x + 0.044715f * x * x * x); return 0.5f * x * (1.0f + tanhf(u)); }
#else
__device__ __forceinline__ float geluf_(float x) { const float t = x * x, e = __builtin_amdgcn_exp2f(x * __builtin_fmaf(t, -0.102943215f, -2.302208198f)); return x * __builtin_amdgcn_rcpf(1.0f + e); }
#endif
__device__ __forceinline__ float softplusf_(float x) { return x > 20.f ? x : log1pf(__expf(x)); }
__device__ __forceinline__ int ada_row(int r) { return r < ML ? r / NSEQ : NB; }
__device__ __forceinline__ const float* ada_ptr(const Params& p, int l, int arow, int which) { return (const float*)(p.ws + WS_ADA) + ((size_t)l * NADA + arow) * ADA6 + (size_t)which * D; }
__device__ __forceinline__ const float* xin_row(const Params& p, int l, int r) {
    if (l == 0) return r < ML ? p.x + (size_t)r * D : p.ctx + (size_t)(r - ML) * D;
    return (const float*)(p.ws + WS_XRES) + (size_t)r * D;
}

#ifndef CPU_EMU
constexpr int ADA_ITEMS = 2 * (ADA6 / 128), ADA_LDS_BYTES = (NADA * D + 16 * NADA * 128) * 4;
__device__ __forceinline__ void ph_ada(const Params& p, float* sil, int bid, int nblocks, int wv_) {
    const int tid = tid_of(wv_), w = wv_, lane = tid & 63, kh = lane >> 5, cq = lane & 31;
    float* ada = (float*)(p.ws + WS_ADA); float* red = sil + NADA * D;
    if (bid < ADA_ITEMS) { for (int i = tid; i < NADA * D; i += 512) { const int r = i / D, k = i % D; sil[i] = siluf_(r < NB ? p.c[(size_t)r * D + k] : p.c_ctx[k]); } }
    __syncthreads();
    for (int item = bid; item < ADA_ITEMS; item += nblocks) {
        const int l = item / (ADA6 / 128), cb = (item % (ADA6 / 128)) * 128, c0 = cb + cq * 4;
        f32x4 acc[NADA];
#pragma unroll
        for (int r = 0; r < NADA; ++r) acc[r] = (f32x4){0.f, 0.f, 0.f, 0.f};
        const float* wp = p.ada_w + (size_t)l * D * ADA6 + c0; const int k0 = w * 256 + kh * 128;
#pragma unroll 16
        for (int k = k0; k < k0 + 128; ++k) {
            const f32x4 wv = *(const f32x4*)(wp + (size_t)k * ADA6);
#pragma unroll
            for (int r = 0; r < NADA; ++r) acc[r] += wv * sil[r * D + k];
        }
        __syncthreads();
#pragma unroll
        for (int r = 0; r < NADA; ++r) *(f32x4*)(red + ((size_t)((w * 2 + kh) * NADA + r) * 128) + cq * 4) = acc[r];
        __syncthreads();
        for (int i = tid; i < NADA * 128; i += 512) { const int r = i / 128, cc = i % 128; float sacc = p.ada_b[(size_t)l * ADA6 + cb + cc];
#pragma unroll
            for (int ww = 0; ww < 16; ++ww) sacc += red[(size_t)(ww * NADA + r) * 128 + cc];
            ada[((size_t)l * NADA + r) * ADA6 + cb + cc] = sacc; }
    }
}
#else
void ph_ada_emu(const Params& p) {
    float* ada = (float*)(p.ws + WS_ADA);
    for (int l = 0; l < 2; ++l) for (int r = 0; r < NADA; ++r) { std::vector<double> acc(ADA6, 0.0);
        for (int k = 0; k < D; ++k) { const float cv = r < NB ? p.c[(size_t)r * D + k] : p.c_ctx[k]; const double sv = siluf_(cv); const float* wr = p.ada_w + ((size_t)l * D + k) * ADA6; for (int j = 0; j < ADA6; ++j) acc[j] += sv * wr[j]; }
        for (int j = 0; j < ADA6; ++j) ada[((size_t)l * NADA + r) * ADA6 + j] = (float)acc[j] + p.ada_b[(size_t)l * ADA6 + j]; }
}
#endif
__device__ __forceinline__ void ph_tables(const Params& p, long gtid, long gthreads) {
    float* rope = (float*)(p.ws + WS_ROPE);
    for (long it = gtid; it < 64 * 16; it += gthreads) {
        const int pos = (int)(it / 16), i = (int)(it % 16);
        const double inv = pow(10000.0, -(double)i / 16.0); const double a = (double)pos * (double)(float)inv;
        rope[it * 2] = (float)cos(a); rope[it * 2 + 1] = (float)sin(a);
    }
    float* lamb = (float*)(p.ws + WS_S5LAM); float* bb = (float*)(p.ws + WS_S5BB);
    for (long it = gtid; it < 2L * S5G * S5S; it += gthreads) {
        const int g = (int)((it / S5S) % S5G), d = (int)(it / (S5S * S5G));
        const double lr = p.s5_lam_re[it], li = p.s5_lam_im[it], step = exp((double)p.s5_log_step[d * S5G + g]);
        const double mag = exp(lr * step), br = mag * cos(li * step), bi = mag * sin(li * step);
        lamb[it * 2] = (float)br; lamb[it * 2 + 1] = (float)bi;
        const double nr = br - 1.0, ni = bi, den = lr * lr + li * li;
        const double cr = (nr * lr + ni * li) / den, ci = (ni * lr - nr * li) / den;
        for (int c = 0; c < S5C; ++c) { const double b_r = p.s5_b_re[it * S5C + c], b_i = p.s5_b_im[it * S5C + c];
            bb[(it * S5C + c) * 2] = (float)(cr * b_r - ci * b_i); bb[(it * S5C + c) * 2 + 1] = (float)(cr * b_i + ci * b_r); }
        const double magT = exp(lr * step * S5_CHUNK); float* lt = (float*)(p.ws + WS_S5LAMT);
        lt[it * 2] = (float)(magT * cos(li * step * S5_CHUNK)); lt[it * 2 + 1] = (float)(magT * sin(li * step * S5_CHUNK));
    }
    { bf16_t* rw = (bf16_t*)(p.ws + WS_RWF);
      for (long it = gtid; it < 64L * 64 * 8; it += gthreads) { const int j = (int)(it & 7), lane = (int)((it >> 3) & 63), st = (int)(it >> 9);
          const float wv = p.router_w[(size_t)(32 * st + 8 * (lane >> 4) + j) * NE + (lane & 15)]; const bf16_t hi = f2bf(wv); rw[it] = hi; rw[64L * 64 * 8 + it] = f2bf(wv - bf2f(hi)); } }
    bf16_t* lb = (bf16_t*)(p.ws + WS_LRUBF);
    for (long it = gtid; it < 2L * 16 * 2 * 2 * 4 * 64 * 8; it += gthreads) {
        const int j = (int)(it & 7), lane = (int)((it >> 3) & 63), ks = (int)((it >> 9) & 3), cs = (int)((it >> 11) & 1), gate = (int)((it >> 12) & 1); const long dh = it >> 13;
        const float* w = gate ? p.lru_wi : p.lru_wa;
        lb[it] = f2bf(w[((size_t)dh * 64 + 16 * ks + 8 * (lane >> 5) + j) * 64 + 32 * cs + (lane & 31)]);
    }
    bf16_t* bf = (bf16_t*)(p.ws + WS_S5BF); bf16_t* cf = (bf16_t*)(p.ws + WS_S5CF);
    for (long it = gtid; it < 2L * S5G * 4 * 64 * 8; it += gthreads) {
        const int j = (int)(it & 7), lane = (int)((it >> 3) & 63), ct = (int)((it >> 9) & 3); const long dg = it >> 11;
        { const int st = (lane & 31) + 32 * (ct >> 1), ch = 8 * (lane >> 5) + j; const size_t gi = (size_t)dg * S5S + st;
          const double lr = p.s5_lam_re[gi], li = p.s5_lam_im[gi], step = exp((double)p.s5_log_step[dg]);
          const double mag = exp(lr * step), br = mag * cos(li * step), bi = mag * sin(li * step), nr = br - 1.0, ni = bi, den = lr * lr + li * li;
          const double cr = (nr * lr + ni * li) / den, ci = (ni * lr - nr * li) / den, b_r = p.s5_b_re[gi * S5C + ch], b_i = p.s5_b_im[gi * S5C + ch];
          bf[it] = f2bf((float)((ct & 1) ? (cr * b_i + ci * b_r) : (cr * b_r - ci * b_i))); }
        { const int ks = ct, q = 32 * ks + 8 * (lane >> 4) + j, st = q >> 1, ch = lane & 15; const size_t ci_ = ((size_t)dg * S5C + ch) * S5S + st;
          cf[it] = f2bf((q & 1) ? -p.s5_c_im[ci_] : p.s5_c_re[ci_]); }
    }
}
__device__ __forceinline__ void ph_norm(const Params& p, int l, int rows, long gtid, long gthreads) {
    bf16_t* h = (bf16_t*)(p.ws + WS_H);
    for (long r = gtid; r < rows; r += gthreads) {
        const float* xr = xin_row(p, l, (int)r); const int ar = ada_row((int)r);
        const float* sh = ada_ptr(p, l, ar, 0); const float* sc = ada_ptr(p, l, ar, 1); const float* g = p.norm_mix + (size_t)l * D;
        float ss = 0.f; for (int k = 0; k < D; ++k) ss += xr[k] * xr[k];
        const float rstd = 1.0f / sqrtf(ss / D + 1e-6f);
        for (int k = 0; k < D; ++k) h[(size_t)r * D + k] = f2bf(xr[k] * rstd * g[k] * (1.0f + sc[k]) + sh[k]);
    }
}
__device__ __forceinline__ void ph_conv(const Params& p, long gtid, long gthreads) {
    const bf16_t* qkv = (const bf16_t*)(p.ws + WS_QKV); float* u = (float*)(p.ws + WS_UCONV);
    for (long it = gtid; it < (long)MT * LW; it += gthreads) {
        const int r = (int)(it / LW), ch = (int)(it % LW);
        int base, t, n; if (r < ML) { base = (r / NSEQ) * NSEQ; t = r % NSEQ; n = NSEQ; } else { const int rc = r - ML; base = ML + (rc / NCTX) * NCTX; t = rc % NCTX; n = NCTX; }
        float acc = p.lru_conv_b[ch];
        for (int tap = 0; tap < 4; ++tap) { const int tt = t + tap - 2; if (tt >= 0 && tt < n) acc += p.lru_conv_w[tap * LW + ch] * bf2f(qkv[(size_t)(base + tt) * EVIN + COL_XR + ch]); }
        u[it] = acc;
    }
}
__device__ __forceinline__ void ph_lru(const Params& p, long gtid, long gthreads) {
    const bf16_t* qkv = (const bf16_t*)(p.ws + WS_QKV); const float* u = (const float*)(p.ws + WS_UCONV); float* hs = (float*)(p.ws + WS_HSUM); bf16_t* mix = (bf16_t*)(p.ws + WS_MIX);
    for (long it = gtid; it < (long)NB * LW; it += gthreads) {
        const int b = (int)(it / LW), ch = (int)(it % LW), hh = ch / 64, j = ch % 64;
        for (int d = 0; d < 2; ++d) {
            const float lamv = softplusf_(-p.lru_lam[d * LW + ch]), ba = p.lru_ba[d * LW + ch], bi = p.lru_bi[d * LW + ch];
            const float* wa = p.lru_wa + ((size_t)(d * 16 + hh) * 64) * 64 + j; const float* wi = p.lru_wi + ((size_t)(d * 16 + hh) * 64) * 64 + j;
            float state = 0.f;
            for (int seg = 0; seg < 2; ++seg) {
                const int n = seg ? NSEQ : NCTX, base = seg ? b * NSEQ : ML + b * NCTX;
                for (int stp = 0; stp < n; ++stp) {
                    const int row = base + (d ? n - 1 - stp : stp); const float* ur = u + (size_t)row * LW + hh * 64;
                    float ra = ba, ia = bi;
                    for (int i = 0; i < 64; ++i) { ra += ur[i] * wa[(size_t)i * 64]; ia += ur[i] * wi[(size_t)i * 64]; }
                    const float rg = sigmoidf_(ra), ig = sigmoidf_(ia), log_a = -8.0f * rg * lamv, a = __expf(log_a), mult = sqrtf(-expm1f(2.0f * log_a));
                    state = a * state + mult * (ig * ur[j]);
                    if (d == 0) hs[(size_t)row * LW + ch] = state;
                    else { const float tot = hs[(size_t)row * LW + ch] + state; mix[(size_t)row * D + QW + ch] = f2bf(tot * geluf_(bf2f(qkv[(size_t)row * EVIN + COL_GR + ch]))); }
                }
            }
        }
    }
}
__device__ __forceinline__ void ph_attn(const Params& p, long gtid, long gthreads) {
    const bf16_t* qkv = (const bf16_t*)(p.ws + WS_QKV); bf16_t* mix = (bf16_t*)(p.ws + WS_MIX);
    for (long it = gtid; it < (long)MT * 16; it += gthreads) {
        const int r = (int)(it / 16), hd = (int)(it % 16), kvh = hd / 4;
        float q[64], o[64];
        for (int d = 0; d < 64; ++d) { q[d] = bf2f(qkv[(size_t)r * EVIN + COL_Q + hd * 64 + d]); o[d] = 0.f; }
        float m = p.attn_sink[hd], lsum = 1.0f;
        const int b = r < ML ? r / NSEQ : (r - ML) / NCTX;
        for (int seg = 0; seg < 2; ++seg) {
            int k0, k1;
            if (seg == 0) { if (r >= ML) continue; const int t = r % NSEQ; const int lo = t - 128 < 0 ? 0 : t - 128, hi = t + 128 > NSEQ - 1 ? NSEQ - 1 : t + 128; k0 = b * NSEQ + lo; k1 = b * NSEQ + hi + 1; }
            else { k0 = ML + b * NCTX; k1 = k0 + NCTX; }
            for (int kr = k0; kr < k1; ++kr) {
                const bf16_t* kp = qkv + (size_t)kr * EVIN + COL_K + kvh * 64; const bf16_t* vp = qkv + (size_t)kr * EVIN + COL_V + kvh * 64;
                float s = 0.f; for (int d = 0; d < 64; ++d) s += q[d] * bf2f(kp[d]);
                if (s > m) { const float f = __expf(m - s); lsum *= f; for (int d = 0; d < 64; ++d) o[d] *= f; m = s; }
                const float pe = __expf(s - m); lsum += pe;
                for (int d = 0; d < 64; ++d) o[d] += pe * bf2f(vp[d]);
            }
        }
        const float inv = 1.0f / lsum;
        for (int d = 0; d < 64; ++d) mix[(size_t)r * D + hd * 64 + d] = f2bf(o[d] * inv);
    }
}
__device__ __forceinline__ void ph_router(const Params& p, int l, int rows, long gtid, long gthreads) {
    bf16_t* h = (bf16_t*)(p.ws + WS_H); const float* xres = (const float*)(p.ws + WS_XRES);
    int* tok_e = (int*)(p.ws + WS_TOK); float* tok_w = (float*)(p.ws + WS_TOK) + (size_t)MT * 2; int* tok_slot = (int*)(p.ws + WS_TOK) + (size_t)MT * 4;
    int* cnt = (int*)(p.ws + WS_CNT) + l * 64;
    for (long r = gtid; r < rows; r += gthreads) {
        const float* xr = xres + (size_t)r * D; const int ar = ada_row((int)r);
        const float* sh = ada_ptr(p, l, ar, 3); const float* sc = ada_ptr(p, l, ar, 4); const float* g = p.norm_ffn + (size_t)l * D;
        float ss = 0.f; for (int k = 0; k < D; ++k) ss += xr[k] * xr[k];
        const float rstd = 1.0f / sqrtf(ss / D + 1e-6f);
        float lg[NE];
#pragma unroll
        for (int e = 0; e < NE; ++e) lg[e] = p.router_b[e];
        for (int k = 0; k < D; ++k) { const float hv = xr[k] * rstd * g[k] * (1.0f + sc[k]) + sh[k]; h[(size_t)r * D + k] = f2bf(hv);
#pragma unroll
            for (int e = 0; e < NE; ++e) lg[e] += hv * p.router_w[(size_t)k * NE + e]; }
        float mx = lg[0];
#pragma unroll
        for (int e = 1; e < NE; ++e) mx = lg[e] > mx ? lg[e] : mx;
        float pr[NE], sum = 0.f;
#pragma unroll
        for (int e = 0; e < NE; ++e) { pr[e] = __expf(lg[e] - mx); sum += pr[e]; }
#pragma unroll
        for (int e = 0; e < NE; ++e) pr[e] /= sum;
        float best = -1.f, w1 = 0.f, w2 = 0.f; int e1 = 0, e2 = 0;
#pragma unroll
        for (int gi = 0; gi < 4; ++gi) { float a1 = -1.f, a2 = -1.f; int j1 = 0, j2 = 0;
#pragma unroll
            for (int j = 0; j < 4; ++j) { const float v = pr[gi * 4 + j]; if (v > a1) { a2 = a1; j2 = j1; a1 = v; j1 = j; } else if (v > a2) { a2 = v; j2 = j; } }
            if (a1 + a2 > best) { best = a1 + a2; e1 = gi * 4 + j1; e2 = gi * 4 + j2; w1 = a1; w2 = a2; } }
        const float ws = w1 + w2;
        tok_e[r * 2] = e1; tok_e[r * 2 + 1] = e2; tok_w[r * 2] = w1 / ws; tok_w[r * 2 + 1] = w2 / ws;
        tok_slot[r * 2] = atomicAdd(cnt + e1, 1); tok_slot[r * 2 + 1] = atomicAdd(cnt + e2, 1);
    }
}
__device__ __forceinline__ int moe_pad_start(const int* cnt, int e) { int acc = 0;
#pragma unroll
    for (int j = 0; j < NE; ++j) { const int pj = (cnt[j] + 255) / 256 * 256; acc += (j < e) ? pj : 0; } return acc; }
__device__ __forceinline__ void ph_dispatch(const Params& p, int l, int rows, long gtid, long gthreads) {
    const int* tok_e = (const int*)(p.ws + WS_TOK); const int* tok_slot = (const int*)(p.ws + WS_TOK) + (size_t)MT * 4; int* tok_dest = (int*)(p.ws + WS_TOK) + (size_t)MT * 6;
    int* rowidx = (int*)(p.ws + WS_ROWIDX); const int* cnt = (const int*)(p.ws + WS_CNT) + l * 64;
    for (long it = gtid; it < (long)rows * 2; it += gthreads) { const int e = tok_e[it], dest = moe_pad_start(cnt, e) + tok_slot[it]; tok_dest[it] = dest; st_coh(rowidx + dest, (int)(it / 2)); }
    const int total = moe_pad_start(cnt, NE);
    for (long it = gtid; it < total; it += gthreads) { int acc = 0, st = 0, ce = 0;
#pragma unroll
        for (int j = 0; j < NE; ++j) { const int pj = (cnt[j] + 255) / 256 * 256; if (it >= acc && it < acc + pj) { st = acc; ce = cnt[j]; } acc += pj; }
        if (it - st >= ce) st_coh(rowidx + it, 0); }
}
__device__ __forceinline__ void ph_combine(const Params& p, int l, int rows, long gtid, long gthreads) {
    float* xres = (float*)(p.ws + WS_XRES); const bf16_t* yb = (const bf16_t*)(p.ws + WS_YBUF);
    const float* tok_w = (const float*)(p.ws + WS_TOK) + (size_t)MT * 2; const int* tok_dest = (const int*)(p.ws + WS_TOK) + (size_t)MT * 6;
    for (long it = gtid; it < (long)rows * (D / 4); it += gthreads) {
        const int r = (int)(it / (D / 4)), c = (int)(it % (D / 4)) * 4; const float* g2 = ada_ptr(p, l, ada_row(r), 5);
        const int d0 = tok_dest[r * 2], d1 = tok_dest[r * 2 + 1]; const float w0 = tok_w[r * 2], w1 = tok_w[r * 2 + 1];
        for (int j = 0; j < 4; ++j) xres[(size_t)r * D + c + j] += g2[c + j] * (w0 * bf2f(yb[(size_t)d0 * D + c + j]) + w1 * bf2f(yb[(size_t)d1 * D + c + j]));
    }
}
__device__ __forceinline__ void ph_s5(const Params& p, long gtid, long gthreads) {
    const bf16_t* u1 = (const bf16_t*)(p.ws + WS_U1); float* ys = (float*)(p.ws + WS_YS5); bf16_t* z = (bf16_t*)(p.ws + WS_Z);
    const float* lamb = (const float*)(p.ws + WS_S5LAM); const float* bb = (const float*)(p.ws + WS_S5BB);
    for (long it = gtid; it < (long)NB * S5W; it += gthreads) {
        const int b = (int)(it / S5W), col = (int)(it % S5W), g = col / S5C, c = col % S5C;
        for (int t = 0; t < NSEQ; ++t) { const size_t row = (size_t)b * NSEQ + t; ys[row * S5W + col] = p.s5_d[col] * bf2f(u1[row * S5W + col]); }
        for (int d = 0; d < 2; ++d)
            for (int s = 0; s < S5S; ++s) {
                const size_t gi = ((size_t)d * S5G + g) * S5S + s;
                const float lr = lamb[gi * 2], li = lamb[gi * 2 + 1];
                const float cr = p.s5_c_re[(((size_t)d * S5G + g) * S5C + c) * S5S + s], ci = p.s5_c_im[(((size_t)d * S5G + g) * S5C + c) * S5S + s];
                float br[S5C], bi[S5C]; for (int cc = 0; cc < S5C; ++cc) { br[cc] = bb[(gi * S5C + cc) * 2]; bi[cc] = bb[(gi * S5C + cc) * 2 + 1]; }
                float xr = 0.f, xi = 0.f;
                for (int seg = 0; seg < 2; ++seg) {
                    const int n = seg ? NSEQ : NCTX, base = seg ? b * NSEQ : ML + b * NCTX;
                    for (int stp = 0; stp < n; ++stp) {
                        const size_t row = (size_t)base + (d ? n - 1 - stp : stp); const bf16_t* ur = u1 + row * S5W + g * S5C;
                        float bur = 0.f, bui = 0.f; for (int cc = 0; cc < S5C; ++cc) { const float uv = bf2f(ur[cc]); bur += br[cc] * uv; bui += bi[cc] * uv; }
                        const float nr = lr * xr - li * xi + bur, ni = lr * xi + li * xr + bui; xr = nr; xi = ni;
                        if (seg) ys[row * S5W + col] += cr * xr - ci * xi;
                    }
                }
            }
        for (int t = 0; t < NSEQ; ++t) { const size_t row = (size_t)b * NSEQ + t; z[row * S5W + col] = f2bf(geluf_(ys[row * S5W + col])); }
    }
}
#ifndef CPU_EMU
typedef float s5_f32x16 __attribute__((ext_vector_type(16)));
constexpr int S5_XPITCH = 272, S5_XBYTES = 32 * S5_XPITCH, S5_ABYTES = 0, S5_WAVE_LDS = S5_XBYTES + S5_ABYTES + 8 * 2 * 64 * 8;
static_assert(8 * S5_WAVE_LDS <= 147456 - 64, "S5 LDS");
__device__ __forceinline__ int s5_chunk_row0(int b, int k) { return k < S5_NCC ? ML + b * NCTX + k * S5_CHUNK : b * NSEQ + (k - S5_NCC) * S5_CHUNK; }
__device__ __forceinline__ int s5_order(int d, int k) { return d == 0 ? k : (k < S5_NCC ? S5_NCC - 1 - k : S5_NCC + (S5_NLC - 1 - (k - S5_NCC))); }
template <int PASS> __device__ __forceinline__ void ph_s5_fast(const Params& p, LAS unsigned char* lds, int gwave, int nwaves, int wv_) {
    const int lane = tid_of(wv_) & 63, wv = wv_;
    LAS unsigned char* xl = lds + wv * S5_WAVE_LDS;
    const int r = lane & 31, hh = lane >> 5, a_half = (r >> 2) & 1, a_n = (r & 3) + 4 * (r >> 3), tk = lane & 15, q4 = lane >> 4;
    const bf16_t* u1 = (const bf16_t*)(p.ws + WS_U1); bf16_t* z = (bf16_t*)(p.ws + WS_Z); float* ys = (float*)(p.ws + WS_YS5);
    const float* lamb = (const float*)(p.ws + WS_S5LAM); const float* lamt = (const float*)(p.ws + WS_S5LAMT);
    const s5_bf16x8* BF = (const s5_bf16x8*)(p.ws + WS_S5BF); const s5_bf16x8* CF = (const s5_bf16x8*)(p.ws + WS_S5CF);
    float* E = (float*)(p.ws + WS_S5E);
    constexpr int P0 = PASS == 2 ? S5_NCC / 2 : 0, NPAIR = S5_NCH / 2 - P0;
    for (int rd = 0; rd <= (NB * S5G * NPAIR) / nwaves; ++rd) {
        const int it = deal_item(rd, gwave, nwaves, NB * S5G * NPAIR); if (it < 0) continue;
        const int g = it % S5G, pr = P0 + (it / S5G) % NPAIR, b = it / (NPAIR * S5G);
        const int k_s = 2 * pr + hh, k_a = 2 * pr + a_half;
        const int rb_a = s5_chunk_row0(b, k_a);
#pragma unroll
        for (int d = 0; d < 2; ++d) {
            const size_t dg = (size_t)d * S5G + g;
            s5_bf16x8 bfr[4], cfr[4];
#pragma unroll
            for (int ct = 0; ct < 4; ++ct) { bfr[ct] = BF[(dg * 4 + ct) * 64 + lane]; if (PASS == 2) cfr[ct] = CF[(dg * 4 + ct) * 64 + lane]; }
            const float l0r = lamb[(dg * S5S + r) * 2], l0i = lamb[(dg * S5S + r) * 2 + 1], l1r = lamb[(dg * S5S + r + 32) * 2], l1i = lamb[(dg * S5S + r + 32) * 2 + 1];
            float x0r = 0.f, x0i = 0.f, x1r = 0.f, x1i = 0.f;
            float* Eb = E + (((size_t)(b * S5G + g) * 2 + d) * S5_NCH) * S5S * 2;
            if (PASS == 2) {
                const float t0r = lamt[(dg * S5S + r) * 2], t0i = lamt[(dg * S5S + r) * 2 + 1], t1r = lamt[(dg * S5S + r + 32) * 2], t1i = lamt[(dg * S5S + r + 32) * 2 + 1];
                const int oi = s5_order(d, k_s);
                const int oa = s5_order(d, 2 * pr), ob = s5_order(d, 2 * pr + 1), oimax = oa > ob ? oa : ob;
#pragma unroll 8
                for (int j = 0; j < oimax; ++j) { const float e0r = Eb[(j * S5S + r) * 2], e0i = Eb[(j * S5S + r) * 2 + 1], e1r = Eb[(j * S5S + r + 32) * 2], e1i = Eb[(j * S5S + r + 32) * 2 + 1];
                    const float n0r = t0r * x0r - t0i * x0i + e0r, n0i = t0r * x0i + t0i * x0r + e0i, n1r = t1r * x1r - t1i * x1i + e1r, n1i = t1r * x1i + t1i * x1r + e1i;
                    if (j < oi) { x0r = n0r; x0i = n0i; x1r = n1r; x1i = n1i; } }
            }
#pragma unroll 1
            for (int i = 0; i < 8; ++i) {
                const int tile = d ? 7 - i : i;
                const s5_bf16x8 a = *(const s5_bf16x8*)(u1 + (size_t)(rb_a + tile * 16 + a_n) * S5W + g * S5C + 8 * hh);
                s5_f32x16 acc[4];
#pragma unroll
                for (int ct = 0; ct < 4; ++ct) { const float z0 = opaque_zero(); s5_f32x16 zz;
#pragma unroll
                    for (int e = 0; e < 16; ++e) zz[e] = z0;
                    acc[ct] = __builtin_amdgcn_mfma_f32_32x32x16_bf16(a, bfr[ct], zz, 0, 0, 0); }
                MFMA_KEEP(acc[3], a);
#pragma unroll
                for (int nn = 0; nn < 16; ++nn) {
                    const int n = d ? 15 - nn : nn;
                    float n0r = __builtin_fmaf(l0r, x0r, __builtin_fmaf(-l0i, x0i, acc[0][n])), n0i = __builtin_fmaf(l0r, x0i, __builtin_fmaf(l0i, x0r, acc[1][n])), n1r = __builtin_fmaf(l1r, x1r, __builtin_fmaf(-l1i, x1i, acc[2][n])), n1i = __builtin_fmaf(l1r, x1i, __builtin_fmaf(l1i, x1r, acc[3][n]));
                    asm volatile("" : "+v"(n0r), "+v"(n0i), "+v"(n1r), "+v"(n1i));
                    x0r = n0r; x0i = n0i; x1r = n1r; x1i = n1i;
                    if (PASS == 2) { *(LAS unsigned*)(xl + (hh * 16 + n) * S5_XPITCH + 4 * r) = pack2bf(x0r, x0i); *(LAS unsigned*)(xl + (hh * 16 + n) * S5_XPITCH + 4 * (r + 32)) = pack2bf(x1r, x1i); }
                }
                if (PASS == 2) asm volatile("" ::: "memory");
                if (PASS == 2) {
#pragma unroll
                    for (int rg = 0; rg < 2; ++rg) {
                        const size_t row = (size_t)s5_chunk_row0(b, 2 * pr + rg) + tile * 16 + tk; const size_t off = row * S5W + g * S5C + 4 * q4;
                        f32x4 yv; LAS u32x2_t* ypark = (LAS u32x2_t*)(xl + S5_XBYTES + S5_ABYTES) + (tile * 2 + rg) * 64 + lane;
                        if (d == 0) { const f32x4 dsk = *(const f32x4*)(p.s5_d + g * S5C + 4 * q4); const u32x2_t uu = *(const u32x2_t*)(u1 + off);
                            yv = (f32x4){dsk[0] * __uint_as_float(uu.x << 16), dsk[1] * __uint_as_float(uu.x & 0xffff0000u), dsk[2] * __uint_as_float(uu.y << 16), dsk[3] * __uint_as_float(uu.y & 0xffff0000u)}; }
                        else { const unsigned y01 = ypark->x, y23 = ypark->y; yv = (f32x4){__uint_as_float(y01 << 16), __uint_as_float(y01 & 0xffff0000u), __uint_as_float(y23 << 16), __uint_as_float(y23 & 0xffff0000u)}; }
#pragma unroll
                        for (int ks = 0; ks < 4; ++ks) { const s5_bf16x8 xb = *(const LAS s5_bf16x8*)(xl + (rg * 16 + tk) * S5_XPITCH + (32 * ks + 8 * q4) * 2);
                            yv = __builtin_amdgcn_mfma_f32_16x16x32_bf16(cfr[ks], xb, yv, 0, 0, 0); MFMA_KEEP(yv, xb); }
                        if (d == 0) { ypark->x = pack2bf(yv[0], yv[1]); ypark->y = pack2bf(yv[2], yv[3]); }
                        else if (DENSE1_FP8) *(unsigned*)((unsigned char*)z + off) = pack4_fp8(geluf_(yv[0]) * Z8_SCALE, geluf_(yv[1]) * Z8_SCALE, geluf_(yv[2]) * Z8_SCALE, geluf_(yv[3]) * Z8_SCALE);
                        else { u32x2_t w; w.x = pack2bf(geluf_(yv[0]), geluf_(yv[1])); w.y = pack2bf(geluf_(yv[2]), geluf_(yv[3])); *(u32x2_t*)(z + off) = w; }
                    }
                    asm volatile("" ::: "memory");
                }
            }
            if (PASS == 1) { const int oi = s5_order(d, k_s); float* ep = Eb + (size_t)oi * S5S * 2;
                ep[r * 2] = x0r; ep[r * 2 + 1] = x0i; ep[(r + 32) * 2] = x1r; ep[(r + 32) * 2 + 1] = x1i; }
        }
    }
}
#endif
#ifndef CPU_EMU
__device__ __forceinline__ void ph_conv_fast(const Params& p, long gtid, long gthreads) {
    const bf16_t* qkv = (const bf16_t*)(p.ws + WS_QKV); bf16_t* ub = (bf16_t*)(p.ws + WS_UBF);
    const int ch = (int)(gtid % (LW / 8)) * 8;
    float wt[4][8], bs[8];
#pragma unroll
    for (int j = 0; j < 8; ++j) bs[j] = p.lru_conv_b[ch + j];
#pragma unroll
    for (int tap = 0; tap < 4; ++tap)
#pragma unroll
        for (int j = 0; j < 8; ++j) wt[tap][j] = p.lru_conv_w[tap * LW + ch + j];
    for (long it = gtid; it < (long)MT * (LW / 8); it += gthreads) {
        const int rr = (int)(it / (LW / 8));
        int base, t, n; if (rr < ML) { base = (rr / NSEQ) * NSEQ; t = rr % NSEQ; n = NSEQ; } else { const int rc = rr - ML; base = ML + (rc / NCTX) * NCTX; t = rc % NCTX; n = NCTX; }
        u32x4_t xv[4];
#pragma unroll
        for (int tap = 0; tap < 4; ++tap) { int tt = t + tap - 2; tt = tt < 0 ? 0 : (tt > n - 1 ? n - 1 : tt); xv[tap] = *(const u32x4_t*)(qkv + (size_t)(base + tt) * EVIN + COL_XR + ch); }
        float acc[8];
#pragma unroll
        for (int j = 0; j < 8; ++j) acc[j] = bs[j];
#pragma unroll
        for (int tap = 0; tap < 4; ++tap) { const int tt = t + tap - 2; const float ok = (tt >= 0 && tt < n) ? 1.0f : 0.0f; const unsigned vw[4] = {xv[tap].x, xv[tap].y, xv[tap].z, xv[tap].w};
#pragma unroll
            for (int j = 0; j < 8; ++j) acc[j] += (wt[tap][j] * ok) * __uint_as_float((j & 1) ? (vw[j >> 1] & 0xffff0000u) : (vw[j >> 1] << 16)); }
        u32x4_t w; w.x = pack2bf(acc[0], acc[1]); w.y = pack2bf(acc[2], acc[3]); w.z = pack2bf(acc[4], acc[5]); w.w = pack2bf(acc[6], acc[7]);
        *(u32x4_t*)(ub + (size_t)rr * LW + ch) = w;
    }
}
__device__ __forceinline__ int lru_chunk_row0(int b, int k) { return k < LRU_NCC ? ML + b * NCTX + k * LRU_CH : b * NSEQ + (k - LRU_NCC) * LRU_CH; }
__device__ __forceinline__ int lru_order(int d, int k) { return d == 0 ? k : (k < LRU_NCC ? LRU_NCC - 1 - k : LRU_NCC + (LRU_NLC - 1 - (k - LRU_NCC))); }
#define LRU_ZERO16(v) do { const float z0_ = opaque_zero(); _Pragma("unroll") for (int e_ = 0; e_ < 16; ++e_) v[e_] = z0_; } while (0)
template <int PASS> __device__ __forceinline__ void ph_lru_fast(const Params& p, LAS unsigned char* lds, int gwave, int nwaves, int wv_) {
    const int lane = tid_of(wv_) & 63; LAS float* hfl = (LAS float*)(lds + wv_ * (LRU_CH * 64 * 4)) + lane;
    const int r = lane & 31, hh = lane >> 5, a_half = (r >> 2) & 1, a_n = (r & 3) + 4 * (r >> 3);
    const bf16_t* ub = (const bf16_t*)(p.ws + WS_UBF); const bf16_t* qkv = (const bf16_t*)(p.ws + WS_QKV); bf16_t* mix = (bf16_t*)(p.ws + WS_MIX);
    const s5_bf16x8* LB = (const s5_bf16x8*)(p.ws + WS_LRUBF); float* AGG = (float*)(p.ws + WS_LRUAGG);
    constexpr int NPAIR = LRU_NCH / 2, NT = LRU_CH / 16;
    s5_bf16x8 idf[2];
#pragma unroll
    for (int kk = 0; kk < 2; ++kk) { const int jj = r - 16 * kk - 8 * hh;
#pragma unroll
        for (int e = 0; e < 8; ++e) idf[kk][e] = (e == jj) ? (short)0x3F80 : (short)0; }
    for (int rd = 0; rd <= (NB * 16 * 2 * NPAIR) / nwaves; ++rd) {
        const int it = deal_item(rd, gwave, nwaves, NB * 16 * 2 * NPAIR, OUT0_FP8 ? 4 : 2); if (it < 0) continue;
        const int cs = it & 1, pr = OUT0_FP8 ? (it >> 2) % NPAIR : (it >> 1) % NPAIR, h = OUT0_FP8 ? 2 * ((it / (4 * NPAIR)) % 8) + ((it >> 1) & 1) : (it / (2 * NPAIR)) % 16, b = it / (32 * NPAIR);
        const int k_s = 2 * pr + hh, k_a = 2 * pr + a_half, rb_a = lru_chunk_row0(b, k_a), rb_s = lru_chunk_row0(b, k_s);
        const int ch = h * 64 + 32 * cs + r;
#pragma unroll
        for (int d = 0; d < 2; ++d) {
            const int oi = lru_order(d, k_s);
            s5_bf16x8 br[4], bi[4];
#pragma unroll
            for (int ks = 0; ks < 4; ++ks) { br[ks] = LB[(((size_t)(d * 16 + h) * 2 + 0) * 2 + cs) * 4 * 64 + ks * 64 + lane]; bi[ks] = LB[(((size_t)(d * 16 + h) * 2 + 1) * 2 + cs) * 4 * 64 + ks * 64 + lane]; }
            const float lamv = softplusf_(-p.lru_lam[d * LW + ch]), bav = p.lru_ba[d * LW + ch], biv = p.lru_bi[d * LW + ch];
            const float nba = -1.44269504089f * bav, nbi = -1.44269504089f * biv, c2 = -8.0f * 1.44269504089f * lamv;
            float state = 0.f, aprod = 1.f;
            float* ag = AGG + (((size_t)b * 2 + d) * LRU_NCH) * LW * 2;
            if (PASS == 2) { const int oa = lru_order(d, 2 * pr), ob = lru_order(d, 2 * pr + 1), oimax = oa > ob ? oa : ob;
#pragma unroll 16
                for (int j = 0; j < oimax; ++j) { const float aj = ag[((size_t)j * LW + ch) * 2], bj = ag[((size_t)j * LW + ch) * 2 + 1]; if (j < oi) state = aj * state + bj; } }
            s5_bf16x8 an[4], gn0, gn1;
            { const int tile0 = d ? NT - 1 : 0; const bf16_t* up = ub + (size_t)(rb_a + tile0 * 16 + a_n) * LW + h * 64 + 8 * hh;
#pragma unroll
              for (int ks = 0; ks < 4; ++ks) an[ks] = *(const s5_bf16x8*)(up + 16 * ks);
              if (PASS == 2 && d == 1) { const bf16_t* gp = qkv + (size_t)(rb_a + tile0 * 16 + a_n) * EVIN + COL_GR + h * 64 + 32 * cs + 8 * hh; gn0 = *(const s5_bf16x8*)gp; gn1 = *(const s5_bf16x8*)(gp + 16); } }
#pragma unroll 1
            for (int i = 0; i < NT; ++i) {
                const int tile = d ? NT - 1 - i : i;
                s5_bf16x8 a[4], g0, g1;
#pragma unroll
                for (int ks = 0; ks < 4; ++ks) a[ks] = an[ks];
                if (PASS == 2 && d == 1) { g0 = gn0; g1 = gn1; }
                if (i + 1 < NT) { const int tl = d ? tile - 1 : tile + 1; const bf16_t* up = ub + (size_t)(rb_a + tl * 16 + a_n) * LW + h * 64 + 8 * hh;
#pragma unroll
                    for (int ks = 0; ks < 4; ++ks) an[ks] = *(const s5_bf16x8*)(up + 16 * ks);
                    if (PASS == 2 && d == 1) { const bf16_t* gp = qkv + (size_t)(rb_a + tl * 16 + a_n) * EVIN + COL_GR + h * 64 + 32 * cs + 8 * hh; gn0 = *(const s5_bf16x8*)gp; gn1 = *(const s5_bf16x8*)(gp + 16); } }
                s5_f32x16 ar, ai, au, agr; LRU_ZERO16(ar); LRU_ZERO16(ai); LRU_ZERO16(au); LRU_ZERO16(agr);
#pragma unroll
                for (int ks = 0; ks < 4; ++ks) { ar = __builtin_amdgcn_mfma_f32_32x32x16_bf16(a[ks], br[ks], ar, 0, 0, 0); ai = __builtin_amdgcn_mfma_f32_32x32x16_bf16(a[ks], bi[ks], ai, 0, 0, 0); }
                au = __builtin_amdgcn_mfma_f32_32x32x16_bf16(cs ? a[2] : a[0], idf[0], au, 0, 0, 0); au = __builtin_amdgcn_mfma_f32_32x32x16_bf16(cs ? a[3] : a[1], idf[1], au, 0, 0, 0);
                if (PASS == 2 && d == 1) { agr = __builtin_amdgcn_mfma_f32_32x32x16_bf16(g0, idf[0], agr, 0, 0, 0); agr = __builtin_amdgcn_mfma_f32_32x32x16_bf16(g1, idf[1], agr, 0, 0, 0); }
                MFMA_KEEP(au, a[0]); MFMA_KEEP(au, a[1]); MFMA_KEEP(au, a[2]); MFMA_KEEP(au, a[3]); MFMA_KEEP(ai, a[3]); if (PASS == 2 && d == 1) { MFMA_KEEP(agr, g0); MFMA_KEEP(agr, g1); }
#pragma unroll
                for (int nn = 0; nn < 16; ++nn) {
                    const int n = d ? 15 - nn : nn;
                    const float rg = fast_rcp(1.0f + __builtin_amdgcn_exp2f(__builtin_fmaf(ar[n], -1.44269504089f, nba))), ig = fast_rcp(1.0f + __builtin_amdgcn_exp2f(__builtin_fmaf(ai[n], -1.44269504089f, nbi))), av = __builtin_amdgcn_exp2f(rg * c2), mult = fast_sqrt(__builtin_fmaf(-av, av, 1.0f));
                    state = av * state + mult * (ig * au[n]);
                    if (PASS == 1) aprod *= av;
                    if (PASS == 2) { if (d == 0) hfl[(tile * 16 + n) * 64] = state; else { const float mv = (hfl[(tile * 16 + n) * 64] + state) * geluf_(agr[n]);
                        if (OUT0_FP8) ((unsigned char*)mix)[(size_t)(rb_s + tile * 16 + n) * D + QW + ch] = (unsigned char)(pack4_fp8(mv, 0.f, 0.f, 0.f) & 0xffu); else mix[(size_t)(rb_s + tile * 16 + n) * D + QW + ch] = f2bf(mv); } }
                }
            }
            if (PASS == 1) { ag[((size_t)oi * LW + ch) * 2] = aprod; ag[((size_t)oi * LW + ch) * 2 + 1] = state; }
        }
    }
}
#endif
#ifndef CPU_EMU
constexpr int AT_KROWS = 320, AT_LDS_K = 0, AT_LDS_V = AT_KROWS * 128, AT_LDS_BYTES = 2 * AT_KROWS * 128;
static_assert(NCTX == 256, "attention key halves assume 256 context keys");
__device__ __forceinline__ void ph_attn_fast(const Params& p, LAS unsigned char* lds, int bid, int nblocks, int wv_) {
    const int tid = tid_of(wv_), lane = tid & 63, w = wv_, r = lane & 31, hh = lane >> 5;
    const bf16_t* qkv = (const bf16_t*)(p.ws + WS_QKV); const bf16_t* vt = (const bf16_t*)(p.ws + WS_VT); bf16_t* mix = (bf16_t*)(p.ws + WS_MIX);
    constexpr int NQB = NSEQ / 128, NCB = NCTX / 128, UNITS = NB * 4 * (NQB + NCB);
    for (int un = bid; un < UNITS; un += nblocks) {
        const int kvh = un & 3, rest = un >> 2; int b, qb; if (rest < NB * NQB) { b = rest / NQB; qb = rest % NQB; } else { b = (rest - NB * NQB) / NCB; qb = NQB + (rest - NB * NQB) % NCB; }
        const bool isc = qb >= NQB;
        const int q0 = isc ? (qb - NQB) * 128 : qb * 128, qrow0 = isc ? ML + b * NCTX + q0 : b * NSEQ + q0, head = 4 * kvh + (w >> 1);
        s5_bf16x8 qf[2][4];
#pragma unroll
        for (int qt = 0; qt < 2; ++qt)
#pragma unroll
            for (int ds = 0; ds < 4; ++ds) qf[qt][ds] = *(const s5_bf16x8*)(qkv + (size_t)(qrow0 + 64 * (w & 1) + 32 * qt + r) * EVIN + COL_Q + head * 64 + 16 * ds + 8 * hh);
        s5_f32x16 oacc[2][2];
#pragma unroll
        for (int qt = 0; qt < 2; ++qt)
#pragma unroll
            for (int dt = 0; dt < 2; ++dt)
#pragma unroll
                for (int e = 0; e < 16; ++e) oacc[qt][dt][e] = 0.f;
        const float sk = p.attn_sink[head];
        float mrun[2] = {sk, sk}, lrun[2] = {hh == 0 ? 1.0f : 0.f, hh == 0 ? 1.0f : 0.f};
#pragma unroll 1
        for (int half = isc ? 1 : 0; half < 2; ++half) {
            __syncthreads();
            static_assert(AT_KROWS * 8 == 5 * 512 && 64 * 40 == 5 * 512, "staging: five 16-byte pieces per thread and operand");
            u4v_t stK[5], stV[5];
#pragma unroll
            for (int k5 = 0; k5 < 5; ++k5) {
                const int i = tid + 512 * k5, row = i >> 3, cc = i & 7; int grow;
                if (half == 1 && row >= 64) grow = ML + b * NCTX + (row - 64);
                else { int kpos = q0 - 128 + 320 * half + row; kpos = kpos < 0 ? 0 : (kpos > NSEQ - 1 ? NSEQ - 1 : kpos); grow = b * NSEQ + kpos; }
                stK[k5] = *(const u4v_t*)(qkv + (size_t)grow * EVIN + COL_K + kvh * 64 + cc * 8);
            }
#pragma unroll
            for (int k5 = 0; k5 < 5; ++k5) {
                const int i = tid + 512 * k5, d = i / 40, pc = i % 40;
                const int pos = (half == 0) ? q0 + pc * 8 : (pc < 8 ? q0 + 320 + pc * 8 : 128 + NSEQ + 128 + (pc - 8) * 8);
                stV[k5] = *(const u4v_t*)(vt + ((size_t)(b * 4 + kvh) * 64 + d) * VT_T + pos);
            }
#pragma unroll
            for (int k5 = 0; k5 < 5; ++k5) { const int i = tid + 512 * k5, row = i >> 3, cc = i & 7; *(LAS u4v_t*)(lds + AT_LDS_K + row * 128 + ((cc ^ (row & 7)) << 4)) = stK[k5]; }
#pragma unroll
            for (int k5 = 0; k5 < 5; ++k5) { const int i = tid + 512 * k5, d = i / 40, pc = i % 40, kt = pc >> 2, cc = pc & 3; *(LAS u4v_t*)(lds + AT_LDS_V + kt * 4096 + d * 64 + ((cc ^ ((d >> 2) & 3)) << 4)) = stV[k5]; }
            __syncthreads();
#pragma unroll 1
            for (int kt = (isc ? 2 : 0); kt < 10; ++kt) {
                const bool local = !(half == 1 && kt >= 2);
                const int Kb = q0 - 128 + 320 * half + 32 * kt;
                s5_bf16x8 kf[4], vf[2][2];
#pragma unroll
                for (int ds = 0; ds < 4; ++ds) kf[ds] = *(const LAS s5_bf16x8*)(lds + AT_LDS_K + (32 * kt + r) * 128 + (((2 * ds + hh) ^ (r & 7)) << 4));
#pragma unroll
                for (int dt = 0; dt < 2; ++dt)
#pragma unroll
                    for (int s2 = 0; s2 < 2; ++s2) vf[dt][s2] = *(const LAS s5_bf16x8*)(lds + AT_LDS_V + kt * 4096 + (32 * dt + r) * 64 + (((2 * s2 + hh) ^ (((32 * dt + r) >> 2) & 3)) << 4));
#pragma unroll
                for (int qt = 0; qt < 2; ++qt) {
                    const int Qb = q0 + 64 * (w & 1) + 32 * qt;
                    bool need_mask = false;
                    if (local) {
                        if (Kb - (Qb + 31) > 128 || Qb - (Kb + 31) > 128 || Kb + 31 < 0 || Kb >= NSEQ) continue;
                        need_mask = !(Kb + 31 - Qb <= 128 && Qb + 31 - Kb <= 128 && Kb >= 0 && Kb + 31 < NSEQ);
                    }
                    s5_f32x16 sc; const float z0 = opaque_zero();
#pragma unroll
                    for (int e = 0; e < 16; ++e) sc[e] = z0;
#pragma unroll
                    for (int ds = 0; ds < 4; ++ds) sc = __builtin_amdgcn_mfma_f32_32x32x16_bf16(kf[ds], qf[qt][ds], sc, 0, 0, 0);
                    MFMA_KEEP(sc, kf[0]); MFMA_KEEP(sc, kf[1]); MFMA_KEEP(sc, kf[2]); MFMA_KEEP(sc, kf[3]);
                    if (need_mask) {
                        const int qpos = Qb + r;
#pragma unroll
                        for (int e = 0; e < 16; ++e) { const int kpos = Kb + (e & 3) + 8 * (e >> 2) + 4 * hh, rel = kpos - qpos; if (rel > 128 || rel < -128 || kpos < 0 || kpos >= NSEQ) sc[e] = -1e30f; }
                    }
                    float tmax = sc[0];
#pragma unroll
                    for (int e = 1; e < 16; ++e) tmax = fmaxf(tmax, sc[e]);
                    tmax = fmaxf(tmax, __shfl_xor(tmax, 32));
                    const float mnew = fmaxf(mrun[qt], tmax), scl = __expf(mrun[qt] - mnew), mneg = -mnew * 1.44269504089f; mrun[qt] = mnew;
                    float psum = 0.f; float pv[16];
#pragma unroll
                    for (int e = 0; e < 16; ++e) { pv[e] = __builtin_amdgcn_exp2f(__builtin_fmaf(sc[e], 1.44269504089f, mneg)); psum += pv[e]; }
                    lrun[qt] = lrun[qt] * scl + psum;
                    if (__ballot(scl != 1.0f) != 0ull) {
#pragma unroll
                    for (int dt = 0; dt < 2; ++dt)
#pragma unroll
                        for (int e = 0; e < 16; ++e) oacc[qt][dt][e] *= scl; }
                    s5_bf16x8 pf[2];
#pragma unroll
                    for (int s2 = 0; s2 < 2; ++s2) { unsigned w0 = pack2bf(pv[8 * s2], pv[8 * s2 + 1]), w1 = pack2bf(pv[8 * s2 + 2], pv[8 * s2 + 3]), w2 = pack2bf(pv[8 * s2 + 4], pv[8 * s2 + 5]), w3 = pack2bf(pv[8 * s2 + 6], pv[8 * s2 + 7]);
                        u4v_t t4 = {w0, w1, w2, w3}; pf[s2] = __builtin_bit_cast(s5_bf16x8, t4); }
#pragma unroll
                    for (int dt = 0; dt < 2; ++dt)
#pragma unroll
                        for (int s2 = 0; s2 < 2; ++s2) oacc[qt][dt] = __builtin_amdgcn_mfma_f32_32x32x16_bf16(vf[dt][s2], pf[s2], oacc[qt][dt], 0, 0, 0);
                    MFMA_KEEP(oacc[qt][1], pf[0]); MFMA_KEEP(oacc[qt][1], pf[1]);
                }
            }
        }
#pragma unroll
        for (int qt = 0; qt < 2; ++qt) {
            const float ltot = lrun[qt] + __shfl_xor(lrun[qt], 32), inv = 1.0f / ltot;
            bf16_t* op = mix + (size_t)(qrow0 + 64 * (w & 1) + 32 * qt + r) * D + head * 64; unsigned char* op8 = (unsigned char*)mix + (size_t)(qrow0 + 64 * (w & 1) + 32 * qt + r) * D + head * 64; const float inv8 = inv * MIX8_SCALE;
#pragma unroll
            for (int dt = 0; dt < 2; ++dt)
#pragma unroll
                for (int g4 = 0; g4 < 4; ++g4) {
                    if (OUT0_FP8) { *(unsigned*)(op8 + 32 * dt + 8 * g4 + 4 * hh) = pack4_fp8(oacc[qt][dt][4 * g4] * inv8, oacc[qt][dt][4 * g4 + 1] * inv8, oacc[qt][dt][4 * g4 + 2] * inv8, oacc[qt][dt][4 * g4 + 3] * inv8); continue; }
                    u32x2_t wv2; wv2.x = pack2bf(oacc[qt][dt][4 * g4] * inv, oacc[qt][dt][4 * g4 + 1] * inv); wv2.y = pack2bf(oacc[qt][dt][4 * g4 + 2] * inv, oacc[qt][dt][4 * g4 + 3] * inv);
                    *(u32x2_t*)(op + 32 * dt + 8 * g4 + 4 * hh) = wv2; }
        }
    }
}
#endif
#ifndef CPU_EMU
__device__ __forceinline__ float wave_sum(float v) {
#pragma unroll
    for (int o = 32; o >= 1; o >>= 1) v += __shfl_xor(v, o);
    return v; }
template <int MODE> __device__ __forceinline__ void ph_norm_fast(const Params& p, int l, int rows, int gwave, int nwaves, int wv_) {
    const int lane = tid_of(wv_) & 63;
    bf16_t* h = (bf16_t*)(p.ws + WS_H); float* xres = (float*)(p.ws + WS_XRES); const bf16_t* yb = (const bf16_t*)(p.ws + WS_YBUF);
    const float* tok_w = (const float*)(p.ws + WS_TOK) + (size_t)MT * 2; const int* tok_dest = (const int*)(p.ws + WS_TOK) + (size_t)MT * 6;
    for (int r = gwave; r < rows; r += nwaves) {
        const int ar = ada_row(r);
        f32x4 xv[8];
        f32x4 cg[8], cs[8], ch[8];
        if (MODE == 2) {
#pragma unroll
            for (int i = 0; i < 8; ++i) cg[i] = *(const f32x4*)(p.norm_final + 4 * lane + 256 * i);
        } else { const float* sh = ada_ptr(p, l, ar, 0); const float* sc = ada_ptr(p, l, ar, 1); const float* g = p.norm_mix + (size_t)l * D;
#pragma unroll
            for (int i = 0; i < 8; ++i) { const int c = 4 * lane + 256 * i; cg[i] = *(const f32x4*)(g + c); cs[i] = *(const f32x4*)(sc + c); ch[i] = *(const f32x4*)(sh + c); } }
        if (MODE == 0) { const float* xr = xin_row(p, l, r);
#pragma unroll
            for (int i = 0; i < 8; ++i) xv[i] = *(const f32x4*)(xr + 4 * lane + 256 * i); }
        else { const int lm = (MODE == 1) ? l - 1 : 1; const float* g2 = ada_ptr(p, lm, ar, 5); float* xr = xres + (size_t)r * D;
            const int d0 = tok_dest[r * 2], d1 = tok_dest[r * 2 + 1]; const float w0 = tok_w[r * 2], w1 = tok_w[r * 2 + 1];
            f32x4 xo[8], gg[8]; unsigned ya8[8], yc8[8]; u32x2_t ya16[8], yc16[8];
#pragma unroll
            for (int i = 0; i < 8; ++i) { const int c = 4 * lane + 256 * i;
                if (RES_BF16) { const u32x2_t t = *(const u32x2_t*)((const bf16_t*)xres + (size_t)r * D + c); xo[i] = unpack4bf(t.x, t.y); } else xo[i] = *(const f32x4*)(xr + c);
                gg[i] = *(const f32x4*)(g2 + c);
                if (Y8) { ya8[i] = *(const unsigned*)((const unsigned char*)yb + (size_t)d0 * D + c); yc8[i] = *(const unsigned*)((const unsigned char*)yb + (size_t)d1 * D + c); }
                else { ya16[i] = *(const u32x2_t*)(yb + (size_t)d0 * D + c); yc16[i] = *(const u32x2_t*)(yb + (size_t)d1 * D + c); } }
#pragma unroll
            for (int i = 0; i < 8; ++i) { f32x4 m;
                if (Y8) { const unsigned ya = ya8[i], yc = yc8[i]; const float u0 = w0 * (1.0f / Y8_SCALE), u1 = w1 * (1.0f / Y8_SCALE);
                    m[0] = u0 * __builtin_amdgcn_cvt_f32_fp8(ya, 0) + u1 * __builtin_amdgcn_cvt_f32_fp8(yc, 0); m[1] = u0 * __builtin_amdgcn_cvt_f32_fp8(ya, 1) + u1 * __builtin_amdgcn_cvt_f32_fp8(yc, 1);
                    m[2] = u0 * __builtin_amdgcn_cvt_f32_fp8(ya, 2) + u1 * __builtin_amdgcn_cvt_f32_fp8(yc, 2); m[3] = u0 * __builtin_amdgcn_cvt_f32_fp8(ya, 3) + u1 * __builtin_amdgcn_cvt_f32_fp8(yc, 3); }
                else { const u32x2_t ya = ya16[i], yc = yc16[i];
                    m[0] = w0 * __uint_as_float(ya.x << 16) + w1 * __uint_as_float(yc.x << 16); m[1] = w0 * __uint_as_float(ya.x & 0xffff0000u) + w1 * __uint_as_float(yc.x & 0xffff0000u);
                    m[2] = w0 * __uint_as_float(ya.y << 16) + w1 * __uint_as_float(yc.y << 16); m[3] = w0 * __uint_as_float(ya.y & 0xffff0000u) + w1 * __uint_as_float(yc.y & 0xffff0000u); }
                xv[i] = xo[i] + gg[i] * m; } }
        float ss = 0.f;
#pragma unroll
        for (int i = 0; i < 8; ++i) ss += (xv[i][0] * xv[i][0] + xv[i][1] * xv[i][1]) + (xv[i][2] * xv[i][2] + xv[i][3] * xv[i][3]);
        ss = wave_sum(ss);
        const float rstd = 1.0f / sqrtf(ss * (1.0f / D) + 1e-6f);
#ifndef CPU_EMU
        asm volatile("" ::: "memory");
#endif
        if (MODE == 2) {
#pragma unroll
            for (int i = 0; i < 8; ++i) { const int c = 4 * lane + 256 * i; *(f32x4*)(p.out + (size_t)r * D + c) = xv[i] * rstd * cg[i]; }
        } else {
#pragma unroll
            for (int i = 0; i < 8; ++i) { const int c = 4 * lane + 256 * i;
                if (MODE == 1) { if (RES_BF16) { u32x2_t t; t.x = pack2bf(xv[i][0], xv[i][1]); t.y = pack2bf(xv[i][2], xv[i][3]); *(u32x2_t*)((bf16_t*)xres + (size_t)r * D + c) = t; } else *(f32x4*)(xres + (size_t)r * D + c) = xv[i]; }
                const f32x4 hv = xv[i] * rstd * cg[i] * (cs[i] + 1.0f) + ch[i];
                if ((MODE == 1 && DENSE1_FP8) || (MODE == 0 && IN0_FP8)) *(unsigned*)((unsigned char*)h + (size_t)r * D + c) = pack4_fp8(hv[0], hv[1], hv[2], hv[3]);
                else { if (MODE == 0 && IN0QKV_FP8) *(unsigned*)(p.ws + WS_H8 + (size_t)r * D + c) = pack4_fp8(hv[0], hv[1], hv[2], hv[3]);
                    u32x2_t w; w.x = pack2bf(hv[0], hv[1]); w.y = pack2bf(hv[2], hv[3]); *(u32x2_t*)(h + (size_t)r * D + c) = w; } } }
    }
}
template <bool H8> __device__ __forceinline__ void ph_router_fast(const Params& p, int l, int rows, LAS unsigned char* lds, int bid, int nblocks, int wv_) {
    const int lane = tid_of(wv_) & 63, rr = lane & 15, q = lane >> 4, w = wv_;
    bf16_t* h = (bf16_t*)(p.ws + WS_H); const float* xres = (const float*)(p.ws + WS_XRES); const s5_bf16x8* RWF = (const s5_bf16x8*)(p.ws + WS_RWF);
    int* tok_e = (int*)(p.ws + WS_TOK); float* tok_w = (float*)(p.ws + WS_TOK) + (size_t)MT * 2; int* tok_slot = (int*)(p.ws + WS_TOK) + (size_t)MT * 4;
    int* hist = (int*)(p.ws + WS_HIST) + (size_t)l * MAXG * HIST_LD;
    int run = 0;
    LAS float* ssq = (LAS float*)lds;
    LAS f32x4* red = (LAS f32x4*)(lds + 1024);
    LAS float* cfA = (LAS float*)(lds + 16384); LAS float* cfB = cfA + D;
    const int tid = w * 64 + lane, ntl = rows / 16, TPW = (ntl + nblocks - 1) / nblocks, t_lo = bid * TPW, t_hi = (t_lo + TPW < ntl) ? t_lo + TPW : ntl;
    s5_bf16x8 rwh[8], rwl[8];
#pragma unroll
    for (int st = 0; st < 8; ++st) { rwh[st] = RWF[(8 * w + st) * 64 + lane]; rwl[st] = RWF[(64 + 8 * w + st) * 64 + lane]; }
    int ar_cur = -1;
    u4v_t nx[8];
    if (RES_BF16 && t_lo < t_hi) { const bf16_t* xr = (const bf16_t*)xres + (size_t)(t_lo * 16 + rr) * D + 256 * w + 8 * q;
#pragma unroll
        for (int st = 0; st < 8; ++st) nx[st] = *(const u4v_t*)(xr + 32 * st); }
    for (int t16 = t_lo; t16 < t_hi; ++t16) {
        const int r = t16 * 16 + rr, ar = ada_row(t16 * 16);
        if (ar != ar_cur) { ar_cur = ar;
            const f32x4 gv = *(const f32x4*)(p.norm_ffn + (size_t)l * D + 4 * tid), sv = *(const f32x4*)(ada_ptr(p, l, ar, 4) + 4 * tid), hv = *(const f32x4*)(ada_ptr(p, l, ar, 3) + 4 * tid);
            *(LAS f32x4*)(cfA + 4 * tid) = gv * (sv + 1.0f); *(LAS f32x4*)(cfB + 4 * tid) = hv; }
        f32x4 xa[8], xb[8];
        if (RES_BF16) {
#pragma unroll
            for (int st = 0; st < 8; ++st) { xa[st] = unpack4bf(nx[st][0], nx[st][1]); xb[st] = unpack4bf(nx[st][2], nx[st][3]); }
            if (t16 + 1 < t_hi) { const bf16_t* xr = (const bf16_t*)xres + (size_t)((t16 + 1) * 16 + rr) * D + 256 * w + 8 * q;
#pragma unroll
                for (int st = 0; st < 8; ++st) nx[st] = *(const u4v_t*)(xr + 32 * st); } }
        else { const float* xr = xres + (size_t)r * D + 256 * w + 8 * q;
#pragma unroll
            for (int st = 0; st < 8; ++st) { xa[st] = *(const f32x4*)(xr + 32 * st); xb[st] = *(const f32x4*)(xr + 32 * st + 4); } }
        float ss = 0.f;
#pragma unroll
        for (int st = 0; st < 8; ++st) ss += (xa[st][0] * xa[st][0] + xa[st][1] * xa[st][1]) + (xa[st][2] * xa[st][2] + xa[st][3] * xa[st][3]) + (xb[st][0] * xb[st][0] + xb[st][1] * xb[st][1]) + (xb[st][2] * xb[st][2] + xb[st][3] * xb[st][3]);
        ss += __shfl_xor(ss, 16); ss += __shfl_xor(ss, 32);
        if (q == 0) ssq[w * 16 + rr] = ss;
        __syncthreads();
        float tot = 0.f;
#pragma unroll
        for (int ww = 0; ww < 8; ++ww) tot += ssq[ww * 16 + rr];
        const float rstd = 1.0f / sqrtf(tot * (1.0f / D) + 1e-6f);
        const LAS float* cA = cfA + 256 * w + 8 * q; const LAS float* cB = cfB + 256 * w + 8 * q;
        f32x4 lhi, llo; { const float z0 = opaque_zero(); lhi = (f32x4){z0, z0, z0, z0}; llo = lhi; }
#pragma unroll
        for (int st = 0; st < 8; ++st) {
            const f32x4 ga = *(const LAS f32x4*)(cA + 32 * st), gb = *(const LAS f32x4*)(cA + 32 * st + 4), ha = *(const LAS f32x4*)(cB + 32 * st), hb = *(const LAS f32x4*)(cB + 32 * st + 4);
            const f32x4 va = xa[st] * rstd * ga + ha, vb = xb[st] * rstd * gb + hb;
            u4v_t wv4 = {pack2bf(va[0], va[1]), pack2bf(va[2], va[3]), pack2bf(vb[0], vb[1]), pack2bf(vb[2], vb[3])};
            if (H8) { u32x2_t w8; w8.x = pack4_fp8(va[0], va[1], va[2], va[3]); w8.y = pack4_fp8(vb[0], vb[1], vb[2], vb[3]); *(u32x2_t*)((unsigned char*)h + (size_t)r * D + 256 * w + 32 * st + 8 * q) = w8; }
            else *(u4v_t*)(h + (size_t)r * D + 256 * w + 32 * st + 8 * q) = wv4;
            const s5_bf16x8 hf = __builtin_bit_cast(s5_bf16x8, wv4);
            lhi = __builtin_amdgcn_mfma_f32_16x16x32_bf16(rwh[st], hf, lhi, 0, 0, 0); MFMA_KEEP(lhi, rwh[st]);
            llo = __builtin_amdgcn_mfma_f32_16x16x32_bf16(rwl[st], hf, llo, 0, 0, 0); MFMA_KEEP(llo, rwl[st]); MFMA_KEEP(llo, hf);
        }
        red[w * 64 + lane] = lhi + llo;
        __syncthreads();
        if (w == 0) {
            f32x4 lsum = red[lane];
#pragma unroll
            for (int ww = 1; ww < 8; ++ww) lsum += red[ww * 64 + lane];
            float lg[4];
#pragma unroll
            for (int i = 0; i < 4; ++i) lg[i] = lsum[i] + p.router_b[4 * q + i];
            float mx = fmaxf(fmaxf(lg[0], lg[1]), fmaxf(lg[2], lg[3])); mx = fmaxf(mx, __shfl_xor(mx, 16)); mx = fmaxf(mx, __shfl_xor(mx, 32));
            float pr[4], sum = 0.f;
#pragma unroll
            for (int i = 0; i < 4; ++i) { pr[i] = __expf(lg[i] - mx); sum += pr[i]; }
            sum += __shfl_xor(sum, 16); sum += __shfl_xor(sum, 32);
            float a1 = -1.f, a2 = -1.f; int j1 = 0, j2 = 0;
#pragma unroll
            for (int i = 0; i < 4; ++i) { const float v = pr[i] / sum; if (v > a1) { a2 = a1; j2 = j1; a1 = v; j1 = i; } else if (v > a2) { a2 = v; j2 = i; } }
            float best = a1 + a2; int bq = q; float w1 = a1, w2 = a2; int e1 = 4 * q + j1, e2 = 4 * q + j2;
#pragma unroll
            for (int o = 16; o <= 32; o <<= 1) {
                const float ob = __shfl_xor(best, o), ow1 = __shfl_xor(w1, o), ow2 = __shfl_xor(w2, o); const int oq = __shfl_xor(bq, o), oe1 = __shfl_xor(e1, o), oe2 = __shfl_xor(e2, o);
                if (ob > best || (ob == best && oq < bq)) { best = ob; bq = oq; w1 = ow1; w2 = ow2; e1 = oe1; e2 = oe2; } }
            int rk1 = 0, rk2 = 0, mine = 0; const unsigned long long below = (1ull << rr) - 1ull;
#pragma unroll
            for (int e = 0; e < NE; ++e) { const unsigned long long m = __ballot(q == 0 && (e1 == e || e2 == e)); const int pc = __popcll(m & below); if (e1 == e) rk1 = pc; if (e2 == e) rk2 = pc; if (rr == e) mine = __popcll(m); }
            const int b1 = __shfl(run, e1), b2 = __shfl(run, e2);
            if (q == 0) { const float ws = w1 + w2; tok_e[r * 2] = e1; tok_e[r * 2 + 1] = e2; tok_w[r * 2] = w1 / ws; tok_w[r * 2 + 1] = w2 / ws;
                tok_slot[r * 2] = b1 + rk1; tok_slot[r * 2 + 1] = b2 + rk2; }
            run += mine;
        }
    }
    if (w == 0 && lane < HIST_LD) hist[bid * HIST_LD + lane] = lane < NE ? run : 0;
}
__device__ __forceinline__ void ph_dispatch_fast(const Params& p, int l, int rows, LAS unsigned char* lds, int bid, int nblocks, int wv_) {
    const int tid = tid_of(wv_); const int* hist = (const int*)(p.ws + WS_HIST) + (size_t)l * MAXG * HIST_LD;
    const int* tok_e = (const int*)(p.ws + WS_TOK); const int* tok_slot = (const int*)(p.ws + WS_TOK) + (size_t)MT * 4; int* tok_dest = (int*)(p.ws + WS_TOK) + (size_t)MT * 6;
    int* rowidx = (int*)(p.ws + WS_ROWIDX); int* cnt = (int*)(p.ws + WS_CNT) + l * 64;
    LAS int* pre = (LAS int*)lds; LAS int* seg = pre + MAXG * NE; LAS int* tot = seg + 32 * NE; LAS int* pst = tot + NE;
    { const int e = tid & 15, sg = tid >> 4; int v[8], sum = 0;
#pragma unroll
        for (int i = 0; i < 8; ++i) { const int wg = 8 * sg + i; v[i] = wg < nblocks ? hist[wg * HIST_LD + e] : 0; sum += v[i]; }
        seg[sg * NE + e] = sum;
        __syncthreads();
        int base = 0; for (int s2 = 0; s2 < sg; ++s2) base += seg[s2 * NE + e];
#pragma unroll
        for (int i = 0; i < 8; ++i) { pre[(8 * sg + i) * NE + e] = base; base += v[i]; }
        if (sg == 31) tot[e] = base;
        __syncthreads();
        if (tid <= NE) { int acc = 0; for (int j = 0; j < tid; ++j) acc += (tot[j] + 255) / 256 * 256; pst[tid] = acc; }
        if (bid == 0 && tid < NE) cnt[tid] = tot[tid];
        __syncthreads(); }
    const long gtid = (long)bid * 512 + tid, gthreads = (long)nblocks * 512; const int tpw = (rows / 16 + nblocks - 1) / nblocks;
    for (long it = gtid; it < (long)rows * 2; it += gthreads) { const int e = tok_e[it], wg = (int)((it >> 5) / tpw), dest = pst[e] + pre[wg * NE + e] + tok_slot[it]; tok_dest[it] = dest; st_coh(rowidx + dest, (int)(it / 2)); }
    const int total = pst[NE];
    for (long it = gtid; it < total; it += gthreads) { int st = 0, ce = 0;
#pragma unroll
        for (int j = 0; j < NE; ++j) { if (it >= pst[j] && it < pst[j + 1]) { st = pst[j]; ce = tot[j]; } }
        if (it - st >= ce) st_coh(rowidx + it, 0); }
}
#endif
__device__ __forceinline__ void ph_final(const Params& p, long gtid, long gthreads) {
    const float* xres = (const float*)(p.ws + WS_XRES);
    for (long r = gtid; r < ML; r += gthreads) {
        const float* xr = xres + (size_t)r * D; float ss = 0.f; for (int k = 0; k < D; ++k) ss += xr[k] * xr[k];
        const float rstd = 1.0f / sqrtf(ss / D + 1e-6f);
        for (int k = 0; k < D; ++k) p.out[(size_t)r * D + k] = xr[k] * rstd * p.norm_final[k];
    }
}

struct CvtJob { const float* src; bf16_t* dst; int K, N, mode, fp8, ld; };
constexpr int NJOBS = 6 + 2 * NE * 3;
constexpr int IN0_NQ = QW + 2 * KVW;
__device__ __forceinline__ CvtJob cvt_job(const Params& p, int j) {
    CvtJob J; unsigned char* ws = p.ws; J.fp8 = 0;
    if (j == 0) { J.src = p.ev_w_in; J.dst = (bf16_t*)(ws + WS_WT_IN0); J.K = D; J.N = IN0_NQ; J.mode = 0; }
    else if (j == 5) { J.src = p.ev_w_in + IN0_NQ; J.dst = (bf16_t*)(ws + WS_WT_IN0) + (size_t)IN0_NQ * D; J.K = D; J.N = EVIN - IN0_NQ; J.mode = 0; }
    else if (j == 1) { J.src = p.ev_w_out; J.dst = (bf16_t*)(ws + WS_WT_OUT0); J.K = D; J.N = D; J.mode = 0; }
    else if (j == 2) { J.src = p.od_w_in; J.dst = (bf16_t*)(ws + WS_WT_IN1); J.K = D; J.N = S5W; J.mode = 0; }
    else if (j == 3) { J.src = p.s5_glu_w; J.dst = (bf16_t*)(ws + WS_WT_GLU); J.K = S5W; J.N = S5W; J.mode = 0; }
    else if (j == 4) { J.src = p.od_w_out; J.dst = (bf16_t*)(ws + WS_WT_OUT1); J.K = S5W; J.N = D; J.mode = 0; }
    else { const int q = j - 6, le = q / 3, kind = q % 3;
        if (kind == 0) { J.src = p.moe_w_gate + (size_t)le * D * FF; J.dst = (bf16_t*)(ws + WS_WT_GU) + (size_t)le * 2 * FF * D; J.K = D; J.N = FF; J.mode = 1; }
        else if (kind == 1) { J.src = p.moe_w_up + (size_t)le * D * FF; J.dst = (bf16_t*)(ws + WS_WT_GU) + (size_t)le * 2 * FF * D; J.K = D; J.N = FF; J.mode = 2; }
        else { J.src = p.moe_w_down + (size_t)le * FF * D; J.dst = (bf16_t*)(ws + WS_WT_DN) + (size_t)le * D * FF; J.K = FF; J.N = D; J.mode = 0; }
        if (le >= NE ? MOE1_FP8 : MOE0_FP8) { const int l8 = le / NE, e = le % NE; J.fp8 = 1;
            J.dst = kind == 2 ? (bf16_t*)(ws + WS_WT_DN + (size_t)l8 * NE * D * FF * 2 + (size_t)e * D * FF) : (bf16_t*)(ws + WS_WT_GU + (size_t)l8 * NE * 2 * FF * D * 2 + (size_t)e * 2 * FF * D); } }
    if (((IN0_FP8 || IN0QKV_FP8) && j == 0) || (IN0_FP8 && j == 5) || (OUT0_FP8 && j == 1)) J.fp8 = 1;
    J.ld = (j == 0 || j == 5) ? EVIN : J.N;
    if (DENSE1_FP8 && j >= 2 && j <= 4) J.fp8 = 1;
    return J;
}
__device__ __forceinline__ int cvt_rowmap(int mode, int n) { return mode == 0 ? n : (n / 128) * 256 + (mode == 2 ? 128 : 0) + n % 128; }
constexpr long cvt_tiles_of(int K, int N) { return (long)(K / 64) * (N / 256); }
constexpr long CVT_TILES = cvt_tiles_of(D, IN0_NQ) + cvt_tiles_of(D, EVIN - IN0_NQ) + cvt_tiles_of(D, D) + cvt_tiles_of(D, S5W) + cvt_tiles_of(S5W, S5W) + cvt_tiles_of(S5W, D) + (long)2 * NE * 3 * cvt_tiles_of(D, FF);
__device__ __forceinline__ void cvt_find(long tile, int& j, long& local) {
    const long t0 = cvt_tiles_of(D, IN0_NQ), t1 = t0 + cvt_tiles_of(D, D), t2 = t1 + cvt_tiles_of(D, S5W), t3 = t2 + cvt_tiles_of(S5W, S5W), t4 = t3 + cvt_tiles_of(S5W, D), t5 = t4 + cvt_tiles_of(D, EVIN - IN0_NQ);
    if (tile < t0) { j = 0; local = tile; } else if (tile < t1) { j = 1; local = tile - t0; } else if (tile < t2) { j = 2; local = tile - t1; } else if (tile < t3) { j = 3; local = tile - t2; }
    else if (tile < t4) { j = 4; local = tile - t3; } else if (tile < t5) { j = 5; local = tile - t4; } else { const long q = tile - t5, per = cvt_tiles_of(D, FF); j = 6 + (int)(q / per); local = q % per; }
}
#ifndef CPU_EMU
constexpr int CVT_PITCH = 257, CVT_LDS_BYTES = 128 * 129 * 4;
struct CvtSrc { const float* src; int N, fp8; };
__device__ __forceinline__ CvtSrc cvt_src(const Params& p, long t) { int j; long loc; cvt_find(t, j, loc); const CvtJob L = cvt_job(p, j); CvtSrc S; S.N = L.ld; S.fp8 = L.fp8;
    if (L.fp8) { const int tn8 = L.N / 128, k0 = (int)(loc / tn8) * 128, n0 = (int)(loc % tn8) * 128; S.src = L.src + (size_t)k0 * L.ld + n0; }
    else { const int tn = L.N / 256, k0 = (int)(loc / tn) * 64, n0 = (int)(loc % tn) * 256; S.src = L.src + (size_t)k0 * L.ld + n0; }
    return S; }
__device__ __forceinline__ f32x4 cvt_load(const CvtSrc& S, int tid, int i) { const int q = tid + 512 * i, kk = S.fp8 ? q >> 5 : q >> 6, n4 = S.fp8 ? (q & 31) * 4 : (q & 63) * 4; return *(const f32x4*)(S.src + (size_t)kk * S.N + n4); }
__device__ __forceinline__ void ph_convert(const Params& p, float* tile, long t_end, int max_tiles, int wv_) {
    const int tid = tid_of(wv_); int* ctr = (int*)(p.ws + WS_CNT) + 128; LAS int* tsh = (LAS int*)((LAS unsigned char*)tile + CVT_LDS_BYTES);
    (void)max_tiles;
    int pend = 0, par = 0;
    __syncthreads();
    if (tid == 0) { const int a0 = atomicAdd(ctr, 1), a1 = atomicAdd(ctr, 1); pend = atomicAdd(ctr, 1); tsh[0] = a0; tsh[1] = a1; }
    __syncthreads();
    long t = tsh[0], tn = tsh[1];
    f32x4 R[8];
    if (t < t_end) { const CvtSrc S = cvt_src(p, t);
#pragma unroll
        for (int i = 0; i < 8; ++i) R[i] = cvt_load(S, tid, i); }
    while (t < t_end) {
        int j; long local; cvt_find(t, j, local); const CvtJob J = cvt_job(p, j);
        const bool more = tn < t_end; const CvtSrc SN = cvt_src(p, more ? tn : t);
#pragma unroll
        for (int i = 0; i < 8; ++i) {
            if (J.fp8) { const int q = tid + 512 * i, kk = q >> 5, n4 = (q & 31) * 4; *(f32x4*)(tile + kk * 128 + (n4 ^ (((kk >> 4) & 3) << 4))) = R[i]; }
            else { const int q = tid + 512 * i, kk = q >> 6, n4 = (q & 63) * 4; tile[kk * CVT_PITCH + n4] = R[i][0]; tile[kk * CVT_PITCH + n4 + 1] = R[i][1]; tile[kk * CVT_PITCH + n4 + 2] = R[i][2]; tile[kk * CVT_PITCH + n4 + 3] = R[i][3]; }
        }
        if (tid == 0) { tsh[2 + par] = pend; pend = atomicAdd(ctr, 1); }
        __syncthreads();
        const long tnn = tsh[2 + par]; par ^= 1;
        if (more) {
#pragma unroll
            for (int i = 0; i < 8; ++i) R[i] = cvt_load(SN, tid, i); }
        if (J.fp8) {
            const int tn8 = J.N / 128, k0 = (int)(local / tn8) * 128, n0 = (int)(local % tn8) * 128;
            const float wsc = (OUT0_FP8 && j == 1 && k0 < QW) ? W8_SCALE / MIX8_SCALE : W8_SCALE;
#pragma unroll
            for (int i = 0; i < 2; ++i) { const int lane = tid & 63, nn = 64 * i + 8 * (tid >> 6) + (lane & 7), kg = lane >> 3, kgl = kg & 3; const float* tp = tile + (16 * kg) * 128 + (nn ^ (kgl << 4)); u4v_t w;
#pragma unroll
                for (int d4 = 0; d4 < 4; ++d4) { int pk = 0; pk = __builtin_amdgcn_cvt_pk_fp8_f32(tp[(4 * d4) * 128] * wsc, tp[(4 * d4 + 1) * 128] * wsc, pk, false);
                    pk = __builtin_amdgcn_cvt_pk_fp8_f32(tp[(4 * d4 + 2) * 128] * wsc, tp[(4 * d4 + 3) * 128] * wsc, pk, true); w[d4] = (unsigned)pk; }
                *(u4v_t*)((unsigned char*)J.dst + (size_t)cvt_rowmap(J.mode, n0 + nn) * J.K + k0 + 16 * kg) = w; }
        } else {
            const int tnn_ = J.N / 256, k0 = (int)(local / tnn_) * 64, n0 = (int)(local % tnn_) * 256;
#pragma unroll
            for (int i = 0; i < 4; ++i) { const int q = tid + 512 * i, nn = q >> 3, k8 = (q & 7) * 8; const float* tp = tile + k8 * CVT_PITCH + nn;
                u4v_t w = {pack2bf(tp[0], tp[CVT_PITCH]), pack2bf(tp[2 * CVT_PITCH], tp[3 * CVT_PITCH]), pack2bf(tp[4 * CVT_PITCH], tp[5 * CVT_PITCH]), pack2bf(tp[6 * CVT_PITCH], tp[7 * CVT_PITCH])};
                *(u4v_t*)(J.dst + (size_t)cvt_rowmap(J.mode, n0 + nn) * J.K + k0 + k8) = w; }
        }
        __syncthreads();
        t = tn; tn = tnn;
    }
}
#else
void ph_convert_emu(const Params& p) {
    for (int j = 0; j < NJOBS; ++j) { const CvtJob J = cvt_job(p, j);
        for (int n = 0; n < J.N; ++n) { bf16_t* dr = J.dst + (size_t)cvt_rowmap(J.mode, n) * J.K; for (int k = 0; k < J.K; ++k) dr[k] = f2bf(J.src[(size_t)k * J.ld + n]); } }
}
#endif

namespace pg8 {
constexpr int BM = 256, BK = 64, HALF = 128, HTB = HALF * BK * 2  , STAGE_BYTES = 8 * HTB, NXCD = 8, WGM = 8;
struct Unit { int pm, pn, e; };
struct Gemm { const bf16_t* A; const bf16_t* Bt; int M, N, K; int sc_w = 0, sc_a = 0; };
__host__ __device__ __forceinline__ int lds_byte(int r, int c) { const int st = (r >> 4) * 2 + (c >> 5), rr = r & 15, cc = c & 31, ob = rr * 64 + cc * 2; return st * 1024 + (ob ^ (((ob >> 9) & 1) << 5)); }
__host__ __device__ __forceinline__ void stage_rc(int b, int& R, int& C) { const int st = b / 1024, sb = b % 1024, swz = sb ^ (((sb >> 9) & 1) << 5); R = (st >> 1) * 16 + swz / 64; C = (st & 1) * 32 + (swz % 64) / 2; }
__host__ __device__ __forceinline__ int perm32(int rho) { const int n = rho >> 4, i = rho & 15; return 8 * (i >> 2) + 4 * n + (i & 3); }

struct StaticOrder {
    static constexpr bool GATHER = false;
    int nM, nN, nwg, G, c;
    __host__ __device__ void init(int M, int N, int G_, int c_) { nM = M / BM; nN = N / BM; nwg = nM * nN; G = G_; c = c_; }
    __host__ __device__ bool next(int i, Unit& u) const {
        const long L = (long)i * G + c; if (L >= nwg) return false;
        int wgid = (int)L; { const int q = nwg / NXCD, r = nwg % NXCD, xcd = wgid % NXCD, off = wgid / NXCD; wgid = (xcd < r ? xcd * (q + 1) : r * (q + 1) + (xcd - r) * q) + off; }
        const int nig = WGM * nN, gid = wgid / nig, fm = gid * WGM, gsz = (nM - fm) < WGM ? (nM - fm) : WGM;
        u.pm = fm + ((wgid % nig) % gsz); u.pn = (wgid % nig) / gsz; u.e = 0; return true;
    }
    __device__ __forceinline__ const char* b_base(const Gemm& g, const Unit& u) const { return (const char*)g.Bt + (size_t)u.pn * ((size_t)BM * g.K * 2); }
    __device__ __forceinline__ int a_row(const Unit& u, int rr) const { return u.pm * BM + rr; }
};
template <bool ROWS> struct MoeOrder {
    static constexpr bool GATHER = ROWS;
    int nN, nwg, G, c; const int* cnt; const int* rowidx; size_t estride;
    __device__ void init(const int* cnt_, int N, int G_, int c_, const int* rowidx_, size_t estride_) { int acc = 0; cnt = cnt_;
#pragma unroll
        for (int e = 0; e < NE; ++e) acc += (cnt[e] + 255) / 256 * 256;
        nN = N / BM; nwg = (acc / 256) * nN; G = G_; c = c_; rowidx = rowidx_; estride = estride_; }
    __device__ bool next(int i, Unit& u) const { const long L = (long)i * G + c; if (L >= nwg) return false; u.pm = (int)(L / nN); u.pn = (int)(L % nN); int e = 0, acc = 0;
#pragma unroll
        for (int j = 0; j < NE - 1; ++j) { acc += (cnt[j] + 255) / 256 * 256; e += (u.pm * 256 >= acc) ? 1 : 0; }
        u.e = e; return true; }
    __device__ __forceinline__ const char* b_base(const Gemm& g, const Unit& u) const { return (const char*)g.Bt + (size_t)u.e * estride + (size_t)u.pn * ((size_t)BM * g.K * 2); }
    __device__ __forceinline__ int a_row(const Unit& u, int rr) const { return ROWS ? ld_coh(rowidx + u.pm * BM + rr) : u.pm * BM + rr; }
};

#ifdef CPU_EMU
typedef unsigned char* LdsPtr;
#else
#define PG8_LAS __attribute__((address_space(3)))
typedef PG8_LAS unsigned char* LdsPtr;
typedef short bf16x8 __attribute__((ext_vector_type(8)));
typedef unsigned u32x4 __attribute__((ext_vector_type(4)));
typedef int pg8_v4i __attribute__((ext_vector_type(4)));
typedef int pg8_v8i __attribute__((ext_vector_type(8)));
template <class Epi, class Sched, bool F8 = false>
__device__ __forceinline__ void gemm_phase(LdsPtr lds, const Gemm g, const Sched& S, const Epi& E, int wv_) {
    const int tid = tid_of(wv_), wid = wv_, lane = tid & 63, wr = wid >> 2, wc = wid & 3, fr = lane & 15, fq = lane >> 4;
    const int K = g.K, nt = K / BK;
    unsigned voffB[2]; int RA[2], CA[2];
#pragma unroll
    for (int i = 0; i < 2; ++i) { int R, C; stage_rc(tid * 16 + i * 8192, R, C); const int Rb = Epi::PERM ? ((R & ~31) + perm32(R & 31)) : R;
        RA[i] = R; CA[i] = C; voffB[i] = (unsigned)(Rb * K + C) * 2u; }
    const size_t kstep = (size_t)(BK * 2);
    const size_t hstep = (size_t)HALF * K * 2;
    const unsigned ldsw = (unsigned)wid * 1024u;
    const int aoff = F8 ? lds_byte(wr * 64 + fr, fq * 16) + ((fq & 1) << 4) : lds_byte(wr * 64 + fr, fq * 8), boff = F8 ? lds_byte(wc * 32 + fr, fq * 16) + ((fq & 1) << 4) : lds_byte(wc * 32 + fr, fq * 8);
    const int sc_both = (g.sc_w & 0xff) | ((g.sc_a & 0xff) << 8);
    const int koff = F8 ? (16 - ((fq & 1) << 5)) : 1024;
#define PG8_SA(b, h) (((b) * 2 + (h)) * HTB)
#define PG8_SB(b, h) ((4 + (b) * 2 + (h)) * HTB)
#define PG8_STAGE(bufoff, gbase, voff) do { _Pragma("unroll") for (int _i = 0; _i < 2; ++_i) \
        __builtin_amdgcn_global_load_lds((const unsigned*)((const char*)(gbase) + (voff)[_i]), (PG8_LAS unsigned*)(lds + (bufoff) + ldsw + _i * 8192), 16, 0, 0); } while (0)
#define PG8_LD8(dst, addr) do { const pg8_v4i lo_ = *(const PG8_LAS pg8_v4i*)(addr), hi_ = *(const PG8_LAS pg8_v4i*)((addr) + koff); dst = __builtin_shufflevector(lo_, hi_, 0, 1, 2, 3, 4, 5, 6, 7); } while (0)
#define PG8_LDA(dst, b, h) do { if constexpr (F8) { _Pragma("unroll") for (int m = 0; m < 4; ++m) PG8_LD8(dst##8[m], lds + PG8_SA(b, h) + aoff + m * 2048); } \
        else { _Pragma("unroll") for (int m = 0; m < 4; ++m) _Pragma("unroll") for (int k = 0; k < 2; ++k) dst[m][k] = *(const PG8_LAS bf16x8*)(lds + PG8_SA(b, h) + aoff + m * 2048 + k * koff); } } while (0)
#define PG8_LDB(dst, b, h) do { if constexpr (F8) { _Pragma("unroll") for (int n = 0; n < 2; ++n) PG8_LD8(dst##8[n], lds + PG8_SB(b, h) + boff + n * 2048); } \
        else { _Pragma("unroll") for (int n = 0; n < 2; ++n) _Pragma("unroll") for (int k = 0; k < 2; ++k) dst[n][k] = *(const PG8_LAS bf16x8*)(lds + PG8_SB(b, h) + boff + n * 2048 + k * koff); } } while (0)
#define PG8_MMA(ai, bj, At, Bt) do { __builtin_amdgcn_s_setprio(1); \
        if constexpr (F8) { _Pragma("unroll") for (int m = 0; m < 4; ++m) _Pragma("unroll") for (int n = 0; n < 2; ++n) \
            acc[ai][bj][m][n] = __builtin_amdgcn_mfma_scale_f32_16x16x128_f8f6f4(Bt##8[n], At##8[m], acc[ai][bj][m][n], 0, 0, 0, sc_both, 1, sc_both); } \
        else { _Pragma("unroll") for (int m = 0; m < 4; ++m) _Pragma("unroll") for (int n = 0; n < 2; ++n) _Pragma("unroll") for (int k = 0; k < 2; ++k) \
            acc[ai][bj][m][n] = __builtin_amdgcn_mfma_f32_16x16x32_bf16(Bt[n][k], At[m][k], acc[ai][bj][m][n], 0, 0, 0); } \
        __builtin_amdgcn_s_setprio(0); } while (0)
#define PG8_WAIT_V(n) asm volatile("s_waitcnt vmcnt(" #n ")" ::: "memory")
#define PG8_WAIT_L(n) asm volatile("s_waitcnt lgkmcnt(" #n ")" ::: "memory")
#define PG8_BAR __builtin_amdgcn_s_barrier()
#define PG8_SCHED __builtin_amdgcn_sched_barrier(0)
#define PG8_VOFFA(dst, U) do { _Pragma("unroll") for (int _h = 0; _h < 2; ++_h) _Pragma("unroll") for (int _i = 0; _i < 2; ++_i) \
        dst[_h][_i] = (unsigned)((size_t)S.a_row(U, _h * HALF + RA[_i]) * K + CA[_i]) * 2u; } while (0)
    Unit cur, nxt; int ui = 0;
    if (!S.next(0, cur)) return;
    f32x4 acc[2][2][4][2];
#pragma unroll
    for (int a = 0; a < 2; ++a)
#pragma unroll
        for (int b = 0; b < 2; ++b)
#pragma unroll
            for (int m = 0; m < 4; ++m)
#pragma unroll
                for (int n = 0; n < 2; ++n) acc[a][b][m][n] = (f32x4){0.f, 0.f, 0.f, 0.f};
    bf16x8 At[4][2], B0[2][2], B1[2][2];
    pg8_v8i At8[4], B08[2], B18[2];
    unsigned vA[2][2];
    PG8_VOFFA(vA, cur);
    const char* cA = (const char*)g.A; const char* cB = S.b_base(g, cur);
    PG8_STAGE(PG8_SB(0, 0), cB, voffB); PG8_STAGE(PG8_SB(0, 1), cB + hstep, voffB); PG8_STAGE(PG8_SA(0, 0), cA, vA[0]); PG8_STAGE(PG8_SA(0, 1), cA, vA[1]);
    if (wr == 1) PG8_BAR;
    PG8_WAIT_V(2); PG8_BAR;
    PG8_STAGE(PG8_SB(1, 0), cB + kstep, voffB); PG8_STAGE(PG8_SA(1, 0), cA + kstep, vA[0]); PG8_STAGE(PG8_SB(1, 1), cB + hstep + kstep, voffB);
    PG8_WAIT_V(6); PG8_BAR;
    for (;;) {
        const bool has_next = S.next(ui + 1, nxt);
        const char* nB = has_next ? S.b_base(g, nxt) : cB;
        for (int t = 0; t < nt; t += 2) {
            const bool last = (t == nt - 2);
            const char* a1 = cA + (size_t)(t + 1) * kstep;
            const char* a2 = last ? cA : cA + (size_t)(t + 2) * kstep; const char* b2 = last ? nB : cB + (size_t)(t + 2) * kstep;
            const char* a3 = a2 + kstep; const char* b3 = b2 + kstep;
            PG8_LDB(B0, 0, 0); PG8_LDB(B1, 0, 1); PG8_SCHED; PG8_LDA(At, 0, 0); PG8_STAGE(PG8_SA(1, 1), a1, vA[1]);
            if (last && has_next) { PG8_VOFFA(vA, nxt); }
            PG8_WAIT_V(8); PG8_WAIT_L(0); PG8_BAR; PG8_MMA(0, 0, At, B0); PG8_MMA(0, 1, At, B1); PG8_BAR; PG8_SCHED;
            PG8_LDA(At, 0, 1); PG8_STAGE(PG8_SB(0, 0), b2, voffB); PG8_STAGE(PG8_SB(0, 1), b2 + hstep, voffB); PG8_STAGE(PG8_SA(0, 0), a2, vA[0]);
            PG8_WAIT_V(8); PG8_WAIT_L(0); PG8_BAR; PG8_MMA(1, 0, At, B0); PG8_MMA(1, 1, At, B1); PG8_BAR; PG8_SCHED;
            PG8_LDB(B0, 1, 0); PG8_LDB(B1, 1, 1); PG8_SCHED; PG8_LDA(At, 1, 0); PG8_STAGE(PG8_SA(0, 1), a2, vA[1]);
            PG8_WAIT_V(8); PG8_WAIT_L(0); PG8_BAR; PG8_MMA(0, 0, At, B0); PG8_MMA(0, 1, At, B1); PG8_BAR; PG8_SCHED;
            PG8_LDA(At, 1, 1); PG8_STAGE(PG8_SB(1, 0), b3, voffB); PG8_STAGE(PG8_SB(1, 1), b3 + hstep, voffB); PG8_STAGE(PG8_SA(1, 0), a3, vA[0]);
            PG8_WAIT_V(8); PG8_WAIT_L(0); PG8_BAR; PG8_MMA(1, 0, At, B0); PG8_MMA(1, 1, At, B1); PG8_BAR; PG8_SCHED;
        }
        if (wr == 0) PG8_BAR;
        E(acc, cur, wr, wc, fr, fq);
        if (!has_next) break;
#pragma unroll
        for (int a = 0; a < 2; ++a)
#pragma unroll
            for (int b = 0; b < 2; ++b)
#pragma unroll
                for (int m = 0; m < 4; ++m)
#pragma unroll
                    for (int n = 0; n < 2; ++n) acc[a][b][m][n] = (f32x4){0.f, 0.f, 0.f, 0.f};
        cur = nxt; cB = nB; ++ui;
        if (wr == 1) PG8_BAR;
    }
    PG8_WAIT_V(0);
    PG8_BAR;
#undef PG8_SA
#undef PG8_SB
#undef PG8_STAGE
#undef PG8_LDA
#undef PG8_LDB
#undef PG8_MMA
#undef PG8_LD8
#undef PG8_WAIT_V
#undef PG8_WAIT_L
#undef PG8_BAR
#undef PG8_SCHED
#undef PG8_VOFFA
}
#endif
}

typedef f32x4 AccT[2][2][4][2];

struct EpiQKV {
    static constexpr bool PERM = false;
    bf16_t* O; const float* rope; bf16_t* VT; int pn0 = 0;
    __device__ __forceinline__ void operator()(const AccT& acc, const pg8::Unit& u, int wr, int wc, int fr, int fq) const {
        const int colt = (u.pn + pn0) * 256; const bool is_q = colt < COL_K, is_k = colt >= COL_K && colt < COL_V, is_v = colt >= COL_V && colt < COL_XR;
#pragma unroll
        for (int ai = 0; ai < 2; ++ai) {
            f32x4 rp[4][2];
            if (is_q || is_k) {
#pragma unroll
                for (int m = 0; m < 4; ++m) { const int r = u.pm * 256 + ai * 128 + wr * 64 + m * 16 + fr, t = r % NSEQ, pos = (wc & 1) ? (t % 64) : (t / 64);
                    rp[m][0] = *(const f32x4*)(rope + (pos * 16 + 4 * fq) * 2); rp[m][1] = *(const f32x4*)(rope + (pos * 16 + 4 * fq) * 2 + 4); }
#ifndef CPU_EMU
                asm volatile("" ::: "memory");
#endif
            }
#pragma unroll
            for (int m = 0; m < 4; ++m) {
                const int r = u.pm * 256 + ai * 128 + wr * 64 + m * 16 + fr; const bool lat = r < ML; const int t = r % NSEQ;
#pragma unroll
                for (int bj = 0; bj < 2; ++bj) {
                    const int cg = colt + bj * 128 + wc * 32;
                    f32x4 v0 = acc[ai][bj][m][0], v1 = acc[ai][bj][m][1];
                    if ((is_q || is_k) && lat) {
#pragma unroll
                        for (int j = 0; j < 4; ++j) { const float cs = rp[m][j >> 1][(j & 1) * 2], sn = rp[m][j >> 1][(j & 1) * 2 + 1]; const float a = v0[j], b = v1[j]; v0[j] = a * cs - b * sn; v1[j] = b * cs + a * sn; }
                    }
                    if (is_q) { v0 *= 0.125f; v1 *= 0.125f; }
                    bf16_t* rowp = O + (size_t)r * EVIN + cg + 4 * fq;
                    u32x2_t w0, w1; w0.x = pack2bf(v0[0], v0[1]); w0.y = pack2bf(v0[2], v0[3]); w1.x = pack2bf(v1[0], v1[1]); w1.y = pack2bf(v1[2], v1[3]);
                    *(u32x2_t*)rowp = w0; *(u32x2_t*)(rowp + 16) = w1;
                    if (is_v) {
                        const int bb = lat ? r / NSEQ : (r - ML) / NCTX, tt = lat ? t : (r - ML) % NCTX, k16 = tt & 15, kp = (k16 & 3) | ((k16 & 4) << 1) | ((k16 & 8) >> 1);
                        const int pos = (lat ? 128 : 128 + NSEQ + 128) + (tt & ~15) + kp, vc = cg - COL_V + 4 * fq;
                        bf16_t* vp = VT + ((size_t)bb * 256 + vc) * VT_T + pos;
#pragma unroll
                        for (int j = 0; j < 4; ++j) { vp[(size_t)j * VT_T] = f2bf(v0[j]); vp[(size_t)(16 + j) * VT_T] = f2bf(v1[j]); }
                    }
                }
            }
        }
    }
};
template <bool IN16, bool OUT16> struct EpiResidT {
    static constexpr bool PERM = false;
    const float* xin_lat; const float* xin_ctx; float* xout; const float* gate;
    __device__ __forceinline__ void operator()(const AccT& acc, const pg8::Unit& u, int wr, int wc, int fr, int fq) const {
        const int row0 = u.pm * 256, arow = row0 < ML ? row0 / NSEQ : NB; const float* gp = gate + (size_t)arow * ADA6;
        const int col0 = u.pn * 256 + wc * 32 + 4 * fq;
        f32x4 gv[2][2];
#pragma unroll
        for (int bj = 0; bj < 2; ++bj)
#pragma unroll
            for (int n = 0; n < 2; ++n) gv[bj][n] = *(const f32x4*)(gp + col0 + bj * 128 + n * 16);
#pragma unroll
        for (int ai = 0; ai < 2; ++ai) {
            f32x4 xi[4][2][2];
#pragma unroll
            for (int m = 0; m < 4; ++m) { const int r = row0 + ai * 128 + wr * 64 + m * 16 + fr;
                const size_t io = (r < ML ? (size_t)r * D : (size_t)(r - ML) * D) + col0; const float* ib = r < ML ? xin_lat : xin_ctx;
#pragma unroll
                for (int bj = 0; bj < 2; ++bj)
#pragma unroll
                    for (int n = 0; n < 2; ++n) {
                        if (IN16) { const u32x2_t t = *(const u32x2_t*)((const bf16_t*)ib + io + bj * 128 + n * 16); xi[m][bj][n] = unpack4bf(t.x, t.y); } else xi[m][bj][n] = *(const f32x4*)(ib + io + bj * 128 + n * 16); } }
#ifndef CPU_EMU
            asm volatile("" ::: "memory");
#endif
#pragma unroll
            for (int m = 0; m < 4; ++m) { const int r = row0 + ai * 128 + wr * 64 + m * 16 + fr; const size_t oo = (size_t)r * D + col0;
#pragma unroll
                for (int bj = 0; bj < 2; ++bj)
#pragma unroll
                    for (int n = 0; n < 2; ++n) { const f32x4 xo = xi[m][bj][n] + gv[bj][n] * acc[ai][bj][m][n];
                        if (OUT16) { u32x2_t t; t.x = pack2bf(xo[0], xo[1]); t.y = pack2bf(xo[2], xo[3]); *(u32x2_t*)((bf16_t*)xout + oo + bj * 128 + n * 16) = t; } else *(f32x4*)(xout + oo + bj * 128 + n * 16) = xo; } }
        }
    }
};
typedef EpiResidT<false, RES_BF16> EpiResid0;
typedef EpiResidT<RES_BF16, RES_BF16> EpiResid;
struct EpiBf16 {
    static constexpr bool PERM = true;
    bf16_t* O; int ldc;
    __device__ __forceinline__ void operator()(const AccT& acc, const pg8::Unit& u, int wr, int wc, int fr, int fq) const {
        const int col0 = u.pn * 256 + wc * 32 + 8 * fq;
#pragma unroll
        for (int ai = 0; ai < 2; ++ai)
#pragma unroll
            for (int m = 0; m < 4; ++m) { bf16_t* rowp = O + (size_t)(u.pm * 256 + ai * 128 + wr * 64 + m * 16 + fr) * ldc + col0;
#pragma unroll
                for (int bj = 0; bj < 2; ++bj) { const f32x4 v0 = acc[ai][bj][m][0], v1 = acc[ai][bj][m][1];
                    u32x4_t w; w.x = pack2bf(v0[0], v0[1]); w.y = pack2bf(v0[2], v0[3]); w.z = pack2bf(v1[0], v1[1]); w.w = pack2bf(v1[2], v1[3]);
                    *(u32x4_t*)(rowp + bj * 128) = w; } }
    }
};
#ifndef CPU_EMU
struct EpiY8 {
    static constexpr bool PERM = true;
    unsigned char* O; int ldc;
    __device__ __forceinline__ void operator()(const AccT& acc, const pg8::Unit& u, int wr, int wc, int fr, int fq) const {
        const int col0 = u.pn * 256 + wc * 32 + 8 * fq;
#pragma unroll
        for (int ai = 0; ai < 2; ++ai)
#pragma unroll
            for (int m = 0; m < 4; ++m) { unsigned char* rowp = O + (size_t)(u.pm * 256 + ai * 128 + wr * 64 + m * 16 + fr) * ldc + col0;
#pragma unroll
                for (int bj = 0; bj < 2; ++bj) { const f32x4 v0 = acc[ai][bj][m][0] * Y8_SCALE, v1 = acc[ai][bj][m][1] * Y8_SCALE;
                    u32x2_t w; w.x = pack4_fp8(v0[0], v0[1], v0[2], v0[3]); w.y = pack4_fp8(v1[0], v1[1], v1[2], v1[3]);
                    *(u32x2_t*)(rowp + bj * 128) = w; } }
    }
};
#endif
struct EpiGU {
    static constexpr bool PERM = true;
    bf16_t* O;
    __device__ __forceinline__ void operator()(const AccT& acc, const pg8::Unit& u, int wr, int wc, int fr, int fq) const {
        const int col0 = u.pn * 128 + wc * 32 + 8 * fq;
#pragma unroll
        for (int ai = 0; ai < 2; ++ai)
#pragma unroll
            for (int m = 0; m < 4; ++m) { bf16_t* rowp = O + (size_t)(u.pm * 256 + ai * 128 + wr * 64 + m * 16 + fr) * FF + col0;
                float o[8];
#pragma unroll
                for (int n = 0; n < 2; ++n)
#pragma unroll
                    for (int j = 0; j < 4; ++j) { const float gt = acc[ai][0][m][n][j], up = acc[ai][1][m][n][j]; o[n * 4 + j] = siluf_(gt) * up; }
                u32x4_t w; w.x = pack2bf(o[0], o[1]); w.y = pack2bf(o[2], o[3]); w.z = pack2bf(o[4], o[5]); w.w = pack2bf(o[6], o[7]);
                *(u32x4_t*)rowp = w; }
    }
};
#ifndef CPU_EMU
struct EpiGU8 {
    static constexpr bool PERM = true;
    unsigned char* O;
    __device__ __forceinline__ void operator()(const AccT& acc, const pg8::Unit& u, int wr, int wc, int fr, int fq) const {
        const int col0 = u.pn * 128 + wc * 32 + 8 * fq;
#pragma unroll
        for (int ai = 0; ai < 2; ++ai)
#pragma unroll
            for (int m = 0; m < 4; ++m) { unsigned char* rowp = O + (size_t)(u.pm * 256 + ai * 128 + wr * 64 + m * 16 + fr) * FF + col0;
                float o[8];
#pragma unroll
                for (int n = 0; n < 2; ++n)
#pragma unroll
                    for (int j = 0; j < 4; ++j) { const float gt = acc[ai][0][m][n][j], up = acc[ai][1][m][n][j]; o[n * 4 + j] = siluf_(gt) * up * ACT8_SCALE; }
                u32x2_t w; w.x = pack4_fp8(o[0], o[1], o[2], o[3]); w.y = pack4_fp8(o[4], o[5], o[6], o[7]);
                *(u32x2_t*)rowp = w; }
    }
};
#endif
struct EpiGLU {
    static constexpr bool PERM = true;
    const bf16_t* Z; bf16_t* O; const float* bias;
    __device__ __forceinline__ void operator()(const AccT& acc, const pg8::Unit& u, int wr, int wc, int fr, int fq) const {
        const int col0 = u.pn * 256 + wc * 32 + 8 * fq;
#pragma unroll
        for (int ai = 0; ai < 2; ++ai)
#pragma unroll
            for (int m = 0; m < 4; ++m) { const size_t ro = (size_t)(u.pm * 256 + ai * 128 + wr * 64 + m * 16 + fr) * S5W + col0;
#pragma unroll
                for (int bj = 0; bj < 2; ++bj) { const u32x4_t zz = *(const u32x4_t*)(Z + ro + bj * 128); const unsigned zw[4] = {zz.x, zz.y, zz.z, zz.w}; float o[8];
#pragma unroll
                    for (int n = 0; n < 2; ++n)
#pragma unroll
                        for (int j = 0; j < 4; ++j) { const int q = n * 4 + j; const float zv = __uint_as_float((q & 1) ? (zw[q >> 1] & 0xffff0000u) : (zw[q >> 1] << 16));
                            o[q] = zv * sigmoidf_(acc[ai][bj][m][n][j] + bias[col0 + bj * 128 + q]); }
                    u32x4_t w; w.x = pack2bf(o[0], o[1]); w.y = pack2bf(o[2], o[3]); w.z = pack2bf(o[4], o[5]); w.w = pack2bf(o[6], o[7]);
                    *(u32x4_t*)(O + ro + bj * 128) = w; } }
    }
};

#ifndef CPU_EMU
struct EpiGLU8 {
    static constexpr bool PERM = true;
    const unsigned char* Z; unsigned char* O; const float* bias;
    __device__ __forceinline__ void operator()(const AccT& acc, const pg8::Unit& u, int wr, int wc, int fr, int fq) const {
        const int col0 = u.pn * 256 + wc * 32 + 8 * fq;
        u32x2_t zall[2][4][2]; f32x4 bv[2][2];
#pragma unroll
        for (int bj = 0; bj < 2; ++bj)
#pragma unroll
            for (int n = 0; n < 2; ++n) bv[bj][n] = *(const f32x4*)(bias + col0 + bj * 128 + n * 4);
#pragma unroll
        for (int ai = 0; ai < 2; ++ai)
#pragma unroll
            for (int m = 0; m < 4; ++m) { const size_t ro = (size_t)(u.pm * 256 + ai * 128 + wr * 64 + m * 16 + fr) * S5W + col0;
#pragma unroll
                for (int bj = 0; bj < 2; ++bj) zall[ai][m][bj] = *(const u32x2_t*)(Z + ro + bj * 128); }
        asm volatile("" ::: "memory");
#pragma unroll
        for (int ai = 0; ai < 2; ++ai)
#pragma unroll
            for (int m = 0; m < 4; ++m) { const size_t ro = (size_t)(u.pm * 256 + ai * 128 + wr * 64 + m * 16 + fr) * S5W + col0;
#pragma unroll
                for (int bj = 0; bj < 2; ++bj) { const u32x2_t zz = zall[ai][m][bj]; float o[8];
#pragma unroll
                    for (int n = 0; n < 2; ++n) { const int zw = (int)(n ? zz.y : zz.x);
                        const float z0 = __builtin_amdgcn_cvt_f32_fp8(zw, 0), z1 = __builtin_amdgcn_cvt_f32_fp8(zw, 1), z2 = __builtin_amdgcn_cvt_f32_fp8(zw, 2), z3 = __builtin_amdgcn_cvt_f32_fp8(zw, 3); const float zv[4] = {z0, z1, z2, z3};
#pragma unroll
                        for (int j = 0; j < 4; ++j) { const int q = n * 4 + j; o[q] = zv[j] * (S8_SCALE / Z8_SCALE) * sigmoidf_(acc[ai][bj][m][n][j] + bv[bj][n][j]); } }
                    u32x2_t w; w.x = pack4_fp8(o[0], o[1], o[2], o[3]); w.y = pack4_fp8(o[4], o[5], o[6], o[7]);
                    *(u32x2_t*)(O + ro + bj * 128) = w; } }
    }
};
#endif

enum { G_IN0 = 0, G_OUT0, G_GU, G_DN, G_IN1, G_GLU, G_OUT1, G_GU8, G_DN8, G_IN18, G_GLU8, G_OUT18, G_IN08, G_OUT08, G_IN0SPLIT };
#ifdef CPU_EMU
namespace pg8 {
template <class Epi, class Sched> void gemm_phase(LdsPtr, const Gemm g, const Sched& S, const Epi& E, int) {
    Unit u; std::vector<float> C(256 * 256), af(g.K), bfv((size_t)256 * g.K);
    for (int i = 0; S.next(i, u); ++i) {
        const bf16_t* Bb = (const bf16_t*)S.b_base(g, u);
        for (size_t q = 0; q < (size_t)256 * g.K; ++q) bfv[q] = bf2f(Bb[q]);
        for (int r = 0; r < 256; ++r) { const bf16_t* a = g.A + (size_t)S.a_row(u, r) * g.K; for (int k = 0; k < g.K; ++k) af[k] = bf2f(a[k]);
            for (int cc = 0; cc < 256; ++cc) { const float* bp = &bfv[(size_t)cc * g.K]; float s = 0.f; for (int k = 0; k < g.K; ++k) s += af[k] * bp[k]; C[r * 256 + cc] = s; } }
        for (int tid = 0; tid < 512; ++tid) { const int wid = tid >> 6, lane = tid & 63, wr = wid >> 2, wc = wid & 3, fr = lane & 15, fq = lane >> 4;
            f32x4 acc[2][2][4][2];
            for (int ai = 0; ai < 2; ++ai) for (int bj = 0; bj < 2; ++bj) for (int m = 0; m < 4; ++m) for (int n = 0; n < 2; ++n) for (int j = 0; j < 4; ++j) {
                const int r = 128 * ai + 64 * wr + 16 * m + fr, cc = Epi::PERM ? 128 * bj + 32 * wc + 8 * fq + 4 * n + j : 128 * bj + 32 * wc + 16 * n + 4 * fq + j;
                acc[ai][bj][m][n][j] = C[r * 256 + cc]; }
            E(acc, u, wr, wc, fr, fq); }
    }
}
}
#endif
#ifndef CPU_EMU
template <class Sched> __device__ __forceinline__ void gemm_stagger(const Sched& S, int tile_us) {
    const int rem = S.nwg % S.G; if (rem == 0 || S.c < rem) return;
    const int units = (int)((long)(S.c - rem) * tile_us * 4 / (5 * (S.G - rem)));
    for (int i = 0; i < units; ++i) __builtin_amdgcn_s_sleep(32);
}
#else
template <class Sched> void gemm_stagger(const Sched&, int) {}
#endif
template <int WHICH> __device__ __forceinline__ void run_gemm(const Params& p, int l, pg8::LdsPtr lds, int G, int c, int wv_ = 0) {
    unsigned char* ws = p.ws; pg8::Gemm g;
    if constexpr (WHICH == G_IN0) { g.A = (const bf16_t*)(ws + WS_H); g.Bt = (const bf16_t*)(ws + WS_WT_IN0); g.M = MT; g.N = EVIN; g.K = D;
        pg8::StaticOrder S; S.init(g.M, g.N, G, c); EpiQKV E; E.O = (bf16_t*)(ws + WS_QKV); E.rope = (const float*)(ws + WS_ROPE); E.VT = (bf16_t*)(ws + WS_VT); pg8::gemm_phase(lds, g, S, E, wv_); }
    else if constexpr (WHICH == G_OUT0) { g.A = (const bf16_t*)(ws + WS_MIX); g.Bt = (const bf16_t*)(ws + WS_WT_OUT0); g.M = MT; g.N = D; g.K = D;
        pg8::StaticOrder S; S.init(g.M, g.N, G, c); EpiResid0 E; E.xin_lat = p.x; E.xin_ctx = p.ctx; E.xout = (float*)(ws + WS_XRES); E.gate = (const float*)(ws + WS_ADA) + 2 * D; pg8::gemm_phase(lds, g, S, E, wv_); }
    else if constexpr (WHICH == G_GU) { g.A = (const bf16_t*)(ws + WS_H); g.Bt = (const bf16_t*)(ws + WS_WT_GU) + (size_t)l * NE * 2 * FF * D; g.M = NBLK * 256; g.N = 2 * FF; g.K = D;
        pg8::MoeOrder<true> S; S.init((const int*)(ws + WS_CNT) + l * 64, g.N, G, c, (const int*)(ws + WS_ROWIDX), (size_t)2 * FF * D * 2); EpiGU E; E.O = (bf16_t*)(ws + WS_ACT); pg8::gemm_phase(lds, g, S, E, wv_); }
    else if constexpr (WHICH == G_DN) { g.A = (const bf16_t*)(ws + WS_ACT); g.Bt = (const bf16_t*)(ws + WS_WT_DN) + (size_t)l * NE * D * FF; g.M = NBLK * 256; g.N = D; g.K = FF;
        pg8::MoeOrder<false> S; S.init((const int*)(ws + WS_CNT) + l * 64, g.N, G, c, nullptr, (size_t)D * FF * 2); EpiBf16 E; E.O = (bf16_t*)(ws + WS_YBUF); E.ldc = D; pg8::gemm_phase(lds, g, S, E, wv_); }
#ifndef CPU_EMU
    else if constexpr (WHICH == G_IN0SPLIT) {
        { g.A = (const bf16_t*)(ws + WS_H); g.Bt = (const bf16_t*)(ws + WS_WT_IN0) + (size_t)IN0_NQ * D; g.M = MT; g.N = EVIN - IN0_NQ; g.K = D;
          pg8::StaticOrder S; S.init(g.M, g.N, G, c); EpiBf16 E; E.O = (bf16_t*)(ws + WS_QKV) + IN0_NQ; E.ldc = EVIN; pg8::gemm_phase(lds, g, S, E, wv_); }
        const int extra = ((MT / 256) * ((EVIN - IN0_NQ) / 256)) % G, G2 = G - extra;
        if (c >= extra) { pg8::Gemm g2; g2.A = (const bf16_t*)(ws + WS_H8); g2.Bt = (const bf16_t*)(ws + WS_WT_IN0); g2.M = MT; g2.N = IN0_NQ; g2.K = D / 2; g2.sc_w = W8_E8M0; g2.sc_a = ONE_E8M0;
          pg8::StaticOrder S; S.init(g2.M, g2.N, G2, c - extra); EpiQKV E; E.O = (bf16_t*)(ws + WS_QKV); E.rope = (const float*)(ws + WS_ROPE); E.VT = (bf16_t*)(ws + WS_VT); pg8::gemm_phase<EpiQKV, pg8::StaticOrder, true>(lds, g2, S, E, wv_); } }
    else if constexpr (WHICH == G_IN08) { g.A = (const bf16_t*)(ws + WS_H); g.Bt = (const bf16_t*)(ws + WS_WT_IN0); g.M = MT; g.N = EVIN; g.K = D / 2; g.sc_w = W8_E8M0; g.sc_a = ONE_E8M0;
        pg8::StaticOrder S; S.init(g.M, g.N, G, c); EpiQKV E; E.O = (bf16_t*)(ws + WS_QKV); E.rope = (const float*)(ws + WS_ROPE); E.VT = (bf16_t*)(ws + WS_VT); pg8::gemm_phase<EpiQKV, pg8::StaticOrder, true>(lds, g, S, E, wv_); }
    else if constexpr (WHICH == G_OUT08) { g.A = (const bf16_t*)(ws + WS_MIX); g.Bt = (const bf16_t*)(ws + WS_WT_OUT0); g.M = MT; g.N = D; g.K = D / 2; g.sc_w = W8_E8M0; g.sc_a = ONE_E8M0;
        pg8::StaticOrder S; S.init(g.M, g.N, G, c); gemm_stagger(S, 30); EpiResid0 E; E.xin_lat = p.x; E.xin_ctx = p.ctx; E.xout = (float*)(ws + WS_XRES); E.gate = (const float*)(ws + WS_ADA) + 2 * D; pg8::gemm_phase<EpiResid0, pg8::StaticOrder, true>(lds, g, S, E, wv_); }
    else if constexpr (WHICH == G_IN18) { g.A = (const bf16_t*)(ws + WS_H); g.Bt = (const bf16_t*)(ws + WS_WT_IN1); g.M = MT; g.N = S5W; g.K = D / 2; g.sc_w = W8_E8M0; g.sc_a = ONE_E8M0;
        pg8::StaticOrder S; S.init(g.M, g.N, G, c); gemm_stagger(S, 16); EpiBf16 E; E.O = (bf16_t*)(ws + WS_U1); E.ldc = S5W; pg8::gemm_phase<EpiBf16, pg8::StaticOrder, true>(lds, g, S, E, wv_); }
    else if constexpr (WHICH == G_GLU8) { g.A = (const bf16_t*)(ws + WS_Z); g.Bt = (const bf16_t*)(ws + WS_WT_GLU); g.M = ML; g.N = S5W; g.K = S5W / 2; g.sc_w = W8_E8M0; g.sc_a = Z8_E8M0;
        pg8::StaticOrder S; S.init(g.M, g.N, G, c); EpiGLU8 E; E.Z = ws + WS_Z; E.O = ws + WS_S; E.bias = p.s5_glu_b; pg8::gemm_phase<EpiGLU8, pg8::StaticOrder, true>(lds, g, S, E, wv_); }
    else if constexpr (WHICH == G_OUT18) { g.A = (const bf16_t*)(ws + WS_S); g.Bt = (const bf16_t*)(ws + WS_WT_OUT1); g.M = ML; g.N = D; g.K = S5W / 2; g.sc_w = W8_E8M0; g.sc_a = S8_E8M0;
        pg8::StaticOrder S; S.init(g.M, g.N, G, c); EpiResid E; E.xin_lat = (const float*)(ws + WS_XRES); E.xin_ctx = (const float*)(ws + WS_XRES + (size_t)ML * D * (RES_BF16 ? 2 : 4)); E.xout = (float*)(ws + WS_XRES);
        E.gate = (const float*)(ws + WS_ADA) + (size_t)NADA * ADA6 + 2 * D; pg8::gemm_phase<EpiResid, pg8::StaticOrder, true>(lds, g, S, E, wv_); }
    else if constexpr (WHICH == G_GU8) { g.A = (const bf16_t*)(ws + WS_H); g.Bt = (const bf16_t*)(ws + WS_WT_GU + (size_t)l * NE * 2 * FF * D * 2); g.M = NBLK * 256; g.N = 2 * FF; g.K = D / 2; g.sc_w = W8_E8M0; g.sc_a = ONE_E8M0;
        pg8::MoeOrder<true> S; S.init((const int*)(ws + WS_CNT) + l * 64, g.N, G, c, (const int*)(ws + WS_ROWIDX), (size_t)2 * FF * D); gemm_stagger(S, 20); EpiGU8 E; E.O = ws + WS_ACT; pg8::gemm_phase<EpiGU8, pg8::MoeOrder<true>, true>(lds, g, S, E, wv_); }
    else if constexpr (WHICH == G_DN8) { g.A = (const bf16_t*)(ws + WS_ACT); g.Bt = (const bf16_t*)(ws + WS_WT_DN + (size_t)l * NE * D * FF * 2); g.M = NBLK * 256; g.N = D; g.K = FF / 2; g.sc_w = W8_E8M0; g.sc_a = ACT8_E8M0;
        pg8::MoeOrder<false> S; S.init((const int*)(ws + WS_CNT) + l * 64, g.N, G, c, nullptr, (size_t)D * FF); gemm_stagger(S, 13);
        if constexpr (Y8) { EpiY8 E; E.O = ws + WS_YBUF; E.ldc = D; pg8::gemm_phase<EpiY8, pg8::MoeOrder<false>, true>(lds, g, S, E, wv_); }
        else { EpiBf16 E; E.O = (bf16_t*)(ws + WS_YBUF); E.ldc = D; pg8::gemm_phase<EpiBf16, pg8::MoeOrder<false>, true>(lds, g, S, E, wv_); } }
#endif
    else if constexpr (WHICH == G_IN1) { g.A = (const bf16_t*)(ws + WS_H); g.Bt = (const bf16_t*)(ws + WS_WT_IN1); g.M = MT; g.N = S5W; g.K = D;
        pg8::StaticOrder S; S.init(g.M, g.N, G, c); EpiBf16 E; E.O = (bf16_t*)(ws + WS_U1); E.ldc = S5W; pg8::gemm_phase(lds, g, S, E, wv_); }
    else if constexpr (WHICH == G_GLU) { g.A = (const bf16_t*)(ws + WS_Z); g.Bt = (const bf16_t*)(ws + WS_WT_GLU); g.M = ML; g.N = S5W; g.K = S5W;
        pg8::StaticOrder S; S.init(g.M, g.N, G, c); EpiGLU E; E.Z = (const bf16_t*)(ws + WS_Z); E.O = (bf16_t*)(ws + WS_S); E.bias = p.s5_glu_b; pg8::gemm_phase(lds, g, S, E, wv_); }
    else { g.A = (const bf16_t*)(ws + WS_S); g.Bt = (const bf16_t*)(ws + WS_WT_OUT1); g.M = ML; g.N = D; g.K = S5W;
        pg8::StaticOrder S; S.init(g.M, g.N, G, c); EpiResid E; E.xin_lat = (const float*)(ws + WS_XRES); E.xin_ctx = (const float*)(ws + WS_XRES + (size_t)ML * D * (RES_BF16 ? 2 : 4)); E.xout = (float*)(ws + WS_XRES);
        E.gate = (const float*)(ws + WS_ADA) + (size_t)NADA * ADA6 + 2 * D; pg8::gemm_phase(lds, g, S, E, wv_); }
}
#ifndef CPU_EMU

#define XB_TMO      128
#define XB_XCNT(j)  (256  + 64 * (j))
#define XB_XSUB(j)  (1280 + 64 * (j))
#define XB_XGEN(j)  (2304 + 64 * (j))
#define XB_TOP      3328
#define XB_TOPGEN   3392
#define XCD_BAR_WORDS 3456
#define XB_SPIN_CAP (1u << 24)

__device__ __forceinline__ unsigned xb_ld(unsigned* p)              { return __hip_atomic_load(p, __ATOMIC_RELAXED, __HIP_MEMORY_SCOPE_AGENT); }
__device__ __forceinline__ unsigned xb_add(unsigned* p, unsigned v) { return __hip_atomic_fetch_add(p, v, __ATOMIC_RELAXED, __HIP_MEMORY_SCOPE_AGENT); }
__device__ __forceinline__ unsigned xb_xcc_id() { return (unsigned)__builtin_amdgcn_s_getreg((3 << 11) | 20) & 0xFu; }
#define XB_SPIN(cond, bar) do { unsigned _sp = 0; while (cond) { __builtin_amdgcn_s_sleep(1); \
    if ((++_sp & 255u) == 0u) { if (xb_ld(&(bar)[XB_TMO])) break; if (_sp > XB_SPIN_CAP) { atomicAdd(&(bar)[XB_TMO], 1u); break; } } } } while (0)

struct XcdBarrier {
    unsigned* bar; unsigned x;
    volatile LAS unsigned* st;
};

__device__ __forceinline__ XcdBarrier xcd_barrier_post(unsigned* bar, volatile LAS unsigned* st, int wv_) {
    XcdBarrier b; b.bar = bar; b.x = xb_xcc_id(); b.st = st;
    if (tid_of(wv_) == 0) (void)xb_add(&bar[XB_XCNT(b.x)], 1u);
    return b;
}
__device__ __forceinline__ void xcd_barrier_complete(unsigned* bar, unsigned x, unsigned& nloc, unsigned& nx) {
    const unsigned G = gridDim.x * gridDim.y * gridDim.z;
    unsigned sum, cnt, mine, sp = 0u;
    for (;;) {
        sum = 0u; cnt = 0u; mine = 0u;
#pragma unroll
        for (unsigned j = 0; j < 16; ++j) { const unsigned c = xb_ld(&bar[XB_XCNT(j)]); sum += c; cnt += (c > 0u) ? 1u : 0u; mine = (j == x) ? c : mine; }
        if (sum == G) break;
        __builtin_amdgcn_s_sleep(1);
        if ((++sp & 255u) == 0u) { if (xb_ld(&bar[XB_TMO])) break; if (sp > XB_SPIN_CAP) { atomicAdd(&bar[XB_TMO], 1u); break; } }
    }
    nloc = mine > 0u ? mine : 1u; nx = cnt > 0u ? cnt : 1u;
}

__device__ __forceinline__ void xcd_barrier(const XcdBarrier& b, int wv_) {
    asm volatile("s_waitcnt vmcnt(0)" ::: "memory");
    __syncthreads();
    if (tid_of(wv_) == 0) {
        unsigned* bar = b.bar;
        __builtin_amdgcn_s_waitcnt(0);
        unsigned nloc = b.st[0], nx = b.st[1];
        if (nloc == 0u) { xcd_barrier_complete(bar, b.x, nloc, nx); b.st[0] = nloc; b.st[1] = nx; }
        const unsigned old = xb_add(&bar[XB_XSUB(b.x)], 1u);
        const unsigned gen = old / nloc;
        if (old + 1u == (gen + 1u) * nloc) {
            __builtin_amdgcn_fence(__ATOMIC_RELEASE, "agent");
            asm volatile("s_waitcnt vmcnt(0)" ::: "memory");
            const unsigned og = xb_add(&bar[XB_TOP], 1u);
            const unsigned tg = og / nx;
            if (og + 1u == (tg + 1u) * nx) xb_add(&bar[XB_TOPGEN], 1u);
            else XB_SPIN(xb_ld(&bar[XB_TOPGEN]) == tg, bar);
            __builtin_amdgcn_fence(__ATOMIC_ACQUIRE, "agent");
            xb_add(&bar[XB_XGEN(b.x)], 1u);
            asm volatile("s_waitcnt vmcnt(0)" ::: "memory");
        } else {
            XB_SPIN(xb_ld(&bar[XB_XGEN(b.x)]) == gen, bar);
            __builtin_amdgcn_fence(__ATOMIC_ACQUIRE, "agent");
            asm volatile("s_waitcnt vmcnt(0)" ::: "memory");
        }
    }
    __syncthreads();
}


#define GT ((long)blockIdx.x * blockDim.x + threadIdx.x)
#define GN ((long)gridDim.x * blockDim.x)
constexpr int MEGA_LDS = 147456;
__device__ __forceinline__ long gt_of(int wv) { return (long)blockIdx.x * 512 + tid_of(wv); }
__global__ void __launch_bounds__(512, 2) k_mega(Params p) {
    extern __shared__ __attribute__((aligned(16))) unsigned char shm[];
    volatile LAS unsigned* st = (volatile LAS unsigned*)(shm + MEGA_LDS - 64);
    const int WV = __builtin_amdgcn_readfirstlane((int)threadIdx.x >> 6);
    if (tid_of(WV) == 0) { st[0] = 0u; st[1] = 0u; st[2] = 0u; st[3] = 0u; }
    __syncthreads();
    const XcdBarrier bar = xcd_barrier_post((unsigned*)(p.ws + WS_BAR), st, WV);
    const long gn = (long)gridDim.x * 512; const int G = (int)gridDim.x, c = (int)blockIdx.x; const pg8::LdsPtr lds = (pg8::LdsPtr)shm;
#define gt gt_of(WV)
    ph_ada(p, (float*)shm, c, G, WV); ph_tables(p, gt, gn); ph_convert(p, (float*)shm, CVT_TILES, -1, WV);
    xcd_barrier(bar, WV);
    ph_norm_fast<0>(p, 0, MT, c * 8 + WV, G * 8, WV);
    xcd_barrier(bar, WV);
    run_gemm<IN0_FP8 ? G_IN08 : (IN0QKV_FP8 ? G_IN0SPLIT : G_IN0)>(p, 0, lds, G, c, WV);
    xcd_barrier(bar, WV);
    ph_attn_fast(p, (LAS unsigned char*)shm, c, G, WV);
    { constexpr int ATT_UNITS = NB * 4 * (NSEQ / 128 + NCTX / 128); const int extra = ATT_UNITS % G;
      if (extra * 2 < G) { if (c >= extra) ph_conv_fast(p, (long)(c - extra) * 512 + tid_of(WV), (long)(G - extra) * 512); } else ph_conv_fast(p, gt, gn); }
    xcd_barrier(bar, WV);
    ph_lru_fast<1>(p, (LAS unsigned char*)shm, c * 8 + WV, G * 8, WV);
    xcd_barrier(bar, WV);
    ph_lru_fast<2>(p, (LAS unsigned char*)shm, c * 8 + WV, G * 8, WV);
    xcd_barrier(bar, WV);
    run_gemm<OUT0_FP8 ? G_OUT08 : G_OUT0>(p, 0, lds, G, c, WV);
    xcd_barrier(bar, WV);
    ph_router_fast<MOE0_FP8>(p, 0, MT, (LAS unsigned char*)shm, c, G, WV);
    xcd_barrier(bar, WV);
    ph_dispatch_fast(p, 0, MT, (LAS unsigned char*)shm, c, G, WV);
    xcd_barrier(bar, WV);
    run_gemm<MOE0_FP8 ? G_GU8 : G_GU>(p, 0, lds, G, c, WV);
    xcd_barrier(bar, WV);
    run_gemm<MOE0_FP8 ? G_DN8 : G_DN>(p, 0, lds, G, c, WV);
    xcd_barrier(bar, WV);
    ph_norm_fast<1>(p, 1, MT, c * 8 + WV, G * 8, WV);
    xcd_barrier(bar, WV);
    run_gemm<DENSE1_FP8 ? G_IN18 : G_IN1>(p, 1, lds, G, c, WV);
    xcd_barrier(bar, WV);
    ph_s5_fast<1>(p, (LAS unsigned char*)shm, c * 8 + WV, G * 8, WV);
    xcd_barrier(bar, WV);
    ph_s5_fast<2>(p, (LAS unsigned char*)shm, c * 8 + WV, G * 8, WV);
    xcd_barrier(bar, WV);
    run_gemm<DENSE1_FP8 ? G_GLU8 : G_GLU>(p, 1, lds, G, c, WV);
    xcd_barrier(bar, WV);
    run_gemm<DENSE1_FP8 ? G_OUT18 : G_OUT1>(p, 1, lds, G, c, WV);
    xcd_barrier(bar, WV);
    ph_router_fast<MOE1_FP8>(p, 1, ML, (LAS unsigned char*)shm, c, G, WV);
    xcd_barrier(bar, WV);
    ph_dispatch_fast(p, 1, ML, (LAS unsigned char*)shm, c, G, WV);
    xcd_barrier(bar, WV);
    run_gemm<MOE1_FP8 ? G_GU8 : G_GU>(p, 1, lds, G, c, WV);
    xcd_barrier(bar, WV);
    run_gemm<MOE1_FP8 ? G_DN8 : G_DN>(p, 1, lds, G, c, WV);
    xcd_barrier(bar, WV);
    ph_norm_fast<2>(p, 1, ML, c * 8 + WV, G * 8, WV);
#undef gt
}

#ifdef MK_MULTI
__global__ void __launch_bounds__(512, 2) k_prologue(Params p) {
    extern __shared__ __attribute__((aligned(16))) unsigned char shm[];
    ph_ada(p, (float*)shm, blockIdx.x, gridDim.x, (int)threadIdx.x >> 6); ph_tables(p, GT, GN); ph_convert(p, (float*)shm, CVT_TILES, -1, (int)threadIdx.x >> 6);
}
template <int WHICH> __global__ void __launch_bounds__(512, 2) k_gemm(Params p, int l) {
    extern __shared__ __attribute__((aligned(16))) unsigned char shm[];
    run_gemm<WHICH>(p, l, (pg8::LdsPtr)shm, (int)gridDim.x, (int)blockIdx.x, __builtin_amdgcn_readfirstlane((int)threadIdx.x >> 6));
}
__global__ void __launch_bounds__(512, 2) k_norm(Params p, int l, int rows) { ph_norm(p, l, rows, GT, GN); }
__global__ void __launch_bounds__(512, 2) k_conv(Params p) { ph_conv(p, GT, GN); }
__global__ void __launch_bounds__(512, 2) k_lru(Params p) { ph_lru(p, GT, GN); }
__global__ void __launch_bounds__(512, 2) k_attn(Params p) { ph_attn(p, GT, GN); }
__global__ void __launch_bounds__(512, 2) k_router(Params p, int l, int rows) { ph_router(p, l, rows, GT, GN); }
__global__ void __launch_bounds__(512, 2) k_dispatch(Params p, int l, int rows) { ph_dispatch(p, l, rows, GT, GN); }
__global__ void __launch_bounds__(512, 2) k_combine(Params p, int l, int rows) { ph_combine(p, l, rows, GT, GN); }
__global__ void __launch_bounds__(512, 2) k_s5(Params p) { ph_s5(p, GT, GN); }
__global__ void __launch_bounds__(512, 2) k_final(Params p) { ph_final(p, GT, GN); }

#endif
static Params make_params(void* const* d_in, void* d_out, void* d_ws) {
    Params p{}; const float* const* in = (const float* const*)d_in;
    p.x = in[0]; p.c = in[1]; p.ctx = in[2]; p.c_ctx = in[3]; p.ada_w = in[4]; p.ada_b = in[5]; p.norm_mix = in[6]; p.norm_ffn = in[7]; p.norm_final = in[8];
    p.ev_w_in = in[9]; p.ev_w_out = in[10]; p.attn_sink = in[11]; p.lru_conv_w = in[12]; p.lru_conv_b = in[13]; p.lru_lam = in[14]; p.lru_wa = in[15]; p.lru_ba = in[16]; p.lru_wi = in[17]; p.lru_bi = in[18];
    p.od_w_in = in[19]; p.s5_lam_re = in[20]; p.s5_lam_im = in[21]; p.s5_log_step = in[22]; p.s5_b_re = in[23]; p.s5_b_im = in[24]; p.s5_c_re = in[25]; p.s5_c_im = in[26]; p.s5_d = in[27];
    p.s5_glu_w = in[28]; p.s5_glu_b = in[29]; p.od_w_out = in[30]; p.router_w = in[31]; p.router_b = in[32]; p.moe_w_gate = in[33]; p.moe_w_up = in[34]; p.moe_w_down = in[35];
    p.out = (float*)d_out; p.ws = (unsigned char*)d_ws; return p;
}

extern "C" void kernel_launch(void* const* d_in, const int* in_sizes, int n_in, void* d_out, int out_size, void* d_ws, size_t ws_size, hipStream_t stream) {
    if (n_in != 36 || ws_size < WS_END || out_size != ML * D) { fprintf(stderr, "kernel_launch: unexpected shapes (n_in %d, out %d, ws %zu < %zu)\n", n_in, out_size, ws_size, (size_t)WS_END); return; }
#ifdef MK_MULTI
    static bool attr_done = false;
    constexpr int GLDS = pg8::STAGE_BYTES;
    if (!attr_done) {
        (void)hipFuncSetAttribute((const void*)k_gemm<G_IN0>, hipFuncAttributeMaxDynamicSharedMemorySize, GLDS); (void)hipFuncSetAttribute((const void*)k_gemm<G_OUT0>, hipFuncAttributeMaxDynamicSharedMemorySize, GLDS);
        (void)hipFuncSetAttribute((const void*)k_gemm<G_GU>, hipFuncAttributeMaxDynamicSharedMemorySize, GLDS); (void)hipFuncSetAttribute((const void*)k_gemm<G_DN>, hipFuncAttributeMaxDynamicSharedMemorySize, GLDS);
        (void)hipFuncSetAttribute((const void*)k_gemm<G_IN1>, hipFuncAttributeMaxDynamicSharedMemorySize, GLDS); (void)hipFuncSetAttribute((const void*)k_gemm<G_GLU>, hipFuncAttributeMaxDynamicSharedMemorySize, GLDS);
        (void)hipFuncSetAttribute((const void*)k_gemm<G_OUT1>, hipFuncAttributeMaxDynamicSharedMemorySize, GLDS);
        attr_done = true;
    }
    const Params p = make_params(d_in, d_out, d_ws);
    (void)hipMemsetAsync(d_ws, 0, CTL_BYTES, stream);
    const dim3 blk(512); const int NG = 256, NW = 1024;
    k_prologue<<<NW, blk, (ADA_LDS_BYTES > CVT_LDS_BYTES + 16 ? ADA_LDS_BYTES : CVT_LDS_BYTES + 16), stream>>>(p);
    k_norm<<<NW, blk, 0, stream>>>(p, 0, MT);
    k_gemm<G_IN0><<<NG, blk, GLDS, stream>>>(p, 0);
    k_attn<<<NW, blk, 0, stream>>>(p);
    k_conv<<<NW, blk, 0, stream>>>(p);
    k_lru<<<NW, blk, 0, stream>>>(p);
    k_gemm<G_OUT0><<<NG, blk, GLDS, stream>>>(p, 0);
    k_router<<<NW, blk, 0, stream>>>(p, 0, MT);
    k_dispatch<<<NW, blk, 0, stream>>>(p, 0, MT);
    k_gemm<G_GU><<<NG, blk, GLDS, stream>>>(p, 0);
    k_gemm<G_DN><<<NG, blk, GLDS, stream>>>(p, 0);
    k_combine<<<NW, blk, 0, stream>>>(p, 0, MT);
    k_norm<<<NW, blk, 0, stream>>>(p, 1, MT);
    k_gemm<G_IN1><<<NG, blk, GLDS, stream>>>(p, 1);
    k_s5<<<NW, blk, 0, stream>>>(p);
    k_gemm<G_GLU><<<NG, blk, GLDS, stream>>>(p, 1);
    k_gemm<G_OUT1><<<NG, blk, GLDS, stream>>>(p, 1);
    k_router<<<NW, blk, 0, stream>>>(p, 1, ML);
    k_dispatch<<<NW, blk, 0, stream>>>(p, 1, ML);
    k_gemm<G_GU><<<NG, blk, GLDS, stream>>>(p, 1);
    k_gemm<G_DN><<<NG, blk, GLDS, stream>>>(p, 1);
    k_combine<<<NW, blk, 0, stream>>>(p, 1, ML);
    k_final<<<NW, blk, 0, stream>>>(p);
#else
    static int grid = 0;
    if (!grid) {
        int dev = 0, cus = 0, per_cu = 0;
        if (hipGetDevice(&dev) != hipSuccess || hipDeviceGetAttribute(&cus, hipDeviceAttributeMultiprocessorCount, dev) != hipSuccess) { fprintf(stderr, "kernel_launch: device query failed\n"); return; }
        if (hipFuncSetAttribute((const void*)k_mega, hipFuncAttributeMaxDynamicSharedMemorySize, MEGA_LDS) != hipSuccess) { fprintf(stderr, "kernel_launch: hipFuncSetAttribute failed\n"); return; }
        if (hipOccupancyMaxActiveBlocksPerMultiprocessor(&per_cu, (const void*)k_mega, 512, MEGA_LDS) != hipSuccess || per_cu < 1) { fprintf(stderr, "kernel_launch: occupancy query says %d\n", per_cu); return; }
        grid = cus < MAXG ? cus : MAXG;
    }
    const Params p = make_params(d_in, d_out, d_ws);
    (void)hipMemsetAsync(d_ws, 0, WS_ADA, stream);
    hipLaunchKernelGGL(k_mega, dim3(grid), dim3(512), MEGA_LDS, stream, p);
#endif
}
#endif
```

```cpp
#ifndef CPU_EMU
#include <hip/hip_runtime.h>
#include <cstdio>
#include <cstdint>
#endif

#ifndef BATCH
#define BATCH 4
#endif
#ifndef SEQ
#define SEQ 4096
#endif
#ifndef CTX_LEN
#define CTX_LEN 256
#endif
constexpr int D = 2048, NB = BATCH, NSEQ = SEQ, NCTX = CTX_LEN;
constexpr int ML = NB * NSEQ, MC = NB * NCTX, MT = ML + MC;
constexpr int NADA = NB + 1;
constexpr int QW = 1024, KVW = 256, LW = 1024, EVIN = 3584;
constexpr int COL_Q = 0, COL_K = 1024, COL_V = 1280, COL_XR = 1536, COL_GR = 2560;
constexpr int S5W = 1024, S5G = 64, S5C = 16, S5S = 64;
constexpr int NE = 16, FF = 1024;
constexpr int NBLK = (2 * MT + 255) / 256 + NE;
constexpr int ADA6 = 6 * D;
static_assert(ML % 256 == 0 && MC % 256 == 0 && NSEQ % 256 == 0 && NCTX % 256 == 0, "tiles must not straddle sequences");

typedef unsigned short bf16_t;
#ifndef CPU_EMU
#define LAS __attribute__((address_space(3)))
__device__ __forceinline__ int tid_of(int wv) { int l; asm volatile("v_mbcnt_lo_u32_b32 %0, -1, 0\n\tv_mbcnt_hi_u32_b32 %0, -1, %0" : "=v"(l)); return wv * 64 + l; }
#endif

#ifdef CPU_EMU
constexpr bool MOE1_FP8 = false, MOE0_FP8 = false, DENSE1_FP8 = false, IN0_FP8 = false, IN0QKV_FP8 = false, OUT0_FP8 = false, RES_BF16 = false, Y8 = false;
#else
constexpr bool Y8 = true;
constexpr bool RES_BF16 = true; constexpr bool IN0_FP8 = false, IN0QKV_FP8 = true, OUT0_FP8 = true;
constexpr bool DENSE1_FP8 = true;
constexpr bool MOE0_FP8 = true;
constexpr bool MOE1_FP8 = true;
#endif
constexpr float W8_SCALE = 64.0f, ACT8_SCALE = 4.0f;
constexpr int W8_E8M0 = 127 - 6, ACT8_E8M0 = 127 - 2, ONE_E8M0 = 127;
constexpr float Z8_SCALE = 8.0f, S8_SCALE = 16.0f, MIX8_SCALE = 16.0f, Y8_SCALE = 16.0f; constexpr int Z8_E8M0 = 127 - 3, S8_E8M0 = 127 - 4, MIX8_E8M0 = 127 - 4;

constexpr size_t al256(size_t x) { return (x + 255) & ~(size_t)255; }
constexpr size_t WS_BAR = 0;
constexpr size_t WS_CNT = 16384;
constexpr size_t WS_ADA = 32768;
constexpr size_t CTL_BYTES = al256(WS_ADA + (size_t)2 * NADA * ADA6 * 4);
constexpr size_t WS_ROPE = CTL_BYTES;
constexpr size_t WS_S5LAM = WS_ROPE + 64 * 16 * 8;
constexpr size_t WS_S5BB = WS_S5LAM + (size_t)2 * S5G * S5S * 8;
constexpr size_t WS_S5LAMT = WS_S5BB + (size_t)2 * S5G * S5S * S5C * 8;
constexpr size_t WS_S5BF = WS_S5LAMT + (size_t)2 * S5G * S5S * 8;
constexpr size_t WS_S5CF = WS_S5BF + (size_t)2 * S5G * 4 * 64 * 16;
constexpr size_t WS_LRUBF = WS_S5CF + (size_t)2 * S5G * 4 * 64 * 16;
constexpr size_t WS_RWF = WS_LRUBF + (size_t)2 * 16 * 2 * 2 * 4 * 64 * 16;
constexpr size_t WS_WT_IN0 = al256(WS_RWF + (size_t)2 * 64 * 64 * 16);
constexpr size_t WS_WT_OUT0 = WS_WT_IN0 + (size_t)EVIN * D * 2;
constexpr size_t WS_WT_IN1 = WS_WT_OUT0 + (size_t)D * D * 2;
constexpr size_t WS_WT_GLU = WS_WT_IN1 + (size_t)S5W * D * 2;
constexpr size_t WS_WT_OUT1 = WS_WT_GLU + (size_t)S5W * S5W * 2;
constexpr size_t WS_WT_GU = WS_WT_OUT1 + (size_t)D * S5W * 2;
constexpr size_t WS_WT_DN = WS_WT_GU + (size_t)2 * NE * 2 * FF * D * 2;
constexpr size_t WS_W8_GU = WS_WT_GU + (size_t)NE * 2 * FF * D * 2;
constexpr size_t WS_W8_DN = WS_WT_DN + (size_t)NE * D * FF * 2;
constexpr size_t WS_XRES = WS_WT_DN + (size_t)2 * NE * D * FF * 2;
constexpr size_t WS_H8 = WS_XRES + (size_t)MT * D * 2;
constexpr size_t WS_H = WS_XRES + (size_t)MT * D * 4;
constexpr size_t WS_TOK = WS_H + (size_t)MT * D * 2;
constexpr size_t WS_ROWIDX = WS_TOK + (size_t)4 * MT * 2 * 4;
constexpr size_t WS_RA = al256(WS_ROWIDX + (size_t)NBLK * 256 * 4);
constexpr size_t WS_QKV = WS_RA;
constexpr size_t WS_MIX = WS_QKV + (size_t)MT * EVIN * 2;
constexpr size_t WS_U1 = WS_RA;
constexpr size_t WS_YS5 = WS_U1 + (size_t)MT * S5W * 2;
constexpr size_t WS_Z = WS_YS5 + (size_t)ML * S5W * 4;
constexpr size_t WS_S = WS_Z + (size_t)ML * S5W * 2;
constexpr int S5_CHUNK = 128, S5_NCC = NCTX / S5_CHUNK, S5_NLC = NSEQ / S5_CHUNK, S5_NCH = S5_NCC + S5_NLC;
static_assert(S5_NCC % 2 == 0 && S5_NLC % 2 == 0, "chunks are processed in pairs");
constexpr size_t WS_S5E = WS_S + (size_t)ML * S5W * 2;
constexpr size_t RA_BYTES = (size_t)MT * EVIN * 2 + (size_t)MT * D * 2;
static_assert(WS_S5E + (size_t)NB * S5G * 2 * S5_NCH * S5S * 8 <= WS_RA + RA_BYTES, "L1 overlay (E)");
static_assert((size_t)MT * S5W * 2 + (size_t)ML * S5W * 4 + 2 * (size_t)ML * S5W * 2 <= RA_BYTES, "L1 overlay");
constexpr size_t WS_RB = al256(WS_RA + RA_BYTES);
constexpr size_t WS_ACT = WS_RB;
constexpr size_t WS_YBUF = WS_ACT + (size_t)NBLK * 256 * FF * 2;
constexpr size_t WS_UCONV = WS_RB;
constexpr size_t WS_HSUM = WS_UCONV + (size_t)MT * LW * 4;
constexpr size_t RB_BYTES = (size_t)NBLK * 256 * FF * 2 + (size_t)NBLK * 256 * D * 2;
static_assert(2 * (size_t)MT * LW * 4 <= RB_BYTES, "LRU overlay");
constexpr size_t WS_UBF = WS_RB;
constexpr int VT_T = 128 + NSEQ + 128 + NCTX;
constexpr size_t WS_VT = WS_UBF + (size_t)MT * LW * 2;
constexpr size_t WS_LRUAGG = al256(WS_VT + (size_t)NB * 4 * 64 * VT_T * 2);
constexpr int LRU_CH = 64, LRU_NCC = NCTX / LRU_CH, LRU_NLC = NSEQ / LRU_CH, LRU_NCH = LRU_NCC + LRU_NLC;
static_assert(LRU_NCC % 2 == 0 && LRU_NLC % 2 == 0, "chunks are processed in pairs");
static_assert(WS_LRUAGG + (size_t)NB * 2 * LRU_NCH * LW * 8 <= WS_RB + RB_BYTES, "RB overlay");
constexpr int MAXG = 256;
constexpr int HIST_LD = 32;
constexpr size_t WS_HIST = al256(WS_RB + RB_BYTES);
constexpr size_t WS_END = WS_HIST + (size_t)2 * MAXG * HIST_LD * 4;

struct Params {
    const float *x, *c, *ctx, *c_ctx, *ada_w, *ada_b, *norm_mix, *norm_ffn, *norm_final;
    const float *ev_w_in, *ev_w_out, *attn_sink, *lru_conv_w, *lru_conv_b, *lru_lam, *lru_wa, *lru_ba, *lru_wi, *lru_bi;
    const float *od_w_in, *s5_lam_re, *s5_lam_im, *s5_log_step, *s5_b_re, *s5_b_im, *s5_c_re, *s5_c_im, *s5_d, *s5_glu_w, *s5_glu_b, *od_w_out;
    const float *router_w, *router_b, *moe_w_gate, *moe_w_up, *moe_w_down;
    float* out;
    unsigned char* ws;
};

#ifdef CPU_EMU
typedef float f32x4 __attribute__((vector_size(16)));
#else
typedef float f32x4 __attribute__((ext_vector_type(4)));
#endif
struct u32x2_t { unsigned x, y; };
struct u32x4_t { unsigned x, y, z, w; };
#ifdef CPU_EMU
__device__ __forceinline__ void st_coh(int* p, int v) { *p = v; }
__device__ __forceinline__ int ld_coh(const int* p) { return *p; }
#else
__device__ __forceinline__ void st_coh(int* p, int v) { __hip_atomic_store(p, v, __ATOMIC_RELAXED, __HIP_MEMORY_SCOPE_AGENT); }
__device__ __forceinline__ int ld_coh(const int* p) { return __hip_atomic_load(p, __ATOMIC_RELAXED, __HIP_MEMORY_SCOPE_AGENT); }
#endif
__device__ __forceinline__ f32x4 unpack4bf(unsigned lo, unsigned hi) { return (f32x4){__uint_as_float(lo << 16), __uint_as_float(lo & 0xffff0000u), __uint_as_float(hi << 16), __uint_as_float(hi & 0xffff0000u)}; }
__device__ __forceinline__ float bf2f(bf16_t b) { return __uint_as_float(((unsigned)b) << 16); }
__device__ __forceinline__ bf16_t f2bf(float f) { unsigned u = __float_as_uint(f); u += 0x7FFFu + ((u >> 16) & 1u); return (bf16_t)(u >> 16); }
#ifdef CPU_EMU
__device__ __forceinline__ unsigned pack2bf(float lo, float hi) { return (unsigned)f2bf(lo) | ((unsigned)f2bf(hi) << 16); }
#else
typedef short s5_bf16x8 __attribute__((ext_vector_type(8)));
typedef unsigned u4v_t __attribute__((ext_vector_type(4)));
__device__ __forceinline__ int deal_item(int round, int gwave, int nwaves, int items, int grp = 2) {
    const int full = items / nwaves; if (round < full) return round * nwaves + gwave; if (round > full) return -1;
    const int rem = items - full * nwaves, blk = gwave >> 3, wv = gwave & 7; if (wv >= grp) return -1; const int j = blk * grp + wv; return j < rem ? full * nwaves + j : -1; }
#ifndef CPU_EMU
__device__ __forceinline__ float clamp_e4m3(float x) { return fminf(fmaxf(x, -448.0f), 448.0f); }
__device__ __forceinline__ unsigned pack4_fp8(float a, float b, float c, float d) { int w = 0; w = __builtin_amdgcn_cvt_pk_fp8_f32(clamp_e4m3(a), clamp_e4m3(b), w, false); w = __builtin_amdgcn_cvt_pk_fp8_f32(clamp_e4m3(c), clamp_e4m3(d), w, true); return (unsigned)w; }
#endif
__device__ __forceinline__ float opaque_zero() { float z = 0.f; asm volatile("" : "+v"(z)); return z; }
#define MFMA_KEEP(acc, x) asm volatile("" : "+v"(acc) : "v"(x))
typedef __bf16 bf16x2_hw __attribute__((ext_vector_type(2)));
typedef float f32x2_hw __attribute__((ext_vector_type(2)));
__device__ __forceinline__ unsigned pack2bf(float lo, float hi) { const f32x2_hw v = {lo, hi}; const bf16x2_hw b = __builtin_convertvector(v, bf16x2_hw); return __builtin_bit_cast(unsigned, b); }
#endif
#ifdef CPU_EMU
__device__ __forceinline__ float sigmoidf_(float x) { return 1.0f / (1.0f + __expf(-x)); }
__device__ __forceinline__ float fast_rcp(float x) { return 1.0f / x; }
__device__ __forceinline__ float fast_sqrt(float x) { return sqrtf(x); }
#else
__device__ __forceinline__ float fast_rcp(float x) { return __builtin_amdgcn_rcpf(x); }
__device__ __forceinline__ float fast_sqrt(float x) { return __builtin_amdgcn_sqrtf(x); }
__device__ __forceinline__ float sigmoidf_(float x) { return __builtin_amdgcn_rcpf(1.0f + __builtin_amdgcn_exp2f(-1.44269504089f * x)); }
#endif
__device__ __forceinline__ float siluf_(float x) { return x * sigmoidf_(x); }
#ifdef CPU_EMU
__device__ __forceinline__ float geluf_(float x) { const float u = 0.7978845608028654f * (x + 0.044715f * x * x * x); return 0.5f * x * (1.0f + tanhf(u)); }
#else
__device__ __forceinline__ float geluf_(float x) { const float t = x * x, e = __builtin_amdgcn_exp2f(x * __builtin_fmaf(t, -0.102943215f, -2.302208198f)); return x * __builtin_amdgcn_rcpf(1.0f + e); }
#endif
__device__ __forceinline__ float softplusf_(float x) { return x > 20.f ? x : log1pf(__expf(x)); }
__device__ __forceinline__ int ada_row(int r) { return r < ML ? r / NSEQ : NB; }
__device__ __forceinline__ const float* ada_ptr(const Params& p, int l, int arow, int which) { return (const float*)(p.ws + WS_ADA) + ((size_t)l * NADA + arow) * ADA6 + (size_t)which * D; }
__device__ __forceinline__ const float* xin_row(const Params& p, int l, int r) {
    if (l == 0) return r < ML ? p.x + (size_t)r * D : p.ctx + (size_t)(r - ML) * D;
    return (const float*)(p.ws + WS_XRES) + (size_t)r * D;
}

#ifndef CPU_EMU
constexpr int ADA_ITEMS = 2 * (ADA6 / 128), ADA_LDS_BYTES = (NADA * D + 16 * NADA * 128) * 4;
__device__ __forceinline__ void ph_ada(const Params& p, float* sil, int bid, int nblocks, int wv_) {
    const int tid = tid_of(wv_), w = wv_, lane = tid & 63, kh = lane >> 5, cq = lane & 31;
    float* ada = (float*)(p.ws + WS_ADA); float* red = sil + NADA * D;
    if (bid < ADA_ITEMS) { for (int i = tid; i < NADA * D; i += 512) { const int r = i / D, k = i % D; sil[i] = siluf_(r < NB ? p.c[(size_t)r * D + k] : p.c_ctx[k]); } }
    __syncthreads();
    for (int item = bid; item < ADA_ITEMS; item += nblocks) {
        const int l = item / (ADA6 / 128), cb = (item % (ADA6 / 128)) * 128, c0 = cb + cq * 4;
        f32x4 acc[NADA];
#pragma unroll
        for (int r = 0; r < NADA; ++r) acc[r] = (f32x4){0.f, 0.f, 0.f, 0.f};
        const float* wp = p.ada_w + (size_t)l * D * ADA6 + c0; const int k0 = w * 256 + kh * 128;
#pragma unroll 16
        for (int k = k0; k < k0 + 128; ++k) {
            const f32x4 wv = *(const f32x4*)(wp + (size_t)k * ADA6);
#pragma unroll
            for (int r = 0; r < NADA; ++r) acc[r] += wv * sil[r * D + k];
        }
        __syncthreads();
#pragma unroll
        for (int r = 0; r < NADA; ++r) *(f32x4*)(red + ((size_t)((w * 2 + kh) * NADA + r) * 128) + cq * 4) = acc[r];
        __syncthreads();
        for (int i = tid; i < NADA * 128; i += 512) { const int r = i / 128, cc = i % 128; float sacc = p.ada_b[(size_t)l * ADA6 + cb + cc];
#pragma unroll
            for (int ww = 0; ww < 16; ++ww) sacc += red[(size_t)(ww * NADA + r) * 128 + cc];
            ada[((size_t)l * NADA + r) * ADA6 + cb + cc] = sacc; }
    }
}
#else
void ph_ada_emu(const Params& p) {
    float* ada = (float*)(p.ws + WS_ADA);
    for (int l = 0; l < 2; ++l) for (int r = 0; r < NADA; ++r) { std::vector<double> acc(ADA6, 0.0);
        for (int k = 0; k < D; ++k) { const float cv = r < NB ? p.c[(size_t)r * D + k] : p.c_ctx[k]; const double sv = siluf_(cv); const float* wr = p.ada_w + ((size_t)l * D + k) * ADA6; for (int j = 0; j < ADA6; ++j) acc[j] += sv * wr[j]; }
        for (int j = 0; j < ADA6; ++j) ada[((size_t)l * NADA + r) * ADA6 + j] = (float)acc[j] + p.ada_b[(size_t)l * ADA6 + j]; }
}
#endif
__device__ __forceinline__ void ph_tables(const Params& p, long gtid, long gthreads) {
    float* rope = (float*)(p.ws + WS_ROPE);
    for (long it = gtid; it < 64 * 16; it += gthreads) {
        const int pos = (int)(it / 16), i = (int)(it % 16);
        const double inv = pow(10000.0, -(double)i / 16.0); const double a = (double)pos * (double)(float)inv;
        rope[it * 2] = (float)cos(a); rope[it * 2 + 1] = (float)sin(a);
    }
    float* lamb = (float*)(p.ws + WS_S5LAM); float* bb = (float*)(p.ws + WS_S5BB);
    for (long it = gtid; it < 2L * S5G * S5S; it += gthreads) {
        const int g = (int)((it / S5S) % S5G), d = (int)(it / (S5S * S5G));
        const double lr = p.s5_lam_re[it], li = p.s5_lam_im[it], step = exp((double)p.s5_log_step[d * S5G + g]);
        const double mag = exp(lr * step), br = mag * cos(li * step), bi = mag * sin(li * step);
        lamb[it * 2] = (float)br; lamb[it * 2 + 1] = (float)bi;
        const double nr = br - 1.0, ni = bi, den = lr * lr + li * li;
        const double cr = (nr * lr + ni * li) / den, ci = (ni * lr - nr * li) / den;
        for (int c = 0; c < S5C; ++c) { const double b_r = p.s5_b_re[it * S5C + c], b_i = p.s5_b_im[it * S5C + c];
            bb[(it * S5C + c) * 2] = (float)(cr * b_r - ci * b_i); bb[(it * S5C + c) * 2 + 1] = (float)(cr * b_i + ci * b_r); }
        const double magT = exp(lr * step * S5_CHUNK); float* lt = (float*)(p.ws + WS_S5LAMT);
        lt[it * 2] = (float)(magT * cos(li * step * S5_CHUNK)); lt[it * 2 + 1] = (float)(magT * sin(li * step * S5_CHUNK));
    }
    { bf16_t* rw = (bf16_t*)(p.ws + WS_RWF);
      for (long it = gtid; it < 64L * 64 * 8; it += gthreads) { const int j = (int)(it & 7), lane = (int)((it >> 3) & 63), st = (int)(it >> 9);
          const float wv = p.router_w[(size_t)(32 * st + 8 * (lane >> 4) + j) * NE + (lane & 15)]; const bf16_t hi = f2bf(wv); rw[it] = hi; rw[64L * 64 * 8 + it] = f2bf(wv - bf2f(hi)); } }
    bf16_t* lb = (bf16_t*)(p.ws + WS_LRUBF);
    for (long it = gtid; it < 2L * 16 * 2 * 2 * 4 * 64 * 8; it += gthreads) {
        const int j = (int)(it & 7), lane = (int)((it >> 3) & 63), ks = (int)((it >> 9) & 3), cs = (int)((it >> 11) & 1), gate = (int)((it >> 12) & 1); const long dh = it >> 13;
        const float* w = gate ? p.lru_wi : p.lru_wa;
        lb[it] = f2bf(w[((size_t)dh * 64 + 16 * ks + 8 * (lane >> 5) + j) * 64 + 32 * cs + (lane & 31)]);
    }
    bf16_t* bf = (bf16_t*)(p.ws + WS_S5BF); bf16_t* cf = (bf16_t*)(p.ws + WS_S5CF);
    for (long it = gtid; it < 2L * S5G * 4 * 64 * 8; it += gthreads) {
        const int j = (int)(it & 7), lane = (int)((it >> 3) & 63), ct = (int)((it >> 9) & 3); const long dg = it >> 11;
        { const int st = (lane & 31) + 32 * (ct >> 1), ch = 8 * (lane >> 5) + j; const size_t gi = (size_t)dg * S5S + st;
          const double lr = p.s5_lam_re[gi], li = p.s5_lam_im[gi], step = exp((double)p.s5_log_step[dg]);
          const double mag = exp(lr * step), br = mag * cos(li * step), bi = mag * sin(li * step), nr = br - 1.0, ni = bi, den = lr * lr + li * li;
          const double cr = (nr * lr + ni * li) / den, ci = (ni * lr - nr * li) / den, b_r = p.s5_b_re[gi * S5C + ch], b_i = p.s5_b_im[gi * S5C + ch];
          bf[it] = f2bf((float)((ct & 1) ? (cr * b_i + ci * b_r) : (cr * b_r - ci * b_i))); }
        { const int ks = ct, q = 32 * ks + 8 * (lane >> 4) + j, st = q >> 1, ch = lane & 15; const size_t ci_ = ((size_t)dg * S5C + ch) * S5S + st;
          cf[it] = f2bf((q & 1) ? -p.s5_c_im[ci_] : p.s5_c_re[ci_]); }
    }
}
__device__ __forceinline__ void ph_norm(const Params& p, int l, int rows, long gtid, long gthreads) {
    bf16_t* h = (bf16_t*)(p.ws + WS_H);
    for (long r = gtid; r < rows; r += gthreads) {
        const float* xr = xin_row(p, l, (int)r); const int ar = ada_row((int)r);
        const float* sh = ada_ptr(p, l, ar, 0); const float* sc = ada_ptr(p, l, ar, 1); const float* g = p.norm_mix + (size_t)l * D;
        float ss = 0.f; for (int k = 0; k < D; ++k) ss += xr[k] * xr[k];
        const float rstd = 1.0f / sqrtf(ss / D + 1e-6f);
        for (int k = 0; k < D; ++k) h[(size_t)r * D + k] = f2bf(xr[k] * rstd * g[k] * (1.0f + sc[k]) + sh[k]);
    }
}
__device__ __forceinline__ void ph_conv(const Params& p, long gtid, long gthreads) {
    const bf16_t* qkv = (const bf16_t*)(p.ws + WS_QKV); float* u = (float*)(p.ws + WS_UCONV);
    for (long it = gtid; it < (long)MT * LW; it += gthreads) {
        const int r = (int)(it / LW), ch = (int)(it % LW);
        int base, t, n; if (r < ML) { base = (r / NSEQ) * NSEQ; t = r % NSEQ; n = NSEQ; } else { const int rc = r - ML; base = ML + (rc / NCTX) * NCTX; t = rc % NCTX; n = NCTX; }
        float acc = p.lru_conv_b[ch];
        for (int tap = 0; tap < 4; ++tap) { const int tt = t + tap - 2; if (tt >= 0 && tt < n) acc += p.lru_conv_w[tap * LW + ch] * bf2f(qkv[(size_t)(base + tt) * EVIN + COL_XR + ch]); }
        u[it] = acc;
    }
}
__device__ __forceinline__ void ph_lru(const Params& p, long gtid, long gthreads) {
    const bf16_t* qkv = (const bf16_t*)(p.ws + WS_QKV); const float* u = (const float*)(p.ws + WS_UCONV); float* hs = (float*)(p.ws + WS_HSUM); bf16_t* mix = (bf16_t*)(p.ws + WS_MIX);
    for (long it = gtid; it < (long)NB * LW; it += gthreads) {
        const int b = (int)(it / LW), ch = (int)(it % LW), hh = ch / 64, j = ch % 64;
        for (int d = 0; d < 2; ++d) {
            const float lamv = softplusf_(-p.lru_lam[d * LW + ch]), ba = p.lru_ba[d * LW + ch], bi = p.lru_bi[d * LW + ch];
            const float* wa = p.lru_wa + ((size_t)(d * 16 + hh) * 64) * 64 + j; const float* wi = p.lru_wi + ((size_t)(d * 16 + hh) * 64) * 64 + j;
            float state = 0.f;
            for (int seg = 0; seg < 2; ++seg) {
                const int n = seg ? NSEQ : NCTX, base = seg ? b * NSEQ : ML + b * NCTX;
                for (int stp = 0; stp < n; ++stp) {
                    const int row = base + (d ? n - 1 - stp : stp); const float* ur = u + (size_t)row * LW + hh * 64;
                    float ra = ba, ia = bi;
                    for (int i = 0; i < 64; ++i) { ra += ur[i] * wa[(size_t)i * 64]; ia += ur[i] * wi[(size_t)i * 64]; }
                    const float rg = sigmoidf_(ra), ig = sigmoidf_(ia), log_a = -8.0f * rg * lamv, a = __expf(log_a), mult = sqrtf(-expm1f(2.0f * log_a));
                    state = a * state + mult * (ig * ur[j]);
                    if (d == 0) hs[(size_t)row * LW + ch] = state;
                    else { const float tot = hs[(size_t)row * LW + ch] + state; mix[(size_t)row * D + QW + ch] = f2bf(tot * geluf_(bf2f(qkv[(size_t)row * EVIN + COL_GR + ch]))); }
                }
            }
        }
    }
}
__device__ __forceinline__ void ph_attn(const Params& p, long gtid, long gthreads) {
    const bf16_t* qkv = (const bf16_t*)(p.ws + WS_QKV); bf16_t* mix = (bf16_t*)(p.ws + WS_MIX);
    for (long it = gtid; it < (long)MT * 16; it += gthreads) {
        const int r = (int)(it / 16), hd = (int)(it % 16), kvh = hd / 4;
        float q[64], o[64];
        for (int d = 0; d < 64; ++d) { q[d] = bf2f(qkv[(size_t)r * EVIN + COL_Q + hd * 64 + d]); o[d] = 0.f; }
        float m = p.attn_sink[hd], lsum = 1.0f;
        const int b = r < ML ? r / NSEQ : (r - ML) / NCTX;
        for (int seg = 0; seg < 2; ++seg) {
            int k0, k1;
            if (seg == 0) { if (r >= ML) continue; const int t = r % NSEQ; const int lo = t - 128 < 0 ? 0 : t - 128, hi = t + 128 > NSEQ - 1 ? NSEQ - 1 : t + 128; k0 = b * NSEQ + lo; k1 = b * NSEQ + hi + 1; }
            else { k0 = ML + b * NCTX; k1 = k0 + NCTX; }
            for (int kr = k0; kr < k1; ++kr) {
                const bf16_t* kp = qkv + (size_t)kr * EVIN + COL_K + kvh * 64; const bf16_t* vp = qkv + (size_t)kr * EVIN + COL_V + kvh * 64;
                float s = 0.f; for (int d = 0; d < 64; ++d) s += q[d] * bf2f(kp[d]);
                if (s > m) { const float f = __expf(m - s); lsum *= f; for (int d = 0; d < 64; ++d) o[d] *= f; m = s; }
                const float pe = __expf(s - m); lsum += pe;
                for (int d = 0; d < 64; ++d) o[d] += pe * bf2f(vp[d]);
            }
        }
        const float inv = 1.0f / lsum;
        for (int d = 0; d < 64; ++d) mix[(size_t)r * D + hd * 64 + d] = f2bf(o[d] * inv);
    }
}
__device__ __forceinline__ void ph_router(const Params& p, int l, int rows, long gtid, long gthreads) {
    bf16_t* h = (bf16_t*)(p.ws + WS_H); const float* xres = (const float*)(p.ws + WS_XRES);
    int* tok_e = (int*)(p.ws + WS_TOK); float* tok_w = (float*)(p.ws + WS_TOK) + (size_t)MT * 2; int* tok_slot = (int*)(p.ws + WS_TOK) + (size_t)MT * 4;
    int* cnt = (int*)(p.ws + WS_CNT) + l * 64;
    for (long r = gtid; r < rows; r += gthreads) {
        const float* xr = xres + (size_t)r * D; const int ar = ada_row((int)r);
        const float* sh = ada_ptr(p, l, ar, 3); const float* sc = ada_ptr(p, l, ar, 4); const float* g = p.norm_ffn + (size_t)l * D;
        float ss = 0.f; for (int k = 0; k < D; ++k) ss += xr[k] * xr[k];
        const float rstd = 1.0f / sqrtf(ss / D + 1e-6f);
        float lg[NE];
#pragma unroll
        for (int e = 0; e < NE; ++e) lg[e] = p.router_b[e];
        for (int k = 0; k < D; ++k) { const float hv = xr[k] * rstd * g[k] * (1.0f + sc[k]) + sh[k]; h[(size_t)r * D + k] = f2bf(hv);
#pragma unroll
            for (int e = 0; e < NE; ++e) lg[e] += hv * p.router_w[(size_t)k * NE + e]; }
        float mx = lg[0];
#pragma unroll
        for (int e = 1; e < NE; ++e) mx = lg[e] > mx ? lg[e] : mx;
        float pr[NE], sum = 0.f;
#pragma unroll
        for (int e = 0; e < NE; ++e) { pr[e] = __expf(lg[e] - mx); sum += pr[e]; }
#pragma unroll
        for (int e = 0; e < NE; ++e) pr[e] /= sum;
        float best = -1.f, w1 = 0.f, w2 = 0.f; int e1 = 0, e2 = 0;
#pragma unroll
        for (int gi = 0; gi < 4; ++gi) { float a1 = -1.f, a2 = -1.f; int j1 = 0, j2 = 0;
#pragma unroll
            for (int j = 0; j < 4; ++j) { const float v = pr[gi * 4 + j]; if (v > a1) { a2 = a1; j2 = j1; a1 = v; j1 = j; } else if (v > a2) { a2 = v; j2 = j; } }
            if (a1 + a2 > best) { best = a1 + a2; e1 = gi * 4 + j1; e2 = gi * 4 + j2; w1 = a1; w2 = a2; } }
        const float ws = w1 + w2;
        tok_e[r * 2] = e1; tok_e[r * 2 + 1] = e2; tok_w[r * 2] = w1 / ws; tok_w[r * 2 + 1] = w2 / ws;
        tok_slot[r * 2] = atomicAdd(cnt + e1, 1); tok_slot[r * 2 + 1] = atomicAdd(cnt + e2, 1);
    }
}
__device__ __forceinline__ int moe_pad_start(const int* cnt, int e) { int acc = 0;
#pragma unroll
    for (int j = 0; j < NE; ++j) { const int pj = (cnt[j] + 255) / 256 * 256; acc += (j < e) ? pj : 0; } return acc; }
__device__ __forceinline__ void ph_dispatch(const Params& p, int l, int rows, long gtid, long gthreads) {
    const int* tok_e = (const int*)(p.ws + WS_TOK); const int* tok_slot = (const int*)(p.ws + WS_TOK) + (size_t)MT * 4; int* tok_dest = (int*)(p.ws + WS_TOK) + (size_t)MT * 6;
    int* rowidx = (int*)(p.ws + WS_ROWIDX); const int* cnt = (const int*)(p.ws + WS_CNT) + l * 64;
    for (long it = gtid; it < (long)rows * 2; it += gthreads) { const int e = tok_e[it], dest = moe_pad_start(cnt, e) + tok_slot[it]; tok_dest[it] = dest; st_coh(rowidx + dest, (int)(it / 2)); }
    const int total = moe_pad_start(cnt, NE);
    for (long it = gtid; it < total; it += gthreads) { int acc = 0, st = 0, ce = 0;
#pragma unroll
        for (int j = 0; j < NE; ++j) { const int pj = (cnt[j] + 255) / 256 * 256; if (it >= acc && it < acc + pj) { st = acc; ce = cnt[j]; } acc += pj; }
        if (it - st >= ce) st_coh(rowidx + it, 0); }
}
__device__ __forceinline__ void ph_combine(const Params& p, int l, int rows, long gtid, long gthreads) {
    float* xres = (float*)(p.ws + WS_XRES); const bf16_t* yb = (const bf16_t*)(p.ws + WS_YBUF);
    const float* tok_w = (const float*)(p.ws + WS_TOK) + (size_t)MT * 2; const int* tok_dest = (const int*)(p.ws + WS_TOK) + (size_t)MT * 6;
    for (long it = gtid; it < (long)rows * (D / 4); it += gthreads) {
        const int r = (int)(it / (D / 4)), c = (int)(it % (D / 4)) * 4; const float* g2 = ada_ptr(p, l, ada_row(r), 5);
        const int d0 = tok_dest[r * 2], d1 = tok_dest[r * 2 + 1]; const float w0 = tok_w[r * 2], w1 = tok_w[r * 2 + 1];
        for (int j = 0; j < 4; ++j) xres[(size_t)r * D + c + j] += g2[c + j] * (w0 * bf2f(yb[(size_t)d0 * D + c + j]) + w1 * bf2f(yb[(size_t)d1 * D + c + j]));
    }
}
__device__ __forceinline__ void ph_s5(const Params& p, long gtid, long gthreads) {
    const bf16_t* u1 = (const bf16_t*)(p.ws + WS_U1); float* ys = (float*)(p.ws + WS_YS5); bf16_t* z = (bf16_t*)(p.ws + WS_Z);
    const float* lamb = (const float*)(p.ws + WS_S5LAM); const float* bb = (const float*)(p.ws + WS_S5BB);
    for (long it = gtid; it < (long)NB * S5W; it += gthreads) {
        const int b = (int)(it / S5W), col = (int)(it % S5W), g = col / S5C, c = col % S5C;
        for (int t = 0; t < NSEQ; ++t) { const size_t row = (size_t)b * NSEQ + t; ys[row * S5W + col] = p.s5_d[col] * bf2f(u1[row * S5W + col]); }
        for (int d = 0; d < 2; ++d)
            for (int s = 0; s < S5S; ++s) {
                const size_t gi = ((size_t)d * S5G + g) * S5S + s;
                const float lr = lamb[gi * 2], li = lamb[gi * 2 + 1];
                const float cr = p.s5_c_re[(((size_t)d * S5G + g) * S5C + c) * S5S + s], ci = p.s5_c_im[(((size_t)d * S5G + g) * S5C + c) * S5S + s];
                float br[S5C], bi[S5C]; for (int cc = 0; cc < S5C; ++cc) { br[cc] = bb[(gi * S5C + cc) * 2]; bi[cc] = bb[(gi * S5C + cc) * 2 + 1]; }
                float xr = 0.f, xi = 0.f;
                for (int seg = 0; seg < 2; ++seg) {
                    const int n = seg ? NSEQ : NCTX, base = seg ? b * NSEQ : ML + b * NCTX;
                    for (int stp = 0; stp < n; ++stp) {
                        const size_t row = (size_t)base + (d ? n - 1 - stp : stp); const bf16_t* ur = u1 + row * S5W + g * S5C;
                        float bur = 0.f, bui = 0.f; for (int cc = 0; cc < S5C; ++cc) { const float uv = bf2f(ur[cc]); bur += br[cc] * uv; bui += bi[cc] * uv; }
                        const float nr = lr * xr - li * xi + bur, ni = lr * xi + li * xr + bui; xr = nr; xi = ni;
                        if (seg) ys[row * S5W + col] += cr * xr - ci * xi;
                    }
                }
            }
        for (int t = 0; t < NSEQ; ++t) { const size_t row = (size_t)b * NSEQ + t; z[row * S5W + col] = f2bf(geluf_(ys[row * S5W + col])); }
    }
}
#ifndef CPU_EMU
typedef float s5_f32x16 __attribute__((ext_vector_type(16)));
constexpr int S5_XPITCH = 272, S5_XBYTES = 32 * S5_XPITCH, S5_ABYTES = 0, S5_WAVE_LDS = S5_XBYTES + S5_ABYTES + 8 * 2 * 64 * 8;
static_assert(8 * S5_WAVE_LDS <= 147456 - 64, "S5 LDS");
__device__ __forceinline__ int s5_chunk_row0(int b, int k) { return k < S5_NCC ? ML + b * NCTX + k * S5_CHUNK : b * NSEQ + (k - S5_NCC) * S5_CHUNK; }
__device__ __forceinline__ int s5_order(int d, int k) { return d == 0 ? k : (k < S5_NCC ? S5_NCC - 1 - k : S5_NCC + (S5_NLC - 1 - (k - S5_NCC))); }
template <int PASS> __device__ __forceinline__ void ph_s5_fast(const Params& p, LAS unsigned char* lds, int gwave, int nwaves, int wv_) {
    const int lane = tid_of(wv_) & 63, wv = wv_;
    LAS unsigned char* xl = lds + wv * S5_WAVE_LDS;
    const int r = lane & 31, hh = lane >> 5, a_half = (r >> 2) & 1, a_n = (r & 3) + 4 * (r >> 3), tk = lane & 15, q4 = lane >> 4;
    const bf16_t* u1 = (const bf16_t*)(p.ws + WS_U1); bf16_t* z = (bf16_t*)(p.ws + WS_Z); float* ys = (float*)(p.ws + WS_YS5);
    const float* lamb = (const float*)(p.ws + WS_S5LAM); const float* lamt = (const float*)(p.ws + WS_S5LAMT);
    const s5_bf16x8* BF = (const s5_bf16x8*)(p.ws + WS_S5BF); const s5_bf16x8* CF = (const s5_bf16x8*)(p.ws + WS_S5CF);
    float* E = (float*)(p.ws + WS_S5E);
    constexpr int P0 = PASS == 2 ? S5_NCC / 2 : 0, NPAIR = S5_NCH / 2 - P0;
    for (int rd = 0; rd <= (NB * S5G * NPAIR) / nwaves; ++rd) {
        const int it = deal_item(rd, gwave, nwaves, NB * S5G * NPAIR); if (it < 0) continue;
        const int g = it % S5G, pr = P0 + (it / S5G) % NPAIR, b = it / (NPAIR * S5G);
        const int k_s = 2 * pr + hh, k_a = 2 * pr + a_half;
        const int rb_a = s5_chunk_row0(b, k_a);
#pragma unroll
        for (int d = 0; d < 2; ++d) {
            const size_t dg = (size_t)d * S5G + g;
            s5_bf16x8 bfr[4], cfr[4];
#pragma unroll
            for (int ct = 0; ct < 4; ++ct) { bfr[ct] = BF[(dg * 4 + ct) * 64 + lane]; if (PASS == 2) cfr[ct] = CF[(dg * 4 + ct) * 64 + lane]; }
            const float l0r = lamb[(dg * S5S + r) * 2], l0i = lamb[(dg * S5S + r) * 2 + 1], l1r = lamb[(dg * S5S + r + 32) * 2], l1i = lamb[(dg * S5S + r + 32) * 2 + 1];
            float x0r = 0.f, x0i = 0.f, x1r = 0.f, x1i = 0.f;
            float* Eb = E + (((size_t)(b * S5G + g) * 2 + d) * S5_NCH) * S5S * 2;
            if (PASS == 2) {
                const float t0r = lamt[(dg * S5S + r) * 2], t0i = lamt[(dg * S5S + r) * 2 + 1], t1r = lamt[(dg * S5S + r + 32) * 2], t1i = lamt[(dg * S5S + r + 32) * 2 + 1];
                const int oi = s5_order(d, k_s);
                const int oa = s5_order(d, 2 * pr), ob = s5_order(d, 2 * pr + 1), oimax = oa > ob ? oa : ob;
                for (int j0 = 0; j0 < oimax; j0 += 4) { float e0r[4], e0i[4], e1r[4], e1i[4];
#pragma unroll
                    for (int k = 0; k < 4; ++k) { const int jc = j0 + k < S5_NCH ? j0 + k : S5_NCH - 1; e0r[k] = Eb[(jc * S5S + r) * 2]; e0i[k] = Eb[(jc * S5S + r) * 2 + 1]; e1r[k] = Eb[(jc * S5S + r + 32) * 2]; e1i[k] = Eb[(jc * S5S + r + 32) * 2 + 1]; }
                    asm volatile("" : "+v"(e0r[0]), "+v"(e0r[1]), "+v"(e0r[2]), "+v"(e0r[3]), "+v"(e0i[0]), "+v"(e0i[1]), "+v"(e0i[2]), "+v"(e0i[3]), "+v"(e1r[0]), "+v"(e1r[1]), "+v"(e1r[2]), "+v"(e1r[3]), "+v"(e1i[0]), "+v"(e1i[1]), "+v"(e1i[2]), "+v"(e1i[3]));
#pragma unroll
                    for (int k = 0; k < 4; ++k) { const float n0r = t0r * x0r - t0i * x0i + e0r[k], n0i = t0r * x0i + t0i * x0r + e0i[k], n1r = t1r * x1r - t1i * x1i + e1r[k], n1i = t1r * x1i + t1i * x1r + e1i[k];
                        if (j0 + k < oi) { x0r = n0r; x0i = n0i; x1r = n1r; x1i = n1i; } } }
            }
#pragma unroll 1
            for (int i = 0; i < 8; ++i) {
                const int tile = d ? 7 - i : i;
                const s5_bf16x8 a = *(const s5_bf16x8*)(u1 + (size_t)(rb_a + tile * 16 + a_n) * S5W + g * S5C + 8 * hh);
                s5_f32x16 acc[4];
#pragma unroll
                for (int ct = 0; ct < 4; ++ct) { const float z0 = opaque_zero(); s5_f32x16 zz;
#pragma unroll
                    for (int e = 0; e < 16; ++e) zz[e] = z0;
                    acc[ct] = __builtin_amdgcn_mfma_f32_32x32x16_bf16(a, bfr[ct], zz, 0, 0, 0); }
                MFMA_KEEP(acc[3], a);
#pragma unroll
                for (int nn = 0; nn < 16; ++nn) {
                    const int n = d ? 15 - nn : nn;
                    float n0r = __builtin_fmaf(l0r, x0r, __builtin_fmaf(-l0i, x0i, acc[0][n])), n0i = __builtin_fmaf(l0r, x0i, __builtin_fmaf(l0i, x0r, acc[1][n])), n1r = __builtin_fmaf(l1r, x1r, __builtin_fmaf(-l1i, x1i, acc[2][n])), n1i = __builtin_fmaf(l1r, x1i, __builtin_fmaf(l1i, x1r, acc[3][n]));
                    asm volatile("" : "+v"(n0r), "+v"(n0i), "+v"(n1r), "+v"(n1i));
                    x0r = n0r; x0i = n0i; x1r = n1r; x1i = n1i;
                    if (PASS == 2) { *(LAS unsigned*)(xl + (hh * 16 + n) * S5_XPITCH + 4 * r) = pack2bf(x0r, x0i); *(LAS unsigned*)(xl + (hh * 16 + n) * S5_XPITCH + 4 * (r + 32)) = pack2bf(x1r, x1i); }
                }
                if (PASS == 2) asm volatile("" ::: "memory");
                if (PASS == 2) {
#pragma unroll
                    for (int rg = 0; rg < 2; ++rg) {
                        const size_t row = (size_t)s5_chunk_row0(b, 2 * pr + rg) + tile * 16 + tk; const size_t off = row * S5W + g * S5C + 4 * q4;
                        f32x4 yv; LAS u32x2_t* ypark = (LAS u32x2_t*)(xl + S5_XBYTES + S5_ABYTES) + (tile * 2 + rg) * 64 + lane;
                        if (d == 0) { const f32x4 dsk = *(const f32x4*)(p.s5_d + g * S5C + 4 * q4); const u32x2_t uu = *(const u32x2_t*)(u1 + off);
                            yv = (f32x4){dsk[0] * __uint_as_float(uu.x << 16), dsk[1] * __uint_as_float(uu.x & 0xffff0000u), dsk[2] * __uint_as_float(uu.y << 16), dsk[3] * __uint_as_float(uu.y & 0xffff0000u)}; }
                        else { const unsigned y01 = ypark->x, y23 = ypark->y; yv = (f32x4){__uint_as_float(y01 << 16), __uint_as_float(y01 & 0xffff0000u), __uint_as_float(y23 << 16), __uint_as_float(y23 & 0xffff0000u)}; }
#pragma unroll
                        for (int ks = 0; ks < 4; ++ks) { const s5_bf16x8 xb = *(const LAS s5_bf16x8*)(xl + (rg * 16 + tk) * S5_XPITCH + (32 * ks + 8 * q4) * 2);
                            yv = __builtin_amdgcn_mfma_f32_16x16x32_bf16(cfr[ks], xb, yv, 0, 0, 0); MFMA_KEEP(yv, xb); }
                        if (d == 0) { ypark->x = pack2bf(yv[0], yv[1]); ypark->y = pack2bf(yv[2], yv[3]); }
                        else if (DENSE1_FP8) *(unsigned*)((unsigned char*)z + off) = pack4_fp8(geluf_(yv[0]) * Z8_SCALE, geluf_(yv[1]) * Z8_SCALE, geluf_(yv[2]) * Z8_SCALE, geluf_(yv[3]) * Z8_SCALE);
                        else { u32x2_t w; w.x = pack2bf(geluf_(yv[0]), geluf_(yv[1])); w.y = pack2bf(geluf_(yv[2]), geluf_(yv[3])); *(u32x2_t*)(z + off) = w; }
                    }
                    asm volatile("" ::: "memory");
                }
            }
            if (PASS == 1) { const int oi = s5_order(d, k_s); float* ep = Eb + (size_t)oi * S5S * 2;
                ep[r * 2] = x0r; ep[r * 2 + 1] = x0i; ep[(r + 32) * 2] = x1r; ep[(r + 32) * 2 + 1] = x1i; }
        }
    }
}
#endif
#ifndef CPU_EMU
__device__ __forceinline__ void ph_conv_fast(const Params& p, long gtid, long gthreads) {
    const bf16_t* qkv = (const bf16_t*)(p.ws + WS_QKV); bf16_t* ub = (bf16_t*)(p.ws + WS_UBF);
    const int ch = (int)(gtid % (LW / 8)) * 8;
    float wt[4][8], bs[8];
#pragma unroll
    for (int j = 0; j < 8; ++j) bs[j] = p.lru_conv_b[ch + j];
#pragma unroll
    for (int tap = 0; tap < 4; ++tap)
#pragma unroll
        for (int j = 0; j < 8; ++j) wt[tap][j] = p.lru_conv_w[tap * LW + ch + j];
    for (long it = gtid; it < (long)MT * (LW / 8); it += gthreads) {
        const int rr = (int)(it / (LW / 8));
        int base, t, n; if (rr < ML) { base = (rr / NSEQ) * NSEQ; t = rr % NSEQ; n = NSEQ; } else { const int rc = rr - ML; base = ML + (rc / NCTX) * NCTX; t = rc % NCTX; n = NCTX; }
        u32x4_t xv[4];
#pragma unroll
        for (int tap = 0; tap < 4; ++tap) { int tt = t + tap - 2; tt = tt < 0 ? 0 : (tt > n - 1 ? n - 1 : tt); xv[tap] = *(const u32x4_t*)(qkv + (size_t)(base + tt) * EVIN + COL_XR + ch); }
        float acc[8];
#pragma unroll
        for (int j = 0; j < 8; ++j) acc[j] = bs[j];
#pragma unroll
        for (int tap = 0; tap < 4; ++tap) { const int tt = t + tap - 2; const float ok = (tt >= 0 && tt < n) ? 1.0f : 0.0f; const unsigned vw[4] = {xv[tap].x, xv[tap].y, xv[tap].z, xv[tap].w};
#pragma unroll
            for (int j = 0; j < 8; ++j) acc[j] += (wt[tap][j] * ok) * __uint_as_float((j & 1) ? (vw[j >> 1] & 0xffff0000u) : (vw[j >> 1] << 16)); }
        u32x4_t w; w.x = pack2bf(acc[0], acc[1]); w.y = pack2bf(acc[2], acc[3]); w.z = pack2bf(acc[4], acc[5]); w.w = pack2bf(acc[6], acc[7]);
        *(u32x4_t*)(ub + (size_t)rr * LW + ch) = w;
    }
}
__device__ __forceinline__ int lru_chunk_row0(int b, int k) { return k < LRU_NCC ? ML + b * NCTX + k * LRU_CH : b * NSEQ + (k - LRU_NCC) * LRU_CH; }
__device__ __forceinline__ int lru_order(int d, int k) { return d == 0 ? k : (k < LRU_NCC ? LRU_NCC - 1 - k : LRU_NCC + (LRU_NLC - 1 - (k - LRU_NCC))); }
#define LRU_ZERO16(v) do { const float z0_ = opaque_zero(); _Pragma("unroll") for (int e_ = 0; e_ < 16; ++e_) v[e_] = z0_; } while (0)
template <int PASS> __device__ __forceinline__ void ph_lru_fast(const Params& p, LAS unsigned char* lds, int gwave, int nwaves, int wv_) {
    const int lane = tid_of(wv_) & 63; LAS float* hfl = (LAS float*)(lds + wv_ * (LRU_CH * 64 * 4)) + lane;
    const int r = lane & 31, hh = lane >> 5, a_half = (r >> 2) & 1, a_n = (r & 3) + 4 * (r >> 3);
    const bf16_t* ub = (const bf16_t*)(p.ws + WS_UBF); const bf16_t* qkv = (const bf16_t*)(p.ws + WS_QKV); bf16_t* mix = (bf16_t*)(p.ws + WS_MIX);
    const s5_bf16x8* LB = (const s5_bf16x8*)(p.ws + WS_LRUBF); float* AGG = (float*)(p.ws + WS_LRUAGG);
    constexpr int NPAIR = LRU_NCH / 2, NT = LRU_CH / 16;
    s5_bf16x8 idf[2];
#pragma unroll
    for (int kk = 0; kk < 2; ++kk) { const int jj = r - 16 * kk - 8 * hh;
#pragma unroll
        for (int e = 0; e < 8; ++e) idf[kk][e] = (e == jj) ? (short)0x3F80 : (short)0; }
    for (int rd = 0; rd <= (NB * 16 * 2 * NPAIR) / nwaves; ++rd) {
        const int it = deal_item(rd, gwave, nwaves, NB * 16 * 2 * NPAIR, OUT0_FP8 ? 4 : 2); if (it < 0) continue;
        const int cs = it & 1, pr = OUT0_FP8 ? (it >> 2) % NPAIR : (it >> 1) % NPAIR, h = OUT0_FP8 ? 2 * ((it / (4 * NPAIR)) % 8) + ((it >> 1) & 1) : (it / (2 * NPAIR)) % 16, b = it / (32 * NPAIR);
        const int k_s = 2 * pr + hh, k_a = 2 * pr + a_half, rb_a = lru_chunk_row0(b, k_a), rb_s = lru_chunk_row0(b, k_s);
        const int ch = h * 64 + 32 * cs + r;
#pragma unroll
        for (int d = 0; d < 2; ++d) {
            const int oi = lru_order(d, k_s);
            s5_bf16x8 br[4], bi[4];
#pragma unroll
            for (int ks = 0; ks < 4; ++ks) { br[ks] = LB[(((size_t)(d * 16 + h) * 2 + 0) * 2 + cs) * 4 * 64 + ks * 64 + lane]; bi[ks] = LB[(((size_t)(d * 16 + h) * 2 + 1) * 2 + cs) * 4 * 64 + ks * 64 + lane]; }
            const float lamv = softplusf_(-p.lru_lam[d * LW + ch]), bav = p.lru_ba[d * LW + ch], biv = p.lru_bi[d * LW + ch];
            const float nba = -1.44269504089f * bav, nbi = -1.44269504089f * biv, c2 = -8.0f * 1.44269504089f * lamv;
            float state = 0.f, aprod = 1.f;
            float* ag = AGG + (((size_t)b * 2 + d) * LRU_NCH) * LW * 2;
            if (PASS == 2) { const int oa = lru_order(d, 2 * pr), ob = lru_order(d, 2 * pr + 1), oimax = oa > ob ? oa : ob;
                for (int j0 = 0; j0 < oimax; j0 += 8) { float aj[8], bj[8];
#pragma unroll
                    for (int k = 0; k < 8; ++k) { const int jc = j0 + k < LRU_NCH ? j0 + k : LRU_NCH - 1; aj[k] = ag[((size_t)jc * LW + ch) * 2]; bj[k] = ag[((size_t)jc * LW + ch) * 2 + 1]; }
                    asm volatile("" : "+v"(aj[0]), "+v"(aj[1]), "+v"(aj[2]), "+v"(aj[3]), "+v"(aj[4]), "+v"(aj[5]), "+v"(aj[6]), "+v"(aj[7]), "+v"(bj[0]), "+v"(bj[1]), "+v"(bj[2]), "+v"(bj[3]), "+v"(bj[4]), "+v"(bj[5]), "+v"(bj[6]), "+v"(bj[7]));
#pragma unroll
                    for (int k = 0; k < 8; ++k) if (j0 + k < oi) state = aj[k] * state + bj[k]; } }
            s5_bf16x8 an[4], gn0, gn1;
            { const int tile0 = d ? NT - 1 : 0; const bf16_t* up = ub + (size_t)(rb_a + tile0 * 16 + a_n) * LW + h * 64 + 8 * hh;
#pragma unroll
              for (int ks = 0; ks < 4; ++ks) an[ks] = *(const s5_bf16x8*)(up + 16 * ks);
              if (PASS == 2 && d == 1) { const bf16_t* gp = qkv + (size_t)(rb_a + tile0 * 16 + a_n) * EVIN + COL_GR + h * 64 + 32 * cs + 8 * hh; gn0 = *(const s5_bf16x8*)gp; gn1 = *(const s5_bf16x8*)(gp + 16); } }
#pragma unroll 1
            for (int i = 0; i < NT; ++i) {
                const int tile = d ? NT - 1 - i : i;
                s5_bf16x8 a[4], g0, g1;
#pragma unroll
                for (int ks = 0; ks < 4; ++ks) a[ks] = an[ks];
                if (PASS == 2 && d == 1) { g0 = gn0; g1 = gn1; }
                if (i + 1 < NT) { const int tl = d ? tile - 1 : tile + 1; const bf16_t* up = ub + (size_t)(rb_a + tl * 16 + a_n) * LW + h * 64 + 8 * hh;
#pragma unroll
                    for (int ks = 0; ks < 4; ++ks) an[ks] = *(const s5_bf16x8*)(up + 16 * ks);
                    if (PASS == 2 && d == 1) { const bf16_t* gp = qkv + (size_t)(rb_a + tl * 16 + a_n) * EVIN + COL_GR + h * 64 + 32 * cs + 8 * hh; gn0 = *(const s5_bf16x8*)gp; gn1 = *(const s5_bf16x8*)(gp + 16); } }
                s5_f32x16 ar, ai, au, agr; LRU_ZERO16(ar); LRU_ZERO16(ai); LRU_ZERO16(au); LRU_ZERO16(agr);
#pragma unroll
                for (int ks = 0; ks < 4; ++ks) { ar = __builtin_amdgcn_mfma_f32_32x32x16_bf16(a[ks], br[ks], ar, 0, 0, 0); ai = __builtin_amdgcn_mfma_f32_32x32x16_bf16(a[ks], bi[ks], ai, 0, 0, 0); }
                au = __builtin_amdgcn_mfma_f32_32x32x16_bf16(cs ? a[2] : a[0], idf[0], au, 0, 0, 0); au = __builtin_amdgcn_mfma_f32_32x32x16_bf16(cs ? a[3] : a[1], idf[1], au, 0, 0, 0);
                if (PASS == 2 && d == 1) { agr = __builtin_amdgcn_mfma_f32_32x32x16_bf16(g0, idf[0], agr, 0, 0, 0); agr = __builtin_amdgcn_mfma_f32_32x32x16_bf16(g1, idf[1], agr, 0, 0, 0); }
                MFMA_KEEP(au, a[0]); MFMA_KEEP(au, a[1]); MFMA_KEEP(au, a[2]); MFMA_KEEP(au, a[3]); MFMA_KEEP(ai, a[3]); if (PASS == 2 && d == 1) { MFMA_KEEP(agr, g0); MFMA_KEEP(agr, g1); }
#pragma unroll
                for (int nn = 0; nn < 16; ++nn) {
                    const int n = d ? 15 - nn : nn;
                    const float rg = fast_rcp(1.0f + __builtin_amdgcn_exp2f(__builtin_fmaf(ar[n], -1.44269504089f, nba))), ig = fast_rcp(1.0f + __builtin_amdgcn_exp2f(__builtin_fmaf(ai[n], -1.44269504089f, nbi))), av = __builtin_amdgcn_exp2f(rg * c2), mult = fast_sqrt(__builtin_fmaf(-av, av, 1.0f));
                    state = av * state + mult * (ig * au[n]);
                    if (PASS == 1) aprod *= av;
                    if (PASS == 2) { if (d == 0) hfl[(tile * 16 + n) * 64] = state; else { const float mv = (hfl[(tile * 16 + n) * 64] + state) * geluf_(agr[n]);
                        if (OUT0_FP8) ((unsigned char*)mix)[(size_t)(rb_s + tile * 16 + n) * D + QW + ch] = (unsigned char)(pack4_fp8(mv, 0.f, 0.f, 0.f) & 0xffu); else mix[(size_t)(rb_s + tile * 16 + n) * D + QW + ch] = f2bf(mv); } }
                }
            }
            if (PASS == 1) { ag[((size_t)oi * LW + ch) * 2] = aprod; ag[((size_t)oi * LW + ch) * 2 + 1] = state; }
        }
    }
}
#endif
#ifndef CPU_EMU
constexpr int AT_KROWS = 320, AT_LDS_K = 0, AT_LDS_V = AT_KROWS * 128, AT_LDS_BYTES = 2 * AT_KROWS * 128;
static_assert(NCTX == 256, "attention key halves assume 256 context keys");
__device__ __forceinline__ void ph_attn_fast(const Params& p, LAS unsigned char* lds, int bid, int nblocks, int wv_) {
    const int tid = tid_of(wv_), lane = tid & 63, w = wv_, r = lane & 31, hh = lane >> 5;
    const bf16_t* qkv = (const bf16_t*)(p.ws + WS_QKV); const bf16_t* vt = (const bf16_t*)(p.ws + WS_VT); bf16_t* mix = (bf16_t*)(p.ws + WS_MIX);
    constexpr int NQB = NSEQ / 128, NCB = NCTX / 128, UNITS = NB * 4 * (NQB + NCB);
    for (int un = bid; un < UNITS; un += nblocks) {
        const int kvh = un & 3, rest = un >> 2; int b, qb; if (rest < NB * NQB) { b = rest / NQB; qb = rest % NQB; } else { b = (rest - NB * NQB) / NCB; qb = NQB + (rest - NB * NQB) % NCB; }
        const bool isc = qb >= NQB;
        const int q0 = isc ? (qb - NQB) * 128 : qb * 128, qrow0 = isc ? ML + b * NCTX + q0 : b * NSEQ + q0, head = 4 * kvh + (w >> 1);
        s5_bf16x8 qf[2][4];
#pragma unroll
        for (int qt = 0; qt < 2; ++qt)
#pragma unroll
            for (int ds = 0; ds < 4; ++ds) qf[qt][ds] = *(const s5_bf16x8*)(qkv + (size_t)(qrow0 + 64 * (w & 1) + 32 * qt + r) * EVIN + COL_Q + head * 64 + 16 * ds + 8 * hh);
        s5_f32x16 oacc[2][2];
#pragma unroll
        for (int qt = 0; qt < 2; ++qt)
#pragma unroll
            for (int dt = 0; dt < 2; ++dt)
#pragma unroll
                for (int e = 0; e < 16; ++e) oacc[qt][dt][e] = 0.f;
        const float sk = p.attn_sink[head];
        float mrun[2] = {sk, sk}, lrun[2] = {hh == 0 ? 1.0f : 0.f, hh == 0 ? 1.0f : 0.f};
#pragma unroll 1
        for (int half = isc ? 1 : 0; half < 2; ++half) {
            __syncthreads();
            static_assert(AT_KROWS * 8 == 5 * 512 && 64 * 40 == 5 * 512, "staging: five 16-byte pieces per thread and operand");
            u4v_t stK[5], stV[5];
#pragma unroll
            for (int k5 = 0; k5 < 5; ++k5) {
                const int i = tid + 512 * k5, row = i >> 3, cc = i & 7; int grow;
                if (half == 1 && row >= 64) grow = ML + b * NCTX + (row - 64);
                else { int kpos = q0 - 128 + 320 * half + row; kpos = kpos < 0 ? 0 : (kpos > NSEQ - 1 ? NSEQ - 1 : kpos); grow = b * NSEQ + kpos; }
                stK[k5] = *(const u4v_t*)(qkv + (size_t)grow * EVIN + COL_K + kvh * 64 + cc * 8);
            }
#pragma unroll
            for (int k5 = 0; k5 < 5; ++k5) {
                const int i = tid + 512 * k5, d = i / 40, pc = i % 40;
                const int pos = (half == 0) ? q0 + pc * 8 : (pc < 8 ? q0 + 320 + pc * 8 : 128 + NSEQ + 128 + (pc - 8) * 8);
                stV[k5] = *(const u4v_t*)(vt + ((size_t)(b * 4 + kvh) * 64 + d) * VT_T + pos);
            }
#pragma unroll
            for (int k5 = 0; k5 < 5; ++k5) { const int i = tid + 512 * k5, row = i >> 3, cc = i & 7; *(LAS u4v_t*)(lds + AT_LDS_K + row * 128 + ((cc ^ (row & 7)) << 4)) = stK[k5]; }
#pragma unroll
            for (int k5 = 0; k5 < 5; ++k5) { const int i = tid + 512 * k5, d = i / 40, pc = i % 40, kt = pc >> 2, cc = pc & 3; *(LAS u4v_t*)(lds + AT_LDS_V + kt * 4096 + d * 64 + ((cc ^ ((d >> 2) & 3)) << 4)) = stV[k5]; }
            __syncthreads();
#pragma unroll 1
            for (int kt = (isc ? 2 : 0); kt < 10; ++kt) {
                const bool local = !(half == 1 && kt >= 2);
                const int Kb = q0 - 128 + 320 * half + 32 * kt;
                s5_bf16x8 kf[4], vf[2][2];
#pragma unroll
                for (int ds = 0; ds < 4; ++ds) kf[ds] = *(const LAS s5_bf16x8*)(lds + AT_LDS_K + (32 * kt + r) * 128 + (((2 * ds + hh) ^ (r & 7)) << 4));
#pragma unroll
                for (int dt = 0; dt < 2; ++dt)
#pragma unroll
                    for (int s2 = 0; s2 < 2; ++s2) vf[dt][s2] = *(const LAS s5_bf16x8*)(lds + AT_LDS_V + kt * 4096 + (32 * dt + r) * 64 + (((2 * s2 + hh) ^ (((32 * dt + r) >> 2) & 3)) << 4));
#pragma unroll
                for (int qt = 0; qt < 2; ++qt) {
                    const int Qb = q0 + 64 * (w & 1) + 32 * qt;
                    bool need_mask = false;
                    if (local) {
                        if (Kb - (Qb + 31) > 128 || Qb - (Kb + 31) > 128 || Kb + 31 < 0 || Kb >= NSEQ) continue;
                        need_mask = !(Kb + 31 - Qb <= 128 && Qb + 31 - Kb <= 128 && Kb >= 0 && Kb + 31 < NSEQ);
                    }
                    s5_f32x16 sc; const float z0 = opaque_zero();
#pragma unroll
                    for (int e = 0; e < 16; ++e) sc[e] = z0;
#pragma unroll
                    for (int ds = 0; ds < 4; ++ds) sc = __builtin_amdgcn_mfma_f32_32x32x16_bf16(kf[ds], qf[qt][ds], sc, 0, 0, 0);
                    MFMA_KEEP(sc, kf[0]); MFMA_KEEP(sc, kf[1]); MFMA_KEEP(sc, kf[2]); MFMA_KEEP(sc, kf[3]);
                    if (need_mask) {
                        const int qpos = Qb + r;
#pragma unroll
                        for (int e = 0; e < 16; ++e) { const int kpos = Kb + (e & 3) + 8 * (e >> 2) + 4 * hh, rel = kpos - qpos; if (rel > 128 || rel < -128 || kpos < 0 || kpos >= NSEQ) sc[e] = -1e30f; }
                    }
                    float tmax = sc[0];
#pragma unroll
                    for (int e = 1; e < 16; ++e) tmax = fmaxf(tmax, sc[e]);
                    tmax = fmaxf(tmax, __shfl_xor(tmax, 32));
                    const float mnew = fmaxf(mrun[qt], tmax), scl = __expf(mrun[qt] - mnew), mneg = -mnew * 1.44269504089f; mrun[qt] = mnew;
                    float psum = 0.f; float pv[16];
#pragma unroll
                    for (int e = 0; e < 16; ++e) { pv[e] = __builtin_amdgcn_exp2f(__builtin_fmaf(sc[e], 1.44269504089f, mneg)); psum += pv[e]; }
                    lrun[qt] = lrun[qt] * scl + psum;
                    if (__ballot(scl != 1.0f) != 0ull) {
#pragma unroll
                    for (int dt = 0; dt < 2; ++dt)
#pragma unroll
                        for (int e = 0; e < 16; ++e) oacc[qt][dt][e] *= scl; }
                    s5_bf16x8 pf[2];
#pragma unroll
                    for (int s2 = 0; s2 < 2; ++s2) { unsigned w0 = pack2bf(pv[8 * s2], pv[8 * s2 + 1]), w1 = pack2bf(pv[8 * s2 + 2], pv[8 * s2 + 3]), w2 = pack2bf(pv[8 * s2 + 4], pv[8 * s2 + 5]), w3 = pack2bf(pv[8 * s2 + 6], pv[8 * s2 + 7]);
                        u4v_t t4 = {w0, w1, w2, w3}; pf[s2] = __builtin_bit_cast(s5_bf16x8, t4); }
#pragma unroll
                    for (int dt = 0; dt < 2; ++dt)
#pragma unroll
                        for (int s2 = 0; s2 < 2; ++s2) oacc[qt][dt] = __builtin_amdgcn_mfma_f32_32x32x16_bf16(vf[dt][s2], pf[s2], oacc[qt][dt], 0, 0, 0);
                    MFMA_KEEP(oacc[qt][1], pf[0]); MFMA_KEEP(oacc[qt][1], pf[1]);
                }
            }
        }
#pragma unroll
        for (int qt = 0; qt < 2; ++qt) {
            const float ltot = lrun[qt] + __shfl_xor(lrun[qt], 32), inv = 1.0f / ltot;
            bf16_t* op = mix + (size_t)(qrow0 + 64 * (w & 1) + 32 * qt + r) * D + head * 64; unsigned char* op8 = (unsigned char*)mix + (size_t)(qrow0 + 64 * (w & 1) + 32 * qt + r) * D + head * 64; const float inv8 = inv * MIX8_SCALE;
#pragma unroll
            for (int dt = 0; dt < 2; ++dt)
#pragma unroll
                for (int g4 = 0; g4 < 4; ++g4) {
                    if (OUT0_FP8) { *(unsigned*)(op8 + 32 * dt + 8 * g4 + 4 * hh) = pack4_fp8(oacc[qt][dt][4 * g4] * inv8, oacc[qt][dt][4 * g4 + 1] * inv8, oacc[qt][dt][4 * g4 + 2] * inv8, oacc[qt][dt][4 * g4 + 3] * inv8); continue; }
                    u32x2_t wv2; wv2.x = pack2bf(oacc[qt][dt][4 * g4] * inv, oacc[qt][dt][4 * g4 + 1] * inv); wv2.y = pack2bf(oacc[qt][dt][4 * g4 + 2] * inv, oacc[qt][dt][4 * g4 + 3] * inv);
                    *(u32x2_t*)(op + 32 * dt + 8 * g4 + 4 * hh) = wv2; }
        }
    }
}
#endif
#ifndef CPU_EMU
__device__ __forceinline__ float wave_sum(float v) {
#pragma unroll
    for (int o = 32; o >= 1; o >>= 1) v += __shfl_xor(v, o);
    return v; }
template <int MODE> __device__ __forceinline__ void ph_norm_fast(const Params& p, int l, int rows, int gwave, int nwaves, int wv_) {
    const int lane = tid_of(wv_) & 63;
    bf16_t* h = (bf16_t*)(p.ws + WS_H); float* xres = (float*)(p.ws + WS_XRES); const bf16_t* yb = (const bf16_t*)(p.ws + WS_YBUF);
    const float* tok_w = (const float*)(p.ws + WS_TOK) + (size_t)MT * 2; const int* tok_dest = (const int*)(p.ws + WS_TOK) + (size_t)MT * 6;
    for (int r = gwave; r < rows; r += nwaves) {
        const int ar = ada_row(r);
        f32x4 xv[8];
        f32x4 cg[8], cs[8], ch[8];
        if (MODE == 2) {
#pragma unroll
            for (int i = 0; i < 8; ++i) cg[i] = *(const f32x4*)(p.norm_final + 4 * lane + 256 * i);
        } else { const float* sh = ada_ptr(p, l, ar, 0); const float* sc = ada_ptr(p, l, ar, 1); const float* g = p.norm_mix + (size_t)l * D;
#pragma unroll
            for (int i = 0; i < 8; ++i) { const int c = 4 * lane + 256 * i; cg[i] = *(const f32x4*)(g + c); cs[i] = *(const f32x4*)(sc + c); ch[i] = *(const f32x4*)(sh + c); } }
        if (MODE == 0) { const float* xr = xin_row(p, l, r);
#pragma unroll
            for (int i = 0; i < 8; ++i) xv[i] = *(const f32x4*)(xr + 4 * lane + 256 * i); }
        else { const int lm = (MODE == 1) ? l - 1 : 1; const float* g2 = ada_ptr(p, lm, ar, 5); float* xr = xres + (size_t)r * D;
            const int d0 = tok_dest[r * 2], d1 = tok_dest[r * 2 + 1]; const float w0 = tok_w[r * 2], w1 = tok_w[r * 2 + 1];
            f32x4 xo[8], gg[8]; unsigned ya8[8], yc8[8]; u32x2_t ya16[8], yc16[8];
#pragma unroll
            for (int i = 0; i < 8; ++i) { const int c = 4 * lane + 256 * i;
                if (RES_BF16) { const u32x2_t t = *(const u32x2_t*)((const bf16_t*)xres + (size_t)r * D + c); xo[i] = unpack4bf(t.x, t.y); } else xo[i] = *(const f32x4*)(xr + c);
                gg[i] = *(const f32x4*)(g2 + c);
                if (Y8) { ya8[i] = *(const unsigned*)((const unsigned char*)yb + (size_t)d0 * D + c); yc8[i] = *(const unsigned*)((const unsigned char*)yb + (size_t)d1 * D + c); }
                else { ya16[i] = *(const u32x2_t*)(yb + (size_t)d0 * D + c); yc16[i] = *(const u32x2_t*)(yb + (size_t)d1 * D + c); } }
#pragma unroll
            for (int i = 0; i < 8; ++i) { f32x4 m;
                if (Y8) { const unsigned ya = ya8[i], yc = yc8[i]; const float u0 = w0 * (1.0f / Y8_SCALE), u1 = w1 * (1.0f / Y8_SCALE);
                    m[0] = u0 * __builtin_amdgcn_cvt_f32_fp8(ya, 0) + u1 * __builtin_amdgcn_cvt_f32_fp8(yc, 0); m[1] = u0 * __builtin_amdgcn_cvt_f32_fp8(ya, 1) + u1 * __builtin_amdgcn_cvt_f32_fp8(yc, 1);
                    m[2] = u0 * __builtin_amdgcn_cvt_f32_fp8(ya, 2) + u1 * __builtin_amdgcn_cvt_f32_fp8(yc, 2); m[3] = u0 * __builtin_amdgcn_cvt_f32_fp8(ya, 3) + u1 * __builtin_amdgcn_cvt_f32_fp8(yc, 3); }
                else { const u32x2_t ya = ya16[i], yc = yc16[i];
                    m[0] = w0 * __uint_as_float(ya.x << 16) + w1 * __uint_as_float(yc.x << 16); m[1] = w0 * __uint_as_float(ya.x & 0xffff0000u) + w1 * __uint_as_float(yc.x & 0xffff0000u);
                    m[2] = w0 * __uint_as_float(ya.y << 16) + w1 * __uint_as_float(yc.y << 16); m[3] = w0 * __uint_as_float(ya.y & 0xffff0000u) + w1 * __uint_as_float(yc.y & 0xffff0000u); }
                xv[i] = xo[i] + gg[i] * m; } }
        float ss = 0.f;
#pragma unroll
        for (int i = 0; i < 8; ++i) ss += (xv[i][0] * xv[i][0] + xv[i][1] * xv[i][1]) + (xv[i][2] * xv[i][2] + xv[i][3] * xv[i][3]);
        ss = wave_sum(ss);
        const float rstd = 1.0f / sqrtf(ss * (1.0f / D) + 1e-6f);
#ifndef CPU_EMU
        asm volatile("" ::: "memory");
#endif
        if (MODE == 2) {
#pragma unroll
            for (int i = 0; i < 8; ++i) { const int c = 4 * lane + 256 * i; *(f32x4*)(p.out + (size_t)r * D + c) = xv[i] * rstd * cg[i]; }
        } else {
#pragma unroll
            for (int i = 0; i < 8; ++i) { const int c = 4 * lane + 256 * i;
                if (MODE == 1) { if (RES_BF16) { u32x2_t t; t.x = pack2bf(xv[i][0], xv[i][1]); t.y = pack2bf(xv[i][2], xv[i][3]); *(u32x2_t*)((bf16_t*)xres + (size_t)r * D + c) = t; } else *(f32x4*)(xres + (size_t)r * D + c) = xv[i]; }
                const f32x4 hv = xv[i] * rstd * cg[i] * (cs[i] + 1.0f) + ch[i];
                if ((MODE == 1 && DENSE1_FP8) || (MODE == 0 && IN0_FP8)) *(unsigned*)((unsigned char*)h + (size_t)r * D + c) = pack4_fp8(hv[0], hv[1], hv[2], hv[3]);
                else { if (MODE == 0 && IN0QKV_FP8) *(unsigned*)(p.ws + WS_H8 + (size_t)r * D + c) = pack4_fp8(hv[0], hv[1], hv[2], hv[3]);
                    u32x2_t w; w.x = pack2bf(hv[0], hv[1]); w.y = pack2bf(hv[2], hv[3]); *(u32x2_t*)(h + (size_t)r * D + c) = w; } } }
    }
}
template <bool H8> __device__ __forceinline__ void ph_router_fast(const Params& p, int l, int rows, LAS unsigned char* lds, int bid, int nblocks, int wv_) {
    const int lane = tid_of(wv_) & 63, rr = lane & 15, q = lane >> 4, w = wv_;
    bf16_t* h = (bf16_t*)(p.ws + WS_H); const float* xres = (const float*)(p.ws + WS_XRES); const s5_bf16x8* RWF = (const s5_bf16x8*)(p.ws + WS_RWF);
    int* tok_e = (int*)(p.ws + WS_TOK); float* tok_w = (float*)(p.ws + WS_TOK) + (size_t)MT * 2; int* tok_slot = (int*)(p.ws + WS_TOK) + (size_t)MT * 4;
    int* hist = (int*)(p.ws + WS_HIST) + (size_t)l * MAXG * HIST_LD;
    int run = 0;
    LAS float* ssq = (LAS float*)lds;
    LAS f32x4* red = (LAS f32x4*)(lds + 1024);
    LAS float* cfA = (LAS float*)(lds + 16384); LAS float* cfB = cfA + D;
    const int tid = w * 64 + lane, ntl = rows / 16, TPW = (ntl + nblocks - 1) / nblocks, t_lo = bid * TPW, t_hi = (t_lo + TPW < ntl) ? t_lo + TPW : ntl;
    s5_bf16x8 rwh[8], rwl[8];
#pragma unroll
    for (int st = 0; st < 8; ++st) { rwh[st] = RWF[(8 * w + st) * 64 + lane]; rwl[st] = RWF[(64 + 8 * w + st) * 64 + lane]; }
    int ar_cur = -1;
    u4v_t nx[8];
    if (RES_BF16 && t_lo < t_hi) { const bf16_t* xr = (const bf16_t*)xres + (size_t)(t_lo * 16 + rr) * D + 256 * w + 8 * q;
#pragma unroll
        for (int st = 0; st < 8; ++st) nx[st] = *(const u4v_t*)(xr + 32 * st); }
    for (int t16 = t_lo; t16 < t_hi; ++t16) {
        const int r = t16 * 16 + rr, ar = ada_row(t16 * 16);
        if (ar != ar_cur) { ar_cur = ar;
            const f32x4 gv = *(const f32x4*)(p.norm_ffn + (size_t)l * D + 4 * tid), sv = *(const f32x4*)(ada_ptr(p, l, ar, 4) + 4 * tid), hv = *(const f32x4*)(ada_ptr(p, l, ar, 3) + 4 * tid);
            *(LAS f32x4*)(cfA + 4 * tid) = gv * (sv + 1.0f); *(LAS f32x4*)(cfB + 4 * tid) = hv; }
        f32x4 xa[8], xb[8];
        if (RES_BF16) {
#pragma unroll
            for (int st = 0; st < 8; ++st) { xa[st] = unpack4bf(nx[st][0], nx[st][1]); xb[st] = unpack4bf(nx[st][2], nx[st][3]); }
            if (t16 + 1 < t_hi) { const bf16_t* xr = (const bf16_t*)xres + (size_t)((t16 + 1) * 16 + rr) * D + 256 * w + 8 * q;
#pragma unroll
                for (int st = 0; st < 8; ++st) nx[st] = *(const u4v_t*)(xr + 32 * st); } }
        else { const float* xr = xres + (size_t)r * D + 256 * w + 8 * q;
#pragma unroll
            for (int st = 0; st < 8; ++st) { xa[st] = *(const f32x4*)(xr + 32 * st); xb[st] = *(const f32x4*)(xr + 32 * st + 4); } }
        float ss = 0.f;
#pragma unroll
        for (int st = 0; st < 8; ++st) ss += (xa[st][0] * xa[st][0] + xa[st][1] * xa[st][1]) + (xa[st][2] * xa[st][2] + xa[st][3] * xa[st][3]) + (xb[st][0] * xb[st][0] + xb[st][1] * xb[st][1]) + (xb[st][2] * xb[st][2] + xb[st][3] * xb[st][3]);
        ss += __shfl_xor(ss, 16); ss += __shfl_xor(ss, 32);
        if (q == 0) ssq[w * 16 + rr] = ss;
        __syncthreads();
        float tot = 0.f;
#pragma unroll
        for (int ww = 0; ww < 8; ++ww) tot += ssq[ww * 16 + rr];
        const float rstd = 1.0f / sqrtf(tot * (1.0f / D) + 1e-6f);
        const LAS float* cA = cfA + 256 * w + 8 * q; const LAS float* cB = cfB + 256 * w + 8 * q;
        f32x4 lhi, llo; { const float z0 = opaque_zero(); lhi = (f32x4){z0, z0, z0, z0}; llo = lhi; }
#pragma unroll
        for (int st = 0; st < 8; ++st) {
            const f32x4 ga = *(const LAS f32x4*)(cA + 32 * st), gb = *(const LAS f32x4*)(cA + 32 * st + 4), ha = *(const LAS f32x4*)(cB + 32 * st), hb = *(const LAS f32x4*)(cB + 32 * st + 4);
            const f32x4 va = xa[st] * rstd * ga + ha, vb = xb[st] * rstd * gb + hb;
            u4v_t wv4 = {pack2bf(va[0], va[1]), pack2bf(va[2], va[3]), pack2bf(vb[0], vb[1]), pack2bf(vb[2], vb[3])};
            if (H8) { u32x2_t w8; w8.x = pack4_fp8(va[0], va[1], va[2], va[3]); w8.y = pack4_fp8(vb[0], vb[1], vb[2], vb[3]); *(u32x2_t*)((unsigned char*)h + (size_t)r * D + 256 * w + 32 * st + 8 * q) = w8; }
            else *(u4v_t*)(h + (size_t)r * D + 256 * w + 32 * st + 8 * q) = wv4;
            const s5_bf16x8 hf = __builtin_bit_cast(s5_bf16x8, wv4);
            lhi = __builtin_amdgcn_mfma_f32_16x16x32_bf16(rwh[st], hf, lhi, 0, 0, 0); MFMA_KEEP(lhi, rwh[st]);
            llo = __builtin_amdgcn_mfma_f32_16x16x32_bf16(rwl[st], hf, llo, 0, 0, 0); MFMA_KEEP(llo, rwl[st]); MFMA_KEEP(llo, hf);
        }
        red[w * 64 + lane] = lhi + llo;
        __syncthreads();
        if (w == 0) {
            f32x4 lsum = red[lane];
#pragma unroll
            for (int ww = 1; ww < 8; ++ww) lsum += red[ww * 64 + lane];
            float lg[4];
#pragma unroll
            for (int i = 0; i < 4; ++i) lg[i] = lsum[i] + p.router_b[4 * q + i];
            float mx = fmaxf(fmaxf(lg[0], lg[1]), fmaxf(lg[2], lg[3])); mx = fmaxf(mx, __shfl_xor(mx, 16)); mx = fmaxf(mx, __shfl_xor(mx, 32));
            float pr[4], sum = 0.f;
#pragma unroll
            for (int i = 0; i < 4; ++i) { pr[i] = __expf(lg[i] - mx); sum += pr[i]; }
            sum += __shfl_xor(sum, 16); sum += __shfl_xor(sum, 32);
            float a1 = -1.f, a2 = -1.f; int j1 = 0, j2 = 0;
#pragma unroll
            for (int i = 0; i < 4; ++i) { const float v = pr[i] / sum; if (v > a1) { a2 = a1; j2 = j1; a1 = v; j1 = i; } else if (v > a2) { a2 = v; j2 = i; } }
            float best = a1 + a2; int bq = q; float w1 = a1, w2 = a2; int e1 = 4 * q + j1, e2 = 4 * q + j2;
#pragma unroll
            for (int o = 16; o <= 32; o <<= 1) {
                const float ob = __shfl_xor(best, o), ow1 = __shfl_xor(w1, o), ow2 = __shfl_xor(w2, o); const int oq = __shfl_xor(bq, o), oe1 = __shfl_xor(e1, o), oe2 = __shfl_xor(e2, o);
                if (ob > best || (ob == best && oq < bq)) { best = ob; bq = oq; w1 = ow1; w2 = ow2; e1 = oe1; e2 = oe2; } }
            int rk1 = 0, rk2 = 0, mine = 0; const unsigned long long below = (1ull << rr) - 1ull;
#pragma unroll
            for (int e = 0; e < NE; ++e) { const unsigned long long m = __ballot(q == 0 && (e1 == e || e2 == e)); const int pc = __popcll(m & below); if (e1 == e) rk1 = pc; if (e2 == e) rk2 = pc; if (rr == e) mine = __popcll(m); }
            const int b1 = __shfl(run, e1), b2 = __shfl(run, e2);
            if (q == 0) { const float ws = w1 + w2; tok_e[r * 2] = e1; tok_e[r * 2 + 1] = e2; tok_w[r * 2] = w1 / ws; tok_w[r * 2 + 1] = w2 / ws;
                tok_slot[r * 2] = b1 + rk1; tok_slot[r * 2 + 1] = b2 + rk2; }
            run += mine;
        }
    }
    if (w == 0 && lane < HIST_LD) hist[bid * HIST_LD + lane] = lane < NE ? run : 0;
}
__device__ __forceinline__ void ph_dispatch_fast(const Params& p, int l, int rows, LAS unsigned char* lds, int bid, int nblocks, int wv_) {
    const int tid = tid_of(wv_); const int* hist = (const int*)(p.ws + WS_HIST) + (size_t)l * MAXG * HIST_LD;
    const int* tok_e = (const int*)(p.ws + WS_TOK); const int* tok_slot = (const int*)(p.ws + WS_TOK) + (size_t)MT * 4; int* tok_dest = (int*)(p.ws + WS_TOK) + (size_t)MT * 6;
    int* rowidx = (int*)(p.ws + WS_ROWIDX); int* cnt = (int*)(p.ws + WS_CNT) + l * 64;
    LAS int* pre = (LAS int*)lds; LAS int* seg = pre + MAXG * NE; LAS int* tot = seg + 32 * NE; LAS int* pst = tot + NE;
    { const int e = tid & 15, sg = tid >> 4; int v[8], sum = 0;
#pragma unroll
        for (int i = 0; i < 8; ++i) { const int wg = 8 * sg + i; v[i] = wg < nblocks ? hist[wg * HIST_LD + e] : 0; sum += v[i]; }
        seg[sg * NE + e] = sum;
        __syncthreads();
        int base = 0; for (int s2 = 0; s2 < sg; ++s2) base += seg[s2 * NE + e];
#pragma unroll
        for (int i = 0; i < 8; ++i) { pre[(8 * sg + i) * NE + e] = base; base += v[i]; }
        if (sg == 31) tot[e] = base;
        __syncthreads();
        if (tid <= NE) { int acc = 0; for (int j = 0; j < tid; ++j) acc += (tot[j] + 255) / 256 * 256; pst[tid] = acc; }
        if (bid == 0 && tid < NE) cnt[tid] = tot[tid];
        __syncthreads(); }
    const long gtid = (long)bid * 512 + tid, gthreads = (long)nblocks * 512; const int tpw = (rows / 16 + nblocks - 1) / nblocks;
    for (long it = gtid; it < (long)rows * 2; it += gthreads) { const int e = tok_e[it], wg = (int)((it >> 5) / tpw), dest = pst[e] + pre[wg * NE + e] + tok_slot[it]; tok_dest[it] = dest; st_coh(rowidx + dest, (int)(it / 2)); }
    const int total = pst[NE];
    for (long it = gtid; it < total; it += gthreads) { int st = 0, ce = 0;
#pragma unroll
        for (int j = 0; j < NE; ++j) { if (it >= pst[j] && it < pst[j + 1]) { st = pst[j]; ce = tot[j]; } }
        if (it - st >= ce) st_coh(rowidx + it, 0); }
}
#endif
__device__ __forceinline__ void ph_final(const Params& p, long gtid, long gthreads) {
    const float* xres = (const float*)(p.ws + WS_XRES);
    for (long r = gtid; r < ML; r += gthreads) {
        const float* xr = xres + (size_t)r * D; float ss = 0.f; for (int k = 0; k < D; ++k) ss += xr[k] * xr[k];
        const float rstd = 1.0f / sqrtf(ss / D + 1e-6f);
        for (int k = 0; k < D; ++k) p.out[(size_t)r * D + k] = xr[k] * rstd * p.norm_final[k];
    }
}

struct CvtJob { const float* src; bf16_t* dst; int K, N, mode, fp8, ld; };
constexpr int NJOBS = 6 + 2 * NE * 3;
constexpr int IN0_NQ = QW + 2 * KVW;
__device__ __forceinline__ CvtJob cvt_job(const Params& p, int j) {
    CvtJob J; unsigned char* ws = p.ws; J.fp8 = 0;
    if (j == 0) { J.src = p.ev_w_in; J.dst = (bf16_t*)(ws + WS_WT_IN0); J.K = D; J.N = IN0_NQ; J.mode = 0; }
    else if (j == 5) { J.src = p.ev_w_in + IN0_NQ; J.dst = (bf16_t*)(ws + WS_WT_IN0) + (size_t)IN0_NQ * D; J.K = D; J.N = EVIN - IN0_NQ; J.mode = 0; }
    else if (j == 1) { J.src = p.ev_w_out; J.dst = (bf16_t*)(ws + WS_WT_OUT0); J.K = D; J.N = D; J.mode = 0; }
    else if (j == 2) { J.src = p.od_w_in; J.dst = (bf16_t*)(ws + WS_WT_IN1); J.K = D; J.N = S5W; J.mode = 0; }
    else if (j == 3) { J.src = p.s5_glu_w; J.dst = (bf16_t*)(ws + WS_WT_GLU); J.K = S5W; J.N = S5W; J.mode = 0; }
    else if (j == 4) { J.src = p.od_w_out; J.dst = (bf16_t*)(ws + WS_WT_OUT1); J.K = S5W; J.N = D; J.mode = 0; }
    else { const int q = j - 6, le = q / 3, kind = q % 3;
        if (kind == 0) { J.src = p.moe_w_gate + (size_t)le * D * FF; J.dst = (bf16_t*)(ws + WS_WT_GU) + (size_t)le * 2 * FF * D; J.K = D; J.N = FF; J.mode = 1; }
        else if (kind == 1) { J.src = p.moe_w_up + (size_t)le * D * FF; J.dst = (bf16_t*)(ws + WS_WT_GU) + (size_t)le * 2 * FF * D; J.K = D; J.N = FF; J.mode = 2; }
        else { J.src = p.moe_w_down + (size_t)le * FF * D; J.dst = (bf16_t*)(ws + WS_WT_DN) + (size_t)le * D * FF; J.K = FF; J.N = D; J.mode = 0; }
        if (le >= NE ? MOE1_FP8 : MOE0_FP8) { const int l8 = le / NE, e = le % NE; J.fp8 = 1;
            J.dst = kind == 2 ? (bf16_t*)(ws + WS_WT_DN + (size_t)l8 * NE * D * FF * 2 + (size_t)e * D * FF) : (bf16_t*)(ws + WS_WT_GU + (size_t)l8 * NE * 2 * FF * D * 2 + (size_t)e * 2 * FF * D); } }
    if (((IN0_FP8 || IN0QKV_FP8) && j == 0) || (IN0_FP8 && j == 5) || (OUT0_FP8 && j == 1)) J.fp8 = 1;
    J.ld = (j == 0 || j == 5) ? EVIN : J.N;
    if (DENSE1_FP8 && j >= 2 && j <= 4) J.fp8 = 1;
    return J;
}
__device__ __forceinline__ int cvt_rowmap(int mode, int n) { return mode == 0 ? n : (n / 128) * 256 + (mode == 2 ? 128 : 0) + n % 128; }
constexpr long cvt_tiles_of(int K, int N) { return (long)(K / 64) * (N / 256); }
constexpr long CVT_TILES = cvt_tiles_of(D, IN0_NQ) + cvt_tiles_of(D, EVIN - IN0_NQ) + cvt_tiles_of(D, D) + cvt_tiles_of(D, S5W) + cvt_tiles_of(S5W, S5W) + cvt_tiles_of(S5W, D) + (long)2 * NE * 3 * cvt_tiles_of(D, FF);
__device__ __forceinline__ void cvt_find(long tile, int& j, long& local) {
    const long t0 = cvt_tiles_of(D, IN0_NQ), t1 = t0 + cvt_tiles_of(D, D), t2 = t1 + cvt_tiles_of(D, S5W), t3 = t2 + cvt_tiles_of(S5W, S5W), t4 = t3 + cvt_tiles_of(S5W, D), t5 = t4 + cvt_tiles_of(D, EVIN - IN0_NQ);
    if (tile < t0) { j = 0; local = tile; } else if (tile < t1) { j = 1; local = tile - t0; } else if (tile < t2) { j = 2; local = tile - t1; } else if (tile < t3) { j = 3; local = tile - t2; }
    else if (tile < t4) { j = 4; local = tile - t3; } else if (tile < t5) { j = 5; local = tile - t4; } else { const long q = tile - t5, per = cvt_tiles_of(D, FF); j = 6 + (int)(q / per); local = q % per; }
}
#ifndef CPU_EMU
constexpr int CVT_PITCH = 257, CVT_LDS_BYTES = 128 * 129 * 4;
struct CvtSrc { const float* src; int N, fp8; };
__device__ __forceinline__ CvtSrc cvt_src(const Params& p, long t) { int j; long loc; cvt_find(t, j, loc); const CvtJob L = cvt_job(p, j); CvtSrc S; S.N = L.ld; S.fp8 = L.fp8;
    if (L.fp8) { const int tn8 = L.N / 128, k0 = (int)(loc / tn8) * 128, n0 = (int)(loc % tn8) * 128; S.src = L.src + (size_t)k0 * L.ld + n0; }
    else { const int tn = L.N / 256, k0 = (int)(loc / tn) * 64, n0 = (int)(loc % tn) * 256; S.src = L.src + (size_t)k0 * L.ld + n0; }
    return S; }
__device__ __forceinline__ f32x4 cvt_load(const CvtSrc& S, int tid, int i) { const int q = tid + 512 * i, kk = S.fp8 ? q >> 5 : q >> 6, n4 = S.fp8 ? (q & 31) * 4 : (q & 63) * 4; return *(const f32x4*)(S.src + (size_t)kk * S.N + n4); }
__device__ __forceinline__ void ph_convert(const Params& p, float* tile, long t_end, int max_tiles, int wv_) {
    const int tid = tid_of(wv_); int* ctr = (int*)(p.ws + WS_CNT) + 128; LAS int* tsh = (LAS int*)((LAS unsigned char*)tile + CVT_LDS_BYTES);
    (void)max_tiles;
    int pend = 0, par = 0;
    __syncthreads();
    if (tid == 0) { const int a0 = atomicAdd(ctr, 1), a1 = atomicAdd(ctr, 1); pend = atomicAdd(ctr, 1); tsh[0] = a0; tsh[1] = a1; }
    __syncthreads();
    long t = tsh[0], tn = tsh[1];
    f32x4 R[8];
    if (t < t_end) { const CvtSrc S = cvt_src(p, t);
#pragma unroll
        for (int i = 0; i < 8; ++i) R[i] = cvt_load(S, tid, i); }
    while (t < t_end) {
        int j; long local; cvt_find(t, j, local); const CvtJob J = cvt_job(p, j);
        const bool more = tn < t_end; const CvtSrc SN = cvt_src(p, more ? tn : t);
#pragma unroll
        for (int i = 0; i < 8; ++i) {
            if (J.fp8) { const int q = tid + 512 * i, kk = q >> 5, n4 = (q & 31) * 4; *(f32x4*)(tile + kk * 128 + (n4 ^ (((kk >> 4) & 3) << 4))) = R[i]; }
            else { const int q = tid + 512 * i, kk = q >> 6, n4 = (q & 63) * 4; tile[kk * CVT_PITCH + n4] = R[i][0]; tile[kk * CVT_PITCH + n4 + 1] = R[i][1]; tile[kk * CVT_PITCH + n4 + 2] = R[i][2]; tile[kk * CVT_PITCH + n4 + 3] = R[i][3]; }
        }
        if (tid == 0) { tsh[2 + par] = pend; pend = atomicAdd(ctr, 1); }
        __syncthreads();
        const long tnn = tsh[2 + par]; par ^= 1;
        if (more) {
#pragma unroll
            for (int i = 0; i < 8; ++i) R[i] = cvt_load(SN, tid, i); }
        if (J.fp8) {
            const int tn8 = J.N / 128, k0 = (int)(local / tn8) * 128, n0 = (int)(local % tn8) * 128;
            const float wsc = (OUT0_FP8 && j == 1 && k0 < QW) ? W8_SCALE / MIX8_SCALE : W8_SCALE;
#pragma unroll
            for (int i = 0; i < 2; ++i) { const int lane = tid & 63, nn = 64 * i + 8 * (tid >> 6) + (lane & 7), kg = lane >> 3, kgl = kg & 3; const float* tp = tile + (16 * kg) * 128 + (nn ^ (kgl << 4)); u4v_t w;
#pragma unroll
                for (int d4 = 0; d4 < 4; ++d4) { int pk = 0; pk = __builtin_amdgcn_cvt_pk_fp8_f32(tp[(4 * d4) * 128] * wsc, tp[(4 * d4 + 1) * 128] * wsc, pk, false);
                    pk = __builtin_amdgcn_cvt_pk_fp8_f32(tp[(4 * d4 + 2) * 128] * wsc, tp[(4 * d4 + 3) * 128] * wsc, pk, true); w[d4] = (unsigned)pk; }
                *(u4v_t*)((unsigned char*)J.dst + (size_t)cvt_rowmap(J.mode, n0 + nn) * J.K + k0 + 16 * kg) = w; }
        } else {
            const int tnn_ = J.N / 256, k0 = (int)(local / tnn_) * 64, n0 = (int)(local % tnn_) * 256;
#pragma unroll
            for (int i = 0; i < 4; ++i) { const int q = tid + 512 * i, nn = q >> 3, k8 = (q & 7) * 8; const float* tp = tile + k8 * CVT_PITCH + nn;
                u4v_t w = {pack2bf(tp[0], tp[CVT_PITCH]), pack2bf(tp[2 * CVT_PITCH], tp[3 * CVT_PITCH]), pack2bf(tp[4 * CVT_PITCH], tp[5 * CVT_PITCH]), pack2bf(tp[6 * CVT_PITCH], tp[7 * CVT_PITCH])};
                *(u4v_t*)(J.dst + (size_t)cvt_rowmap(J.mode, n0 + nn) * J.K + k0 + k8) = w; }
        }
        __syncthreads();
        t = tn; tn = tnn;
    }
}
#else
void ph_convert_emu(const Params& p) {
    for (int j = 0; j < NJOBS; ++j) { const CvtJob J = cvt_job(p, j);
        for (int n = 0; n < J.N; ++n) { bf16_t* dr = J.dst + (size_t)cvt_rowmap(J.mode, n) * J.K; for (int k = 0; k < J.K; ++k) dr[k] = f2bf(J.src[(size_t)k * J.ld + n]); } }
}
#endif

namespace pg8 {
constexpr int BM = 256, BK = 64, HALF = 128, HTB = HALF * BK * 2  , STAGE_BYTES = 8 * HTB, NXCD = 8, WGM = 8;
struct Unit { int pm, pn, e; };
struct Gemm { const bf16_t* A; const bf16_t* Bt; int M, N, K; int sc_w = 0, sc_a = 0; };
__host__ __device__ __forceinline__ int lds_byte(int r, int c) { const int st = (r >> 4) * 2 + (c >> 5), rr = r & 15, cc = c & 31, ob = rr * 64 + cc * 2; return st * 1024 + (ob ^ (((ob >> 9) & 1) << 5)); }
__host__ __device__ __forceinline__ void stage_rc(int b, int& R, int& C) { const int st = b / 1024, sb = b % 1024, swz = sb ^ (((sb >> 9) & 1) << 5); R = (st >> 1) * 16 + swz / 64; C = (st & 1) * 32 + (swz % 64) / 2; }
__host__ __device__ __forceinline__ int perm32(int rho) { const int n = rho >> 4, i = rho & 15; return 8 * (i >> 2) + 4 * n + (i & 3); }

struct StaticOrder {
    static constexpr bool GATHER = false;
    int nM, nN, nwg, G, c;
    __host__ __device__ void init(int M, int N, int G_, int c_) { nM = M / BM; nN = N / BM; nwg = nM * nN; G = G_; c = c_; }
    __host__ __device__ bool next(int i, Unit& u) const {
        const long L = (long)i * G + c; if (L >= nwg) return false;
        int wgid = (int)L; { const int q = nwg / NXCD, r = nwg % NXCD, xcd = wgid % NXCD, off = wgid / NXCD; wgid = (xcd < r ? xcd * (q + 1) : r * (q + 1) + (xcd - r) * q) + off; }
        const int nig = WGM * nN, gid = wgid / nig, fm = gid * WGM, gsz = (nM - fm) < WGM ? (nM - fm) : WGM;
        u.pm = fm + ((wgid % nig) % gsz); u.pn = (wgid % nig) / gsz; u.e = 0; return true;
    }
    __device__ __forceinline__ const char* b_base(const Gemm& g, const Unit& u) const { return (const char*)g.Bt + (size_t)u.pn * ((size_t)BM * g.K * 2); }
    __device__ __forceinline__ int a_row(const Unit& u, int rr) const { return u.pm * BM + rr; }
};
template <bool ROWS> struct MoeOrder {
    static constexpr bool GATHER = ROWS;
    int nN, nwg, G, c; const int* cnt; const int* rowidx; size_t estride;
    __device__ void init(const int* cnt_, int N, int G_, int c_, const int* rowidx_, size_t estride_) { int acc = 0; cnt = cnt_;
#pragma unroll
        for (int e = 0; e < NE; ++e) acc += (cnt[e] + 255) / 256 * 256;
        nN = N / BM; nwg = (acc / 256) * nN; G = G_; c = c_; rowidx = rowidx_; estride = estride_; }
    __device__ bool next(int i, Unit& u) const { const long L = (long)i * G + c; if (L >= nwg) return false; u.pm = (int)(L / nN); u.pn = (int)(L % nN); int e = 0, acc = 0;
#pragma unroll
        for (int j = 0; j < NE - 1; ++j) { acc += (cnt[j] + 255) / 256 * 256; e += (u.pm * 256 >= acc) ? 1 : 0; }
        u.e = e; return true; }
    __device__ __forceinline__ const char* b_base(const Gemm& g, const Unit& u) const { return (const char*)g.Bt + (size_t)u.e * estride + (size_t)u.pn * ((size_t)BM * g.K * 2); }
    __device__ __forceinline__ int a_row(const Unit& u, int rr) const { return ROWS ? ld_coh(rowidx + u.pm * BM + rr) : u.pm * BM + rr; }
};

#ifdef CPU_EMU
typedef unsigned char* LdsPtr;
#else
#define PG8_LAS __attribute__((address_space(3)))
typedef PG8_LAS unsigned char* LdsPtr;
typedef short bf16x8 __attribute__((ext_vector_type(8)));
typedef unsigned u32x4 __attribute__((ext_vector_type(4)));
typedef int pg8_v4i __attribute__((ext_vector_type(4)));
typedef int pg8_v8i __attribute__((ext_vector_type(8)));
template <class Epi, class Sched, bool F8 = false>
__device__ __forceinline__ void gemm_phase(LdsPtr lds, const Gemm g, const Sched& S, const Epi& E, int wv_) {
    const int tid = tid_of(wv_), wid = wv_, lane = tid & 63, wr = wid >> 2, wc = wid & 3, fr = lane & 15, fq = lane >> 4;
    const int K = g.K, nt = K / BK;
    unsigned voffB[2]; int RA[2], CA[2];
#pragma unroll
    for (int i = 0; i < 2; ++i) { int R, C; stage_rc(tid * 16 + i * 8192, R, C); const int Rb = Epi::PERM ? ((R & ~31) + perm32(R & 31)) : R;
        RA[i] = R; CA[i] = C; voffB[i] = (unsigned)(Rb * K + C) * 2u; }
    const size_t kstep = (size_t)(BK * 2);
    const size_t hstep = (size_t)HALF * K * 2;
    const unsigned ldsw = (unsigned)wid * 1024u;
    const int aoff = F8 ? lds_byte(wr * 64 + fr, fq * 16) + ((fq & 1) << 4) : lds_byte(wr * 64 + fr, fq * 8), boff = F8 ? lds_byte(wc * 32 + fr, fq * 16) + ((fq & 1) << 4) : lds_byte(wc * 32 + fr, fq * 8);
    const int sc_both = (g.sc_w & 0xff) | ((g.sc_a & 0xff) << 8);
    const int koff = F8 ? (16 - ((fq & 1) << 5)) : 1024;
#define PG8_SA(b, h) (((b) * 2 + (h)) * HTB)
#define PG8_SB(b, h) ((4 + (b) * 2 + (h)) * HTB)
#define PG8_STAGE(bufoff, gbase, voff) do { _Pragma("unroll") for (int _i = 0; _i < 2; ++_i) \
        __builtin_amdgcn_global_load_lds((const unsigned*)((const char*)(gbase) + (voff)[_i]), (PG8_LAS unsigned*)(lds + (bufoff) + ldsw + _i * 8192), 16, 0, 0); } while (0)
#define PG8_LD8(dst, addr) do { const pg8_v4i lo_ = *(const PG8_LAS pg8_v4i*)(addr), hi_ = *(const PG8_LAS pg8_v4i*)((addr) + koff); dst = __builtin_shufflevector(lo_, hi_, 0, 1, 2, 3, 4, 5, 6, 7); } while (0)
#define PG8_LDA(dst, b, h) do { if constexpr (F8) { _Pragma("unroll") for (int m = 0; m < 4; ++m) PG8_LD8(dst##8[m], lds + PG8_SA(b, h) + aoff + m * 2048); } \
        else { _Pragma("unroll") for (int m = 0; m < 4; ++m) _Pragma("unroll") for (int k = 0; k < 2; ++k) dst[m][k] = *(const PG8_LAS bf16x8*)(lds + PG8_SA(b, h) + aoff + m * 2048 + k * koff); } } while (0)
#define PG8_LDB(dst, b, h) do { if constexpr (F8) { _Pragma("unroll") for (int n = 0; n < 2; ++n) PG8_LD8(dst##8[n], lds + PG8_SB(b, h) + boff + n * 2048); } \
        else { _Pragma("unroll") for (int n = 0; n < 2; ++n) _Pragma("unroll") for (int k = 0; k < 2; ++k) dst[n][k] = *(const PG8_LAS bf16x8*)(lds + PG8_SB(b, h) + boff + n * 2048 + k * koff); } } while (0)
#define PG8_MMA(ai, bj, At, Bt) do { __builtin_amdgcn_s_setprio(1); \
        if constexpr (F8) { _Pragma("unroll") for (int m = 0; m < 4; ++m) _Pragma("unroll") for (int n = 0; n < 2; ++n) \
            acc[ai][bj][m][n] = __builtin_amdgcn_mfma_scale_f32_16x16x128_f8f6f4(Bt##8[n], At##8[m], acc[ai][bj][m][n], 0, 0, 0, sc_both, 1, sc_both); } \
        else { _Pragma("unroll") for (int m = 0; m < 4; ++m) _Pragma("unroll") for (int n = 0; n < 2; ++n) _Pragma("unroll") for (int k = 0; k < 2; ++k) \
            acc[ai][bj][m][n] = __builtin_amdgcn_mfma_f32_16x16x32_bf16(Bt[n][k], At[m][k], acc[ai][bj][m][n], 0, 0, 0); } \
        __builtin_amdgcn_s_setprio(0); } while (0)
#define PG8_WAIT_V(n) asm volatile("s_waitcnt vmcnt(" #n ")" ::: "memory")
#define PG8_WAIT_L(n) asm volatile("s_waitcnt lgkmcnt(" #n ")" ::: "memory")
#define PG8_BAR __builtin_amdgcn_s_barrier()
#define PG8_SCHED __builtin_amdgcn_sched_barrier(0)
#define PG8_VOFFA(dst, U) do { _Pragma("unroll") for (int _h = 0; _h < 2; ++_h) _Pragma("unroll") for (int _i = 0; _i < 2; ++_i) \
        dst[_h][_i] = (unsigned)((size_t)S.a_row(U, _h * HALF + RA[_i]) * K + CA[_i]) * 2u; } while (0)
    Unit cur, nxt; int ui = 0;
    if (!S.next(0, cur)) return;
    f32x4 acc[2][2][4][2];
#pragma unroll
    for (int a = 0; a < 2; ++a)
#pragma unroll
        for (int b = 0; b < 2; ++b)
#pragma unroll
            for (int m = 0; m < 4; ++m)
#pragma unroll
                for (int n = 0; n < 2; ++n) acc[a][b][m][n] = (f32x4){0.f, 0.f, 0.f, 0.f};
    bf16x8 At[4][2], B0[2][2], B1[2][2];
    pg8_v8i At8[4], B08[2], B18[2];
    unsigned vA[2][2];
    PG8_VOFFA(vA, cur);
    const char* cA = (const char*)g.A; const char* cB = S.b_base(g, cur);
    PG8_STAGE(PG8_SB(0, 0), cB, voffB); PG8_STAGE(PG8_SB(0, 1), cB + hstep, voffB); PG8_STAGE(PG8_SA(0, 0), cA, vA[0]); PG8_STAGE(PG8_SA(0, 1), cA, vA[1]);
    if (wr == 1) PG8_BAR;
    PG8_WAIT_V(2); PG8_BAR;
    PG8_STAGE(PG8_SB(1, 0), cB + kstep, voffB); PG8_STAGE(PG8_SA(1, 0), cA + kstep, vA[0]); PG8_STAGE(PG8_SB(1, 1), cB + hstep + kstep, voffB);
    PG8_WAIT_V(6); PG8_BAR;
    for (;;) {
        const bool has_next = S.next(ui + 1, nxt);
        const char* nB = has_next ? S.b_base(g, nxt) : cB;
        for (int t = 0; t < nt; t += 2) {
            const bool last = (t == nt - 2);
            const char* a1 = cA + (size_t)(t + 1) * kstep;
            const char* a2 = last ? cA : cA + (size_t)(t + 2) * kstep; const char* b2 = last ? nB : cB + (size_t)(t + 2) * kstep;
            const char* a3 = a2 + kstep; const char* b3 = b2 + kstep;
            PG8_LDB(B0, 0, 0); PG8_LDB(B1, 0, 1); PG8_SCHED; PG8_LDA(At, 0, 0); PG8_STAGE(PG8_SA(1, 1), a1, vA[1]);
            if (last && has_next) { PG8_VOFFA(vA, nxt); }
            PG8_WAIT_V(8); PG8_WAIT_L(0); PG8_BAR; PG8_MMA(0, 0, At, B0); PG8_MMA(0, 1, At, B1); PG8_BAR; PG8_SCHED;
            PG8_LDA(At, 0, 1); PG8_STAGE(PG8_SB(0, 0), b2, voffB); PG8_STAGE(PG8_SB(0, 1), b2 + hstep, voffB); PG8_STAGE(PG8_SA(0, 0), a2, vA[0]);
            PG8_WAIT_V(8); PG8_WAIT_L(0); PG8_BAR; PG8_MMA(1, 0, At, B0); PG8_MMA(1, 1, At, B1); PG8_BAR; PG8_SCHED;
            PG8_LDB(B0, 1, 0); PG8_LDB(B1, 1, 1); PG8_SCHED; PG8_LDA(At, 1, 0); PG8_STAGE(PG8_SA(0, 1), a2, vA[1]);
            PG8_WAIT_V(8); PG8_WAIT_L(0); PG8_BAR; PG8_MMA(0, 0, At, B0); PG8_MMA(0, 1, At, B1); PG8_BAR; PG8_SCHED;
            PG8_LDA(At, 1, 1); PG8_STAGE(PG8_SB(1, 0), b3, voffB); PG8_STAGE(PG8_SB(1, 1), b3 + hstep, voffB); PG8_STAGE(PG8_SA(1, 0), a3, vA[0]);
            PG8_WAIT_V(8); PG8_WAIT_L(0); PG8_BAR; PG8_MMA(1, 0, At, B0); PG8_MMA(1, 1, At, B1); PG8_BAR; PG8_SCHED;
        }
        if (wr == 0) PG8_BAR;
        E(acc, cur, wr, wc, fr, fq);
        if (!has_next) break;
#pragma unroll
        for (int a = 0; a < 2; ++a)
#pragma unroll
            for (int b = 0; b < 2; ++b)
#pragma unroll
                for (int m = 0; m < 4; ++m)
#pragma unroll
                    for (int n = 0; n < 2; ++n) acc[a][b][m][n] = (f32x4){0.f, 0.f, 0.f, 0.f};
        cur = nxt; cB = nB; ++ui;
        if (wr == 1) PG8_BAR;
    }
    PG8_WAIT_V(0);
    PG8_BAR;
#undef PG8_SA
#undef PG8_SB
#undef PG8_STAGE
#undef PG8_LDA
#undef PG8_LDB
#undef PG8_MMA
#undef PG8_LD8
#undef PG8_WAIT_V
#undef PG8_WAIT_L
#undef PG8_BAR
#undef PG8_SCHED
#undef PG8_VOFFA
}
#endif
}

typedef f32x4 AccT[2][2][4][2];

struct EpiQKV {
    static constexpr bool PERM = false;
    bf16_t* O; const float* rope; bf16_t* VT; int pn0 = 0;
    __device__ __forceinline__ void operator()(const AccT& acc, const pg8::Unit& u, int wr, int wc, int fr, int fq) const {
        const int colt = (u.pn + pn0) * 256; const bool is_q = colt < COL_K, is_k = colt >= COL_K && colt < COL_V, is_v = colt >= COL_V && colt < COL_XR;
#pragma unroll
        for (int ai = 0; ai < 2; ++ai) {
            f32x4 rp[4][2];
            if (is_q || is_k) {
#pragma unroll
                for (int m = 0; m < 4; ++m) { const int r = u.pm * 256 + ai * 128 + wr * 64 + m * 16 + fr, t = r % NSEQ, pos = (wc & 1) ? (t % 64) : (t / 64);
                    rp[m][0] = *(const f32x4*)(rope + (pos * 16 + 4 * fq) * 2); rp[m][1] = *(const f32x4*)(rope + (pos * 16 + 4 * fq) * 2 + 4); }
#ifndef CPU_EMU
                asm volatile("" ::: "memory");
#endif
            }
#pragma unroll
            for (int m = 0; m < 4; ++m) {
                const int r = u.pm * 256 + ai * 128 + wr * 64 + m * 16 + fr; const bool lat = r < ML; const int t = r % NSEQ;
#pragma unroll
                for (int bj = 0; bj < 2; ++bj) {
                    const int cg = colt + bj * 128 + wc * 32;
                    f32x4 v0 = acc[ai][bj][m][0], v1 = acc[ai][bj][m][1];
                    if ((is_q || is_k) && lat) {
#pragma unroll
                        for (int j = 0; j < 4; ++j) { const float cs = rp[m][j >> 1][(j & 1) * 2], sn = rp[m][j >> 1][(j & 1) * 2 + 1]; const float a = v0[j], b = v1[j]; v0[j] = a * cs - b * sn; v1[j] = b * cs + a * sn; }
                    }
                    if (is_q) { v0 *= 0.125f; v1 *= 0.125f; }
                    bf16_t* rowp = O + (size_t)r * EVIN + cg + 4 * fq;
                    u32x2_t w0, w1; w0.x = pack2bf(v0[0], v0[1]); w0.y = pack2bf(v0[2], v0[3]); w1.x = pack2bf(v1[0], v1[1]); w1.y = pack2bf(v1[2], v1[3]);
                    *(u32x2_t*)rowp = w0; *(u32x2_t*)(rowp + 16) = w1;
                    if (is_v) {
                        const int bb = lat ? r / NSEQ : (r - ML) / NCTX, tt = lat ? t : (r - ML) % NCTX, k16 = tt & 15, kp = (k16 & 3) | ((k16 & 4) << 1) | ((k16 & 8) >> 1);
                        const int pos = (lat ? 128 : 128 + NSEQ + 128) + (tt & ~15) + kp, vc = cg - COL_V + 4 * fq;
                        bf16_t* vp = VT + ((size_t)bb * 256 + vc) * VT_T + pos;
#pragma unroll
                        for (int j = 0; j < 4; ++j) { vp[(size_t)j * VT_T] = f2bf(v0[j]); vp[(size_t)(16 + j) * VT_T] = f2bf(v1[j]); }
                    }
                }
            }
        }
    }
};
template <bool IN16, bool OUT16> struct EpiResidT {
    static constexpr bool PERM = false;
    const float* xin_lat; const float* xin_ctx; float* xout; const float* gate;
    __device__ __forceinline__ void operator()(const AccT& acc, const pg8::Unit& u, int wr, int wc, int fr, int fq) const {
        const int row0 = u.pm * 256, arow = row0 < ML ? row0 / NSEQ : NB; const float* gp = gate + (size_t)arow * ADA6;
        const int col0 = u.pn * 256 + wc * 32 + 4 * fq;
        f32x4 gv[2][2];
#pragma unroll
        for (int bj = 0; bj < 2; ++bj)
#pragma unroll
            for (int n = 0; n < 2; ++n) gv[bj][n] = *(const f32x4*)(gp + col0 + bj * 128 + n * 16);
#pragma unroll
        for (int ai = 0; ai < 2; ++ai) {
            f32x4 xi[4][2][2];
#pragma unroll
            for (int m = 0; m < 4; ++m) { const int r = row0 + ai * 128 + wr * 64 + m * 16 + fr;
                const size_t io = (r < ML ? (size_t)r * D : (size_t)(r - ML) * D) + col0; const float* ib = r < ML ? xin_lat : xin_ctx;
#pragma unroll
                for (int bj = 0; bj < 2; ++bj)
#pragma unroll
                    for (int n = 0; n < 2; ++n) {
                        if (IN16) { const u32x2_t t = *(const u32x2_t*)((const bf16_t*)ib + io + bj * 128 + n * 16); xi[m][bj][n] = unpack4bf(t.x, t.y); } else xi[m][bj][n] = *(const f32x4*)(ib + io + bj * 128 + n * 16); } }
#ifndef CPU_EMU
            asm volatile("" ::: "memory");
#endif
#pragma unroll
            for (int m = 0; m < 4; ++m) { const int r = row0 + ai * 128 + wr * 64 + m * 16 + fr; const size_t oo = (size_t)r * D + col0;
#pragma unroll
                for (int bj = 0; bj < 2; ++bj)
#pragma unroll
                    for (int n = 0; n < 2; ++n) { const f32x4 xo = xi[m][bj][n] + gv[bj][n] * acc[ai][bj][m][n];
                        if (OUT16) { u32x2_t t; t.x = pack2bf(xo[0], xo[1]); t.y = pack2bf(xo[2], xo[3]); *(u32x2_t*)((bf16_t*)xout + oo + bj * 128 + n * 16) = t; } else *(f32x4*)(xout + oo + bj * 128 + n * 16) = xo; } }
        }
    }
};
typedef EpiResidT<false, RES_BF16> EpiResid0;
typedef EpiResidT<RES_BF16, RES_BF16> EpiResid;
struct EpiBf16 {
    static constexpr bool PERM = true;
    bf16_t* O; int ldc;
    __device__ __forceinline__ void operator()(const AccT& acc, const pg8::Unit& u, int wr, int wc, int fr, int fq) const {
        const int col0 = u.pn * 256 + wc * 32 + 8 * fq;
#pragma unroll
        for (int ai = 0; ai < 2; ++ai)
#pragma unroll
            for (int m = 0; m < 4; ++m) { bf16_t* rowp = O + (size_t)(u.pm * 256 + ai * 128 + wr * 64 + m * 16 + fr) * ldc + col0;
#pragma unroll
                for (int bj = 0; bj < 2; ++bj) { const f32x4 v0 = acc[ai][bj][m][0], v1 = acc[ai][bj][m][1];
                    u32x4_t w; w.x = pack2bf(v0[0], v0[1]); w.y = pack2bf(v0[2], v0[3]); w.z = pack2bf(v1[0], v1[1]); w.w = pack2bf(v1[2], v1[3]);
                    *(u32x4_t*)(rowp + bj * 128) = w; } }
    }
};
#ifndef CPU_EMU
struct EpiY8 {
    static constexpr bool PERM = true;
    unsigned char* O; int ldc;
    __device__ __forceinline__ void operator()(const AccT& acc, const pg8::Unit& u, int wr, int wc, int fr, int fq) const {
        const int col0 = u.pn * 256 + wc * 32 + 8 * fq;
#pragma unroll
        for (int ai = 0; ai < 2; ++ai)
#pragma unroll
            for (int m = 0; m < 4; ++m) { unsigned char* rowp = O + (size_t)(u.pm * 256 + ai * 128 + wr * 64 + m * 16 + fr) * ldc + col0;
#pragma unroll
                for (int bj = 0; bj < 2; ++bj) { const f32x4 v0 = acc[ai][bj][m][0] * Y8_SCALE, v1 = acc[ai][bj][m][1] * Y8_SCALE;
                    u32x2_t w; w.x = pack4_fp8(v0[0], v0[1], v0[2], v0[3]); w.y = pack4_fp8(v1[0], v1[1], v1[2], v1[3]);
                    *(u32x2_t*)(rowp + bj * 128) = w; } }
    }
};
#endif
struct EpiGU {
    static constexpr bool PERM = true;
    bf16_t* O;
    __device__ __forceinline__ void operator()(const AccT& acc, const pg8::Unit& u, int wr, int wc, int fr, int fq) const {
        const int col0 = u.pn * 128 + wc * 32 + 8 * fq;
#pragma unroll
        for (int ai = 0; ai < 2; ++ai)
#pragma unroll
            for (int m = 0; m < 4; ++m) { bf16_t* rowp = O + (size_t)(u.pm * 256 + ai * 128 + wr * 64 + m * 16 + fr) * FF + col0;
                float o[8];
#pragma unroll
                for (int n = 0; n < 2; ++n)
#pragma unroll
                    for (int j = 0; j < 4; ++j) { const float gt = acc[ai][0][m][n][j], up = acc[ai][1][m][n][j]; o[n * 4 + j] = siluf_(gt) * up; }
                u32x4_t w; w.x = pack2bf(o[0], o[1]); w.y = pack2bf(o[2], o[3]); w.z = pack2bf(o[4], o[5]); w.w = pack2bf(o[6], o[7]);
                *(u32x4_t*)rowp = w; }
    }
};
#ifndef CPU_EMU
struct EpiGU8 {
    static constexpr bool PERM = true;
    unsigned char* O;
    __device__ __forceinline__ void operator()(const AccT& acc, const pg8::Unit& u, int wr, int wc, int fr, int fq) const {
        const int col0 = u.pn * 128 + wc * 32 + 8 * fq;
#pragma unroll
        for (int ai = 0; ai < 2; ++ai)
#pragma unroll
            for (int m = 0; m < 4; ++m) { unsigned char* rowp = O + (size_t)(u.pm * 256 + ai * 128 + wr * 64 + m * 16 + fr) * FF + col0;
                float o[8];
#pragma unroll
                for (int n = 0; n < 2; ++n)
#pragma unroll
                    for (int j = 0; j < 4; ++j) { const float gt = acc[ai][0][m][n][j], up = acc[ai][1][m][n][j]; o[n * 4 + j] = siluf_(gt) * up * ACT8_SCALE; }
                u32x2_t w; w.x = pack4_fp8(o[0], o[1], o[2], o[3]); w.y = pack4_fp8(o[4], o[5], o[6], o[7]);
                *(u32x2_t*)rowp = w; }
    }
};
#endif
struct EpiGLU {
    static constexpr bool PERM = true;
    const bf16_t* Z; bf16_t* O; const float* bias;
    __device__ __forceinline__ void operator()(const AccT& acc, const pg8::Unit& u, int wr, int wc, int fr, int fq) const {
        const int col0 = u.pn * 256 + wc * 32 + 8 * fq;
#pragma unroll
        for (int ai = 0; ai < 2; ++ai)
#pragma unroll
            for (int m = 0; m < 4; ++m) { const size_t ro = (size_t)(u.pm * 256 + ai * 128 + wr * 64 + m * 16 + fr) * S5W + col0;
#pragma unroll
                for (int bj = 0; bj < 2; ++bj) { const u32x4_t zz = *(const u32x4_t*)(Z + ro + bj * 128); const unsigned zw[4] = {zz.x, zz.y, zz.z, zz.w}; float o[8];
#pragma unroll
                    for (int n = 0; n < 2; ++n)
#pragma unroll
                        for (int j = 0; j < 4; ++j) { const int q = n * 4 + j; const float zv = __uint_as_float((q & 1) ? (zw[q >> 1] & 0xffff0000u) : (zw[q >> 1] << 16));
                            o[q] = zv * sigmoidf_(acc[ai][bj][m][n][j] + bias[col0 + bj * 128 + q]); }
                    u32x4_t w; w.x = pack2bf(o[0], o[1]); w.y = pack2bf(o[2], o[3]); w.z = pack2bf(o[4], o[5]); w.w = pack2bf(o[6], o[7]);
                    *(u32x4_t*)(O + ro + bj * 128) = w; } }
    }
};

#ifndef CPU_EMU
struct EpiGLU8 {
    static constexpr bool PERM = true;
    const unsigned char* Z; unsigned char* O; const float* bias;
    __device__ __forceinline__ void operator()(const AccT& acc, const pg8::Unit& u, int wr, int wc, int fr, int fq) const {
        const int col0 = u.pn * 256 + wc * 32 + 8 * fq;
        u32x2_t zall[2][4][2]; f32x4 bv[2][2];
#pragma unroll
        for (int bj = 0; bj < 2; ++bj)
#pragma unroll
            for (int n = 0; n < 2; ++n) bv[bj][n] = *(const f32x4*)(bias + col0 + bj * 128 + n * 4);
#pragma unroll
        for (int ai = 0; ai < 2; ++ai)
#pragma unroll
            for (int m = 0; m < 4; ++m) { const size_t ro = (size_t)(u.pm * 256 + ai * 128 + wr * 64 + m * 16 + fr) * S5W + col0;
#pragma unroll
                for (int bj = 0; bj < 2; ++bj) zall[ai][m][bj] = *(const u32x2_t*)(Z + ro + bj * 128); }
        asm volatile("" ::: "memory");
#pragma unroll
        for (int ai = 0; ai < 2; ++ai)
#pragma unroll
            for (int m = 0; m < 4; ++m) { const size_t ro = (size_t)(u.pm * 256 + ai * 128 + wr * 64 + m * 16 + fr) * S5W + col0;
#pragma unroll
                for (int bj = 0; bj < 2; ++bj) { const u32x2_t zz = zall[ai][m][bj]; float o[8];
#pragma unroll
                    for (int n = 0; n < 2; ++n) { const int zw = (int)(n ? zz.y : zz.x);
                        const float z0 = __builtin_amdgcn_cvt_f32_fp8(zw, 0), z1 = __builtin_amdgcn_cvt_f32_fp8(zw, 1), z2 = __builtin_amdgcn_cvt_f32_fp8(zw, 2), z3 = __builtin_amdgcn_cvt_f32_fp8(zw, 3); const float zv[4] = {z0, z1, z2, z3};
#pragma unroll
                        for (int j = 0; j < 4; ++j) { const int q = n * 4 + j; o[q] = zv[j] * (S8_SCALE / Z8_SCALE) * sigmoidf_(acc[ai][bj][m][n][j] + bv[bj][n][j]); } }
                    u32x2_t w; w.x = pack4_fp8(o[0], o[1], o[2], o[3]); w.y = pack4_fp8(o[4], o[5], o[6], o[7]);
                    *(u32x2_t*)(O + ro + bj * 128) = w; } }
    }
};
#endif

enum { G_IN0 = 0, G_OUT0, G_GU, G_DN, G_IN1, G_GLU, G_OUT1, G_GU8, G_DN8, G_IN18, G_GLU8, G_OUT18, G_IN08, G_OUT08, G_IN0SPLIT };
#ifdef CPU_EMU
namespace pg8 {
template <class Epi, class Sched> void gemm_phase(LdsPtr, const Gemm g, const Sched& S, const Epi& E, int) {
    Unit u; std::vector<float> C(256 * 256), af(g.K), bfv((size_t)256 * g.K);
    for (int i = 0; S.next(i, u); ++i) {
        const bf16_t* Bb = (const bf16_t*)S.b_base(g, u);
        for (size_t q = 0; q < (size_t)256 * g.K; ++q) bfv[q] = bf2f(Bb[q]);
        for (int r = 0; r < 256; ++r) { const bf16_t* a = g.A + (size_t)S.a_row(u, r) * g.K; for (int k = 0; k < g.K; ++k) af[k] = bf2f(a[k]);
            for (int cc = 0; cc < 256; ++cc) { const float* bp = &bfv[(size_t)cc * g.K]; float s = 0.f; for (int k = 0; k < g.K; ++k) s += af[k] * bp[k]; C[r * 256 + cc] = s; } }
        for (int tid = 0; tid < 512; ++tid) { const int wid = tid >> 6, lane = tid & 63, wr = wid >> 2, wc = wid & 3, fr = lane & 15, fq = lane >> 4;
            f32x4 acc[2][2][4][2];
            for (int ai = 0; ai < 2; ++ai) for (int bj = 0; bj < 2; ++bj) for (int m = 0; m < 4; ++m) for (int n = 0; n < 2; ++n) for (int j = 0; j < 4; ++j) {
                const int r = 128 * ai + 64 * wr + 16 * m + fr, cc = Epi::PERM ? 128 * bj + 32 * wc + 8 * fq + 4 * n + j : 128 * bj + 32 * wc + 16 * n + 4 * fq + j;
                acc[ai][bj][m][n][j] = C[r * 256 + cc]; }
            E(acc, u, wr, wc, fr, fq); }
    }
}
}
#endif
#ifndef CPU_EMU
template <class Sched> __device__ __forceinline__ void gemm_stagger(const Sched& S, int tile_us) {
    const int rem = S.nwg % S.G; if (rem == 0 || S.c < rem) return;
    const int units = (int)((long)(S.c - rem) * tile_us * 4 / (5 * (S.G - rem)));
    for (int i = 0; i < units; ++i) __builtin_amdgcn_s_sleep(32);
}
#else
template <class Sched> void gemm_stagger(const Sched&, int) {}
#endif
template <int WHICH> __device__ __forceinline__ void run_gemm(const Params& p, int l, pg8::LdsPtr lds, int G, int c, int wv_ = 0) {
    unsigned char* ws = p.ws; pg8::Gemm g;
    if constexpr (WHICH == G_IN0) { g.A = (const bf16_t*)(ws + WS_H); g.Bt = (const bf16_t*)(ws + WS_WT_IN0); g.M = MT; g.N = EVIN; g.K = D;
        pg8::StaticOrder S; S.init(g.M, g.N, G, c); EpiQKV E; E.O = (bf16_t*)(ws + WS_QKV); E.rope = (const float*)(ws + WS_ROPE); E.VT = (bf16_t*)(ws + WS_VT); pg8::gemm_phase(lds, g, S, E, wv_); }
    else if constexpr (WHICH == G_OUT0) { g.A = (const bf16_t*)(ws + WS_MIX); g.Bt = (const bf16_t*)(ws + WS_WT_OUT0); g.M = MT; g.N = D; g.K = D;
        pg8::StaticOrder S; S.init(g.M, g.N, G, c); EpiResid0 E; E.xin_lat = p.x; E.xin_ctx = p.ctx; E.xout = (float*)(ws + WS_XRES); E.gate = (const float*)(ws + WS_ADA) + 2 * D; pg8::gemm_phase(lds, g, S, E, wv_); }
    else if constexpr (WHICH == G_GU) { g.A = (const bf16_t*)(ws + WS_H); g.Bt = (const bf16_t*)(ws + WS_WT_GU) + (size_t)l * NE * 2 * FF * D; g.M = NBLK * 256; g.N = 2 * FF; g.K = D;
        pg8::MoeOrder<true> S; S.init((const int*)(ws + WS_CNT) + l * 64, g.N, G, c, (const int*)(ws + WS_ROWIDX), (size_t)2 * FF * D * 2); EpiGU E; E.O = (bf16_t*)(ws + WS_ACT); pg8::gemm_phase(lds, g, S, E, wv_); }
    else if constexpr (WHICH == G_DN) { g.A = (const bf16_t*)(ws + WS_ACT); g.Bt = (const bf16_t*)(ws + WS_WT_DN) + (size_t)l * NE * D * FF; g.M = NBLK * 256; g.N = D; g.K = FF;
        pg8::MoeOrder<false> S; S.init((const int*)(ws + WS_CNT) + l * 64, g.N, G, c, nullptr, (size_t)D * FF * 2); EpiBf16 E; E.O = (bf16_t*)(ws + WS_YBUF); E.ldc = D; pg8::gemm_phase(lds, g, S, E, wv_); }
#ifndef CPU_EMU
    else if constexpr (WHICH == G_IN0SPLIT) {
        { g.A = (const bf16_t*)(ws + WS_H); g.Bt = (const bf16_t*)(ws + WS_WT_IN0) + (size_t)IN0_NQ * D; g.M = MT; g.N = EVIN - IN0_NQ; g.K = D;
          pg8::StaticOrder S; S.init(g.M, g.N, G, c); EpiBf16 E; E.O = (bf16_t*)(ws + WS_QKV) + IN0_NQ; E.ldc = EVIN; pg8::gemm_phase(lds, g, S, E, wv_); }
        const int extra = ((MT / 256) * ((EVIN - IN0_NQ) / 256)) % G, G2 = G - extra;
        if (c >= extra) { pg8::Gemm g2; g2.A = (const bf16_t*)(ws + WS_H8); g2.Bt = (const bf16_t*)(ws + WS_WT_IN0); g2.M = MT; g2.N = IN0_NQ; g2.K = D / 2; g2.sc_w = W8_E8M0; g2.sc_a = ONE_E8M0;
          pg8::StaticOrder S; S.init(g2.M, g2.N, G2, c - extra); EpiQKV E; E.O = (bf16_t*)(ws + WS_QKV); E.rope = (const float*)(ws + WS_ROPE); E.VT = (bf16_t*)(ws + WS_VT); pg8::gemm_phase<EpiQKV, pg8::StaticOrder, true>(lds, g2, S, E, wv_); } }
    else if constexpr (WHICH == G_IN08) { g.A = (const bf16_t*)(ws + WS_H); g.Bt = (const bf16_t*)(ws + WS_WT_IN0); g.M = MT; g.N = EVIN; g.K = D / 2; g.sc_w = W8_E8M0; g.sc_a = ONE_E8M0;
        pg8::StaticOrder S; S.init(g.M, g.N, G, c); EpiQKV E; E.O = (bf16_t*)(ws + WS_QKV); E.rope = (const float*)(ws + WS_ROPE); E.VT = (bf16_t*)(ws + WS_VT); pg8::gemm_phase<EpiQKV, pg8::StaticOrder, true>(lds, g, S, E, wv_); }
    else if constexpr (WHICH == G_OUT08) { g.A = (const bf16_t*)(ws + WS_MIX); g.Bt = (const bf16_t*)(ws + WS_WT_OUT0); g.M = MT; g.N = D; g.K = D / 2; g.sc_w = W8_E8M0; g.sc_a = ONE_E8M0;
        pg8::StaticOrder S; S.init(g.M, g.N, G, c); gemm_stagger(S, 30); EpiResid0 E; E.xin_lat = p.x; E.xin_ctx = p.ctx; E.xout = (float*)(ws + WS_XRES); E.gate = (const float*)(ws + WS_ADA) + 2 * D; pg8::gemm_phase<EpiResid0, pg8::StaticOrder, true>(lds, g, S, E, wv_); }
    else if constexpr (WHICH == G_IN18) { g.A = (const bf16_t*)(ws + WS_H); g.Bt = (const bf16_t*)(ws + WS_WT_IN1); g.M = MT; g.N = S5W; g.K = D / 2; g.sc_w = W8_E8M0; g.sc_a = ONE_E8M0;
        pg8::StaticOrder S; S.init(g.M, g.N, G, c); gemm_stagger(S, 16); EpiBf16 E; E.O = (bf16_t*)(ws + WS_U1); E.ldc = S5W; pg8::gemm_phase<EpiBf16, pg8::StaticOrder, true>(lds, g, S, E, wv_); }
    else if constexpr (WHICH == G_GLU8) { g.A = (const bf16_t*)(ws + WS_Z); g.Bt = (const bf16_t*)(ws + WS_WT_GLU); g.M = ML; g.N = S5W; g.K = S5W / 2; g.sc_w = W8_E8M0; g.sc_a = Z8_E8M0;
        pg8::StaticOrder S; S.init(g.M, g.N, G, c); EpiGLU8 E; E.Z = ws + WS_Z; E.O = ws + WS_S; E.bias = p.s5_glu_b; pg8::gemm_phase<EpiGLU8, pg8::StaticOrder, true>(lds, g, S, E, wv_); }
    else if constexpr (WHICH == G_OUT18) { g.A = (const bf16_t*)(ws + WS_S); g.Bt = (const bf16_t*)(ws + WS_WT_OUT1); g.M = ML; g.N = D; g.K = S5W / 2; g.sc_w = W8_E8M0; g.sc_a = S8_E8M0;
        pg8::StaticOrder S; S.init(g.M, g.N, G, c); EpiResid E; E.xin_lat = (const float*)(ws + WS_XRES); E.xin_ctx = (const float*)(ws + WS_XRES + (size_t)ML * D * (RES_BF16 ? 2 : 4)); E.xout = (float*)(ws + WS_XRES);
        E.gate = (const float*)(ws + WS_ADA) + (size_t)NADA * ADA6 + 2 * D; pg8::gemm_phase<EpiResid, pg8::StaticOrder, true>(lds, g, S, E, wv_); }
    else if constexpr (WHICH == G_GU8) { g.A = (const bf16_t*)(ws + WS_H); g.Bt = (const bf16_t*)(ws + WS_WT_GU + (size_t)l * NE * 2 * FF * D * 2); g.M = NBLK * 256; g.N = 2 * FF; g.K = D / 2; g.sc_w = W8_E8M0; g.sc_a = ONE_E8M0;
        pg8::MoeOrder<true> S; S.init((const int*)(ws + WS_CNT) + l * 64, g.N, G, c, (const int*)(ws + WS_ROWIDX), (size_t)2 * FF * D); gemm_stagger(S, 20); EpiGU8 E; E.O = ws + WS_ACT; pg8::gemm_phase<EpiGU8, pg8::MoeOrder<true>, true>(lds, g, S, E, wv_); }
    else if constexpr (WHICH == G_DN8) { g.A = (const bf16_t*)(ws + WS_ACT); g.Bt = (const bf16_t*)(ws + WS_WT_DN + (size_t)l * NE * D * FF * 2); g.M = NBLK * 256; g.N = D; g.K = FF / 2; g.sc_w = W8_E8M0; g.sc_a = ACT8_E8M0;
        pg8::MoeOrder<false> S; S.init((const int*)(ws + WS_CNT) + l * 64, g.N, G, c, nullptr, (size_t)D * FF); gemm_stagger(S, 13);
        if constexpr (Y8) { EpiY8 E; E.O = ws + WS_YBUF; E.ldc = D; pg8::gemm_phase<EpiY8, pg8::MoeOrder<false>, true>(lds, g, S, E, wv_); }
        else { EpiBf16 E; E.O = (bf16_t*)(ws + WS_YBUF); E.ldc = D; pg8::gemm_phase<EpiBf16, pg8::MoeOrder<false>, true>(lds, g, S, E, wv_); } }
#endif
    else if constexpr (WHICH == G_IN1) { g.A = (const bf16_t*)(ws + WS_H); g.Bt = (const bf16_t*)(ws + WS_WT_IN1); g.M = MT; g.N = S5W; g.K = D;
        pg8::StaticOrder S; S.init(g.M, g.N, G, c); EpiBf16 E; E.O = (bf16_t*)(ws + WS_U1); E.ldc = S5W; pg8::gemm_phase(lds, g, S, E, wv_); }
    else if constexpr (WHICH == G_GLU) { g.A = (const bf16_t*)(ws + WS_Z); g.Bt = (const bf16_t*)(ws + WS_WT_GLU); g.M = ML; g.N = S5W; g.K = S5W;
        pg8::StaticOrder S; S.init(g.M, g.N, G, c); EpiGLU E; E.Z = (const bf16_t*)(ws + WS_Z); E.O = (bf16_t*)(ws + WS_S); E.bias = p.s5_glu_b; pg8::gemm_phase(lds, g, S, E, wv_); }
    else { g.A = (const bf16_t*)(ws + WS_S); g.Bt = (const bf16_t*)(ws + WS_WT_OUT1); g.M = ML; g.N = D; g.K = S5W;
        pg8::StaticOrder S; S.init(g.M, g.N, G, c); EpiResid E; E.xin_lat = (const float*)(ws + WS_XRES); E.xin_ctx = (const float*)(ws + WS_XRES + (size_t)ML * D * (RES_BF16 ? 2 : 4)); E.xout = (float*)(ws + WS_XRES);
        E.gate = (const float*)(ws + WS_ADA) + (size_t)NADA * ADA6 + 2 * D; pg8::gemm_phase(lds, g, S, E, wv_); }
}
#ifndef CPU_EMU

#define XB_TMO      128
#define XB_XCNT(j)  (256  + 64 * (j))
#define XB_XSUB(j)  (1280 + 64 * (j))
#define XB_XGEN(j)  (2304 + 64 * (j))
#define XB_TOP      3328
#define XB_TOPGEN   3392
#define XCD_BAR_WORDS 3456
#define XB_SPIN_CAP (1u << 24)

__device__ __forceinline__ unsigned xb_ld(unsigned* p)              { return __hip_atomic_load(p, __ATOMIC_RELAXED, __HIP_MEMORY_SCOPE_AGENT); }
__device__ __forceinline__ unsigned xb_add(unsigned* p, unsigned v) { return __hip_atomic_fetch_add(p, v, __ATOMIC_RELAXED, __HIP_MEMORY_SCOPE_AGENT); }
__device__ __forceinline__ unsigned xb_xcc_id() { return (unsigned)__builtin_amdgcn_s_getreg((3 << 11) | 20) & 0xFu; }
#define XB_SPIN(cond, bar) do { unsigned _sp = 0; while (cond) { __builtin_amdgcn_s_sleep(1); \
    if ((++_sp & 255u) == 0u) { if (xb_ld(&(bar)[XB_TMO])) break; if (_sp > XB_SPIN_CAP) { atomicAdd(&(bar)[XB_TMO], 1u); break; } } } } while (0)

struct XcdBarrier {
    unsigned* bar; unsigned x;
    volatile LAS unsigned* st;
};

__device__ __forceinline__ XcdBarrier xcd_barrier_post(unsigned* bar, volatile LAS unsigned* st, int wv_) {
    XcdBarrier b; b.bar = bar; b.x = xb_xcc_id(); b.st = st;
    if (tid_of(wv_) == 0) (void)xb_add(&bar[XB_XCNT(b.x)], 1u);
    return b;
}
__device__ __forceinline__ void xcd_barrier_complete(unsigned* bar, unsigned x, unsigned& nloc, unsigned& nx) {
    const unsigned G = gridDim.x * gridDim.y * gridDim.z;
    unsigned sum, cnt, mine, sp = 0u;
    for (;;) {
        sum = 0u; cnt = 0u; mine = 0u;
#pragma unroll
        for (unsigned j = 0; j < 16; ++j) { const unsigned c = xb_ld(&bar[XB_XCNT(j)]); sum += c; cnt += (c > 0u) ? 1u : 0u; mine = (j == x) ? c : mine; }
        if (sum == G) break;
        __builtin_amdgcn_s_sleep(1);
        if ((++sp & 255u) == 0u) { if (xb_ld(&bar[XB_TMO])) break; if (sp > XB_SPIN_CAP) { atomicAdd(&bar[XB_TMO], 1u); break; } }
    }
    nloc = mine > 0u ? mine : 1u; nx = cnt > 0u ? cnt : 1u;
}

__device__ __forceinline__ void xcd_barrier(const XcdBarrier& b, int wv_) {
    asm volatile("s_waitcnt vmcnt(0)" ::: "memory");
    __syncthreads();
    if (tid_of(wv_) == 0) {
        unsigned* bar = b.bar;
        __builtin_amdgcn_s_waitcnt(0);
        unsigned nloc = b.st[0], nx = b.st[1];
        if (nloc == 0u) { xcd_barrier_complete(bar, b.x, nloc, nx); b.st[0] = nloc; b.st[1] = nx; }
        const unsigned old = xb_add(&bar[XB_XSUB(b.x)], 1u);
        const unsigned gen = old / nloc;
        if (old + 1u == (gen + 1u) * nloc) {
            __builtin_amdgcn_fence(__ATOMIC_RELEASE, "agent");
            asm volatile("s_waitcnt vmcnt(0)" ::: "memory");
            const unsigned og = xb_add(&bar[XB_TOP], 1u);
            const unsigned tg = og / nx;
            if (og + 1u == (tg + 1u) * nx) xb_add(&bar[XB_TOPGEN], 1u);
            else XB_SPIN(xb_ld(&bar[XB_TOPGEN]) == tg, bar);
            __builtin_amdgcn_fence(__ATOMIC_ACQUIRE, "agent");
            xb_add(&bar[XB_XGEN(b.x)], 1u);
            asm volatile("s_waitcnt vmcnt(0)" ::: "memory");
        } else {
            XB_SPIN(xb_ld(&bar[XB_XGEN(b.x)]) == gen, bar);
            __builtin_amdgcn_fence(__ATOMIC_ACQUIRE, "agent");
            asm volatile("s_waitcnt vmcnt(0)" ::: "memory");
        }
    }
    __syncthreads();
}


#define GT ((long)blockIdx.x * blockDim.x + threadIdx.x)
#define GN ((long)gridDim.x * blockDim.x)
constexpr int MEGA_LDS = 147456;
__device__ __forceinline__ long gt_of(int wv) { return (long)blockIdx.x * 512 + tid_of(wv); }
__global__ void __launch_bounds__(512, 2) k_mega(Params p) {
    extern __shared__ __attribute__((aligned(16))) unsigned char shm[];
    volatile LAS unsigned* st = (volatile LAS unsigned*)(shm + MEGA_LDS - 64);
    const int WV = __builtin_amdgcn_readfirstlane((int)threadIdx.x >> 6);
    if (tid_of(WV) == 0) { st[0] = 0u; st[1] = 0u; st[2] = 0u; st[3] = 0u; }
    __syncthreads();
    const XcdBarrier bar = xcd_barrier_post((unsigned*)(p.ws + WS_BAR), st, WV);
    const long gn = (long)gridDim.x * 512; const int G = (int)gridDim.x, c = (int)blockIdx.x; const pg8::LdsPtr lds = (pg8::LdsPtr)shm;
#define gt gt_of(WV)
    ph_ada(p, (float*)shm, c, G, WV); ph_tables(p, gt, gn); ph_convert(p, (float*)shm, CVT_TILES, -1, WV);
    xcd_barrier(bar, WV);
    ph_norm_fast<0>(p, 0, MT, c * 8 + WV, G * 8, WV);
    xcd_barrier(bar, WV);
    run_gemm<IN0_FP8 ? G_IN08 : (IN0QKV_FP8 ? G_IN0SPLIT : G_IN0)>(p, 0, lds, G, c, WV);
    xcd_barrier(bar, WV);
    ph_attn_fast(p, (LAS unsigned char*)shm, c, G, WV);
    { constexpr int ATT_UNITS = NB * 4 * (NSEQ / 128 + NCTX / 128); const int extra = ATT_UNITS % G;
      if (extra * 2 < G) { if (c >= extra) ph_conv_fast(p, (long)(c - extra) * 512 + tid_of(WV), (long)(G - extra) * 512); } else ph_conv_fast(p, gt, gn); }
    xcd_barrier(bar, WV);
    ph_lru_fast<1>(p, (LAS unsigned char*)shm, c * 8 + WV, G * 8, WV);
    xcd_barrier(bar, WV);
    ph_lru_fast<2>(p, (LAS unsigned char*)shm, c * 8 + WV, G * 8, WV);
    xcd_barrier(bar, WV);
    run_gemm<OUT0_FP8 ? G_OUT08 : G_OUT0>(p, 0, lds, G, c, WV);
    xcd_barrier(bar, WV);
    ph_router_fast<MOE0_FP8>(p, 0, MT, (LAS unsigned char*)shm, c, G, WV);
    xcd_barrier(bar, WV);
    ph_dispatch_fast(p, 0, MT, (LAS unsigned char*)shm, c, G, WV);
    xcd_barrier(bar, WV);
    run_gemm<MOE0_FP8 ? G_GU8 : G_GU>(p, 0, lds, G, c, WV);
    xcd_barrier(bar, WV);
    run_gemm<MOE0_FP8 ? G_DN8 : G_DN>(p, 0, lds, G, c, WV);
    xcd_barrier(bar, WV);
    ph_norm_fast<1>(p, 1, MT, c * 8 + WV, G * 8, WV);
    xcd_barrier(bar, WV);
    run_gemm<DENSE1_FP8 ? G_IN18 : G_IN1>(p, 1, lds, G, c, WV);
    xcd_barrier(bar, WV);
    ph_s5_fast<1>(p, (LAS unsigned char*)shm, c * 8 + WV, G * 8, WV);
    xcd_barrier(bar, WV);
    ph_s5_fast<2>(p, (LAS unsigned char*)shm, c * 8 + WV, G * 8, WV);
    xcd_barrier(bar, WV);
    run_gemm<DENSE1_FP8 ? G_GLU8 : G_GLU>(p, 1, lds, G, c, WV);
    xcd_barrier(bar, WV);
    run_gemm<DENSE1_FP8 ? G_OUT18 : G_OUT1>(p, 1, lds, G, c, WV);
    xcd_barrier(bar, WV);
    ph_router_fast<MOE1_FP8>(p, 1, ML, (LAS unsigned char*)shm, c, G, WV);
    xcd_barrier(bar, WV);
    ph_dispatch_fast(p, 1, ML, (LAS unsigned char*)shm, c, G, WV);
    xcd_barrier(bar, WV);
    run_gemm<MOE1_FP8 ? G_GU8 : G_GU>(p, 1, lds, G, c, WV);
    xcd_barrier(bar, WV);
    run_gemm<MOE1_FP8 ? G_DN8 : G_DN>(p, 1, lds, G, c, WV);
    xcd_barrier(bar, WV);
    ph_norm_fast<2>(p, 1, ML, c * 8 + WV, G * 8, WV);
#undef gt
}

#ifdef MK_MULTI
__global__ void __launch_bounds__(512, 2) k_prologue(Params p) {
    extern __shared__ __attribute__((aligned(16))) unsigned char shm[];
    ph_ada(p, (float*)shm, blockIdx.x, gridDim.x, (int)threadIdx.x >> 6); ph_tables(p, GT, GN); ph_convert(p, (float*)shm, CVT_TILES, -1, (int)threadIdx.x >> 6);
}
template <int WHICH> __global__ void __launch_bounds__(512, 2) k_gemm(Params p, int l) {
    extern __shared__ __attribute__((aligned(16))) unsigned char shm[];
    run_gemm<WHICH>(p, l, (pg8::LdsPtr)shm, (int)gridDim.x, (int)blockIdx.x, __builtin_amdgcn_readfirstlane((int)threadIdx.x >> 6));
}
__global__ void __launch_bounds__(512, 2) k_norm(Params p, int l, int rows) { ph_norm(p, l, rows, GT, GN); }
__global__ void __launch_bounds__(512, 2) k_conv(Params p) { ph_conv(p, GT, GN); }
__global__ void __launch_bounds__(512, 2) k_lru(Params p) { ph_lru(p, GT, GN); }
__global__ void __launch_bounds__(512, 2) k_attn(Params p) { ph_attn(p, GT, GN); }
__global__ void __launch_bounds__(512, 2) k_router(Params p, int l, int rows) { ph_router(p, l, rows, GT, GN); }
__global__ void __launch_bounds__(512, 2) k_dispatch(Params p, int l, int rows) { ph_dispatch(p, l, rows, GT, GN); }
__global__ void __launch_bounds__(512, 2) k_combine(Params p, int l, int rows) { ph_combine(p, l, rows, GT, GN); }
__global__ void __launch_bounds__(512, 2) k_s5(Params p) { ph_s5(p, GT, GN); }
__global__ void __launch_bounds__(512, 2) k_final(Params p) { ph_final(p, GT, GN); }

#endif
static Params make_params(void* const* d_in, void* d_out, void* d_ws) {
    Params p{}; const float* const* in = (const float* const*)d_in;
    p.x = in[0]; p.c = in[1]; p.ctx = in[2]; p.c_ctx = in[3]; p.ada_w = in[4]; p.ada_b = in[5]; p.norm_mix = in[6]; p.norm_ffn = in[7]; p.norm_final = in[8];
    p.ev_w_in = in[9]; p.ev_w_out = in[10]; p.attn_sink = in[11]; p.lru_conv_w = in[12]; p.lru_conv_b = in[13]; p.lru_lam = in[14]; p.lru_wa = in[15]; p.lru_ba = in[16]; p.lru_wi = in[17]; p.lru_bi = in[18];
    p.od_w_in = in[19]; p.s5_lam_re = in[20]; p.s5_lam_im = in[21]; p.s5_log_step = in[22]; p.s5_b_re = in[23]; p.s5_b_im = in[24]; p.s5_c_re = in[25]; p.s5_c_im = in[26]; p.s5_d = in[27];
    p.s5_glu_w = in[28]; p.s5_glu_b = in[29]; p.od_w_out = in[30]; p.router_w = in[31]; p.router_b = in[32]; p.moe_w_gate = in[33]; p.moe_w_up = in[34]; p.moe_w_down = in[35];
    p.out = (float*)d_out; p.ws = (unsigned char*)d_ws; return p;
}

extern "C" void kernel_launch(void* const* d_in, const int* in_sizes, int n_in, void* d_out, int out_size, void* d_ws, size_t ws_size, hipStream_t stream) {
    if (n_in != 36 || ws_size < WS_END || out_size != ML * D) { fprintf(stderr, "kernel_launch: unexpected shapes (n_in %d, out %d, ws %zu < %zu)\n", n_in, out_size, ws_size, (size_t)WS_END); return; }
#ifdef MK_MULTI
    static bool attr_done = false;
    constexpr int GLDS = pg8::STAGE_BYTES;
    if (!attr_done) {
        (void)hipFuncSetAttribute((const void*)k_gemm<G_IN0>, hipFuncAttributeMaxDynamicSharedMemorySize, GLDS); (void)hipFuncSetAttribute((const void*)k_gemm<G_OUT0>, hipFuncAttributeMaxDynamicSharedMemorySize, GLDS);
        (void)hipFuncSetAttribute((const void*)k_gemm<G_GU>, hipFuncAttributeMaxDynamicSharedMemorySize, GLDS); (void)hipFuncSetAttribute((const void*)k_gemm<G_DN>, hipFuncAttributeMaxDynamicSharedMemorySize, GLDS);
        (void)hipFuncSetAttribute((const void*)k_gemm<G_IN1>, hipFuncAttributeMaxDynamicSharedMemorySize, GLDS); (void)hipFuncSetAttribute((const void*)k_gemm<G_GLU>, hipFuncAttributeMaxDynamicSharedMemorySize, GLDS);
        (void)hipFuncSetAttribute((const void*)k_gemm<G_OUT1>, hipFuncAttributeMaxDynamicSharedMemorySize, GLDS);
        attr_done = true;
    }
    const Params p = make_params(d_in, d_out, d_ws);
    (void)hipMemsetAsync(d_ws, 0, CTL_BYTES, stream);
    const dim3 blk(512); const int NG = 256, NW = 1024;
    k_prologue<<<NW, blk, (ADA_LDS_BYTES > CVT_LDS_BYTES + 16 ? ADA_LDS_BYTES : CVT_LDS_BYTES + 16), stream>>>(p);
    k_norm<<<NW, blk, 0, stream>>>(p, 0, MT);
    k_gemm<G_IN0><<<NG, blk, GLDS, stream>>>(p, 0);
    k_attn<<<NW, blk, 0, stream>>>(p);
    k_conv<<<NW, blk, 0, stream>>>(p);
    k_lru<<<NW, blk, 0, stream>>>(p);
    k_gemm<G_OUT0><<<NG, blk, GLDS, stream>>>(p, 0);
    k_router<<<NW, blk, 0, stream>>>(p, 0, MT);
    k_dispatch<<<NW, blk, 0, stream>>>(p, 0, MT);
    k_gemm<G_GU><<<NG, blk, GLDS, stream>>>(p, 0);
    k_gemm<G_DN><<<NG, blk, GLDS, stream>>>(p, 0);
    k_combine<<<NW, blk, 0, stream>>>(p, 0, MT);
    k_norm<<<NW, blk, 0, stream>>>(p, 1, MT);
    k_gemm<G_IN1><<<NG, blk, GLDS, stream>>>(p, 1);
    k_s5<<<NW, blk, 0, stream>>>(p);
    k_gemm<G_GLU><<<NG, blk, GLDS, stream>>>(p, 1);
    k_gemm<G_OUT1><<<NG, blk, GLDS, stream>>>(p, 1);
    k_router<<<NW, blk, 0, stream>>>(p, 1, ML);
    k_dispatch<<<NW, blk, 0, stream>>>(p, 1, ML);
    k_gemm<G_GU><<<NG, blk, GLDS, stream>>>(p, 1);
    k_gemm<G_DN><<<NG, blk, GLDS, stream>>>(p, 1);
    k_combine<<<NW, blk, 0, stream>>>(p, 1, ML);
    k_final<<<NW, blk, 0, stream>>>(p);
#else
    static int grid = 0;
    if (!grid) {
        int dev = 0, cus = 0, per_cu = 0;
        if (hipGetDevice(&dev) != hipSuccess || hipDeviceGetAttribute(&cus, hipDeviceAttributeMultiprocessorCount, dev) != hipSuccess) { fprintf(stderr, "kernel_launch: device query failed\n"); return; }
        if (hipFuncSetAttribute((const void*)k_mega, hipFuncAttributeMaxDynamicSharedMemorySize, MEGA_LDS) != hipSuccess) { fprintf(stderr, "kernel_launch: hipFuncSetAttribute failed\n"); return; }
        if (hipOccupancyMaxActiveBlocksPerMultiprocessor(&per_cu, (const void*)k_mega, 512, MEGA_LDS) != hipSuccess || per_cu < 1) { fprintf(stderr, "kernel_launch: occupancy query says %d\n", per_cu); return; }
        grid = cus < MAXG ? cus : MAXG;
    }
    const Params p = make_params(d_in, d_out, d_ws);
    (void)hipMemsetAsync(d_ws, 0, WS_ADA, stream);
    hipLaunchKernelGGL(k_mega, dim3(grid), dim3(512), MEGA_LDS, stream, p);
#endif
}
#endif
```

```cpp
#ifndef CPU_EMU
#include <hip/hip_runtime.h>
#include <cstdio>
#include <cstdint>
#endif

#ifndef BATCH
#define BATCH 4
#endif
#ifndef SEQ
#define SEQ 4096
#endif
#ifndef CTX_LEN
#define CTX_LEN 256
#endif
constexpr int D = 2048, NB = BATCH, NSEQ = SEQ, NCTX = CTX_LEN;
constexpr int ML = NB * NSEQ, MC = NB * NCTX, MT = ML + MC;
constexpr int NADA = NB + 1;
constexpr int QW = 1024, KVW = 256, LW = 1024, EVIN = 3584;
constexpr int COL_Q = 0, COL_K = 1024, COL_V = 1280, COL_XR = 1536, COL_GR = 2560;
constexpr int S5W = 1024, S5G = 64, S5C = 16, S5S = 64;
constexpr int NE = 16, FF = 1024;
constexpr int NBLK = (2 * MT + 255) / 256 + NE;
constexpr int ADA6 = 6 * D;
static_assert(ML % 256 == 0 && MC % 256 == 0 && NSEQ % 256 == 0 && NCTX % 256 == 0, "tiles must not straddle sequences");

typedef unsigned short bf16_t;
#ifndef CPU_EMU
#define LAS __attribute__((address_space(3)))
__device__ __forceinline__ int tid_of(int wv) { int l; asm volatile("v_mbcnt_lo_u32_b32 %0, -1, 0\n\tv_mbcnt_hi_u32_b32 %0, -1, %0" : "=v"(l)); return wv * 64 + l; }
#endif

#ifdef CPU_EMU
constexpr bool MOE1_FP8 = false, MOE0_FP8 = false, DENSE1_FP8 = false, IN0_FP8 = false, IN0QKV_FP8 = false, OUT0_FP8 = false, RES_BF16 = false, Y8 = false;
#else
constexpr bool Y8 = true;
constexpr bool RES_BF16 = true; constexpr bool IN0_FP8 = false, IN0QKV_FP8 = true, OUT0_FP8 = true;
constexpr bool DENSE1_FP8 = true;
constexpr bool MOE0_FP8 = true;
constexpr bool MOE1_FP8 = true;
#endif
constexpr float W8_SCALE = 64.0f, ACT8_SCALE = 4.0f;
constexpr int W8_E8M0 = 127 - 6, ACT8_E8M0 = 127 - 2, ONE_E8M0 = 127;
constexpr float Z8_SCALE = 8.0f, S8_SCALE = 16.0f, MIX8_SCALE = 16.0f, Y8_SCALE = 16.0f; constexpr int Z8_E8M0 = 127 - 3, S8_E8M0 = 127 - 4, MIX8_E8M0 = 127 - 4;

constexpr size_t al256(size_t x) { return (x + 255) & ~(size_t)255; }
constexpr size_t WS_BAR = 0;
constexpr size_t WS_CNT = 16384;
constexpr size_t WS_ADA = 32768;
constexpr size_t CTL_BYTES = al256(WS_ADA + (size_t)2 * NADA * ADA6 * 4);
constexpr size_t WS_ROPE = CTL_BYTES;
constexpr size_t WS_S5LAM = WS_ROPE + 64 * 16 * 8;
constexpr size_t WS_S5BB = WS_S5LAM + (size_t)2 * S5G * S5S * 8;
constexpr size_t WS_S5LAMT = WS_S5BB + (size_t)2 * S5G * S5S * S5C * 8;
constexpr size_t WS_S5BF = WS_S5LAMT + (size_t)2 * S5G * S5S * 8;
constexpr size_t WS_S5CF = WS_S5BF + (size_t)2 * S5G * 4 * 64 * 16;
constexpr size_t WS_LRUBF = WS_S5CF + (size_t)2 * S5G * 4 * 64 * 16;
constexpr size_t WS_RWF = WS_LRUBF + (size_t)2 * 16 * 2 * 2 * 4 * 64 * 16;
constexpr size_t WS_WT_IN0 = al256(WS_RWF + (size_t)2 * 64 * 64 * 16);
constexpr size_t WS_WT_OUT0 = WS_WT_IN0 + (size_t)EVIN * D * 2;
constexpr size_t WS_WT_IN1 = WS_WT_OUT0 + (size_t)D * D * 2;
constexpr size_t WS_WT_GLU = WS_WT_IN1 + (size_t)S5W * D * 2;
constexpr size_t WS_WT_OUT1 = WS_WT_GLU + (size_t)S5W * S5W * 2;
constexpr size_t WS_WT_GU = WS_WT_OUT1 + (size_t)D * S5W * 2;
constexpr size_t WS_WT_DN = WS_WT_GU + (size_t)2 * NE * 2 * FF * D * 2;
constexpr size_t WS_W8_GU = WS_WT_GU + (size_t)NE * 2 * FF * D * 2;
constexpr size_t WS_W8_DN = WS_WT_DN + (size_t)NE * D * FF * 2;
constexpr size_t WS_XRES = WS_WT_DN + (size_t)2 * NE * D * FF * 2;
constexpr size_t WS_H8 = WS_XRES + (size_t)MT * D * 2;
constexpr size_t WS_H = WS_XRES + (size_t)MT * D * 4;
constexpr size_t WS_TOK = WS_H + (size_t)MT * D * 2;
constexpr size_t WS_ROWIDX = WS_TOK + (size_t)4 * MT * 2 * 4;
constexpr size_t WS_RA = al256(WS_ROWIDX + (size_t)NBLK * 256 * 4);
constexpr size_t WS_QKV = WS_RA;
constexpr size_t WS_MIX = WS_QKV + (size_t)MT * EVIN * 2;
constexpr size_t WS_U1 = WS_RA;
constexpr size_t WS_YS5 = WS_U1 + (size_t)MT * S5W * 2;
constexpr size_t WS_Z = WS_YS5 + (size_t)ML * S5W * 4;
constexpr size_t WS_S = WS_Z + (size_t)ML * S5W * 2;
constexpr int S5_CHUNK = 128, S5_NCC = NCTX / S5_CHUNK, S5_NLC = NSEQ / S5_CHUNK, S5_NCH = S5_NCC + S5_NLC;
static_assert(S5_NCC % 2 == 0 && S5_NLC % 2 == 0, "chunks are processed in pairs");
constexpr size_t WS_S5E = WS_S + (size_t)ML * S5W * 2;
constexpr size_t RA_BYTES = (size_t)MT * EVIN * 2 + (size_t)MT * D * 2;
static_assert(WS_S5E + (size_t)NB * S5G * 2 * S5_NCH * S5S * 8 <= WS_RA + RA_BYTES, "L1 overlay (E)");
static_assert((size_t)MT * S5W * 2 + (size_t)ML * S5W * 4 + 2 * (size_t)ML * S5W * 2 <= RA_BYTES, "L1 overlay");
constexpr size_t WS_RB = al256(WS_RA + RA_BYTES);
constexpr size_t WS_ACT = WS_RB;
constexpr size_t WS_YBUF = WS_ACT + (size_t)NBLK * 256 * FF * 2;
constexpr size_t WS_UCONV = WS_RB;
constexpr size_t WS_HSUM = WS_UCONV + (size_t)MT * LW * 4;
constexpr size_t RB_BYTES = (size_t)NBLK * 256 * FF * 2 + (size_t)NBLK * 256 * D * 2;
static_assert(2 * (size_t)MT * LW * 4 <= RB_BYTES, "LRU overlay");
constexpr size_t WS_UBF = WS_RB;
constexpr int VT_T = 128 + NSEQ + 128 + NCTX;
constexpr size_t WS_VT = WS_UBF + (size_t)MT * LW * 2;
constexpr size_t WS_LRUAGG = al256(WS_VT + (size_t)NB * 4 * 64 * VT_T * 2);
constexpr int LRU_CH = 64, LRU_NCC = NCTX / LRU_CH, LRU_NLC = NSEQ / LRU_CH, LRU_NCH = LRU_NCC + LRU_NLC;
static_assert(LRU_NCC % 2 == 0 && LRU_NLC % 2 == 0, "chunks are processed in pairs");
static_assert(WS_LRUAGG + (size_t)NB * 2 * LRU_NCH * LW * 8 <= WS_RB + RB_BYTES, "RB overlay");
constexpr int MAXG = 256;
constexpr int HIST_LD = 32;
constexpr size_t WS_HIST = al256(WS_RB + RB_BYTES);
constexpr size_t WS_END = WS_HIST + (size_t)2 * MAXG * HIST_LD * 4;

struct Params {
    const float *x, *c, *ctx, *c_ctx, *ada_w, *ada_b, *norm_mix, *norm_ffn, *norm_final;
    const float *ev_w_in, *ev_w_out, *attn_sink, *lru_conv_w, *lru_conv_b, *lru_lam, *lru_wa, *lru_ba, *lru_wi, *lru_bi;
    const float *od_w_in, *s5_lam_re, *s5_lam_im, *s5_log_step, *s5_b_re, *s5_b_im, *s5_c_re, *s5_c_im, *s5_d, *s5_glu_w, *s5_glu_b, *od_w_out;
    const float *router_w, *router_b, *moe_w_gate, *moe_w_up, *moe_w_down;
    float* out;
    unsigned char* ws;
};

#ifdef CPU_EMU
typedef float f32x4 __attribute__((vector_size(16)));
#else
typedef float f32x4 __attribute__((ext_vector_type(4)));
#endif
struct u32x2_t { unsigned x, y; };
struct u32x4_t { unsigned x, y, z, w; };
#ifdef CPU_EMU
__device__ __forceinline__ void st_coh(int* p, int v) { *p = v; }
__device__ __forceinline__ int ld_coh(const int* p) { return *p; }
#else
__device__ __forceinline__ void st_coh(int* p, int v) { __hip_atomic_store(p, v, __ATOMIC_RELAXED, __HIP_MEMORY_SCOPE_AGENT); }
__device__ __forceinline__ int ld_coh(const int* p) { return __hip_atomic_load(p, __ATOMIC_RELAXED, __HIP_MEMORY_SCOPE_AGENT); }
#endif
__device__ __forceinline__ f32x4 unpack4bf(unsigned lo, unsigned hi) { return (f32x4){__uint_as_float(lo << 16), __uint_as_float(lo & 0xffff0000u), __uint_as_float(hi << 16), __uint_as_float(hi & 0xffff0000u)}; }
__device__ __forceinline__ float bf2f(bf16_t b) { return __uint_as_float(((unsigned)b) << 16); }
__device__ __forceinline__ bf16_t f2bf(float f) { unsigned u = __float_as_uint(f); u += 0x7FFFu + ((u >> 16) & 1u); return (bf16_t)(u >> 16); }
#ifdef CPU_EMU
__device__ __forceinline__ unsigned pack2bf(float lo, float hi) { return (unsigned)f2bf(lo) | ((unsigned)f2bf(hi) << 16); }
#else
typedef short s5_bf16x8 __attribute__((ext_vector_type(8)));
typedef unsigned u4v_t __attribute__((ext_vector_type(4)));
__device__ __forceinline__ int deal_item(int round, int gwave, int nwaves, int items, int grp = 2) {
    const int full = items / nwaves; if (round < full) return round * nwaves + gwave; if (round > full) return -1;
    const int rem = items - full * nwaves, blk = gwave >> 3, wv = gwave & 7; if (wv >= grp) return -1; const int j = blk * grp + wv; return j < rem ? full * nwaves + j : -1; }
#ifndef CPU_EMU
__device__ __forceinline__ float clamp_e4m3(float x) { return fminf(fmaxf(x, -448.0f), 448.0f); }
__device__ __forceinline__ unsigned pack4_fp8(float a, float b, float c, float d) { int w = 0; w = __builtin_amdgcn_cvt_pk_fp8_f32(clamp_e4m3(a), clamp_e4m3(b), w, false); w = __builtin_amdgcn_cvt_pk_fp8_f32(clamp_e4m3(c), clamp_e4m3(d), w, true); return (unsigned)w; }
#endif
__device__ __forceinline__ float opaque_zero() { float z = 0.f; asm volatile("" : "+v"(z)); return z; }
#define MFMA_KEEP(acc, x) asm volatile("" : "+v"(acc) : "v"(x))
typedef __bf16 bf16x2_hw __attribute__((ext_vector_type(2)));
typedef float f32x2_hw __attribute__((ext_vector_type(2)));
__device__ __forceinline__ unsigned pack2bf(float lo, float hi) { const f32x2_hw v = {lo, hi}; const bf16x2_hw b = __builtin_convertvector(v, bf16x2_hw); return __builtin_bit_cast(unsigned, b); }
#endif
#ifdef CPU_EMU
__device__ __forceinline__ float sigmoidf_(float x) { return 1.0f / (1.0f + __expf(-x)); }
__device__ __forceinline__ float fast_rcp(float x) { return 1.0f / x; }
__device__ __forceinline__ float fast_sqrt(float x) { return sqrtf(x); }
#else
__device__ __forceinline__ float fast_rcp(float x) { return __builtin_amdgcn_rcpf(x); }
__device__ __forceinline__ float fast_sqrt(float x) { return __builtin_amdgcn_sqrtf(x); }
__device__ __forceinline__ float sigmoidf_(float x) { return __builtin_amdgcn_rcpf(1.0f + __builtin_amdgcn_exp2f(-1.44269504089f * x)); }
#endif
__device__ __forceinline__ float siluf_(float x) { return x * sigmoidf_(x); }
#ifdef CPU_EMU
__device__ __forceinline__ float geluf_(float x) { const float u = 0.7978845608028654f * (x + 0.044715f * x * x * x); return 0.5f * x * (1.0f + tanhf(u)); }
#else
__device__ __forceinline__ float geluf_(float x) { const float t = x * x, e = __builtin_amdgcn_exp2f(x * __builtin_fmaf(t, -0.102943215f, -2.302208198f)); return x * __builtin_amdgcn_rcpf(1.0f + e); }
#endif
__device__ __forceinline__ float softplusf_(float x) { return x > 20.f ? x : log1pf(__expf(x)); }
__device__ __forceinline__ int ada_row(int r) { return r < ML ? r / NSEQ : NB; }
__device__ __forceinline__ const float* ada_ptr(const Params& p, int l, int arow, int which) { return (const float*)(p.ws + WS_ADA) + ((size_t)l * NADA + arow) * ADA6 + (size_t)which * D; }
__device__ __forceinline__ const float* xin_row(const Params& p, int l, int r) {
    if (l == 0) return r < ML ? p.x + (size_t)r * D : p.ctx + (size_t)(r - ML) * D;
    return (const float*)(p.ws + WS_XRES) + (size_t)r * D;
}

#ifndef CPU_EMU
constexpr int ADA_ITEMS = 2 * (ADA6 / 128), ADA_LDS_BYTES = (NADA * D + 16 * NADA * 128) * 4;
__device__ __forceinline__ void ph_ada(const Params& p, float* sil, int bid, int nblocks, int wv_) {
    const int tid = tid_of(wv_), w = wv_, lane = tid & 63, kh = lane >> 5, cq = lane & 31;
    float* ada = (float*)(p.ws + WS_ADA); float* red = sil + NADA * D;
    if (bid < ADA_ITEMS) { for (int i = tid; i < NADA * D; i += 512) { const int r = i / D, k = i % D; sil[i] = siluf_(r < NB ? p.c[(size_t)r * D + k] : p.c_ctx[k]); } }
    __syncthreads();
    for (int item = bid; item < ADA_ITEMS; item += nblocks) {
        const int l = item / (ADA6 / 128), cb = (item % (ADA6 / 128)) * 128, c0 = cb + cq * 4;
        f32x4 acc[NADA];
#pragma unroll
        for (int r = 0; r < NADA; ++r) acc[r] = (f32x4){0.f, 0.f, 0.f, 0.f};
        const float* wp = p.ada_w + (size_t)l * D * ADA6 + c0; const int k0 = w * 256 + kh * 128;
#pragma unroll 16
        for (int k = k0; k < k0 + 128; ++k) {
            const f32x4 wv = *(const f32x4*)(wp + (size_t)k * ADA6);
#pragma unroll
            for (int r = 0; r < NADA; ++r) acc[r] += wv * sil[r * D + k];
        }
        __syncthreads();
#pragma unroll
        for (int r = 0; r < NADA; ++r) *(f32x4*)(red + ((size_t)((w * 2 + kh) * NADA + r) * 128) + cq * 4) = acc[r];
        __syncthreads();
        for (int i = tid; i < NADA * 128; i += 512) { const int r = i / 128, cc = i % 128; float sacc = p.ada_b[(size_t)l * ADA6 + cb + cc];
#pragma unroll
            for (int ww = 0; ww < 16; ++ww) sacc += red[(size_t)(ww * NADA + r) * 128 + cc];
            ada[((size_t)l * NADA + r) * ADA6 + cb + cc] = sacc; }
    }
}
#else
void ph_ada_emu(const Params& p) {
    float* ada = (float*)(p.ws + WS_ADA);
    for (int l = 0; l < 2; ++l) for (int r = 0; r < NADA; ++r) { std::vector<double> acc(ADA6, 0.0);
        for (int k = 0; k < D; ++k) { const float cv = r < NB ? p.c[(size_t)r * D + k] : p.c_ctx[k]; const double sv = siluf_(cv); const float* wr = p.ada_w + ((size_t)l * D + k) * ADA6; for (int j = 0; j < ADA6; ++j) acc[j] += sv * wr[j]; }
        for (int j = 0; j < ADA6; ++j) ada[((size_t)l * NADA + r) * ADA6 + j] = (float)acc[j] + p.ada_b[(size_t)l * ADA6 + j]; }
}
#endif
__device__ __forceinline__ void ph_tables(const Params& p, long gtid, long gthreads) {
    float* rope = (float*)(p.ws + WS_ROPE);
    for (long it = gtid; it < 64 * 16; it += gthreads) {
        const int pos = (int)(it / 16), i = (int)(it % 16);
        const double inv = pow(10000.0, -(double)i / 16.0); const double a = (double)pos * (double)(float)inv;
        rope[it * 2] = (float)cos(a); rope[it * 2 + 1] = (float)sin(a);
    }
    float* lamb = (float*)(p.ws + WS_S5LAM); float* bb = (float*)(p.ws + WS_S5BB);
    for (long it = gtid; it < 2L * S5G * S5S; it += gthreads) {
        const int g = (int)((it / S5S) % S5G), d = (int)(it / (S5S * S5G));
        const double lr = p.s5_lam_re[it], li = p.s5_lam_im[it], step = exp((double)p.s5_log_step[d * S5G + g]);
        const double mag = exp(lr * step), br = mag * cos(li * step), bi = mag * sin(li * step);
        lamb[it * 2] = (float)br; lamb[it * 2 + 1] = (float)bi;
        const double nr = br - 1.0, ni = bi, den = lr * lr + li * li;
        const double cr = (nr * lr + ni * li) / den, ci = (ni * lr - nr * li) / den;
        float b_r[S5C], b_i[S5C];
#pragma unroll
        for (int c = 0; c < S5C; ++c) { b_r[c] = p.s5_b_re[it * S5C + c]; b_i[c] = p.s5_b_im[it * S5C + c]; }
#pragma unroll
        for (int c = 0; c < S5C; ++c) { bb[(it * S5C + c) * 2] = (float)(cr * (double)b_r[c] - ci * (double)b_i[c]); bb[(it * S5C + c) * 2 + 1] = (float)(cr * (double)b_i[c] + ci * (double)b_r[c]); }
        const double magT = exp(lr * step * S5_CHUNK); float* lt = (float*)(p.ws + WS_S5LAMT);
        lt[it * 2] = (float)(magT * cos(li * step * S5_CHUNK)); lt[it * 2 + 1] = (float)(magT * sin(li * step * S5_CHUNK));
    }
    { bf16_t* rw = (bf16_t*)(p.ws + WS_RWF);
      for (long it = gtid; it < 64L * 64 * 8; it += gthreads) { const int j = (int)(it & 7), lane = (int)((it >> 3) & 63), st = (int)(it >> 9);
          const float wv = p.router_w[(size_t)(32 * st + 8 * (lane >> 4) + j) * NE + (lane & 15)]; const bf16_t hi = f2bf(wv); rw[it] = hi; rw[64L * 64 * 8 + it] = f2bf(wv - bf2f(hi)); } }
    bf16_t* lb = (bf16_t*)(p.ws + WS_LRUBF);
    for (long it = gtid; it < 2L * 16 * 2 * 2 * 4 * 64 * 8; it += gthreads) {
        const int j = (int)(it & 7), lane = (int)((it >> 3) & 63), ks = (int)((it >> 9) & 3), cs = (int)((it >> 11) & 1), gate = (int)((it >> 12) & 1); const long dh = it >> 13;
        const float* w = gate ? p.lru_wi : p.lru_wa;
        lb[it] = f2bf(w[((size_t)dh * 64 + 16 * ks + 8 * (lane >> 5) + j) * 64 + 32 * cs + (lane & 31)]);
    }
    bf16_t* bf = (bf16_t*)(p.ws + WS_S5BF); bf16_t* cf = (bf16_t*)(p.ws + WS_S5CF);
    for (long it = gtid; it < 2L * S5G * 4 * 64 * 8; it += gthreads) {
        const int j = (int)(it & 7), lane = (int)((it >> 3) & 63), ct = (int)((it >> 9) & 3); const long dg = it >> 11;
        { const int st = (lane & 31) + 32 * (ct >> 1), ch = 8 * (lane >> 5) + j; const size_t gi = (size_t)dg * S5S + st;
          const double lr = p.s5_lam_re[gi], li = p.s5_lam_im[gi], step = exp((double)p.s5_log_step[dg]);
          const double mag = exp(lr * step), br = mag * cos(li * step), bi = mag * sin(li * step), nr = br - 1.0, ni = bi, den = lr * lr + li * li;
          const double cr = (nr * lr + ni * li) / den, ci = (ni * lr - nr * li) / den, b_r = p.s5_b_re[gi * S5C + ch], b_i = p.s5_b_im[gi * S5C + ch];
          bf[it] = f2bf((float)((ct & 1) ? (cr * b_i + ci * b_r) : (cr * b_r - ci * b_i))); }
        { const int ks = ct, q = 32 * ks + 8 * (lane >> 4) + j, st = q >> 1, ch = lane & 15; const size_t ci_ = ((size_t)dg * S5C + ch) * S5S + st;
          cf[it] = f2bf((q & 1) ? -p.s5_c_im[ci_] : p.s5_c_re[ci_]); }
    }
}
__device__ __forceinline__ void ph_norm(const Params& p, int l, int rows, long gtid, long gthreads) {
    bf16_t* h = (bf16_t*)(p.ws + WS_H);
    for (long r = gtid; r < rows; r += gthreads) {
        const float* xr = xin_row(p, l, (int)r); const int ar = ada_row((int)r);
        const float* sh = ada_ptr(p, l, ar, 0); const float* sc = ada_ptr(p, l, ar, 1); const float* g = p.norm_mix + (size_t)l * D;
        float ss = 0.f; for (int k = 0; k < D; ++k) ss += xr[k] * xr[k];
        const float rstd = 1.0f / sqrtf(ss / D + 1e-6f);
        for (int k = 0; k < D; ++k) h[(size_t)r * D + k] = f2bf(xr[k] * rstd * g[k] * (1.0f + sc[k]) + sh[k]);
    }
}
__device__ __forceinline__ void ph_conv(const Params& p, long gtid, long gthreads) {
    const bf16_t* qkv = (const bf16_t*)(p.ws + WS_QKV); float* u = (float*)(p.ws + WS_UCONV);
    for (long it = gtid; it < (long)MT * LW; it += gthreads) {
        const int r = (int)(it / LW), ch = (int)(it % LW);
        int base, t, n; if (r < ML) { base = (r / NSEQ) * NSEQ; t = r % NSEQ; n = NSEQ; } else { const int rc = r - ML; base = ML + (rc / NCTX) * NCTX; t = rc % NCTX; n = NCTX; }
        float acc = p.lru_conv_b[ch];
        for (int tap = 0; tap < 4; ++tap) { const int tt = t + tap - 2; if (tt >= 0 && tt < n) acc += p.lru_conv_w[tap * LW + ch] * bf2f(qkv[(size_t)(base + tt) * EVIN + COL_XR + ch]); }
        u[it] = acc;
    }
}
__device__ __forceinline__ void ph_lru(const Params& p, long gtid, long gthreads) {
    const bf16_t* qkv = (const bf16_t*)(p.ws + WS_QKV); const float* u = (const float*)(p.ws + WS_UCONV); float* hs = (float*)(p.ws + WS_HSUM); bf16_t* mix = (bf16_t*)(p.ws + WS_MIX);
    for (long it = gtid; it < (long)NB * LW; it += gthreads) {
        const int b = (int)(it / LW), ch = (int)(it % LW), hh = ch / 64, j = ch % 64;
        for (int d = 0; d < 2; ++d) {
            const float lamv = softplusf_(-p.lru_lam[d * LW + ch]), ba = p.lru_ba[d * LW + ch], bi = p.lru_bi[d * LW + ch];
            const float* wa = p.lru_wa + ((size_t)(d * 16 + hh) * 64) * 64 + j; const float* wi = p.lru_wi + ((size_t)(d * 16 + hh) * 64) * 64 + j;
            float state = 0.f;
            for (int seg = 0; seg < 2; ++seg) {
                const int n = seg ? NSEQ : NCTX, base = seg ? b * NSEQ : ML + b * NCTX;
                for (int stp = 0; stp < n; ++stp) {
                    const int row = base + (d ? n - 1 - stp : stp); const float* ur = u + (size_t)row * LW + hh * 64;
                    float ra = ba, ia = bi;
                    for (int i = 0; i < 64; ++i) { ra += ur[i] * wa[(size_t)i * 64]; ia += ur[i] * wi[(size_t)i * 64]; }
                    const float rg = sigmoidf_(ra), ig = sigmoidf_(ia), log_a = -8.0f * rg * lamv, a = __expf(log_a), mult = sqrtf(-expm1f(2.0f * log_a));
                    state = a * state + mult * (ig * ur[j]);
                    if (d == 0) hs[(size_t)row * LW + ch] = state;
                    else { const float tot = hs[(size_t)row * LW + ch] + state; mix[(size_t)row * D + QW + ch] = f2bf(tot * geluf_(bf2f(qkv[(size_t)row * EVIN + COL_GR + ch]))); }
                }
            }
        }
    }
}
__device__ __forceinline__ void ph_attn(const Params& p, long gtid, long gthreads) {
    const bf16_t* qkv = (const bf16_t*)(p.ws + WS_QKV); bf16_t* mix = (bf16_t*)(p.ws + WS_MIX);
    for (long it = gtid; it < (long)MT * 16; it += gthreads) {
        const int r = (int)(it / 16), hd = (int)(it % 16), kvh = hd / 4;
        float q[64], o[64];
        for (int d = 0; d < 64; ++d) { q[d] = bf2f(qkv[(size_t)r * EVIN + COL_Q + hd * 64 + d]); o[d] = 0.f; }
        float m = p.attn_sink[hd], lsum = 1.0f;
        const int b = r < ML ? r / NSEQ : (r - ML) / NCTX;
        for (int seg = 0; seg < 2; ++seg) {
            int k0, k1;
            if (seg == 0) { if (r >= ML) continue; const int t = r % NSEQ; const int lo = t - 128 < 0 ? 0 : t - 128, hi = t + 128 > NSEQ - 1 ? NSEQ - 1 : t + 128; k0 = b * NSEQ + lo; k1 = b * NSEQ + hi + 1; }
            else { k0 = ML + b * NCTX; k1 = k0 + NCTX; }
            for (int kr = k0; kr < k1; ++kr) {
                const bf16_t* kp = qkv + (size_t)kr * EVIN + COL_K + kvh * 64; const bf16_t* vp = qkv + (size_t)kr * EVIN + COL_V + kvh * 64;
                float s = 0.f; for (int d = 0; d < 64; ++d) s += q[d] * bf2f(kp[d]);
                if (s > m) { const float f = __expf(m - s); lsum *= f; for (int d = 0; d < 64; ++d) o[d] *= f; m = s; }
                const float pe = __expf(s - m); lsum += pe;
                for (int d = 0; d < 64; ++d) o[d] += pe * bf2f(vp[d]);
            }
        }
        const float inv = 1.0f / lsum;
        for (int d = 0; d < 64; ++d) mix[(size_t)r * D + hd * 64 + d] = f2bf(o[d] * inv);
    }
}
__device__ __forceinline__ void ph_router(const Params& p, int l, int rows, long gtid, long gthreads) {
    bf16_t* h = (bf16_t*)(p.ws + WS_H); const float* xres = (const float*)(p.ws + WS_XRES);
    int* tok_e = (int*)(p.ws + WS_TOK); float* tok_w = (float*)(p.ws + WS_TOK) + (size_t)MT * 2; int* tok_slot = (int*)(p.ws + WS_TOK) + (size_t)MT * 4;
    int* cnt = (int*)(p.ws + WS_CNT) + l * 64;
    for (long r = gtid; r < rows; r += gthreads) {
        const float* xr = xres + (size_t)r * D; const int ar = ada_row((int)r);
        const float* sh = ada_ptr(p, l, ar, 3); const float* sc = ada_ptr(p, l, ar, 4); const float* g = p.norm_ffn + (size_t)l * D;
        float ss = 0.f; for (int k = 0; k < D; ++k) ss += xr[k] * xr[k];
        const float rstd = 1.0f / sqrtf(ss / D + 1e-6f);
        float lg[NE];
#pragma unroll
        for (int e = 0; e < NE; ++e) lg[e] = p.router_b[e];
        for (int k = 0; k < D; ++k) { const float hv = xr[k] * rstd * g[k] * (1.0f + sc[k]) + sh[k]; h[(size_t)r * D + k] = f2bf(hv);
#pragma unroll
            for (int e = 0; e < NE; ++e) lg[e] += hv * p.router_w[(size_t)k * NE + e]; }
        float mx = lg[0];
#pragma unroll
        for (int e = 1; e < NE; ++e) mx = lg[e] > mx ? lg[e] : mx;
        float pr[NE], sum = 0.f;
#pragma unroll
        for (int e = 0; e < NE; ++e) { pr[e] = __expf(lg[e] - mx); sum += pr[e]; }
#pragma unroll
        for (int e = 0; e < NE; ++e) pr[e] /= sum;
        float best = -1.f, w1 = 0.f, w2 = 0.f; int e1 = 0, e2 = 0;
#pragma unroll
        for (int gi = 0; gi < 4; ++gi) { float a1 = -1.f, a2 = -1.f; int j1 = 0, j2 = 0;
#pragma unroll
            for (int j = 0; j < 4; ++j) { const float v = pr[gi * 4 + j]; if (v > a1) { a2 = a1; j2 = j1; a1 = v; j1 = j; } else if (v > a2) { a2 = v; j2 = j; } }
            if (a1 + a2 > best) { best = a1 + a2; e1 = gi * 4 + j1; e2 = gi * 4 + j2; w1 = a1; w2 = a2; } }
        const float ws = w1 + w2;
        tok_e[r * 2] = e1; tok_e[r * 2 + 1] = e2; tok_w[r * 2] = w1 / ws; tok_w[r * 2 + 1] = w2 / ws;
        tok_slot[r * 2] = atomicAdd(cnt + e1, 1); tok_slot[r * 2 + 1] = atomicAdd(cnt + e2, 1);
    }
}
__device__ __forceinline__ int moe_pad_start(const int* cnt, int e) { int acc = 0;
#pragma unroll
    for (int j = 0; j < NE; ++j) { const int pj = (cnt[j] + 255) / 256 * 256; acc += (j < e) ? pj : 0; } return acc; }
__device__ __forceinline__ void ph_dispatch(const Params& p, int l, int rows, long gtid, long gthreads) {
    const int* tok_e = (const int*)(p.ws + WS_TOK); const int* tok_slot = (const int*)(p.ws + WS_TOK) + (size_t)MT * 4; int* tok_dest = (int*)(p.ws + WS_TOK) + (size_t)MT * 6;
    int* rowidx = (int*)(p.ws + WS_ROWIDX); const int* cnt = (const int*)(p.ws + WS_CNT) + l * 64;
    for (long it = gtid; it < (long)rows * 2; it += gthreads) { const int e = tok_e[it], dest = moe_pad_start(cnt, e) + tok_slot[it]; tok_dest[it] = dest; st_coh(rowidx + dest, (int)(it / 2)); }
    const int total = moe_pad_start(cnt, NE);
    for (long it = gtid; it < total; it += gthreads) { int acc = 0, st = 0, ce = 0;
#pragma unroll
        for (int j = 0; j < NE; ++j) { const int pj = (cnt[j] + 255) / 256 * 256; if (it >= acc && it < acc + pj) { st = acc; ce = cnt[j]; } acc += pj; }
        if (it - st >= ce) st_coh(rowidx + it, 0); }
}
__device__ __forceinline__ void ph_combine(const Params& p, int l, int rows, long gtid, long gthreads) {
    float* xres = (float*)(p.ws + WS_XRES); const bf16_t* yb = (const bf16_t*)(p.ws + WS_YBUF);
    const float* tok_w = (const float*)(p.ws + WS_TOK) + (size_t)MT * 2; const int* tok_dest = (const int*)(p.ws + WS_TOK) + (size_t)MT * 6;
    for (long it = gtid; it < (long)rows * (D / 4); it += gthreads) {
        const int r = (int)(it / (D / 4)), c = (int)(it % (D / 4)) * 4; const float* g2 = ada_ptr(p, l, ada_row(r), 5);
        const int d0 = tok_dest[r * 2], d1 = tok_dest[r * 2 + 1]; const float w0 = tok_w[r * 2], w1 = tok_w[r * 2 + 1];
        for (int j = 0; j < 4; ++j) xres[(size_t)r * D + c + j] += g2[c + j] * (w0 * bf2f(yb[(size_t)d0 * D + c + j]) + w1 * bf2f(yb[(size_t)d1 * D + c + j]));
    }
}
__device__ __forceinline__ void ph_s5(const Params& p, long gtid, long gthreads) {
    const bf16_t* u1 = (const bf16_t*)(p.ws + WS_U1); float* ys = (float*)(p.ws + WS_YS5); bf16_t* z = (bf16_t*)(p.ws + WS_Z);
    const float* lamb = (const float*)(p.ws + WS_S5LAM); const float* bb = (const float*)(p.ws + WS_S5BB);
    for (long it = gtid; it < (long)NB * S5W; it += gthreads) {
        const int b = (int)(it / S5W), col = (int)(it % S5W), g = col / S5C, c = col % S5C;
        for (int t = 0; t < NSEQ; ++t) { const size_t row = (size_t)b * NSEQ + t; ys[row * S5W + col] = p.s5_d[col] * bf2f(u1[row * S5W + col]); }
        for (int d = 0; d < 2; ++d)
            for (int s = 0; s < S5S; ++s) {
                const size_t gi = ((size_t)d * S5G + g) * S5S + s;
                const float lr = lamb[gi * 2], li = lamb[gi * 2 + 1];
                const float cr = p.s5_c_re[(((size_t)d * S5G + g) * S5C + c) * S5S + s], ci = p.s5_c_im[(((size_t)d * S5G + g) * S5C + c) * S5S + s];
                float br[S5C], bi[S5C]; for (int cc = 0; cc < S5C; ++cc) { br[cc] = bb[(gi * S5C + cc) * 2]; bi[cc] = bb[(gi * S5C + cc) * 2 + 1]; }
                float xr = 0.f, xi = 0.f;
                for (int seg = 0; seg < 2; ++seg) {
                    const int n = seg ? NSEQ : NCTX, base = seg ? b * NSEQ : ML + b * NCTX;
                    for (int stp = 0; stp < n; ++stp) {
                        const size_t row = (size_t)base + (d ? n - 1 - stp : stp); const bf16_t* ur = u1 + row * S5W + g * S5C;
                        float bur = 0.f, bui = 0.f; for (int cc = 0; cc < S5C; ++cc) { const float uv = bf2f(ur[cc]); bur += br[cc] * uv; bui += bi[cc] * uv; }
                        const float nr = lr * xr - li * xi + bur, ni = lr * xi + li * xr + bui; xr = nr; xi = ni;
                        if (seg) ys[row * S5W + col] += cr * xr - ci * xi;
                    }
                }
            }
        for (int t = 0; t < NSEQ; ++t) { const size_t row = (size_t)b * NSEQ + t; z[row * S5W + col] = f2bf(geluf_(ys[row * S5W + col])); }
    }
}
#ifndef CPU_EMU
typedef float s5_f32x16 __attribute__((ext_vector_type(16)));
constexpr int S5_XPITCH = 272, S5_XBYTES = 32 * S5_XPITCH, S5_ABYTES = 0, S5_WAVE_LDS = S5_XBYTES + S5_ABYTES + 8 * 2 * 64 * 8;
static_assert(8 * S5_WAVE_LDS <= 147456 - 64, "S5 LDS");
__device__ __forceinline__ int s5_chunk_row0(int b, int k) { return k < S5_NCC ? ML + b * NCTX + k * S5_CHUNK : b * NSEQ + (k - S5_NCC) * S5_CHUNK; }
__device__ __forceinline__ int s5_order(int d, int k) { return d == 0 ? k : (k < S5_NCC ? S5_NCC - 1 - k : S5_NCC + (S5_NLC - 1 - (k - S5_NCC))); }
template <int PASS> __device__ __forceinline__ void ph_s5_fast(const Params& p, LAS unsigned char* lds, int gwave, int nwaves, int wv_) {
    const int lane = tid_of(wv_) & 63, wv = wv_;
    LAS unsigned char* xl = lds + wv * S5_WAVE_LDS;
    const int r = lane & 31, hh = lane >> 5, a_half = (r >> 2) & 1, a_n = (r & 3) + 4 * (r >> 3), tk = lane & 15, q4 = lane >> 4;
    const bf16_t* u1 = (const bf16_t*)(p.ws + WS_U1); bf16_t* z = (bf16_t*)(p.ws + WS_Z); float* ys = (float*)(p.ws + WS_YS5);
    const float* lamb = (const float*)(p.ws + WS_S5LAM); const float* lamt = (const float*)(p.ws + WS_S5LAMT);
    const s5_bf16x8* BF = (const s5_bf16x8*)(p.ws + WS_S5BF); const s5_bf16x8* CF = (const s5_bf16x8*)(p.ws + WS_S5CF);
    float* E = (float*)(p.ws + WS_S5E);
    constexpr int P0 = PASS == 2 ? S5_NCC / 2 : 0, NPAIR = S5_NCH / 2 - P0;
    for (int rd = 0; rd <= (NB * S5G * NPAIR) / nwaves; ++rd) {
        const int it = deal_item(rd, gwave, nwaves, NB * S5G * NPAIR); if (it < 0) continue;
        const int g = it % S5G, pr = P0 + (it / S5G) % NPAIR, b = it / (NPAIR * S5G);
        const int k_s = 2 * pr + hh, k_a = 2 * pr + a_half;
        const int rb_a = s5_chunk_row0(b, k_a);
#pragma unroll
        for (int d = 0; d < 2; ++d) {
            const size_t dg = (size_t)d * S5G + g;
            s5_bf16x8 bfr[4], cfr[4];
#pragma unroll
            for (int ct = 0; ct < 4; ++ct) { bfr[ct] = BF[(dg * 4 + ct) * 64 + lane]; if (PASS == 2) cfr[ct] = CF[(dg * 4 + ct) * 64 + lane]; }
            const float l0r = lamb[(dg * S5S + r) * 2], l0i = lamb[(dg * S5S + r) * 2 + 1], l1r = lamb[(dg * S5S + r + 32) * 2], l1i = lamb[(dg * S5S + r + 32) * 2 + 1];
            const f32x4 dsk = *(const f32x4*)(p.s5_d + g * S5C + 4 * q4);
            float x0r = 0.f, x0i = 0.f, x1r = 0.f, x1i = 0.f;
            float* Eb = E + (((size_t)(b * S5G + g) * 2 + d) * S5_NCH) * S5S * 2;
            if (PASS == 2) {
                const float t0r = lamt[(dg * S5S + r) * 2], t0i = lamt[(dg * S5S + r) * 2 + 1], t1r = lamt[(dg * S5S + r + 32) * 2], t1i = lamt[(dg * S5S + r + 32) * 2 + 1];
                const int oi = s5_order(d, k_s);
                const int oa = s5_order(d, 2 * pr), ob = s5_order(d, 2 * pr + 1), oimax = oa > ob ? oa : ob;
                for (int j0 = 0; j0 < oimax; j0 += 4) { float e0r[4], e0i[4], e1r[4], e1i[4];
#pragma unroll
                    for (int k = 0; k < 4; ++k) { const int jc = j0 + k < S5_NCH ? j0 + k : S5_NCH - 1; e0r[k] = Eb[(jc * S5S + r) * 2]; e0i[k] = Eb[(jc * S5S + r) * 2 + 1]; e1r[k] = Eb[(jc * S5S + r + 32) * 2]; e1i[k] = Eb[(jc * S5S + r + 32) * 2 + 1]; }
                    asm volatile("" : "+v"(e0r[0]), "+v"(e0r[1]), "+v"(e0r[2]), "+v"(e0r[3]), "+v"(e0i[0]), "+v"(e0i[1]), "+v"(e0i[2]), "+v"(e0i[3]), "+v"(e1r[0]), "+v"(e1r[1]), "+v"(e1r[2]), "+v"(e1r[3]), "+v"(e1i[0]), "+v"(e1i[1]), "+v"(e1i[2]), "+v"(e1i[3]));
#pragma unroll
                    for (int k = 0; k < 4; ++k) { const float n0r = t0r * x0r - t0i * x0i + e0r[k], n0i = t0r * x0i + t0i * x0r + e0i[k], n1r = t1r * x1r - t1i * x1i + e1r[k], n1i = t1r * x1i + t1i * x1r + e1i[k];
                        if (j0 + k < oi) { x0r = n0r; x0i = n0i; x1r = n1r; x1i = n1i; } } }
            }
#pragma unroll 1
            for (int i = 0; i < 8; ++i) {
                const int tile = d ? 7 - i : i;
                const s5_bf16x8 a = *(const s5_bf16x8*)(u1 + (size_t)(rb_a + tile * 16 + a_n) * S5W + g * S5C + 8 * hh);
                u32x2_t uu0, uu1; if (PASS == 2 && d == 0) { uu0 = *(const u32x2_t*)(u1 + (size_t)(s5_chunk_row0(b, 2 * pr) + tile * 16 + tk) * S5W + g * S5C + 4 * q4); uu1 = *(const u32x2_t*)(u1 + (size_t)(s5_chunk_row0(b, 2 * pr + 1) + tile * 16 + tk) * S5W + g * S5C + 4 * q4); }
                s5_f32x16 acc[4];
#pragma unroll
                for (int ct = 0; ct < 4; ++ct) { const float z0 = opaque_zero(); s5_f32x16 zz;
#pragma unroll
                    for (int e = 0; e < 16; ++e) zz[e] = z0;
                    acc[ct] = __builtin_amdgcn_mfma_f32_32x32x16_bf16(a, bfr[ct], zz, 0, 0, 0); }
                MFMA_KEEP(acc[3], a);
#pragma unroll
                for (int nn = 0; nn < 16; ++nn) {
                    const int n = d ? 15 - nn : nn;
                    float n0r = __builtin_fmaf(l0r, x0r, __builtin_fmaf(-l0i, x0i, acc[0][n])), n0i = __builtin_fmaf(l0r, x0i, __builtin_fmaf(l0i, x0r, acc[1][n])), n1r = __builtin_fmaf(l1r, x1r, __builtin_fmaf(-l1i, x1i, acc[2][n])), n1i = __builtin_fmaf(l1r, x1i, __builtin_fmaf(l1i, x1r, acc[3][n]));
                    asm volatile("" : "+v"(n0r), "+v"(n0i), "+v"(n1r), "+v"(n1i));
                    x0r = n0r; x0i = n0i; x1r = n1r; x1i = n1i;
                    if (PASS == 2) { *(LAS unsigned*)(xl + (hh * 16 + n) * S5_XPITCH + 4 * r) = pack2bf(x0r, x0i); *(LAS unsigned*)(xl + (hh * 16 + n) * S5_XPITCH + 4 * (r + 32)) = pack2bf(x1r, x1i); }
                }
                if (PASS == 2 && d == 0) asm volatile("" : "+v"(uu0.x), "+v"(uu0.y), "+v"(uu1.x), "+v"(uu1.y));
                if (PASS == 2) asm volatile("" ::: "memory");
                if (PASS == 2) {
#pragma unroll
                    for (int rg = 0; rg < 2; ++rg) {
                        const size_t row = (size_t)s5_chunk_row0(b, 2 * pr + rg) + tile * 16 + tk; const size_t off = row * S5W + g * S5C + 4 * q4;
                        f32x4 yv; LAS u32x2_t* ypark = (LAS u32x2_t*)(xl + S5_XBYTES + S5_ABYTES) + (tile * 2 + rg) * 64 + lane;
                        if (d == 0) { const u32x2_t uu = rg ? uu1 : uu0;
                            yv = (f32x4){dsk[0] * __uint_as_float(uu.x << 16), dsk[1] * __uint_as_float(uu.x & 0xffff0000u), dsk[2] * __uint_as_float(uu.y << 16), dsk[3] * __uint_as_float(uu.y & 0xffff0000u)}; }
                        else { const unsigned y01 = ypark->x, y23 = ypark->y; yv = (f32x4){__uint_as_float(y01 << 16), __uint_as_float(y01 & 0xffff0000u), __uint_as_float(y23 << 16), __uint_as_float(y23 & 0xffff0000u)}; }
#pragma unroll
                        for (int ks = 0; ks < 4; ++ks) { const s5_bf16x8 xb = *(const LAS s5_bf16x8*)(xl + (rg * 16 + tk) * S5_XPITCH + (32 * ks + 8 * q4) * 2);
                            yv = __builtin_amdgcn_mfma_f32_16x16x32_bf16(cfr[ks], xb, yv, 0, 0, 0); MFMA_KEEP(yv, xb); }
                        if (d == 0) { ypark->x = pack2bf(yv[0], yv[1]); ypark->y = pack2bf(yv[2], yv[3]); }
                        else if (DENSE1_FP8) *(unsigned*)((unsigned char*)z + off) = pack4_fp8(geluf_(yv[0]) * Z8_SCALE, geluf_(yv[1]) * Z8_SCALE, geluf_(yv[2]) * Z8_SCALE, geluf_(yv[3]) * Z8_SCALE);
                        else { u32x2_t w; w.x = pack2bf(geluf_(yv[0]), geluf_(yv[1])); w.y = pack2bf(geluf_(yv[2]), geluf_(yv[3])); *(u32x2_t*)(z + off) = w; }
                    }
                    asm volatile("" ::: "memory");
                }
            }
            if (PASS == 1) { const int oi = s5_order(d, k_s); float* ep = Eb + (size_t)oi * S5S * 2;
                ep[r * 2] = x0r; ep[r * 2 + 1] = x0i; ep[(r + 32) * 2] = x1r; ep[(r + 32) * 2 + 1] = x1i; }
        }
    }
}
#endif
#ifndef CPU_EMU
__device__ __forceinline__ void ph_conv_fast(const Params& p, long gtid, long gthreads) {
    const bf16_t* qkv = (const bf16_t*)(p.ws + WS_QKV); bf16_t* ub = (bf16_t*)(p.ws + WS_UBF);
    const int ch = (int)(gtid % (LW / 8)) * 8;
    float wt[4][8], bs[8];
#pragma unroll
    for (int j = 0; j < 8; ++j) bs[j] = p.lru_conv_b[ch + j];
#pragma unroll
    for (int tap = 0; tap < 4; ++tap)
#pragma unroll
        for (int j = 0; j < 8; ++j) wt[tap][j] = p.lru_conv_w[tap * LW + ch + j];
    for (long it = gtid; it < (long)MT * (LW / 8); it += gthreads) {
        const int rr = (int)(it / (LW / 8));
        int base, t, n; if (rr < ML) { base = (rr / NSEQ) * NSEQ; t = rr % NSEQ; n = NSEQ; } else { const int rc = rr - ML; base = ML + (rc / NCTX) * NCTX; t = rc % NCTX; n = NCTX; }
        u32x4_t xv[4];
#pragma unroll
        for (int tap = 0; tap < 4; ++tap) { int tt = t + tap - 2; tt = tt < 0 ? 0 : (tt > n - 1 ? n - 1 : tt); xv[tap] = *(const u32x4_t*)(qkv + (size_t)(base + tt) * EVIN + COL_XR + ch); }
        float acc[8];
#pragma unroll
        for (int j = 0; j < 8; ++j) acc[j] = bs[j];
#pragma unroll
        for (int tap = 0; tap < 4; ++tap) { const int tt = t + tap - 2; const float ok = (tt >= 0 && tt < n) ? 1.0f : 0.0f; const unsigned vw[4] = {xv[tap].x, xv[tap].y, xv[tap].z, xv[tap].w};
#pragma unroll
            for (int j = 0; j < 8; ++j) acc[j] += (wt[tap][j] * ok) * __uint_as_float((j & 1) ? (vw[j >> 1] & 0xffff0000u) : (vw[j >> 1] << 16)); }
        u32x4_t w; w.x = pack2bf(acc[0], acc[1]); w.y = pack2bf(acc[2], acc[3]); w.z = pack2bf(acc[4], acc[5]); w.w = pack2bf(acc[6], acc[7]);
        *(u32x4_t*)(ub + (size_t)rr * LW + ch) = w;
    }
}
__device__ __forceinline__ int lru_chunk_row0(int b, int k) { return k < LRU_NCC ? ML + b * NCTX + k * LRU_CH : b * NSEQ + (k - LRU_NCC) * LRU_CH; }
__device__ __forceinline__ int lru_order(int d, int k) { return d == 0 ? k : (k < LRU_NCC ? LRU_NCC - 1 - k : LRU_NCC + (LRU_NLC - 1 - (k - LRU_NCC))); }
#define LRU_ZERO16(v) do { const float z0_ = opaque_zero(); _Pragma("unroll") for (int e_ = 0; e_ < 16; ++e_) v[e_] = z0_; } while (0)
template <int PASS> __device__ __forceinline__ void ph_lru_fast(const Params& p, LAS unsigned char* lds, int gwave, int nwaves, int wv_) {
    const int lane = tid_of(wv_) & 63; LAS float* hfl = (LAS float*)(lds + wv_ * (LRU_CH * 64 * 4)) + lane;
    const int r = lane & 31, hh = lane >> 5, a_half = (r >> 2) & 1, a_n = (r & 3) + 4 * (r >> 3);
    const bf16_t* ub = (const bf16_t*)(p.ws + WS_UBF); const bf16_t* qkv = (const bf16_t*)(p.ws + WS_QKV); bf16_t* mix = (bf16_t*)(p.ws + WS_MIX);
    const s5_bf16x8* LB = (const s5_bf16x8*)(p.ws + WS_LRUBF); float* AGG = (float*)(p.ws + WS_LRUAGG);
    constexpr int NPAIR = LRU_NCH / 2, NT = LRU_CH / 16;
    s5_bf16x8 idf[2];
#pragma unroll
    for (int kk = 0; kk < 2; ++kk) { const int jj = r - 16 * kk - 8 * hh;
#pragma unroll
        for (int e = 0; e < 8; ++e) idf[kk][e] = (e == jj) ? (short)0x3F80 : (short)0; }
    for (int rd = 0; rd <= (NB * 16 * 2 * NPAIR) / nwaves; ++rd) {
        const int it = deal_item(rd, gwave, nwaves, NB * 16 * 2 * NPAIR, OUT0_FP8 ? 4 : 2); if (it < 0) continue;
        const int cs = it & 1, pr = OUT0_FP8 ? (it >> 2) % NPAIR : (it >> 1) % NPAIR, h = OUT0_FP8 ? 2 * ((it / (4 * NPAIR)) % 8) + ((it >> 1) & 1) : (it / (2 * NPAIR)) % 16, b = it / (32 * NPAIR);
        const int k_s = 2 * pr + hh, k_a = 2 * pr + a_half, rb_a = lru_chunk_row0(b, k_a), rb_s = lru_chunk_row0(b, k_s);
        const int ch = h * 64 + 32 * cs + r;
#pragma unroll
        for (int d = 0; d < 2; ++d) {
            const int oi = lru_order(d, k_s);
            s5_bf16x8 br[4], bi[4];
#pragma unroll
            for (int ks = 0; ks < 4; ++ks) { br[ks] = LB[(((size_t)(d * 16 + h) * 2 + 0) * 2 + cs) * 4 * 64 + ks * 64 + lane]; bi[ks] = LB[(((size_t)(d * 16 + h) * 2 + 1) * 2 + cs) * 4 * 64 + ks * 64 + lane]; }
            const float lamv = softplusf_(-p.lru_lam[d * LW + ch]), bav = p.lru_ba[d * LW + ch], biv = p.lru_bi[d * LW + ch];
            const float nba = -1.44269504089f * bav, nbi = -1.44269504089f * biv, c2 = -8.0f * 1.44269504089f * lamv;
            float state = 0.f, aprod = 1.f;
            float* ag = AGG + (((size_t)b * 2 + d) * LRU_NCH) * LW * 2;
            if (PASS == 2) { const int oa = lru_order(d, 2 * pr), ob = lru_order(d, 2 * pr + 1), oimax = oa > ob ? oa : ob;
                for (int j0 = 0; j0 < oimax; j0 += 8) { float aj[8], bj[8];
#pragma unroll
                    for (int k = 0; k < 8; ++k) { const int jc = j0 + k < LRU_NCH ? j0 + k : LRU_NCH - 1; aj[k] = ag[((size_t)jc * LW + ch) * 2]; bj[k] = ag[((size_t)jc * LW + ch) * 2 + 1]; }
                    asm volatile("" : "+v"(aj[0]), "+v"(aj[1]), "+v"(aj[2]), "+v"(aj[3]), "+v"(aj[4]), "+v"(aj[5]), "+v"(aj[6]), "+v"(aj[7]), "+v"(bj[0]), "+v"(bj[1]), "+v"(bj[2]), "+v"(bj[3]), "+v"(bj[4]), "+v"(bj[5]), "+v"(bj[6]), "+v"(bj[7]));
#pragma unroll
                    for (int k = 0; k < 8; ++k) if (j0 + k < oi) state = aj[k] * state + bj[k]; } }
            s5_bf16x8 an[4], gn0, gn1;
            { const int tile0 = d ? NT - 1 : 0; const bf16_t* up = ub + (size_t)(rb_a + tile0 * 16 + a_n) * LW + h * 64 + 8 * hh;
#pragma unroll
              for (int ks = 0; ks < 4; ++ks) an[ks] = *(const s5_bf16x8*)(up + 16 * ks);
              if (PASS == 2 && d == 1) { const bf16_t* gp = qkv + (size_t)(rb_a + tile0 * 16 + a_n) * EVIN + COL_GR + h * 64 + 32 * cs + 8 * hh; gn0 = *(const s5_bf16x8*)gp; gn1 = *(const s5_bf16x8*)(gp + 16); } }
#pragma unroll 1
            for (int i = 0; i < NT; ++i) {
                const int tile = d ? NT - 1 - i : i;
                s5_bf16x8 a[4], g0, g1;
#pragma unroll
                for (int ks = 0; ks < 4; ++ks) a[ks] = an[ks];
                if (PASS == 2 && d == 1) { g0 = gn0; g1 = gn1; }
                if (i + 1 < NT) { const int tl = d ? tile - 1 : tile + 1; const bf16_t* up = ub + (size_t)(rb_a + tl * 16 + a_n) * LW + h * 64 + 8 * hh;
#pragma unroll
                    for (int ks = 0; ks < 4; ++ks) an[ks] = *(const s5_bf16x8*)(up + 16 * ks);
                    if (PASS == 2 && d == 1) { const bf16_t* gp = qkv + (size_t)(rb_a + tl * 16 + a_n) * EVIN + COL_GR + h * 64 + 32 * cs + 8 * hh; gn0 = *(const s5_bf16x8*)gp; gn1 = *(const s5_bf16x8*)(gp + 16); } }
                s5_f32x16 ar, ai, au, agr; LRU_ZERO16(ar); LRU_ZERO16(ai); LRU_ZERO16(au); LRU_ZERO16(agr);
#pragma unroll
                for (int ks = 0; ks < 4; ++ks) { ar = __builtin_amdgcn_mfma_f32_32x32x16_bf16(a[ks], br[ks], ar, 0, 0, 0); ai = __builtin_amdgcn_mfma_f32_32x32x16_bf16(a[ks], bi[ks], ai, 0, 0, 0); }
                au = __builtin_amdgcn_mfma_f32_32x32x16_bf16(cs ? a[2] : a[0], idf[0], au, 0, 0, 0); au = __builtin_amdgcn_mfma_f32_32x32x16_bf16(cs ? a[3] : a[1], idf[1], au, 0, 0, 0);
                if (PASS == 2 && d == 1) { agr = __builtin_amdgcn_mfma_f32_32x32x16_bf16(g0, idf[0], agr, 0, 0, 0); agr = __builtin_amdgcn_mfma_f32_32x32x16_bf16(g1, idf[1], agr, 0, 0, 0); }
                MFMA_KEEP(au, a[0]); MFMA_KEEP(au, a[1]); MFMA_KEEP(au, a[2]); MFMA_KEEP(au, a[3]); MFMA_KEEP(ai, a[3]); if (PASS == 2 && d == 1) { MFMA_KEEP(agr, g0); MFMA_KEEP(agr, g1); }
#pragma unroll
                for (int nn = 0; nn < 16; ++nn) {
                    const int n = d ? 15 - nn : nn;
                    const float rg = fast_rcp(1.0f + __builtin_amdgcn_exp2f(__builtin_fmaf(ar[n], -1.44269504089f, nba))), ig = fast_rcp(1.0f + __builtin_amdgcn_exp2f(__builtin_fmaf(ai[n], -1.44269504089f, nbi))), av = __builtin_amdgcn_exp2f(rg * c2), mult = fast_sqrt(__builtin_fmaf(-av, av, 1.0f));
                    state = av * state + mult * (ig * au[n]);
                    if (PASS == 1) aprod *= av;
                    if (PASS == 2) { if (d == 0) hfl[(tile * 16 + n) * 64] = state; else { const float mv = (hfl[(tile * 16 + n) * 64] + state) * geluf_(agr[n]);
                        if (OUT0_FP8) ((unsigned char*)mix)[(size_t)(rb_s + tile * 16 + n) * D + QW + ch] = (unsigned char)(pack4_fp8(mv, 0.f, 0.f, 0.f) & 0xffu); else mix[(size_t)(rb_s + tile * 16 + n) * D + QW + ch] = f2bf(mv); } }
                }
            }
            if (PASS == 1) { ag[((size_t)oi * LW + ch) * 2] = aprod; ag[((size_t)oi * LW + ch) * 2 + 1] = state; }
        }
    }
}
#endif
#ifndef CPU_EMU
constexpr int AT_KROWS = 320, AT_LDS_K = 0, AT_LDS_V = AT_KROWS * 128, AT_LDS_BYTES = 2 * AT_KROWS * 128;
static_assert(NCTX == 256, "attention key halves assume 256 context keys");
__device__ __forceinline__ void ph_attn_fast(const Params& p, LAS unsigned char* lds, int bid, int nblocks, int wv_) {
    const int tid = tid_of(wv_), lane = tid & 63, w = wv_, r = lane & 31, hh = lane >> 5;
    const bf16_t* qkv = (const bf16_t*)(p.ws + WS_QKV); const bf16_t* vt = (const bf16_t*)(p.ws + WS_VT); bf16_t* mix = (bf16_t*)(p.ws + WS_MIX);
    constexpr int NQB = NSEQ / 128, NCB = NCTX / 128, UNITS = NB * 4 * (NQB + NCB);
    for (int un = bid; un < UNITS; un += nblocks) {
        const int kvh = un & 3, rest = un >> 2; int b, qb; if (rest < NB * NQB) { b = rest / NQB; qb = rest % NQB; } else { b = (rest - NB * NQB) / NCB; qb = NQB + (rest - NB * NQB) % NCB; }
        const bool isc = qb >= NQB;
        const int q0 = isc ? (qb - NQB) * 128 : qb * 128, qrow0 = isc ? ML + b * NCTX + q0 : b * NSEQ + q0, head = 4 * kvh + (w >> 1);
        s5_bf16x8 qf[2][4];
#pragma unroll
        for (int qt = 0; qt < 2; ++qt)
#pragma unroll
            for (int ds = 0; ds < 4; ++ds) qf[qt][ds] = *(const s5_bf16x8*)(qkv + (size_t)(qrow0 + 64 * (w & 1) + 32 * qt + r) * EVIN + COL_Q + head * 64 + 16 * ds + 8 * hh);
        s5_f32x16 oacc[2][2];
#pragma unroll
        for (int qt = 0; qt < 2; ++qt)
#pragma unroll
            for (int dt = 0; dt < 2; ++dt)
#pragma unroll
                for (int e = 0; e < 16; ++e) oacc[qt][dt][e] = 0.f;
        const float sk = p.attn_sink[head];
        float mrun[2] = {sk, sk}, lrun[2] = {hh == 0 ? 1.0f : 0.f, hh == 0 ? 1.0f : 0.f};
#pragma unroll 1
        for (int half = isc ? 1 : 0; half < 2; ++half) {
            __syncthreads();
            static_assert(AT_KROWS * 8 == 5 * 512 && 64 * 40 == 5 * 512, "staging: five 16-byte pieces per thread and operand");
            u4v_t stK[5], stV[5];
#pragma unroll
            for (int k5 = 0; k5 < 5; ++k5) {
                const int i = tid + 512 * k5, row = i >> 3, cc = i & 7; int grow;
                if (half == 1 && row >= 64) grow = ML + b * NCTX + (row - 64);
                else { int kpos = q0 - 128 + 320 * half + row; kpos = kpos < 0 ? 0 : (kpos > NSEQ - 1 ? NSEQ - 1 : kpos); grow = b * NSEQ + kpos; }
                stK[k5] = *(const u4v_t*)(qkv + (size_t)grow * EVIN + COL_K + kvh * 64 + cc * 8);
            }
#pragma unroll
            for (int k5 = 0; k5 < 5; ++k5) {
                const int i = tid + 512 * k5, d = i / 40, pc = i % 40;
                const int pos = (half == 0) ? q0 + pc * 8 : (pc < 8 ? q0 + 320 + pc * 8 : 128 + NSEQ + 128 + (pc - 8) * 8);
                stV[k5] = *(const u4v_t*)(vt + ((size_t)(b * 4 + kvh) * 64 + d) * VT_T + pos);
            }
#pragma unroll
            for (int k5 = 0; k5 < 5; ++k5) { const int i = tid + 512 * k5, row = i >> 3, cc = i & 7; *(LAS u4v_t*)(lds + AT_LDS_K + row * 128 + ((cc ^ (row & 7)) << 4)) = stK[k5]; }
#pragma unroll
            for (int k5 = 0; k5 < 5; ++k5) { const int i = tid + 512 * k5, d = i / 40, pc = i % 40, kt = pc >> 2, cc = pc & 3; *(LAS u4v_t*)(lds + AT_LDS_V + kt * 4096 + d * 64 + ((cc ^ ((d >> 2) & 3)) << 4)) = stV[k5]; }
            __syncthreads();
#pragma unroll 1
            for (int kt = (isc ? 2 : 0); kt < 10; ++kt) {
                const bool local = !(half == 1 && kt >= 2);
                const int Kb = q0 - 128 + 320 * half + 32 * kt;
                s5_bf16x8 kf[4], vf[2][2];
#pragma unroll
                for (int ds = 0; ds < 4; ++ds) kf[ds] = *(const LAS s5_bf16x8*)(lds + AT_LDS_K + (32 * kt + r) * 128 + (((2 * ds + hh) ^ (r & 7)) << 4));
#pragma unroll
                for (int dt = 0; dt < 2; ++dt)
#pragma unroll
                    for (int s2 = 0; s2 < 2; ++s2) vf[dt][s2] = *(const LAS s5_bf16x8*)(lds + AT_LDS_V + kt * 4096 + (32 * dt + r) * 64 + (((2 * s2 + hh) ^ (((32 * dt + r) >> 2) & 3)) << 4));
#pragma unroll
                for (int qt = 0; qt < 2; ++qt) {
                    const int Qb = q0 + 64 * (w & 1) + 32 * qt;
                    bool need_mask = false;
                    if (local) {
                        if (Kb - (Qb + 31) > 128 || Qb - (Kb + 31) > 128 || Kb + 31 < 0 || Kb >= NSEQ) continue;
                        need_mask = !(Kb + 31 - Qb <= 128 && Qb + 31 - Kb <= 128 && Kb >= 0 && Kb + 31 < NSEQ);
                    }
                    s5_f32x16 sc; const float z0 = opaque_zero();
#pragma unroll
                    for (int e = 0; e < 16; ++e) sc[e] = z0;
#pragma unroll
                    for (int ds = 0; ds < 4; ++ds) sc = __builtin_amdgcn_mfma_f32_32x32x16_bf16(kf[ds], qf[qt][ds], sc, 0, 0, 0);
                    MFMA_KEEP(sc, kf[0]); MFMA_KEEP(sc, kf[1]); MFMA_KEEP(sc, kf[2]); MFMA_KEEP(sc, kf[3]);
                    if (need_mask) {
                        const int qpos = Qb + r;
#pragma unroll
                        for (int e = 0; e < 16; ++e) { const int kpos = Kb + (e & 3) + 8 * (e >> 2) + 4 * hh, rel = kpos - qpos; if (rel > 128 || rel < -128 || kpos < 0 || kpos >= NSEQ) sc[e] = -1e30f; }
                    }
                    float tmax = sc[0];
#pragma unroll
                    for (int e = 1; e < 16; ++e) tmax = fmaxf(tmax, sc[e]);
                    tmax = fmaxf(tmax, __shfl_xor(tmax, 32));
                    const float mnew = fmaxf(mrun[qt], tmax), scl = __expf(mrun[qt] - mnew), mneg = -mnew * 1.44269504089f; mrun[qt] = mnew;
                    float psum = 0.f; float pv[16];
#pragma unroll
                    for (int e = 0; e < 16; ++e) { pv[e] = __builtin_amdgcn_exp2f(__builtin_fmaf(sc[e], 1.44269504089f, mneg)); psum += pv[e]; }
                    lrun[qt] = lrun[qt] * scl + psum;
                    if (__ballot(scl != 1.0f) != 0ull) {
#pragma unroll
                    for (int dt = 0; dt < 2; ++dt)
#pragma unroll
                        for (int e = 0; e < 16; ++e) oacc[qt][dt][e] *= scl; }
                    s5_bf16x8 pf[2];
#pragma unroll
                    for (int s2 = 0; s2 < 2; ++s2) { unsigned w0 = pack2bf(pv[8 * s2], pv[8 * s2 + 1]), w1 = pack2bf(pv[8 * s2 + 2], pv[8 * s2 + 3]), w2 = pack2bf(pv[8 * s2 + 4], pv[8 * s2 + 5]), w3 = pack2bf(pv[8 * s2 + 6], pv[8 * s2 + 7]);
                        u4v_t t4 = {w0, w1, w2, w3}; pf[s2] = __builtin_bit_cast(s5_bf16x8, t4); }
#pragma unroll
                    for (int dt = 0; dt < 2; ++dt)
#pragma unroll
                        for (int s2 = 0; s2 < 2; ++s2) oacc[qt][dt] = __builtin_amdgcn_mfma_f32_32x32x16_bf16(vf[dt][s2], pf[s2], oacc[qt][dt], 0, 0, 0);
                    MFMA_KEEP(oacc[qt][1], pf[0]); MFMA_KEEP(oacc[qt][1], pf[1]);
                }
            }
        }
#pragma unroll
        for (int qt = 0; qt < 2; ++qt) {
            const float ltot = lrun[qt] + __shfl_xor(lrun[qt], 32), inv = 1.0f / ltot;
            bf16_t* op = mix + (size_t)(qrow0 + 64 * (w & 1) + 32 * qt + r) * D + head * 64; unsigned char* op8 = (unsigned char*)mix + (size_t)(qrow0 + 64 * (w & 1) + 32 * qt + r) * D + head * 64; const float inv8 = inv * MIX8_SCALE;
#pragma unroll
            for (int dt = 0; dt < 2; ++dt)
#pragma unroll
                for (int g4 = 0; g4 < 4; ++g4) {
                    if (OUT0_FP8) { *(unsigned*)(op8 + 32 * dt + 8 * g4 + 4 * hh) = pack4_fp8(oacc[qt][dt][4 * g4] * inv8, oacc[qt][dt][4 * g4 + 1] * inv8, oacc[qt][dt][4 * g4 + 2] * inv8, oacc[qt][dt][4 * g4 + 3] * inv8); continue; }
                    u32x2_t wv2; wv2.x = pack2bf(oacc[qt][dt][4 * g4] * inv, oacc[qt][dt][4 * g4 + 1] * inv); wv2.y = pack2bf(oacc[qt][dt][4 * g4 + 2] * inv, oacc[qt][dt][4 * g4 + 3] * inv);
                    *(u32x2_t*)(op + 32 * dt + 8 * g4 + 4 * hh) = wv2; }
        }
    }
}
#endif
#ifndef CPU_EMU
__device__ __forceinline__ float wave_sum(float v) {
#pragma unroll
    for (int o = 32; o >= 1; o >>= 1) v += __shfl_xor(v, o);
    return v; }
template <int MODE> __device__ __forceinline__ void ph_norm_fast(const Params& p, int l, int rows, int gwave, int nwaves, int wv_) {
    const int lane = tid_of(wv_) & 63;
    bf16_t* h = (bf16_t*)(p.ws + WS_H); float* xres = (float*)(p.ws + WS_XRES); const bf16_t* yb = (const bf16_t*)(p.ws + WS_YBUF);
    const float* tok_w = (const float*)(p.ws + WS_TOK) + (size_t)MT * 2; const int* tok_dest = (const int*)(p.ws + WS_TOK) + (size_t)MT * 6;
    for (int r = gwave; r < rows; r += nwaves) {
        const int ar = ada_row(r);
        f32x4 xv[8];
        f32x4 cg[8], cs[8], ch[8];
        if (MODE == 2) {
#pragma unroll
            for (int i = 0; i < 8; ++i) cg[i] = *(const f32x4*)(p.norm_final + 4 * lane + 256 * i);
        } else { const float* sh = ada_ptr(p, l, ar, 0); const float* sc = ada_ptr(p, l, ar, 1); const float* g = p.norm_mix + (size_t)l * D;
#pragma unroll
            for (int i = 0; i < 8; ++i) { const int c = 4 * lane + 256 * i; cg[i] = *(const f32x4*)(g + c); cs[i] = *(const f32x4*)(sc + c); ch[i] = *(const f32x4*)(sh + c); } }
        if (MODE == 0) { const float* xr = xin_row(p, l, r);
#pragma unroll
            for (int i = 0; i < 8; ++i) xv[i] = *(const f32x4*)(xr + 4 * lane + 256 * i); }
        else { const int lm = (MODE == 1) ? l - 1 : 1; const float* g2 = ada_ptr(p, lm, ar, 5); float* xr = xres + (size_t)r * D;
            const int d0 = tok_dest[r * 2], d1 = tok_dest[r * 2 + 1]; const float w0 = tok_w[r * 2], w1 = tok_w[r * 2 + 1];
            f32x4 xo[8], gg[8]; unsigned ya8[8], yc8[8]; u32x2_t ya16[8], yc16[8];
#pragma unroll
            for (int i = 0; i < 8; ++i) { const int c = 4 * lane + 256 * i;
                if (RES_BF16) { const u32x2_t t = *(const u32x2_t*)((const bf16_t*)xres + (size_t)r * D + c); xo[i] = unpack4bf(t.x, t.y); } else xo[i] = *(const f32x4*)(xr + c);
                gg[i] = *(const f32x4*)(g2 + c);
                if (Y8) { ya8[i] = *(const unsigned*)((const unsigned char*)yb + (size_t)d0 * D + c); yc8[i] = *(const unsigned*)((const unsigned char*)yb + (size_t)d1 * D + c); }
                else { ya16[i] = *(const u32x2_t*)(yb + (size_t)d0 * D + c); yc16[i] = *(const u32x2_t*)(yb + (size_t)d1 * D + c); } }
#pragma unroll
            for (int i = 0; i < 8; ++i) { f32x4 m;
                if (Y8) { const unsigned ya = ya8[i], yc = yc8[i]; const float u0 = w0 * (1.0f / Y8_SCALE), u1 = w1 * (1.0f / Y8_SCALE);
                    m[0] = u0 * __builtin_amdgcn_cvt_f32_fp8(ya, 0) + u1 * __builtin_amdgcn_cvt_f32_fp8(yc, 0); m[1] = u0 * __builtin_amdgcn_cvt_f32_fp8(ya, 1) + u1 * __builtin_amdgcn_cvt_f32_fp8(yc, 1);
                    m[2] = u0 * __builtin_amdgcn_cvt_f32_fp8(ya, 2) + u1 * __builtin_amdgcn_cvt_f32_fp8(yc, 2); m[3] = u0 * __builtin_amdgcn_cvt_f32_fp8(ya, 3) + u1 * __builtin_amdgcn_cvt_f32_fp8(yc, 3); }
                else { const u32x2_t ya = ya16[i], yc = yc16[i];
                    m[0] = w0 * __uint_as_float(ya.x << 16) + w1 * __uint_as_float(yc.x << 16); m[1] = w0 * __uint_as_float(ya.x & 0xffff0000u) + w1 * __uint_as_float(yc.x & 0xffff0000u);
                    m[2] = w0 * __uint_as_float(ya.y << 16) + w1 * __uint_as_float(yc.y << 16); m[3] = w0 * __uint_as_float(ya.y & 0xffff0000u) + w1 * __uint_as_float(yc.y & 0xffff0000u); }
                xv[i] = xo[i] + gg[i] * m; } }
        float ss = 0.f;
#pragma unroll
        for (int i = 0; i < 8; ++i) ss += (xv[i][0] * xv[i][0] + xv[i][1] * xv[i][1]) + (xv[i][2] * xv[i][2] + xv[i][3] * xv[i][3]);
        ss = wave_sum(ss);
        const float rstd = 1.0f / sqrtf(ss * (1.0f / D) + 1e-6f);
#ifndef CPU_EMU
        asm volatile("" ::: "memory");
#endif
        if (MODE == 2) {
#pragma unroll
            for (int i = 0; i < 8; ++i) { const int c = 4 * lane + 256 * i; *(f32x4*)(p.out + (size_t)r * D + c) = xv[i] * rstd * cg[i]; }
        } else {
#pragma unroll
            for (int i = 0; i < 8; ++i) { const int c = 4 * lane + 256 * i;
                if (MODE == 1) { if (RES_BF16) { u32x2_t t; t.x = pack2bf(xv[i][0], xv[i][1]); t.y = pack2bf(xv[i][2], xv[i][3]); *(u32x2_t*)((bf16_t*)xres + (size_t)r * D + c) = t; } else *(f32x4*)(xres + (size_t)r * D + c) = xv[i]; }
                const f32x4 hv = xv[i] * rstd * cg[i] * (cs[i] + 1.0f) + ch[i];
                if ((MODE == 1 && DENSE1_FP8) || (MODE == 0 && IN0_FP8)) *(unsigned*)((unsigned char*)h + (size_t)r * D + c) = pack4_fp8(hv[0], hv[1], hv[2], hv[3]);
                else { if (MODE == 0 && IN0QKV_FP8) *(unsigned*)(p.ws + WS_H8 + (size_t)r * D + c) = pack4_fp8(hv[0], hv[1], hv[2], hv[3]);
                    u32x2_t w; w.x = pack2bf(hv[0], hv[1]); w.y = pack2bf(hv[2], hv[3]); *(u32x2_t*)(h + (size_t)r * D + c) = w; } } }
    }
}
template <bool H8> __device__ __forceinline__ void ph_router_fast(const Params& p, int l, int rows, LAS unsigned char* lds, int bid, int nblocks, int wv_) {
    const int lane = tid_of(wv_) & 63, rr = lane & 15, q = lane >> 4, w = wv_;
    bf16_t* h = (bf16_t*)(p.ws + WS_H); const float* xres = (const float*)(p.ws + WS_XRES); const s5_bf16x8* RWF = (const s5_bf16x8*)(p.ws + WS_RWF);
    int* tok_e = (int*)(p.ws + WS_TOK); float* tok_w = (float*)(p.ws + WS_TOK) + (size_t)MT * 2; int* tok_slot = (int*)(p.ws + WS_TOK) + (size_t)MT * 4;
    int* hist = (int*)(p.ws + WS_HIST) + (size_t)l * MAXG * HIST_LD;
    int run = 0;
    LAS float* ssq = (LAS float*)lds;
    LAS f32x4* red = (LAS f32x4*)(lds + 1024);
    LAS float* cfA = (LAS float*)(lds + 16384); LAS float* cfB = cfA + D;
    const int tid = w * 64 + lane, ntl = rows / 16, TPW = (ntl + nblocks - 1) / nblocks, t_lo = bid * TPW, t_hi = (t_lo + TPW < ntl) ? t_lo + TPW : ntl;
    s5_bf16x8 rwh[8], rwl[8];
#pragma unroll
    for (int st = 0; st < 8; ++st) { rwh[st] = RWF[(8 * w + st) * 64 + lane]; rwl[st] = RWF[(64 + 8 * w + st) * 64 + lane]; }
    const f32x4 rbias = *(const f32x4*)(p.router_b + 4 * q);
    int ar_cur = -1;
    u4v_t nx[8];
    if (RES_BF16 && t_lo < t_hi) { const bf16_t* xr = (const bf16_t*)xres + (size_t)(t_lo * 16 + rr) * D + 256 * w + 8 * q;
#pragma unroll
        for (int st = 0; st < 8; ++st) nx[st] = *(const u4v_t*)(xr + 32 * st); }
    for (int t16 = t_lo; t16 < t_hi; ++t16) {
        const int r = t16 * 16 + rr, ar = ada_row(t16 * 16);
        if (ar != ar_cur) { ar_cur = ar;
            const f32x4 gv = *(const f32x4*)(p.norm_ffn + (size_t)l * D + 4 * tid), sv = *(const f32x4*)(ada_ptr(p, l, ar, 4) + 4 * tid), hv = *(const f32x4*)(ada_ptr(p, l, ar, 3) + 4 * tid);
            *(LAS f32x4*)(cfA + 4 * tid) = gv * (sv + 1.0f); *(LAS f32x4*)(cfB + 4 * tid) = hv; }
        f32x4 xa[8], xb[8];
        if (RES_BF16) {
#pragma unroll
            for (int st = 0; st < 8; ++st) { xa[st] = unpack4bf(nx[st][0], nx[st][1]); xb[st] = unpack4bf(nx[st][2], nx[st][3]); }
            if (t16 + 1 < t_hi) { const bf16_t* xr = (const bf16_t*)xres + (size_t)((t16 + 1) * 16 + rr) * D + 256 * w + 8 * q;
#pragma unroll
                for (int st = 0; st < 8; ++st) nx[st] = *(const u4v_t*)(xr + 32 * st); } }
        else { const float* xr = xres + (size_t)r * D + 256 * w + 8 * q;
#pragma unroll
            for (int st = 0; st < 8; ++st) { xa[st] = *(const f32x4*)(xr + 32 * st); xb[st] = *(const f32x4*)(xr + 32 * st + 4); } }
        float ss = 0.f;
#pragma unroll
        for (int st = 0; st < 8; ++st) ss += (xa[st][0] * xa[st][0] + xa[st][1] * xa[st][1]) + (xa[st][2] * xa[st][2] + xa[st][3] * xa[st][3]) + (xb[st][0] * xb[st][0] + xb[st][1] * xb[st][1]) + (xb[st][2] * xb[st][2] + xb[st][3] * xb[st][3]);
        ss += __shfl_xor(ss, 16); ss += __shfl_xor(ss, 32);
        if (q == 0) ssq[w * 16 + rr] = ss;
        __syncthreads();
        float tot = 0.f;
#pragma unroll
        for (int ww = 0; ww < 8; ++ww) tot += ssq[ww * 16 + rr];
        const float rstd = 1.0f / sqrtf(tot * (1.0f / D) + 1e-6f);
        const LAS float* cA = cfA + 256 * w + 8 * q; const LAS float* cB = cfB + 256 * w + 8 * q;
        f32x4 lhi, llo; { const float z0 = opaque_zero(); lhi = (f32x4){z0, z0, z0, z0}; llo = lhi; }
#pragma unroll
        for (int st = 0; st < 8; ++st) {
            const f32x4 ga = *(const LAS f32x4*)(cA + 32 * st), gb = *(const LAS f32x4*)(cA + 32 * st + 4), ha = *(const LAS f32x4*)(cB + 32 * st), hb = *(const LAS f32x4*)(cB + 32 * st + 4);
            const f32x4 va = xa[st] * rstd * ga + ha, vb = xb[st] * rstd * gb + hb;
            u4v_t wv4 = {pack2bf(va[0], va[1]), pack2bf(va[2], va[3]), pack2bf(vb[0], vb[1]), pack2bf(vb[2], vb[3])};
            if (H8) { u32x2_t w8; w8.x = pack4_fp8(va[0], va[1], va[2], va[3]); w8.y = pack4_fp8(vb[0], vb[1], vb[2], vb[3]); *(u32x2_t*)((unsigned char*)h + (size_t)r * D + 256 * w + 32 * st + 8 * q) = w8; }
            else *(u4v_t*)(h + (size_t)r * D + 256 * w + 32 * st + 8 * q) = wv4;
            const s5_bf16x8 hf = __builtin_bit_cast(s5_bf16x8, wv4);
            lhi = __builtin_amdgcn_mfma_f32_16x16x32_bf16(rwh[st], hf, lhi, 0, 0, 0); MFMA_KEEP(lhi, rwh[st]);
            llo = __builtin_amdgcn_mfma_f32_16x16x32_bf16(rwl[st], hf, llo, 0, 0, 0); MFMA_KEEP(llo, rwl[st]); MFMA_KEEP(llo, hf);
        }
        red[w * 64 + lane] = lhi + llo;
        __syncthreads();
        if (w == 0) {
            f32x4 lsum = red[lane];
#pragma unroll
            for (int ww = 1; ww < 8; ++ww) lsum += red[ww * 64 + lane];
            float lg[4];
#pragma unroll
            for (int i = 0; i < 4; ++i) lg[i] = lsum[i] + rbias[i];
            float mx = fmaxf(fmaxf(lg[0], lg[1]), fmaxf(lg[2], lg[3])); mx = fmaxf(mx, __shfl_xor(mx, 16)); mx = fmaxf(mx, __shfl_xor(mx, 32));
            float pr[4], sum = 0.f;
#pragma unroll
            for (int i = 0; i < 4; ++i) { pr[i] = __expf(lg[i] - mx); sum += pr[i]; }
            sum += __shfl_xor(sum, 16); sum += __shfl_xor(sum, 32);
            float a1 = -1.f, a2 = -1.f; int j1 = 0, j2 = 0;
#pragma unroll
            for (int i = 0; i < 4; ++i) { const float v = pr[i] / sum; if (v > a1) { a2 = a1; j2 = j1; a1 = v; j1 = i; } else if (v > a2) { a2 = v; j2 = i; } }
            float best = a1 + a2; int bq = q; float w1 = a1, w2 = a2; int e1 = 4 * q + j1, e2 = 4 * q + j2;
#pragma unroll
            for (int o = 16; o <= 32; o <<= 1) {
                const float ob = __shfl_xor(best, o), ow1 = __shfl_xor(w1, o), ow2 = __shfl_xor(w2, o); const int oq = __shfl_xor(bq, o), oe1 = __shfl_xor(e1, o), oe2 = __shfl_xor(e2, o);
                if (ob > best || (ob == best && oq < bq)) { best = ob; bq = oq; w1 = ow1; w2 = ow2; e1 = oe1; e2 = oe2; } }
            int rk1 = 0, rk2 = 0, mine = 0; const unsigned long long below = (1ull << rr) - 1ull;
#pragma unroll
            for (int e = 0; e < NE; ++e) { const unsigned long long m = __ballot(q == 0 && (e1 == e || e2 == e)); const int pc = __popcll(m & below); if (e1 == e) rk1 = pc; if (e2 == e) rk2 = pc; if (rr == e) mine = __popcll(m); }
            const int b1 = __shfl(run, e1), b2 = __shfl(run, e2);
            if (q == 0) { const float ws = w1 + w2; tok_e[r * 2] = e1; tok_e[r * 2 + 1] = e2; tok_w[r * 2] = w1 / ws; tok_w[r * 2 + 1] = w2 / ws;
                tok_slot[r * 2] = b1 + rk1; tok_slot[r * 2 + 1] = b2 + rk2; }
            run += mine;
        }
    }
    if (w == 0 && lane < HIST_LD) hist[bid * HIST_LD + lane] = lane < NE ? run : 0;
}
__device__ __forceinline__ void ph_dispatch_fast(const Params& p, int l, int rows, LAS unsigned char* lds, int bid, int nblocks, int wv_) {
    const int tid = tid_of(wv_); const int* hist = (const int*)(p.ws + WS_HIST) + (size_t)l * MAXG * HIST_LD;
    const int* tok_e = (const int*)(p.ws + WS_TOK); const int* tok_slot = (const int*)(p.ws + WS_TOK) + (size_t)MT * 4; int* tok_dest = (int*)(p.ws + WS_TOK) + (size_t)MT * 6;
    int* rowidx = (int*)(p.ws + WS_ROWIDX); int* cnt = (int*)(p.ws + WS_CNT) + l * 64;
    LAS int* pre = (LAS int*)lds; LAS int* seg = pre + MAXG * NE; LAS int* tot = seg + 32 * NE; LAS int* pst = tot + NE;
    { const int e = tid & 15, sg = tid >> 4; int v[8], sum = 0;
#pragma unroll
        for (int i = 0; i < 8; ++i) { const int wg = 8 * sg + i; v[i] = wg < nblocks ? hist[wg * HIST_LD + e] : 0; sum += v[i]; }
        seg[sg * NE + e] = sum;
        __syncthreads();
        int base = 0; for (int s2 = 0; s2 < sg; ++s2) base += seg[s2 * NE + e];
#pragma unroll
        for (int i = 0; i < 8; ++i) { pre[(8 * sg + i) * NE + e] = base; base += v[i]; }
        if (sg == 31) tot[e] = base;
        __syncthreads();
        if (tid <= NE) { int acc = 0; for (int j = 0; j < tid; ++j) acc += (tot[j] + 255) / 256 * 256; pst[tid] = acc; }
        if (bid == 0 && tid < NE) cnt[tid] = tot[tid];
        __syncthreads(); }
    const long gtid = (long)bid * 512 + tid, gthreads = (long)nblocks * 512; const int tpw = (rows / 16 + nblocks - 1) / nblocks;
    for (long it = gtid; it < (long)rows * 2; it += gthreads) { const int e = tok_e[it], wg = (int)((it >> 5) / tpw), dest = pst[e] + pre[wg * NE + e] + tok_slot[it]; tok_dest[it] = dest; st_coh(rowidx + dest, (int)(it / 2)); }
    const int total = pst[NE];
    for (long it = gtid; it < total; it += gthreads) { int st = 0, ce = 0;
#pragma unroll
        for (int j = 0; j < NE; ++j) { if (it >= pst[j] && it < pst[j + 1]) { st = pst[j]; ce = tot[j]; } }
        if (it - st >= ce) st_coh(rowidx + it, 0); }
}
#endif
__device__ __forceinline__ void ph_final(const Params& p, long gtid, long gthreads) {
    const float* xres = (const float*)(p.ws + WS_XRES);
    for (long r = gtid; r < ML; r += gthreads) {
        const float* xr = xres + (size_t)r * D; float ss = 0.f; for (int k = 0; k < D; ++k) ss += xr[k] * xr[k];
        const float rstd = 1.0f / sqrtf(ss / D + 1e-6f);
        for (int k = 0; k < D; ++k) p.out[(size_t)r * D + k] = xr[k] * rstd * p.norm_final[k];
    }
}

struct CvtJob { const float* src; bf16_t* dst; int K, N, mode, fp8, ld; };
constexpr int NJOBS = 6 + 2 * NE * 3;
constexpr int IN0_NQ = QW + 2 * KVW;
__device__ __forceinline__ CvtJob cvt_job(const Params& p, int j) {
    CvtJob J; unsigned char* ws = p.ws; J.fp8 = 0;
    if (j == 0) { J.src = p.ev_w_in; J.dst = (bf16_t*)(ws + WS_WT_IN0); J.K = D; J.N = IN0_NQ; J.mode = 0; }
    else if (j == 5) { J.src = p.ev_w_in + IN0_NQ; J.dst = (bf16_t*)(ws + WS_WT_IN0) + (size_t)IN0_NQ * D; J.K = D; J.N = EVIN - IN0_NQ; J.mode = 0; }
    else if (j == 1) { J.src = p.ev_w_out; J.dst = (bf16_t*)(ws + WS_WT_OUT0); J.K = D; J.N = D; J.mode = 0; }
    else if (j == 2) { J.src = p.od_w_in; J.dst = (bf16_t*)(ws + WS_WT_IN1); J.K = D; J.N = S5W; J.mode = 0; }
    else if (j == 3) { J.src = p.s5_glu_w; J.dst = (bf16_t*)(ws + WS_WT_GLU); J.K = S5W; J.N = S5W; J.mode = 0; }
    else if (j == 4) { J.src = p.od_w_out; J.dst = (bf16_t*)(ws + WS_WT_OUT1); J.K = S5W; J.N = D; J.mode = 0; }
    else { const int q = j - 6, le = q / 3, kind = q % 3;
        if (kind == 0) { J.src = p.moe_w_gate + (size_t)le * D * FF; J.dst = (bf16_t*)(ws + WS_WT_GU) + (size_t)le * 2 * FF * D; J.K = D; J.N = FF; J.mode = 1; }
        else if (kind == 1) { J.src = p.moe_w_up + (size_t)le * D * FF; J.dst = (bf16_t*)(ws + WS_WT_GU) + (size_t)le * 2 * FF * D; J.K = D; J.N = FF; J.mode = 2; }
        else { J.src = p.moe_w_down + (size_t)le * FF * D; J.dst = (bf16_t*)(ws + WS_WT_DN) + (size_t)le * D * FF; J.K = FF; J.N = D; J.mode = 0; }
        if (le >= NE ? MOE1_FP8 : MOE0_FP8) { const int l8 = le / NE, e = le % NE; J.fp8 = 1;
            J.dst = kind == 2 ? (bf16_t*)(ws + WS_WT_DN + (size_t)l8 * NE * D * FF * 2 + (size_t)e * D * FF) : (bf16_t*)(ws + WS_WT_GU + (size_t)l8 * NE * 2 * FF * D * 2 + (size_t)e * 2 * FF * D); } }
    if (((IN0_FP8 || IN0QKV_FP8) && j == 0) || (IN0_FP8 && j == 5) || (OUT0_FP8 && j == 1)) J.fp8 = 1;
    J.ld = (j == 0 || j == 5) ? EVIN : J.N;
    if (DENSE1_FP8 && j >= 2 && j <= 4) J.fp8 = 1;
    return J;
}
__device__ __forceinline__ int cvt_rowmap(int mode, int n) { return mode == 0 ? n : (n / 128) * 256 + (mode == 2 ? 128 : 0) + n % 128; }
constexpr long cvt_tiles_of(int K, int N) { return (long)(K / 64) * (N / 256); }
constexpr long CVT_TILES = cvt_tiles_of(D, IN0_NQ) + cvt_tiles_of(D, EVIN - IN0_NQ) + cvt_tiles_of(D, D) + cvt_tiles_of(D, S5W) + cvt_tiles_of(S5W, S5W) + cvt_tiles_of(S5W, D) + (long)2 * NE * 3 * cvt_tiles_of(D, FF);
__device__ __forceinline__ void cvt_find(long tile, int& j, long& local) {
    const long t0 = cvt_tiles_of(D, IN0_NQ), t1 = t0 + cvt_tiles_of(D, D), t2 = t1 + cvt_tiles_of(D, S5W), t3 = t2 + cvt_tiles_of(S5W, S5W), t4 = t3 + cvt_tiles_of(S5W, D), t5 = t4 + cvt_tiles_of(D, EVIN - IN0_NQ);
    if (tile < t0) { j = 0; local = tile; } else if (tile < t1) { j = 1; local = tile - t0; } else if (tile < t2) { j = 2; local = tile - t1; } else if (tile < t3) { j = 3; local = tile - t2; }
    else if (tile < t4) { j = 4; local = tile - t3; } else if (tile < t5) { j = 5; local = tile - t4; } else { const long q = tile - t5, per = cvt_tiles_of(D, FF); j = 6 + (int)(q / per); local = q % per; }
}
#ifndef CPU_EMU
constexpr int CVT_PITCH = 257, CVT_LDS_BYTES = 128 * 129 * 4;
struct CvtSrc { const float* src; int N, fp8; };
__device__ __forceinline__ CvtSrc cvt_src(const Params& p, long t) { int j; long loc; cvt_find(t, j, loc); const CvtJob L = cvt_job(p, j); CvtSrc S; S.N = L.ld; S.fp8 = L.fp8;
    if (L.fp8) { const int tn8 = L.N / 128, k0 = (int)(loc / tn8) * 128, n0 = (int)(loc % tn8) * 128; S.src = L.src + (size_t)k0 * L.ld + n0; }
    else { const int tn = L.N / 256, k0 = (int)(loc / tn) * 64, n0 = (int)(loc % tn) * 256; S.src = L.src + (size_t)k0 * L.ld + n0; }
    return S; }
__device__ __forceinline__ f32x4 cvt_load(const CvtSrc& S, int tid, int i) { const int q = tid + 512 * i, kk = S.fp8 ? q >> 5 : q >> 6, n4 = S.fp8 ? (q & 31) * 4 : (q & 63) * 4; return *(const f32x4*)(S.src + (size_t)kk * S.N + n4); }
__device__ __forceinline__ void ph_convert(const Params& p, float* tile, long t_end, int max_tiles, int wv_) {
    const int tid = tid_of(wv_); int* ctr = (int*)(p.ws + WS_CNT) + 128; LAS int* tsh = (LAS int*)((LAS unsigned char*)tile + CVT_LDS_BYTES);
    (void)max_tiles;
    int pend = 0, par = 0;
    __syncthreads();
    if (tid == 0) { const int a0 = atomicAdd(ctr, 1), a1 = atomicAdd(ctr, 1); pend = atomicAdd(ctr, 1); tsh[0] = a0; tsh[1] = a1; }
    __syncthreads();
    long t = tsh[0], tn = tsh[1];
    f32x4 R[8];
    if (t < t_end) { const CvtSrc S = cvt_src(p, t);
#pragma unroll
        for (int i = 0; i < 8; ++i) R[i] = cvt_load(S, tid, i); }
    while (t < t_end) {
        int j; long local; cvt_find(t, j, local); const CvtJob J = cvt_job(p, j);
        const bool more = tn < t_end; const CvtSrc SN = cvt_src(p, more ? tn : t);
#pragma unroll
        for (int i = 0; i < 8; ++i) {
            if (J.fp8) { const int q = tid + 512 * i, kk = q >> 5, n4 = (q & 31) * 4; *(f32x4*)(tile + kk * 128 + (n4 ^ (((kk >> 4) & 3) << 4))) = R[i]; }
            else { const int q = tid + 512 * i, kk = q >> 6, n4 = (q & 63) * 4; tile[kk * CVT_PITCH + n4] = R[i][0]; tile[kk * CVT_PITCH + n4 + 1] = R[i][1]; tile[kk * CVT_PITCH + n4 + 2] = R[i][2]; tile[kk * CVT_PITCH + n4 + 3] = R[i][3]; }
        }
        if (tid == 0) { tsh[2 + par] = pend; pend = atomicAdd(ctr, 1); }
        __syncthreads();
        const long tnn = tsh[2 + par]; par ^= 1;
        if (more) {
#pragma unroll
            for (int i = 0; i < 8; ++i) R[i] = cvt_load(SN, tid, i); }
        if (J.fp8) {
            const int tn8 = J.N / 128, k0 = (int)(local / tn8) * 128, n0 = (int)(local % tn8) * 128;
            const float wsc = (OUT0_FP8 && j == 1 && k0 < QW) ? W8_SCALE / MIX8_SCALE : W8_SCALE;
#pragma unroll
            for (int i = 0; i < 2; ++i) { const int lane = tid & 63, nn = 64 * i + 8 * (tid >> 6) + (lane & 7), kg = lane >> 3, kgl = kg & 3; const float* tp = tile + (16 * kg) * 128 + (nn ^ (kgl << 4)); u4v_t w;
#pragma unroll
                for (int d4 = 0; d4 < 4; ++d4) { int pk = 0; pk = __builtin_amdgcn_cvt_pk_fp8_f32(tp[(4 * d4) * 128] * wsc, tp[(4 * d4 + 1) * 128] * wsc, pk, false);
                    pk = __builtin_amdgcn_cvt_pk_fp8_f32(tp[(4 * d4 + 2) * 128] * wsc, tp[(4 * d4 + 3) * 128] * wsc, pk, true); w[d4] = (unsigned)pk; }
                *(u4v_t*)((unsigned char*)J.dst + (size_t)cvt_rowmap(J.mode, n0 + nn) * J.K + k0 + 16 * kg) = w; }
        } else {
            const int tnn_ = J.N / 256, k0 = (int)(local / tnn_) * 64, n0 = (int)(local % tnn_) * 256;
#pragma unroll
            for (int i = 0; i < 4; ++i) { const int q = tid + 512 * i, nn = q >> 3, k8 = (q & 7) * 8; const float* tp = tile + k8 * CVT_PITCH + nn;
                u4v_t w = {pack2bf(tp[0], tp[CVT_PITCH]), pack2bf(tp[2 * CVT_PITCH], tp[3 * CVT_PITCH]), pack2bf(tp[4 * CVT_PITCH], tp[5 * CVT_PITCH]), pack2bf(tp[6 * CVT_PITCH], tp[7 * CVT_PITCH])};
                *(u4v_t*)(J.dst + (size_t)cvt_rowmap(J.mode, n0 + nn) * J.K + k0 + k8) = w; }
        }
        __syncthreads();
        t = tn; tn = tnn;
    }
}
#else
void ph_convert_emu(const Params& p) {
    for (int j = 0; j < NJOBS; ++j) { const CvtJob J = cvt_job(p, j);
        for (int n = 0; n < J.N; ++n) { bf16_t* dr = J.dst + (size_t)cvt_rowmap(J.mode, n) * J.K; for (int k = 0; k < J.K; ++k) dr[k] = f2bf(J.src[(size_t)k * J.ld + n]); } }
}
#endif

namespace pg8 {
constexpr int BM = 256, BK = 64, HALF = 128, HTB = HALF * BK * 2  , STAGE_BYTES = 8 * HTB, NXCD = 8, WGM = 8;
struct Unit { int pm, pn, e; };
struct Gemm { const bf16_t* A; const bf16_t* Bt; int M, N, K; int sc_w = 0, sc_a = 0; };
__host__ __device__ __forceinline__ int lds_byte(int r, int c) { const int st = (r >> 4) * 2 + (c >> 5), rr = r & 15, cc = c & 31, ob = rr * 64 + cc * 2; return st * 1024 + (ob ^ (((ob >> 9) & 1) << 5)); }
__host__ __device__ __forceinline__ void stage_rc(int b, int& R, int& C) { const int st = b / 1024, sb = b % 1024, swz = sb ^ (((sb >> 9) & 1) << 5); R = (st >> 1) * 16 + swz / 64; C = (st & 1) * 32 + (swz % 64) / 2; }
__host__ __device__ __forceinline__ int perm32(int rho) { const int n = rho >> 4, i = rho & 15; return 8 * (i >> 2) + 4 * n + (i & 3); }

struct StaticOrder {
    static constexpr bool GATHER = false;
    int nM, nN, nwg, G, c;
    __host__ __device__ void init(int M, int N, int G_, int c_) { nM = M / BM; nN = N / BM; nwg = nM * nN; G = G_; c = c_; }
    __host__ __device__ bool next(int i, Unit& u) const {
        const long L = (long)i * G + c; if (L >= nwg) return false;
        int wgid = (int)L; { const int q = nwg / NXCD, r = nwg % NXCD, xcd = wgid % NXCD, off = wgid / NXCD; wgid = (xcd < r ? xcd * (q + 1) : r * (q + 1) + (xcd - r) * q) + off; }
        const int nig = WGM * nN, gid = wgid / nig, fm = gid * WGM, gsz = (nM - fm) < WGM ? (nM - fm) : WGM;
        u.pm = fm + ((wgid % nig) % gsz); u.pn = (wgid % nig) / gsz; u.e = 0; return true;
    }
    __device__ __forceinline__ const char* b_base(const Gemm& g, const Unit& u) const { return (const char*)g.Bt + (size_t)u.pn * ((size_t)BM * g.K * 2); }
    __device__ __forceinline__ int a_row(const Unit& u, int rr) const { return u.pm * BM + rr; }
};
template <bool ROWS> struct MoeOrder {
    static constexpr bool GATHER = ROWS;
    int nN, nwg, G, c; const int* cnt; const int* rowidx; size_t estride;
    __device__ void init(const int* cnt_, int N, int G_, int c_, const int* rowidx_, size_t estride_) { int acc = 0; cnt = cnt_;
#pragma unroll
        for (int e = 0; e < NE; ++e) acc += (cnt[e] + 255) / 256 * 256;
        nN = N / BM; nwg = (acc / 256) * nN; G = G_; c = c_; rowidx = rowidx_; estride = estride_; }
    __device__ bool next(int i, Unit& u) const { const long L = (long)i * G + c; if (L >= nwg) return false; u.pm = (int)(L / nN); u.pn = (int)(L % nN); int e = 0, acc = 0;
#pragma unroll
        for (int j = 0; j < NE - 1; ++j) { acc += (cnt[j] + 255) / 256 * 256; e += (u.pm * 256 >= acc) ? 1 : 0; }
        u.e = e; return true; }
    __device__ __forceinline__ const char* b_base(const Gemm& g, const Unit& u) const { return (const char*)g.Bt + (size_t)u.e * estride + (size_t)u.pn * ((size_t)BM * g.K * 2); }
    __device__ __forceinline__ int a_row(const Unit& u, int rr) const { return ROWS ? ld_coh(rowidx + u.pm * BM + rr) : u.pm * BM + rr; }
};

#ifdef CPU_EMU
typedef unsigned char* LdsPtr;
#else
#define PG8_LAS __attribute__((address_space(3)))
typedef PG8_LAS unsigned char* LdsPtr;
typedef short bf16x8 __attribute__((ext_vector_type(8)));
typedef unsigned u32x4 __attribute__((ext_vector_type(4)));
typedef int pg8_v4i __attribute__((ext_vector_type(4)));
typedef int pg8_v8i __attribute__((ext_vector_type(8)));
template <class Epi, class Sched, bool F8 = false>
__device__ __forceinline__ void gemm_phase(LdsPtr lds, const Gemm g, const Sched& S, const Epi& E, int wv_) {
    const int tid = tid_of(wv_), wid = wv_, lane = tid & 63, wr = wid >> 2, wc = wid & 3, fr = lane & 15, fq = lane >> 4;
    const int K = g.K, nt = K / BK;
    unsigned voffB[2]; int RA[2], CA[2];
#pragma unroll
    for (int i = 0; i < 2; ++i) { int R, C; stage_rc(tid * 16 + i * 8192, R, C); const int Rb = Epi::PERM ? ((R & ~31) + perm32(R & 31)) : R;
        RA[i] = R; CA[i] = C; voffB[i] = (unsigned)(Rb * K + C) * 2u; }
    const size_t kstep = (size_t)(BK * 2);
    const size_t hstep = (size_t)HALF * K * 2;
    const unsigned ldsw = (unsigned)wid * 1024u;
    const int aoff = F8 ? lds_byte(wr * 64 + fr, fq * 16) + ((fq & 1) << 4) : lds_byte(wr * 64 + fr, fq * 8), boff = F8 ? lds_byte(wc * 32 + fr, fq * 16) + ((fq & 1) << 4) : lds_byte(wc * 32 + fr, fq * 8);
    const int sc_both = (g.sc_w & 0xff) | ((g.sc_a & 0xff) << 8);
    const int koff = F8 ? (16 - ((fq & 1) << 5)) : 1024;
#define PG8_SA(b, h) (((b) * 2 + (h)) * HTB)
#define PG8_SB(b, h) ((4 + (b) * 2 + (h)) * HTB)
#define PG8_STAGE(bufoff, gbase, voff) do { _Pragma("unroll") for (int _i = 0; _i < 2; ++_i) \
        __builtin_amdgcn_global_load_lds((const unsigned*)((const char*)(gbase) + (voff)[_i]), (PG8_LAS unsigned*)(lds + (bufoff) + ldsw + _i * 8192), 16, 0, 0); } while (0)
#define PG8_LD8(dst, addr) do { const pg8_v4i lo_ = *(const PG8_LAS pg8_v4i*)(addr), hi_ = *(const PG8_LAS pg8_v4i*)((addr) + koff); dst = __builtin_shufflevector(lo_, hi_, 0, 1, 2, 3, 4, 5, 6, 7); } while (0)
#define PG8_LDA(dst, b, h) do { if constexpr (F8) { _Pragma("unroll") for (int m = 0; m < 4; ++m) PG8_LD8(dst##8[m], lds + PG8_SA(b, h) + aoff + m * 2048); } \
        else { _Pragma("unroll") for (int m = 0; m < 4; ++m) _Pragma("unroll") for (int k = 0; k < 2; ++k) dst[m][k] = *(const PG8_LAS bf16x8*)(lds + PG8_SA(b, h) + aoff + m * 2048 + k * koff); } } while (0)
#define PG8_LDB(dst, b, h) do { if constexpr (F8) { _Pragma("unroll") for (int n = 0; n < 2; ++n) PG8_LD8(dst##8[n], lds + PG8_SB(b, h) + boff + n * 2048); } \
        else { _Pragma("unroll") for (int n = 0; n < 2; ++n) _Pragma("unroll") for (int k = 0; k < 2; ++k) dst[n][k] = *(const PG8_LAS bf16x8*)(lds + PG8_SB(b, h) + boff + n * 2048 + k * koff); } } while (0)
#define PG8_MMA(ai, bj, At, Bt) do { __builtin_amdgcn_s_setprio(1); \
        if constexpr (F8) { _Pragma("unroll") for (int m = 0; m < 4; ++m) _Pragma("unroll") for (int n = 0; n < 2; ++n) \
            acc[ai][bj][m][n] = __builtin_amdgcn_mfma_scale_f32_16x16x128_f8f6f4(Bt##8[n], At##8[m], acc[ai][bj][m][n], 0, 0, 0, sc_both, 1, sc_both); } \
        else { _Pragma("unroll") for (int m = 0; m < 4; ++m) _Pragma("unroll") for (int n = 0; n < 2; ++n) _Pragma("unroll") for (int k = 0; k < 2; ++k) \
            acc[ai][bj][m][n] = __builtin_amdgcn_mfma_f32_16x16x32_bf16(Bt[n][k], At[m][k], acc[ai][bj][m][n], 0, 0, 0); } \
        __builtin_amdgcn_s_setprio(0); } while (0)
#define PG8_WAIT_V(n) asm volatile("s_waitcnt vmcnt(" #n ")" ::: "memory")
#define PG8_WAIT_L(n) asm volatile("s_waitcnt lgkmcnt(" #n ")" ::: "memory")
#define PG8_BAR __builtin_amdgcn_s_barrier()
#define PG8_SCHED __builtin_amdgcn_sched_barrier(0)
#define PG8_VOFFA(dst, U) do { _Pragma("unroll") for (int _h = 0; _h < 2; ++_h) _Pragma("unroll") for (int _i = 0; _i < 2; ++_i) \
        dst[_h][_i] = (unsigned)((size_t)S.a_row(U, _h * HALF + RA[_i]) * K + CA[_i]) * 2u; } while (0)
    Unit cur, nxt; int ui = 0;
    if (!S.next(0, cur)) return;
    f32x4 acc[2][2][4][2];
#pragma unroll
    for (int a = 0; a < 2; ++a)
#pragma unroll
        for (int b = 0; b < 2; ++b)
#pragma unroll
            for (int m = 0; m < 4; ++m)
#pragma unroll
                for (int n = 0; n < 2; ++n) acc[a][b][m][n] = (f32x4){0.f, 0.f, 0.f, 0.f};
    bf16x8 At[4][2], B0[2][2], B1[2][2];
    pg8_v8i At8[4], B08[2], B18[2];
    unsigned vA[2][2];
    PG8_VOFFA(vA, cur);
    const char* cA = (const char*)g.A; const char* cB = S.b_base(g, cur);
    PG8_STAGE(PG8_SB(0, 0), cB, voffB); PG8_STAGE(PG8_SB(0, 1), cB + hstep, voffB); PG8_STAGE(PG8_SA(0, 0), cA, vA[0]); PG8_STAGE(PG8_SA(0, 1), cA, vA[1]);
    if (wr == 1) PG8_BAR;
    PG8_WAIT_V(2); PG8_BAR;
    PG8_STAGE(PG8_SB(1, 0), cB + kstep, voffB); PG8_STAGE(PG8_SA(1, 0), cA + kstep, vA[0]); PG8_STAGE(PG8_SB(1, 1), cB + hstep + kstep, voffB);
    PG8_WAIT_V(6); PG8_BAR;
    for (;;) {
        const bool has_next = S.next(ui + 1, nxt);
        const char* nB = has_next ? S.b_base(g, nxt) : cB;
        for (int t = 0; t < nt; t += 2) {
            const bool last = (t == nt - 2);
            const char* a1 = cA + (size_t)(t + 1) * kstep;
            const char* a2 = last ? cA : cA + (size_t)(t + 2) * kstep; const char* b2 = last ? nB : cB + (size_t)(t + 2) * kstep;
            const char* a3 = a2 + kstep; const char* b3 = b2 + kstep;
            PG8_LDB(B0, 0, 0); PG8_LDB(B1, 0, 1); PG8_SCHED; PG8_LDA(At, 0, 0); PG8_STAGE(PG8_SA(1, 1), a1, vA[1]);
            if (last && has_next) { PG8_VOFFA(vA, nxt); }
            PG8_WAIT_V(8); PG8_WAIT_L(0); PG8_BAR; PG8_MMA(0, 0, At, B0); PG8_MMA(0, 1, At, B1); PG8_BAR; PG8_SCHED;
            PG8_LDA(At, 0, 1); PG8_STAGE(PG8_SB(0, 0), b2, voffB); PG8_STAGE(PG8_SB(0, 1), b2 + hstep, voffB); PG8_STAGE(PG8_SA(0, 0), a2, vA[0]);
            PG8_WAIT_V(8); PG8_WAIT_L(0); PG8_BAR; PG8_MMA(1, 0, At, B0); PG8_MMA(1, 1, At, B1); PG8_BAR; PG8_SCHED;
            PG8_LDB(B0, 1, 0); PG8_LDB(B1, 1, 1); PG8_SCHED; PG8_LDA(At, 1, 0); PG8_STAGE(PG8_SA(0, 1), a2, vA[1]);
            PG8_WAIT_V(8); PG8_WAIT_L(0); PG8_BAR; PG8_MMA(0, 0, At, B0); PG8_MMA(0, 1, At, B1); PG8_BAR; PG8_SCHED;
            PG8_LDA(At, 1, 1); PG8_STAGE(PG8_SB(1, 0), b3, voffB); PG8_STAGE(PG8_SB(1, 1), b3 + hstep, voffB); PG8_STAGE(PG8_SA(1, 0), a3, vA[0]);
            PG8_WAIT_V(8); PG8_WAIT_L(0); PG8_BAR; PG8_MMA(1, 0, At, B0); PG8_MMA(1, 1, At, B1); PG8_BAR; PG8_SCHED;
        }
        if (wr == 0) PG8_BAR;
        E(acc, cur, wr, wc, fr, fq);
        if (!has_next) break;
#pragma unroll
        for (int a = 0; a < 2; ++a)
#pragma unroll
            for (int b = 0; b < 2; ++b)
#pragma unroll
                for (int m = 0; m < 4; ++m)
#pragma unroll
                    for (int n = 0; n < 2; ++n) acc[a][b][m][n] = (f32x4){0.f, 0.f, 0.f, 0.f};
        cur = nxt; cB = nB; ++ui;
        if (wr == 1) PG8_BAR;
    }
    PG8_WAIT_V(0);
    PG8_BAR;
#undef PG8_SA
#undef PG8_SB
#undef PG8_STAGE
#undef PG8_LDA
#undef PG8_LDB
#undef PG8_MMA
#undef PG8_LD8
#undef PG8_WAIT_V
#undef PG8_WAIT_L
#undef PG8_BAR
#undef PG8_SCHED
#undef PG8_VOFFA
}
#endif
}

typedef f32x4 AccT[2][2][4][2];

struct EpiQKV {
    static constexpr bool PERM = false;
    bf16_t* O; const float* rope; bf16_t* VT; int pn0 = 0;
    __device__ __forceinline__ void operator()(const AccT& acc, const pg8::Unit& u, int wr, int wc, int fr, int fq) const {
        const int colt = (u.pn + pn0) * 256; const bool is_q = colt < COL_K, is_k = colt >= COL_K && colt < COL_V, is_v = colt >= COL_V && colt < COL_XR;
#pragma unroll
        for (int ai = 0; ai < 2; ++ai) {
            f32x4 rp[4][2];
            if (is_q || is_k) {
#pragma unroll
                for (int m = 0; m < 4; ++m) { const int r = u.pm * 256 + ai * 128 + wr * 64 + m * 16 + fr, t = r % NSEQ, pos = (wc & 1) ? (t % 64) : (t / 64);
                    rp[m][0] = *(const f32x4*)(rope + (pos * 16 + 4 * fq) * 2); rp[m][1] = *(const f32x4*)(rope + (pos * 16 + 4 * fq) * 2 + 4); }
#ifndef CPU_EMU
                asm volatile("" ::: "memory");
#endif
            }
#pragma unroll
            for (int m = 0; m < 4; ++m) {
                const int r = u.pm * 256 + ai * 128 + wr * 64 + m * 16 + fr; const bool lat = r < ML; const int t = r % NSEQ;
#pragma unroll
                for (int bj = 0; bj < 2; ++bj) {
                    const int cg = colt + bj * 128 + wc * 32;
                    f32x4 v0 = acc[ai][bj][m][0], v1 = acc[ai][bj][m][1];
                    if ((is_q || is_k) && lat) {
#pragma unroll
                        for (int j = 0; j < 4; ++j) { const float cs = rp[m][j >> 1][(j & 1) * 2], sn = rp[m][j >> 1][(j & 1) * 2 + 1]; const float a = v0[j], b = v1[j]; v0[j] = a * cs - b * sn; v1[j] = b * cs + a * sn; }
                    }
                    if (is_q) { v0 *= 0.125f; v1 *= 0.125f; }
                    bf16_t* rowp = O + (size_t)r * EVIN + cg + 4 * fq;
                    u32x2_t w0, w1; w0.x = pack2bf(v0[0], v0[1]); w0.y = pack2bf(v0[2], v0[3]); w1.x = pack2bf(v1[0], v1[1]); w1.y = pack2bf(v1[2], v1[3]);
                    *(u32x2_t*)rowp = w0; *(u32x2_t*)(rowp + 16) = w1;
                    if (is_v) {
                        const int bb = lat ? r / NSEQ : (r - ML) / NCTX, tt = lat ? t : (r - ML) % NCTX, k16 = tt & 15, kp = (k16 & 3) | ((k16 & 4) << 1) | ((k16 & 8) >> 1);
                        const int pos = (lat ? 128 : 128 + NSEQ + 128) + (tt & ~15) + kp, vc = cg - COL_V + 4 * fq;
                        bf16_t* vp = VT + ((size_t)bb * 256 + vc) * VT_T + pos;
#pragma unroll
                        for (int j = 0; j < 4; ++j) { vp[(size_t)j * VT_T] = f2bf(v0[j]); vp[(size_t)(16 + j) * VT_T] = f2bf(v1[j]); }
                    }
                }
            }
        }
    }
};
template <bool IN16, bool OUT16> struct EpiResidT {
    static constexpr bool PERM = false;
    const float* xin_lat; const float* xin_ctx; float* xout; const float* gate;
    __device__ __forceinline__ void operator()(const AccT& acc, const pg8::Unit& u, int wr, int wc, int fr, int fq) const {
        const int row0 = u.pm * 256, arow = row0 < ML ? row0 / NSEQ : NB; const float* gp = gate + (size_t)arow * ADA6;
        const int col0 = u.pn * 256 + wc * 32 + 4 * fq;
        f32x4 gv[2][2];
#pragma unroll
        for (int bj = 0; bj < 2; ++bj)
#pragma unroll
            for (int n = 0; n < 2; ++n) gv[bj][n] = *(const f32x4*)(gp + col0 + bj * 128 + n * 16);
#pragma unroll
        for (int ai = 0; ai < 2; ++ai) {
            f32x4 xi[4][2][2];
#pragma unroll
            for (int m = 0; m < 4; ++m) { const int r = row0 + ai * 128 + wr * 64 + m * 16 + fr;
                const size_t io = (r < ML ? (size_t)r * D : (size_t)(r - ML) * D) + col0; const float* ib = r < ML ? xin_lat : xin_ctx;
#pragma unroll
                for (int bj = 0; bj < 2; ++bj)
#pragma unroll
                    for (int n = 0; n < 2; ++n) {
                        if (IN16) { const u32x2_t t = *(const u32x2_t*)((const bf16_t*)ib + io + bj * 128 + n * 16); xi[m][bj][n] = unpack4bf(t.x, t.y); } else xi[m][bj][n] = *(const f32x4*)(ib + io + bj * 128 + n * 16); } }
#ifndef CPU_EMU
            asm volatile("" ::: "memory");
#endif
#pragma unroll
            for (int m = 0; m < 4; ++m) { const int r = row0 + ai * 128 + wr * 64 + m * 16 + fr; const size_t oo = (size_t)r * D + col0;
#pragma unroll
                for (int bj = 0; bj < 2; ++bj)
#pragma unroll
                    for (int n = 0; n < 2; ++n) { const f32x4 xo = xi[m][bj][n] + gv[bj][n] * acc[ai][bj][m][n];
                        if (OUT16) { u32x2_t t; t.x = pack2bf(xo[0], xo[1]); t.y = pack2bf(xo[2], xo[3]); *(u32x2_t*)((bf16_t*)xout + oo + bj * 128 + n * 16) = t; } else *(f32x4*)(xout + oo + bj * 128 + n * 16) = xo; } }
        }
    }
};
typedef EpiResidT<false, RES_BF16> EpiResid0;
typedef EpiResidT<RES_BF16, RES_BF16> EpiResid;
struct EpiBf16 {
    static constexpr bool PERM = true;
    bf16_t* O; int ldc;
    __device__ __forceinline__ void operator()(const AccT& acc, const pg8::Unit& u, int wr, int wc, int fr, int fq) const {
        const int col0 = u.pn * 256 + wc * 32 + 8 * fq;
#pragma unroll
        for (int ai = 0; ai < 2; ++ai)
#pragma unroll
            for (int m = 0; m < 4; ++m) { bf16_t* rowp = O + (size_t)(u.pm * 256 + ai * 128 + wr * 64 + m * 16 + fr) * ldc + col0;
#pragma unroll
                for (int bj = 0; bj < 2; ++bj) { const f32x4 v0 = acc[ai][bj][m][0], v1 = acc[ai][bj][m][1];
                    u32x4_t w; w.x = pack2bf(v0[0], v0[1]); w.y = pack2bf(v0[2], v0[3]); w.z = pack2bf(v1[0], v1[1]); w.w = pack2bf(v1[2], v1[3]);
                    *(u32x4_t*)(rowp + bj * 128) = w; } }
    }
};
#ifndef CPU_EMU
struct EpiY8 {
    static constexpr bool PERM = true;
    unsigned char* O; int ldc;
    __device__ __forceinline__ void operator()(const AccT& acc, const pg8::Unit& u, int wr, int wc, int fr, int fq) const {
        const int col0 = u.pn * 256 + wc * 32 + 8 * fq;
#pragma unroll
        for (int ai = 0; ai < 2; ++ai)
#pragma unroll
            for (int m = 0; m < 4; ++m) { unsigned char* rowp = O + (size_t)(u.pm * 256 + ai * 128 + wr * 64 + m * 16 + fr) * ldc + col0;
#pragma unroll
                for (int bj = 0; bj < 2; ++bj) { const f32x4 v0 = acc[ai][bj][m][0] * Y8_SCALE, v1 = acc[ai][bj][m][1] * Y8_SCALE;
                    u32x2_t w; w.x = pack4_fp8(v0[0], v0[1], v0[2], v0[3]); w.y = pack4_fp8(v1[0], v1[1], v1[2], v1[3]);
                    *(u32x2_t*)(rowp + bj * 128) = w; } }
    }
};
#endif
struct EpiGU {
    static constexpr bool PERM = true;
    bf16_t* O;
    __device__ __forceinline__ void operator()(const AccT& acc, const pg8::Unit& u, int wr, int wc, int fr, int fq) const {
        const int col0 = u.pn * 128 + wc * 32 + 8 * fq;
#pragma unroll
        for (int ai = 0; ai < 2; ++ai)
#pragma unroll
            for (int m = 0; m < 4; ++m) { bf16_t* rowp = O + (size_t)(u.pm * 256 + ai * 128 + wr * 64 + m * 16 + fr) * FF + col0;
                float o[8];
#pragma unroll
                for (int n = 0; n < 2; ++n)
#pragma unroll
                    for (int j = 0; j < 4; ++j) { const float gt = acc[ai][0][m][n][j], up = acc[ai][1][m][n][j]; o[n * 4 + j] = siluf_(gt) * up; }
                u32x4_t w; w.x = pack2bf(o[0], o[1]); w.y = pack2bf(o[2], o[3]); w.z = pack2bf(o[4], o[5]); w.w = pack2bf(o[6], o[7]);
                *(u32x4_t*)rowp = w; }
    }
};
#ifndef CPU_EMU
struct EpiGU8 {
    static constexpr bool PERM = true;
    unsigned char* O;
    __device__ __forceinline__ void operator()(const AccT& acc, const pg8::Unit& u, int wr, int wc, int fr, int fq) const {
        const int col0 = u.pn * 128 + wc * 32 + 8 * fq;
#pragma unroll
        for (int ai = 0; ai < 2; ++ai)
#pragma unroll
            for (int m = 0; m < 4; ++m) { unsigned char* rowp = O + (size_t)(u.pm * 256 + ai * 128 + wr * 64 + m * 16 + fr) * FF + col0;
                float o[8];
#pragma unroll
                for (int n = 0; n < 2; ++n)
#pragma unroll
                    for (int j = 0; j < 4; ++j) { const float gt = acc[ai][0][m][n][j], up = acc[ai][1][m][n][j]; o[n * 4 + j] = siluf_(gt) * up * ACT8_SCALE; }
                u32x2_t w; w.x = pack4_fp8(o[0], o[1], o[2], o[3]); w.y = pack4_fp8(o[4], o[5], o[6], o[7]);
                *(u32x2_t*)rowp = w; }
    }
};
#endif
struct EpiGLU {
    static constexpr bool PERM = true;
    const bf16_t* Z; bf16_t* O; const float* bias;
    __device__ __forceinline__ void operator()(const AccT& acc, const pg8::Unit& u, int wr, int wc, int fr, int fq) const {
        const int col0 = u.pn * 256 + wc * 32 + 8 * fq;
#pragma unroll
        for (int ai = 0; ai < 2; ++ai)
#pragma unroll
            for (int m = 0; m < 4; ++m) { const size_t ro = (size_t)(u.pm * 256 + ai * 128 + wr * 64 + m * 16 + fr) * S5W + col0;
#pragma unroll
                for (int bj = 0; bj < 2; ++bj) { const u32x4_t zz = *(const u32x4_t*)(Z + ro + bj * 128); const unsigned zw[4] = {zz.x, zz.y, zz.z, zz.w}; float o[8];
#pragma unroll
                    for (int n = 0; n < 2; ++n)
#pragma unroll
                        for (int j = 0; j < 4; ++j) { const int q = n * 4 + j; const float zv = __uint_as_float((q & 1) ? (zw[q >> 1] & 0xffff0000u) : (zw[q >> 1] << 16));
                            o[q] = zv * sigmoidf_(acc[ai][bj][m][n][j] + bias[col0 + bj * 128 + q]); }
                    u32x4_t w; w.x = pack2bf(o[0], o[1]); w.y = pack2bf(o[2], o[3]); w.z = pack2bf(o[4], o[5]); w.w = pack2bf(o[6], o[7]);
                    *(u32x4_t*)(O + ro + bj * 128) = w; } }
    }
};

#ifndef CPU_EMU
struct EpiGLU8 {
    static constexpr bool PERM = true;
    const unsigned char* Z; unsigned char* O; const float* bias;
    __device__ __forceinline__ void operator()(const AccT& acc, const pg8::Unit& u, int wr, int wc, int fr, int fq) const {
        const int col0 = u.pn * 256 + wc * 32 + 8 * fq;
        u32x2_t zall[2][4][2]; f32x4 bv[2][2];
#pragma unroll
        for (int bj = 0; bj < 2; ++bj)
#pragma unroll
            for (int n = 0; n < 2; ++n) bv[bj][n] = *(const f32x4*)(bias + col0 + bj * 128 + n * 4);
#pragma unroll
        for (int ai = 0; ai < 2; ++ai)
#pragma unroll
            for (int m = 0; m < 4; ++m) { const size_t ro = (size_t)(u.pm * 256 + ai * 128 + wr * 64 + m * 16 + fr) * S5W + col0;
#pragma unroll
                for (int bj = 0; bj < 2; ++bj) zall[ai][m][bj] = *(const u32x2_t*)(Z + ro + bj * 128); }
        asm volatile("" ::: "memory");
#pragma unroll
        for (int ai = 0; ai < 2; ++ai)
#pragma unroll
            for (int m = 0; m < 4; ++m) { const size_t ro = (size_t)(u.pm * 256 + ai * 128 + wr * 64 + m * 16 + fr) * S5W + col0;
#pragma unroll
                for (int bj = 0; bj < 2; ++bj) { const u32x2_t zz = zall[ai][m][bj]; float o[8];
#pragma unroll
                    for (int n = 0; n < 2; ++n) { const int zw = (int)(n ? zz.y : zz.x);
                        const float z0 = __builtin_amdgcn_cvt_f32_fp8(zw, 0), z1 = __builtin_amdgcn_cvt_f32_fp8(zw, 1), z2 = __builtin_amdgcn_cvt_f32_fp8(zw, 2), z3 = __builtin_amdgcn_cvt_f32_fp8(zw, 3); const float zv[4] = {z0, z1, z2, z3};
#pragma unroll
                        for (int j = 0; j < 4; ++j) { const int q = n * 4 + j; o[q] = zv[j] * (S8_SCALE / Z8_SCALE) * sigmoidf_(acc[ai][bj][m][n][j] + bv[bj][n][j]); } }
                    u32x2_t w; w.x = pack4_fp8(o[0], o[1], o[2], o[3]); w.y = pack4_fp8(o[4], o[5], o[6], o[7]);
                    *(u32x2_t*)(O + ro + bj * 128) = w; } }
    }
};
#endif

enum { G_IN0 = 0, G_OUT0, G_GU, G_DN, G_IN1, G_GLU, G_OUT1, G_GU8, G_DN8, G_IN18, G_GLU8, G_OUT18, G_IN08, G_OUT08, G_IN0SPLIT };
#ifdef CPU_EMU
namespace pg8 {
template <class Epi, class Sched> void gemm_phase(LdsPtr, const Gemm g, const Sched& S, const Epi& E, int) {
    Unit u; std::vector<float> C(256 * 256), af(g.K), bfv((size_t)256 * g.K);
    for (int i = 0; S.next(i, u); ++i) {
        const bf16_t* Bb = (const bf16_t*)S.b_base(g, u);
        for (size_t q = 0; q < (size_t)256 * g.K; ++q) bfv[q] = bf2f(Bb[q]);
        for (int r = 0; r < 256; ++r) { const bf16_t* a = g.A + (size_t)S.a_row(u, r) * g.K; for (int k = 0; k < g.K; ++k) af[k] = bf2f(a[k]);
            for (int cc = 0; cc < 256; ++cc) { const float* bp = &bfv[(size_t)cc * g.K]; float s = 0.f; for (int k = 0; k < g.K; ++k) s += af[k] * bp[k]; C[r * 256 + cc] = s; } }
        for (int tid = 0; tid < 512; ++tid) { const int wid = tid >> 6, lane = tid & 63, wr = wid >> 2, wc = wid & 3, fr = lane & 15, fq = lane >> 4;
            f32x4 acc[2][2][4][2];
            for (int ai = 0; ai < 2; ++ai) for (int bj = 0; bj < 2; ++bj) for (int m = 0; m < 4; ++m) for (int n = 0; n < 2; ++n) for (int j = 0; j < 4; ++j) {
                const int r = 128 * ai + 64 * wr + 16 * m + fr, cc = Epi::PERM ? 128 * bj + 32 * wc + 8 * fq + 4 * n + j : 128 * bj + 32 * wc + 16 * n + 4 * fq + j;
                acc[ai][bj][m][n][j] = C[r * 256 + cc]; }
            E(acc, u, wr, wc, fr, fq); }
    }
}
}
#endif
#ifndef CPU_EMU
template <class Sched> __device__ __forceinline__ void gemm_stagger(const Sched& S, int tile_us) {
    const int rem = S.nwg % S.G; if (rem == 0 || S.c < rem) return;
    const int units = (int)((long)(S.c - rem) * tile_us * 4 / (5 * (S.G - rem)));
    for (int i = 0; i < units; ++i) __builtin_amdgcn_s_sleep(32);
}
#else
template <class Sched> void gemm_stagger(const Sched&, int) {}
#endif
template <int WHICH> __device__ __forceinline__ void run_gemm(const Params& p, int l, pg8::LdsPtr lds, int G, int c, int wv_ = 0) {
    unsigned char* ws = p.ws; pg8::Gemm g;
    if constexpr (WHICH == G_IN0) { g.A = (const bf16_t*)(ws + WS_H); g.Bt = (const bf16_t*)(ws + WS_WT_IN0); g.M = MT; g.N = EVIN; g.K = D;
        pg8::StaticOrder S; S.init(g.M, g.N, G, c); EpiQKV E; E.O = (bf16_t*)(ws + WS_QKV); E.rope = (const float*)(ws + WS_ROPE); E.VT = (bf16_t*)(ws + WS_VT); pg8::gemm_phase(lds, g, S, E, wv_); }
    else if constexpr (WHICH == G_OUT0) { g.A = (const bf16_t*)(ws + WS_MIX); g.Bt = (const bf16_t*)(ws + WS_WT_OUT0); g.M = MT; g.N = D; g.K = D;
        pg8::StaticOrder S; S.init(g.M, g.N, G, c); EpiResid0 E; E.xin_lat = p.x; E.xin_ctx = p.ctx; E.xout = (float*)(ws + WS_XRES); E.gate = (const float*)(ws + WS_ADA) + 2 * D; pg8::gemm_phase(lds, g, S, E, wv_); }
    else if constexpr (WHICH == G_GU) { g.A = (const bf16_t*)(ws + WS_H); g.Bt = (const bf16_t*)(ws + WS_WT_GU) + (size_t)l * NE * 2 * FF * D; g.M = NBLK * 256; g.N = 2 * FF; g.K = D;
        pg8::MoeOrder<true> S; S.init((const int*)(ws + WS_CNT) + l * 64, g.N, G, c, (const int*)(ws + WS_ROWIDX), (size_t)2 * FF * D * 2); EpiGU E; E.O = (bf16_t*)(ws + WS_ACT); pg8::gemm_phase(lds, g, S, E, wv_); }
    else if constexpr (WHICH == G_DN) { g.A = (const bf16_t*)(ws + WS_ACT); g.Bt = (const bf16_t*)(ws + WS_WT_DN) + (size_t)l * NE * D * FF; g.M = NBLK * 256; g.N = D; g.K = FF;
        pg8::MoeOrder<false> S; S.init((const int*)(ws + WS_CNT) + l * 64, g.N, G, c, nullptr, (size_t)D * FF * 2); EpiBf16 E; E.O = (bf16_t*)(ws + WS_YBUF); E.ldc = D; pg8::gemm_phase(lds, g, S, E, wv_); }
#ifndef CPU_EMU
    else if constexpr (WHICH == G_IN0SPLIT) {
        { g.A = (const bf16_t*)(ws + WS_H); g.Bt = (const bf16_t*)(ws + WS_WT_IN0) + (size_t)IN0_NQ * D; g.M = MT; g.N = EVIN - IN0_NQ; g.K = D;
          pg8::StaticOrder S; S.init(g.M, g.N, G, c); EpiBf16 E; E.O = (bf16_t*)(ws + WS_QKV) + IN0_NQ; E.ldc = EVIN; pg8::gemm_phase(lds, g, S, E, wv_); }
        const int extra = ((MT / 256) * ((EVIN - IN0_NQ) / 256)) % G, G2 = G - extra;
        if (c >= extra) { pg8::Gemm g2; g2.A = (const bf16_t*)(ws + WS_H8); g2.Bt = (const bf16_t*)(ws + WS_WT_IN0); g2.M = MT; g2.N = IN0_NQ; g2.K = D / 2; g2.sc_w = W8_E8M0; g2.sc_a = ONE_E8M0;
          pg8::StaticOrder S; S.init(g2.M, g2.N, G2, c - extra); EpiQKV E; E.O = (bf16_t*)(ws + WS_QKV); E.rope = (const float*)(ws + WS_ROPE); E.VT = (bf16_t*)(ws + WS_VT); pg8::gemm_phase<EpiQKV, pg8::StaticOrder, true>(lds, g2, S, E, wv_); } }
    else if constexpr (WHICH == G_IN08) { g.A = (const bf16_t*)(ws + WS_H); g.Bt = (const bf16_t*)(ws + WS_WT_IN0); g.M = MT; g.N = EVIN; g.K = D / 2; g.sc_w = W8_E8M0; g.sc_a = ONE_E8M0;
        pg8::StaticOrder S; S.init(g.M, g.N, G, c); EpiQKV E; E.O = (bf16_t*)(ws + WS_QKV); E.rope = (const float*)(ws + WS_ROPE); E.VT = (bf16_t*)(ws + WS_VT); pg8::gemm_phase<EpiQKV, pg8::StaticOrder, true>(lds, g, S, E, wv_); }
    else if constexpr (WHICH == G_OUT08) { g.A = (const bf16_t*)(ws + WS_MIX); g.Bt = (const bf16_t*)(ws + WS_WT_OUT0); g.M = MT; g.N = D; g.K = D / 2; g.sc_w = W8_E8M0; g.sc_a = ONE_E8M0;
        pg8::StaticOrder S; S.init(g.M, g.N, G, c); gemm_stagger(S, 30); EpiResid0 E; E.xin_lat = p.x; E.xin_ctx = p.ctx; E.xout = (float*)(ws + WS_XRES); E.gate = (const float*)(ws + WS_ADA) + 2 * D; pg8::gemm_phase<EpiResid0, pg8::StaticOrder, true>(lds, g, S, E, wv_); }
    else if constexpr (WHICH == G_IN18) { g.A = (const bf16_t*)(ws + WS_H); g.Bt = (const bf16_t*)(ws + WS_WT_IN1); g.M = MT; g.N = S5W; g.K = D / 2; g.sc_w = W8_E8M0; g.sc_a = ONE_E8M0;
        pg8::StaticOrder S; S.init(g.M, g.N, G, c); gemm_stagger(S, 16); EpiBf16 E; E.O = (bf16_t*)(ws + WS_U1); E.ldc = S5W; pg8::gemm_phase<EpiBf16, pg8::StaticOrder, true>(lds, g, S, E, wv_); }
    else if constexpr (WHICH == G_GLU8) { g.A = (const bf16_t*)(ws + WS_Z); g.Bt = (const bf16_t*)(ws + WS_WT_GLU); g.M = ML; g.N = S5W; g.K = S5W / 2; g.sc_w = W8_E8M0; g.sc_a = Z8_E8M0;
        pg8::StaticOrder S; S.init(g.M, g.N, G, c); EpiGLU8 E; E.Z = ws + WS_Z; E.O = ws + WS_S; E.bias = p.s5_glu_b; pg8::gemm_phase<EpiGLU8, pg8::StaticOrder, true>(lds, g, S, E, wv_); }
    else if constexpr (WHICH == G_OUT18) { g.A = (const bf16_t*)(ws + WS_S); g.Bt = (const bf16_t*)(ws + WS_WT_OUT1); g.M = ML; g.N = D; g.K = S5W / 2; g.sc_w = W8_E8M0; g.sc_a = S8_E8M0;
        pg8::StaticOrder S; S.init(g.M, g.N, G, c); EpiResid E; E.xin_lat = (const float*)(ws + WS_XRES); E.xin_ctx = (const float*)(ws + WS_XRES + (size_t)ML * D * (RES_BF16 ? 2 : 4)); E.xout = (float*)(ws + WS_XRES);
        E.gate = (const float*)(ws + WS_ADA) + (size_t)NADA * ADA6 + 2 * D; pg8::gemm_phase<EpiResid, pg8::StaticOrder, true>(lds, g, S, E, wv_); }
    else if constexpr (WHICH == G_GU8) { g.A = (const bf16_t*)(ws + WS_H); g.Bt = (const bf16_t*)(ws + WS_WT_GU + (size_t)l * NE * 2 * FF * D * 2); g.M = NBLK * 256; g.N = 2 * FF; g.K = D / 2; g.sc_w = W8_E8M0; g.sc_a = ONE_E8M0;
        pg8::MoeOrder<true> S; S.init((const int*)(ws + WS_CNT) + l * 64, g.N, G, c, (const int*)(ws + WS_ROWIDX), (size_t)2 * FF * D); gemm_stagger(S, 20); EpiGU8 E; E.O = ws + WS_ACT; pg8::gemm_phase<EpiGU8, pg8::MoeOrder<true>, true>(lds, g, S, E, wv_); }
    else if constexpr (WHICH == G_DN8) { g.A = (const bf16_t*)(ws + WS_ACT); g.Bt = (const bf16_t*)(ws + WS_WT_DN + (size_t)l * NE * D * FF * 2); g.M = NBLK * 256; g.N = D; g.K = FF / 2; g.sc_w = W8_E8M0; g.sc_a = ACT8_E8M0;
        pg8::MoeOrder<false> S; S.init((const int*)(ws + WS_CNT) + l * 64, g.N, G, c, nullptr, (size_t)D * FF); gemm_stagger(S, 13);
        if constexpr (Y8) { EpiY8 E; E.O = ws + WS_YBUF; E.ldc = D; pg8::gemm_phase<EpiY8, pg8::MoeOrder<false>, true>(lds, g, S, E, wv_); }
        else { EpiBf16 E; E.O = (bf16_t*)(ws + WS_YBUF); E.ldc = D; pg8::gemm_phase<EpiBf16, pg8::MoeOrder<false>, true>(lds, g, S, E, wv_); } }
#endif
    else if constexpr (WHICH == G_IN1) { g.A = (const bf16_t*)(ws + WS_H); g.Bt = (const bf16_t*)(ws + WS_WT_IN1); g.M = MT; g.N = S5W; g.K = D;
        pg8::StaticOrder S; S.init(g.M, g.N, G, c); EpiBf16 E; E.O = (bf16_t*)(ws + WS_U1); E.ldc = S5W; pg8::gemm_phase(lds, g, S, E, wv_); }
    else if constexpr (WHICH == G_GLU) { g.A = (const bf16_t*)(ws + WS_Z); g.Bt = (const bf16_t*)(ws + WS_WT_GLU); g.M = ML; g.N = S5W; g.K = S5W;
        pg8::StaticOrder S; S.init(g.M, g.N, G, c); EpiGLU E; E.Z = (const bf16_t*)(ws + WS_Z); E.O = (bf16_t*)(ws + WS_S); E.bias = p.s5_glu_b; pg8::gemm_phase(lds, g, S, E, wv_); }
    else { g.A = (const bf16_t*)(ws + WS_S); g.Bt = (const bf16_t*)(ws + WS_WT_OUT1); g.M = ML; g.N = D; g.K = S5W;
        pg8::StaticOrder S; S.init(g.M, g.N, G, c); EpiResid E; E.xin_lat = (const float*)(ws + WS_XRES); E.xin_ctx = (const float*)(ws + WS_XRES + (size_t)ML * D * (RES_BF16 ? 2 : 4)); E.xout = (float*)(ws + WS_XRES);
        E.gate = (const float*)(ws + WS_ADA) + (size_t)NADA * ADA6 + 2 * D; pg8::gemm_phase(lds, g, S, E, wv_); }
}
#ifndef CPU_EMU

#define XB_TMO      128
#define XB_XCNT(j)  (256  + 64 * (j))
#define XB_XSUB(j)  (1280 + 64 * (j))
#define XB_XGEN(j)  (2304 + 64 * (j))
#define XB_TOP      3328
#define XB_TOPGEN   3392
#define XCD_BAR_WORDS 3456
#define XB_SPIN_CAP (1u << 24)

__device__ __forceinline__ unsigned xb_ld(unsigned* p)              { return __hip_atomic_load(p, __ATOMIC_RELAXED, __HIP_MEMORY_SCOPE_AGENT); }
__device__ __forceinline__ unsigned xb_add(unsigned* p, unsigned v) { return __hip_atomic_fetch_add(p, v, __ATOMIC_RELAXED, __HIP_MEMORY_SCOPE_AGENT); }
__device__ __forceinline__ unsigned xb_xcc_id() { return (unsigned)__builtin_amdgcn_s_getreg((3 << 11) | 20) & 0xFu; }
#define XB_SPIN(cond, bar) do { unsigned _sp = 0; while (cond) { __builtin_amdgcn_s_sleep(1); \
    if ((++_sp & 255u) == 0u) { if (xb_ld(&(bar)[XB_TMO])) break; if (_sp > XB_SPIN_CAP) { atomicAdd(&(bar)[XB_TMO], 1u); break; } } } } while (0)

struct XcdBarrier {
    unsigned* bar; unsigned x;
    volatile LAS unsigned* st;
};

__device__ __forceinline__ XcdBarrier xcd_barrier_post(unsigned* bar, volatile LAS unsigned* st, int wv_) {
    XcdBarrier b; b.bar = bar; b.x = xb_xcc_id(); b.st = st;
    if (tid_of(wv_) == 0) (void)xb_add(&bar[XB_XCNT(b.x)], 1u);
    return b;
}
__device__ __forceinline__ void xcd_barrier_complete(unsigned* bar, unsigned x, unsigned& nloc, unsigned& nx) {
    const unsigned G = gridDim.x * gridDim.y * gridDim.z;
    unsigned sum, cnt, mine, sp = 0u;
    for (;;) {
        sum = 0u; cnt = 0u; mine = 0u;
#pragma unroll
        for (unsigned j = 0; j < 16; ++j) { const unsigned c = xb_ld(&bar[XB_XCNT(j)]); sum += c; cnt += (c > 0u) ? 1u : 0u; mine = (j == x) ? c : mine; }
        if (sum == G) break;
        __builtin_amdgcn_s_sleep(1);
        if ((++sp & 255u) == 0u) { if (xb_ld(&bar[XB_TMO])) break; if (sp > XB_SPIN_CAP) { atomicAdd(&bar[XB_TMO], 1u); break; } }
    }
    nloc = mine > 0u ? mine : 1u; nx = cnt > 0u ? cnt : 1u;
}

__device__ __forceinline__ void xcd_barrier(const XcdBarrier& b, int wv_) {
    asm volatile("s_waitcnt vmcnt(0)" ::: "memory");
    __syncthreads();
    if (tid_of(wv_) == 0) {
        unsigned* bar = b.bar;
        __builtin_amdgcn_s_waitcnt(0);
        unsigned nloc = b.st[0], nx = b.st[1];
        if (nloc == 0u) { xcd_barrier_complete(bar, b.x, nloc, nx); b.st[0] = nloc; b.st[1] = nx; }
        const unsigned old = xb_add(&bar[XB_XSUB(b.x)], 1u);
        const unsigned gen = old / nloc;
        if (old + 1u == (gen + 1u) * nloc) {
            __builtin_amdgcn_fence(__ATOMIC_RELEASE, "agent");
            asm volatile("s_waitcnt vmcnt(0)" ::: "memory");
            const unsigned og = xb_add(&bar[XB_TOP], 1u);
            const unsigned tg = og / nx;
            if (og + 1u == (tg + 1u) * nx) xb_add(&bar[XB_TOPGEN], 1u);
            else XB_SPIN(xb_ld(&bar[XB_TOPGEN]) == tg, bar);
            __builtin_amdgcn_fence(__ATOMIC_ACQUIRE, "agent");
            xb_add(&bar[XB_XGEN(b.x)], 1u);
            asm volatile("s_waitcnt vmcnt(0)" ::: "memory");
        } else {
            XB_SPIN(xb_ld(&bar[XB_XGEN(b.x)]) == gen, bar);
            __builtin_amdgcn_fence(__ATOMIC_ACQUIRE, "agent");
            asm volatile("s_waitcnt vmcnt(0)" ::: "memory");
        }
    }
    __syncthreads();
}


#define GT ((long)blockIdx.x * blockDim.x + threadIdx.x)
#define GN ((long)gridDim.x * blockDim.x)
constexpr int MEGA_LDS = 147456;
__device__ __forceinline__ long gt_of(int wv) { return (long)blockIdx.x * 512 + tid_of(wv); }
__global__ void __launch_bounds__(512, 2) k_mega(Params p) {
    extern __shared__ __attribute__((aligned(16))) unsigned char shm[];
    volatile LAS unsigned* st = (volatile LAS unsigned*)(shm + MEGA_LDS - 64);
    const int WV = __builtin_amdgcn_readfirstlane((int)threadIdx.x >> 6);
    if (tid_of(WV) == 0) { st[0] = 0u; st[1] = 0u; st[2] = 0u; st[3] = 0u; }
    __syncthreads();
    const XcdBarrier bar = xcd_barrier_post((unsigned*)(p.ws + WS_BAR), st, WV);
    const long gn = (long)gridDim.x * 512; const int G = (int)gridDim.x, c = (int)blockIdx.x; const pg8::LdsPtr lds = (pg8::LdsPtr)shm;
#define gt gt_of(WV)
    ph_ada(p, (float*)shm, c, G, WV); ph_tables(p, gt, gn); ph_convert(p, (float*)shm, CVT_TILES, -1, WV);
    xcd_barrier(bar, WV);
    ph_norm_fast<0>(p, 0, MT, c * 8 + WV, G * 8, WV);
    xcd_barrier(bar, WV);
    run_gemm<IN0_FP8 ? G_IN08 : (IN0QKV_FP8 ? G_IN0SPLIT : G_IN0)>(p, 0, lds, G, c, WV);
    xcd_barrier(bar, WV);
    ph_attn_fast(p, (LAS unsigned char*)shm, c, G, WV);
    { constexpr int ATT_UNITS = NB * 4 * (NSEQ / 128 + NCTX / 128); const int extra = ATT_UNITS % G;
      if (extra * 2 < G) { if (c >= extra) ph_conv_fast(p, (long)(c - extra) * 512 + tid_of(WV), (long)(G - extra) * 512); } else ph_conv_fast(p, gt, gn); }
    xcd_barrier(bar, WV);
    ph_lru_fast<1>(p, (LAS unsigned char*)shm, c * 8 + WV, G * 8, WV);
    xcd_barrier(bar, WV);
    ph_lru_fast<2>(p, (LAS unsigned char*)shm, c * 8 + WV, G * 8, WV);
    xcd_barrier(bar, WV);
    run_gemm<OUT0_FP8 ? G_OUT08 : G_OUT0>(p, 0, lds, G, c, WV);
    xcd_barrier(bar, WV);
    ph_router_fast<MOE0_FP8>(p, 0, MT, (LAS unsigned char*)shm, c, G, WV);
    xcd_barrier(bar, WV);
    ph_dispatch_fast(p, 0, MT, (LAS unsigned char*)shm, c, G, WV);
    xcd_barrier(bar, WV);
    run_gemm<MOE0_FP8 ? G_GU8 : G_GU>(p, 0, lds, G, c, WV);
    xcd_barrier(bar, WV);
    run_gemm<MOE0_FP8 ? G_DN8 : G_DN>(p, 0, lds, G, c, WV);
    xcd_barrier(bar, WV);
    ph_norm_fast<1>(p, 1, MT, c * 8 + WV, G * 8, WV);
    xcd_barrier(bar, WV);
    run_gemm<DENSE1_FP8 ? G_IN18 : G_IN1>(p, 1, lds, G, c, WV);
    xcd_barrier(bar, WV);
    ph_s5_fast<1>(p, (LAS unsigned char*)shm, c * 8 + WV, G * 8, WV);
    xcd_barrier(bar, WV);
    ph_s5_fast<2>(p, (LAS unsigned char*)shm, c * 8 + WV, G * 8, WV);
    xcd_barrier(bar, WV);
    run_gemm<DENSE1_FP8 ? G_GLU8 : G_GLU>(p, 1, lds, G, c, WV);
    xcd_barrier(bar, WV);
    run_gemm<DENSE1_FP8 ? G_OUT18 : G_OUT1>(p, 1, lds, G, c, WV);
    xcd_barrier(bar, WV);
    ph_router_fast<MOE1_FP8>(p, 1, ML, (LAS unsigned char*)shm, c, G, WV);
    xcd_barrier(bar, WV);
    ph_dispatch_fast(p, 1, ML, (LAS unsigned char*)shm, c, G, WV);
    xcd_barrier(bar, WV);
    run_gemm<MOE1_FP8 ? G_GU8 : G_GU>(p, 1, lds, G, c, WV);
    xcd_barrier(bar, WV);
    run_gemm<MOE1_FP8 ? G_DN8 : G_DN>(p, 1, lds, G, c, WV);
    xcd_barrier(bar, WV);
    ph_norm_fast<2>(p, 1, ML, c * 8 + WV, G * 8, WV);
#undef gt
}

#ifdef MK_MULTI
__global__ void __launch_bounds__(512, 2) k_prologue(Params p) {
    extern __shared__ __attribute__((aligned(16))) unsigned char shm[];
    ph_ada(p, (float*)shm, blockIdx.x, gridDim.x, (int)threadIdx.x >> 6); ph_tables(p, GT, GN); ph_convert(p, (float*)shm, CVT_TILES, -1, (int)threadIdx.x >> 6);
}
template <int WHICH> __global__ void __launch_bounds__(512, 2) k_gemm(Params p, int l) {
    extern __shared__ __attribute__((aligned(16))) unsigned char shm[];
    run_gemm<WHICH>(p, l, (pg8::LdsPtr)shm, (int)gridDim.x, (int)blockIdx.x, __builtin_amdgcn_readfirstlane((int)threadIdx.x >> 6));
}
__global__ void __launch_bounds__(512, 2) k_norm(Params p, int l, int rows) { ph_norm(p, l, rows, GT, GN); }
__global__ void __launch_bounds__(512, 2) k_conv(Params p) { ph_conv(p, GT, GN); }
__global__ void __launch_bounds__(512, 2) k_lru(Params p) { ph_lru(p, GT, GN); }
__global__ void __launch_bounds__(512, 2) k_attn(Params p) { ph_attn(p, GT, GN); }
__global__ void __launch_bounds__(512, 2) k_router(Params p, int l, int rows) { ph_router(p, l, rows, GT, GN); }
__global__ void __launch_bounds__(512, 2) k_dispatch(Params p, int l, int rows) { ph_dispatch(p, l, rows, GT, GN); }
__global__ void __launch_bounds__(512, 2) k_combine(Params p, int l, int rows) { ph_combine(p, l, rows, GT, GN); }
__global__ void __launch_bounds__(512, 2) k_s5(Params p) { ph_s5(p, GT, GN); }
__global__ void __launch_bounds__(512, 2) k_final(Params p) { ph_final(p, GT, GN); }

#endif
static Params make_params(void* const* d_in, void* d_out, void* d_ws) {
    Params p{}; const float* const* in = (const float* const*)d_in;
    p.x = in[0]; p.c = in[1]; p.ctx = in[2]; p.c_ctx = in[3]; p.ada_w = in[4]; p.ada_b = in[5]; p.norm_mix = in[6]; p.norm_ffn = in[7]; p.norm_final = in[8];
    p.ev_w_in = in[9]; p.ev_w_out = in[10]; p.attn_sink = in[11]; p.lru_conv_w = in[12]; p.lru_conv_b = in[13]; p.lru_lam = in[14]; p.lru_wa = in[15]; p.lru_ba = in[16]; p.lru_wi = in[17]; p.lru_bi = in[18];
    p.od_w_in = in[19]; p.s5_lam_re = in[20]; p.s5_lam_im = in[21]; p.s5_log_step = in[22]; p.s5_b_re = in[23]; p.s5_b_im = in[24]; p.s5_c_re = in[25]; p.s5_c_im = in[26]; p.s5_d = in[27];
    p.s5_glu_w = in[28]; p.s5_glu_b = in[29]; p.od_w_out = in[30]; p.router_w = in[31]; p.router_b = in[32]; p.moe_w_gate = in[33]; p.moe_w_up = in[34]; p.moe_w_down = in[35];
    p.out = (float*)d_out; p.ws = (unsigned char*)d_ws; return p;
}

extern "C" void kernel_launch(void* const* d_in, const int* in_sizes, int n_in, void* d_out, int out_size, void* d_ws, size_t ws_size, hipStream_t stream) {
    if (n_in != 36 || ws_size < WS_END || out_size != ML * D) { fprintf(stderr, "kernel_launch: unexpected shapes (n_in %d, out %d, ws %zu < %zu)\n", n_in, out_size, ws_size, (size_t)WS_END); return; }
#ifdef MK_MULTI
    static bool attr_done = false;
    constexpr int GLDS = pg8::STAGE_BYTES;
    if (!attr_done) {
        (void)hipFuncSetAttribute((const void*)k_gemm<G_IN0>, hipFuncAttributeMaxDynamicSharedMemorySize, GLDS); (void)hipFuncSetAttribute((const void*)k_gemm<G_OUT0>, hipFuncAttributeMaxDynamicSharedMemorySize, GLDS);
        (void)hipFuncSetAttribute((const void*)k_gemm<G_GU>, hipFuncAttributeMaxDynamicSharedMemorySize, GLDS); (void)hipFuncSetAttribute((const void*)k_gemm<G_DN>, hipFuncAttributeMaxDynamicSharedMemorySize, GLDS);
        (void)hipFuncSetAttribute((const void*)k_gemm<G_IN1>, hipFuncAttributeMaxDynamicSharedMemorySize, GLDS); (void)hipFuncSetAttribute((const void*)k_gemm<G_GLU>, hipFuncAttributeMaxDynamicSharedMemorySize, GLDS);
        (void)hipFuncSetAttribute((const void*)k_gemm<G_OUT1>, hipFuncAttributeMaxDynamicSharedMemorySize, GLDS);
        attr_done = true;
    }
    const Params p = make_params(d_in, d_out, d_ws);
    (void)hipMemsetAsync(d_ws, 0, CTL_BYTES, stream);
    const dim3 blk(512); const int NG = 256, NW = 1024;
    k_prologue<<<NW, blk, (ADA_LDS_BYTES > CVT_LDS_BYTES + 16 ? ADA_LDS_BYTES : CVT_LDS_BYTES + 16), stream>>>(p);
    k_norm<<<NW, blk, 0, stream>>>(p, 0, MT);
    k_gemm<G_IN0><<<NG, blk, GLDS, stream>>>(p, 0);
    k_attn<<<NW, blk, 0, stream>>>(p);
    k_conv<<<NW, blk, 0, stream>>>(p);
    k_lru<<<NW, blk, 0, stream>>>(p);
    k_gemm<G_OUT0><<<NG, blk, GLDS, stream>>>(p, 0);
    k_router<<<NW, blk, 0, stream>>>(p, 0, MT);
    k_dispatch<<<NW, blk, 0, stream>>>(p, 0, MT);
    k_gemm<G_GU><<<NG, blk, GLDS, stream>>>(p, 0);
    k_gemm<G_DN><<<NG, blk, GLDS, stream>>>(p, 0);
    k_combine<<<NW, blk, 0, stream>>>(p, 0, MT);
    k_norm<<<NW, blk, 0, stream>>>(p, 1, MT);
    k_gemm<G_IN1><<<NG, blk, GLDS, stream>>>(p, 1);
    k_s5<<<NW, blk, 0, stream>>>(p);
    k_gemm<G_GLU><<<NG, blk, GLDS, stream>>>(p, 1);
    k_gemm<G_OUT1><<<NG, blk, GLDS, stream>>>(p, 1);
    k_router<<<NW, blk, 0, stream>>>(p, 1, ML);
    k_dispatch<<<NW, blk, 0, stream>>>(p, 1, ML);
    k_gemm<G_GU><<<NG, blk, GLDS, stream>>>(p, 1);
    k_gemm<G_DN><<<NG, blk, GLDS, stream>>>(p, 1);
    k_combine<<<NW, blk, 0, stream>>>(p, 1, ML);
    k_final<<<NW, blk, 0, stream>>>(p);
#else
    static int grid = 0;
    if (!grid) {
        int dev = 0, cus = 0, per_cu = 0;
        if (hipGetDevice(&dev) != hipSuccess || hipDeviceGetAttribute(&cus, hipDeviceAttributeMultiprocessorCount, dev) != hipSuccess) { fprintf(stderr, "kernel_launch: device query failed\n"); return; }
        if (hipFuncSetAttribute((const void*)k_mega, hipFuncAttributeMaxDynamicSharedMemorySize, MEGA_LDS) != hipSuccess) { fprintf(stderr, "kernel_launch: hipFuncSetAttribute failed\n"); return; }
        if (hipOccupancyMaxActiveBlocksPerMultiprocessor(&per_cu, (const void*)k_mega, 512, MEGA_LDS) != hipSuccess || per_cu < 1) { fprintf(stderr, "kernel_launch: occupancy query says %d\n", per_cu); return; }
        grid = cus < MAXG ? cus : MAXG;
    }
    const Params p = make_params(d_in, d_out, d_ws);
    (void)hipMemsetAsync(d_ws, 0, WS_ADA, stream);
    hipLaunchKernelGGL(k_mega, dim3(grid), dim3(512), MEGA_LDS, stream, p);
#endif
}
#endif
```

```cpp
#ifndef CPU_EMU
#include <hip/hip_runtime.h>
#include <cstdio>
#include <cstdint>
#endif

#ifndef BATCH
#define BATCH 4
#endif
#ifndef SEQ
#define SEQ 4096
#endif
#ifndef CTX_LEN
#define CTX_LEN 256
#endif
constexpr int D = 2048, NB = BATCH, NSEQ = SEQ, NCTX = CTX_LEN;
constexpr int ML = NB * NSEQ, MC = NB * NCTX, MT = ML + MC;
constexpr int NADA = NB + 1;
constexpr int QW = 1024, KVW = 256, LW = 1024, EVIN = 3584;
constexpr int COL_Q = 0, COL_K = 1024, COL_V = 1280, COL_XR = 1536, COL_GR = 2560;
constexpr int S5W = 1024, S5G = 64, S5C = 16, S5S = 64;
constexpr int NE = 16, FF = 1024;
constexpr int NBLK = (2 * MT + 255) / 256 + NE;
constexpr int ADA6 = 6 * D;
static_assert(ML % 256 == 0 && MC % 256 == 0 && NSEQ % 256 == 0 && NCTX % 256 == 0, "tiles must not straddle sequences");

typedef unsigned short bf16_t;
#ifndef CPU_EMU
#define LAS __attribute__((address_space(3)))
__device__ __forceinline__ int tid_of(int wv) { int l; asm volatile("v_mbcnt_lo_u32_b32 %0, -1, 0\n\tv_mbcnt_hi_u32_b32 %0, -1, %0" : "=v"(l)); return wv * 64 + l; }
#endif

#ifdef CPU_EMU
constexpr bool MOE1_FP8 = false, MOE0_FP8 = false, DENSE1_FP8 = false, IN0_FP8 = false, IN0QKV_FP8 = false, OUT0_FP8 = false, RES_BF16 = false, Y8 = false;
#else
constexpr bool Y8 = true;
constexpr bool RES_BF16 = true; constexpr bool IN0_FP8 = false, IN0QKV_FP8 = true, OUT0_FP8 = true;
constexpr bool DENSE1_FP8 = true;
constexpr bool MOE0_FP8 = true;
constexpr bool MOE1_FP8 = true;
#endif
constexpr float W8_SCALE = 64.0f, ACT8_SCALE = 4.0f;
constexpr int W8_E8M0 = 127 - 6, ACT8_E8M0 = 127 - 2, ONE_E8M0 = 127;
constexpr float Z8_SCALE = 8.0f, S8_SCALE = 16.0f, MIX8_SCALE = 16.0f, Y8_SCALE = 16.0f; constexpr int Z8_E8M0 = 127 - 3, S8_E8M0 = 127 - 4, MIX8_E8M0 = 127 - 4;

constexpr size_t al256(size_t x) { return (x + 255) & ~(size_t)255; }
constexpr size_t WS_BAR = 0;
constexpr size_t WS_CNT = 16384;
constexpr size_t WS_ADA = 32768;
constexpr size_t CTL_BYTES = al256(WS_ADA + (size_t)2 * NADA * ADA6 * 4);
constexpr size_t WS_ROPE = CTL_BYTES;
constexpr size_t WS_S5LAM = WS_ROPE + 64 * 16 * 8;
constexpr size_t WS_S5BB = WS_S5LAM + (size_t)2 * S5G * S5S * 8;
constexpr size_t WS_S5LAMT = WS_S5BB + (size_t)2 * S5G * S5S * S5C * 8;
constexpr size_t WS_S5BF = WS_S5LAMT + (size_t)2 * S5G * S5S * 8;
constexpr size_t WS_S5CF = WS_S5BF + (size_t)2 * S5G * 4 * 64 * 16;
constexpr size_t WS_LRUBF = WS_S5CF + (size_t)2 * S5G * 4 * 64 * 16;
constexpr size_t WS_RWF = WS_LRUBF + (size_t)2 * 16 * 2 * 2 * 4 * 64 * 16;
constexpr size_t WS_WT_IN0 = al256(WS_RWF + (size_t)2 * 64 * 64 * 16);
constexpr size_t WS_WT_OUT0 = WS_WT_IN0 + (size_t)EVIN * D * 2;
constexpr size_t WS_WT_IN1 = WS_WT_OUT0 + (size_t)D * D * 2;
constexpr size_t WS_WT_GLU = WS_WT_IN1 + (size_t)S5W * D * 2;
constexpr size_t WS_WT_OUT1 = WS_WT_GLU + (size_t)S5W * S5W * 2;
constexpr size_t WS_WT_GU = WS_WT_OUT1 + (size_t)D * S5W * 2;
constexpr size_t WS_WT_DN = WS_WT_GU + (size_t)2 * NE * 2 * FF * D * 2;
constexpr size_t WS_W8_GU = WS_WT_GU + (size_t)NE * 2 * FF * D * 2;
constexpr size_t WS_W8_DN = WS_WT_DN + (size_t)NE * D * FF * 2;
constexpr size_t WS_XRES = WS_WT_DN + (size_t)2 * NE * D * FF * 2;
constexpr size_t WS_H8 = WS_XRES + (size_t)MT * D * 2;
constexpr size_t WS_H = WS_XRES + (size_t)MT * D * 4;
constexpr size_t WS_TOK = WS_H + (size_t)MT * D * 2;
constexpr size_t WS_ROWIDX = WS_TOK + (size_t)4 * MT * 2 * 4;
constexpr size_t WS_RA = al256(WS_ROWIDX + (size_t)NBLK * 256 * 4);
constexpr size_t WS_QKV = WS_RA;
constexpr size_t WS_MIX = WS_QKV + (size_t)MT * EVIN * 2;
constexpr size_t WS_U1 = WS_RA;
constexpr size_t WS_YS5 = WS_U1 + (size_t)MT * S5W * 2;
constexpr size_t WS_Z = WS_YS5 + (size_t)ML * S5W * 4;
constexpr size_t WS_S = WS_Z + (size_t)ML * S5W * 2;
constexpr int S5_CHUNK = 128, S5_NCC = NCTX / S5_CHUNK, S5_NLC = NSEQ / S5_CHUNK, S5_NCH = S5_NCC + S5_NLC;
static_assert(S5_NCC % 2 == 0 && S5_NLC % 2 == 0, "chunks are processed in pairs");
constexpr size_t WS_S5E = WS_S + (size_t)ML * S5W * 2;
constexpr size_t RA_BYTES = (size_t)MT * EVIN * 2 + (size_t)MT * D * 2;
static_assert(WS_S5E + (size_t)NB * S5G * 2 * S5_NCH * S5S * 8 <= WS_RA + RA_BYTES, "L1 overlay (E)");
static_assert((size_t)MT * S5W * 2 + (size_t)ML * S5W * 4 + 2 * (size_t)ML * S5W * 2 <= RA_BYTES, "L1 overlay");
constexpr size_t WS_RB = al256(WS_RA + RA_BYTES);
constexpr size_t WS_ACT = WS_RB;
constexpr size_t WS_YBUF = WS_ACT + (size_t)NBLK * 256 * FF * 2;
constexpr size_t WS_UCONV = WS_RB;
constexpr size_t WS_HSUM = WS_UCONV + (size_t)MT * LW * 4;
constexpr size_t RB_BYTES = (size_t)NBLK * 256 * FF * 2 + (size_t)NBLK * 256 * D * 2;
static_assert(2 * (size_t)MT * LW * 4 <= RB_BYTES, "LRU overlay");
constexpr size_t WS_UBF = WS_RB;
constexpr int VT_T = 128 + NSEQ + 128 + NCTX;
constexpr size_t WS_VT = WS_UBF + (size_t)MT * LW * 2;
constexpr size_t WS_LRUAGG = al256(WS_VT + (size_t)NB * 4 * 64 * VT_T * 2);
constexpr int LRU_CH = 64, LRU_NCC = NCTX / LRU_CH, LRU_NLC = NSEQ / LRU_CH, LRU_NCH = LRU_NCC + LRU_NLC;
static_assert(LRU_NCC % 2 == 0 && LRU_NLC % 2 == 0, "chunks are processed in pairs");
static_assert(WS_LRUAGG + (size_t)NB * 2 * LRU_NCH * LW * 8 <= WS_RB + RB_BYTES, "RB overlay");
constexpr int MAXG = 256;
constexpr int HIST_LD = 32;
constexpr size_t WS_HIST = al256(WS_RB + RB_BYTES);
constexpr size_t WS_END = WS_HIST + (size_t)2 * MAXG * HIST_LD * 4;

struct Params {
    const float *x, *c, *ctx, *c_ctx, *ada_w, *ada_b, *norm_mix, *norm_ffn, *norm_final;
    const float *ev_w_in, *ev_w_out, *attn_sink, *lru_conv_w, *lru_conv_b, *lru_lam, *lru_wa, *lru_ba, *lru_wi, *lru_bi;
    const float *od_w_in, *s5_lam_re, *s5_lam_im, *s5_log_step, *s5_b_re, *s5_b_im, *s5_c_re, *s5_c_im, *s5_d, *s5_glu_w, *s5_glu_b, *od_w_out;
    const float *router_w, *router_b, *moe_w_gate, *moe_w_up, *moe_w_down;
    float* out;
    unsigned char* ws;
};

#ifdef CPU_EMU
typedef float f32x4 __attribute__((vector_size(16)));
#else
typedef float f32x4 __attribute__((ext_vector_type(4)));
#endif
struct u32x2_t { unsigned x, y; };
struct u32x4_t { unsigned x, y, z, w; };
#ifdef CPU_EMU
__device__ __forceinline__ void st_coh(int* p, int v) { *p = v; }
__device__ __forceinline__ int ld_coh(const int* p) { return *p; }
#else
__device__ __forceinline__ void st_coh(int* p, int v) { __hip_atomic_store(p, v, __ATOMIC_RELAXED, __HIP_MEMORY_SCOPE_AGENT); }
__device__ __forceinline__ int ld_coh(const int* p) { return __hip_atomic_load(p, __ATOMIC_RELAXED, __HIP_MEMORY_SCOPE_AGENT); }
#endif
__device__ __forceinline__ f32x4 unpack4bf(unsigned lo, unsigned hi) { return (f32x4){__uint_as_float(lo << 16), __uint_as_float(lo & 0xffff0000u), __uint_as_float(hi << 16), __uint_as_float(hi & 0xffff0000u)}; }
__device__ __forceinline__ float bf2f(bf16_t b) { return __uint_as_float(((unsigned)b) << 16); }
__device__ __forceinline__ bf16_t f2bf(float f) { unsigned u = __float_as_uint(f); u += 0x7FFFu + ((u >> 16) & 1u); return (bf16_t)(u >> 16); }
#ifdef CPU_EMU
__device__ __forceinline__ unsigned pack2bf(float lo, float hi) { return (unsigned)f2bf(lo) | ((unsigned)f2bf(hi) << 16); }
#else
typedef short s5_bf16x8 __attribute__((ext_vector_type(8)));
typedef unsigned u4v_t __attribute__((ext_vector_type(4)));
__device__ __forceinline__ int deal_item(int round, int gwave, int nwaves, int items, int grp = 2) {
    const int full = items / nwaves; if (round < full) return round * nwaves + gwave; if (round > full) return -1;
    const int rem = items - full * nwaves, blk = gwave >> 3, wv = gwave & 7; if (wv >= grp) return -1; const int j = blk * grp + wv; return j < rem ? full * nwaves + j : -1; }
#ifndef CPU_EMU
__device__ __forceinline__ float clamp_e4m3(float x) { return fminf(fmaxf(x, -448.0f), 448.0f); }
__device__ __forceinline__ unsigned pack4_fp8(float a, float b, float c, float d) { int w = 0; w = __builtin_amdgcn_cvt_pk_fp8_f32(clamp_e4m3(a), clamp_e4m3(b), w, false); w = __builtin_amdgcn_cvt_pk_fp8_f32(clamp_e4m3(c), clamp_e4m3(d), w, true); return (unsigned)w; }
#endif
__device__ __forceinline__ float opaque_zero() { float z = 0.f; asm volatile("" : "+v"(z)); return z; }
#define MFMA_KEEP(acc, x) asm volatile("" : "+v"(acc) : "v"(x))
typedef __bf16 bf16x2_hw __attribute__((ext_vector_type(2)));
typedef float f32x2_hw __attribute__((ext_vector_type(2)));
__device__ __forceinline__ unsigned pack2bf(float lo, float hi) { const f32x2_hw v = {lo, hi}; const bf16x2_hw b = __builtin_convertvector(v, bf16x2_hw); return __builtin_bit_cast(unsigned, b); }
#endif
#ifdef CPU_EMU
__device__ __forceinline__ float sigmoidf_(float x) { return 1.0f / (1.0f + __expf(-x)); }
__device__ __forceinline__ float fast_rcp(float x) { return 1.0f / x; }
__device__ __forceinline__ float fast_sqrt(float x) { return sqrtf(x); }
#else
__device__ __forceinline__ float fast_rcp(float x) { return __builtin_amdgcn_rcpf(x); }
__device__ __forceinline__ float fast_sqrt(float x) { return __builtin_amdgcn_sqrtf(x); }
__device__ __forceinline__ float sigmoidf_(float x) { return __builtin_amdgcn_rcpf(1.0f + __builtin_amdgcn_exp2f(-1.44269504089f * x)); }
#endif
__device__ __forceinline__ float siluf_(float x) { return x * sigmoidf_(x); }
#ifdef CPU_EMU
__device__ __forceinline__ float geluf_(float x) { const float u = 0.7978845608028654f * (x + 0.044715f * x * x * x); return 0.5f * x * (1.0f + tanhf(u)); }
#else
__device__ __forceinline__ float geluf_(float x) { const float t = x * x, e = __builtin_amdgcn_exp2f(x * __builtin_fmaf(t, -0.102943215f, -2.302208198f)); return x * __builtin_amdgcn_rcpf(1.0f + e); }
#endif
__device__ __forceinline__ float softplusf_(float x) { return x > 20.f ? x : log1pf(__expf(x)); }
__device__ __forceinline__ int ada_row(int r) { return r < ML ? r / NSEQ : NB; }
__device__ __forceinline__ const float* ada_ptr(const Params& p, int l, int arow, int which) { return (const float*)(p.ws + WS_ADA) + ((size_t)l * NADA + arow) * ADA6 + (size_t)which * D; }
__device__ __forceinline__ const float* xin_row(const Params& p, int l, int r) {
    if (l == 0) return r < ML ? p.x + (size_t)r * D : p.ctx + (size_t)(r - ML) * D;
    return (const float*)(p.ws + WS_XRES) + (size_t)r * D;
}

#ifndef CPU_EMU
constexpr int ADA_ITEMS = 2 * (ADA6 / 128), ADA_LDS_BYTES = (NADA * D + 16 * NADA * 128) * 4;
__device__ __forceinline__ void ph_ada(const Params& p, float* sil, int bid, int nblocks, int wv_) {
    const int tid = tid_of(wv_), w = wv_, lane = tid & 63, kh = lane >> 5, cq = lane & 31;
    float* ada = (float*)(p.ws + WS_ADA); float* red = sil + NADA * D;
    if (bid < ADA_ITEMS) { for (int i = tid; i < NADA * D; i += 512) { const int r = i / D, k = i % D; sil[i] = siluf_(r < NB ? p.c[(size_t)r * D + k] : p.c_ctx[k]); } }
    __syncthreads();
    for (int item = bid; item < ADA_ITEMS; item += nblocks) {
        const int l = item / (ADA6 / 128), cb = (item % (ADA6 / 128)) * 128, c0 = cb + cq * 4;
        f32x4 acc[NADA];
#pragma unroll
        for (int r = 0; r < NADA; ++r) acc[r] = (f32x4){0.f, 0.f, 0.f, 0.f};
        const float* wp = p.ada_w + (size_t)l * D * ADA6 + c0; const int k0 = w * 256 + kh * 128;
#pragma unroll 16
        for (int k = k0; k < k0 + 128; ++k) {
            const f32x4 wv = *(const f32x4*)(wp + (size_t)k * ADA6);
#pragma unroll
            for (int r = 0; r < NADA; ++r) acc[r] += wv * sil[r * D + k];
        }
        __syncthreads();
#pragma unroll
        for (int r = 0; r < NADA; ++r) *(f32x4*)(red + ((size_t)((w * 2 + kh) * NADA + r) * 128) + cq * 4) = acc[r];
        __syncthreads();
        for (int i = tid; i < NADA * 128; i += 512) { const int r = i / 128, cc = i % 128; float sacc = p.ada_b[(size_t)l * ADA6 + cb + cc];
#pragma unroll
            for (int ww = 0; ww < 16; ++ww) sacc += red[(size_t)(ww * NADA + r) * 128 + cc];
            ada[((size_t)l * NADA + r) * ADA6 + cb + cc] = sacc; }
    }
}
#else
void ph_ada_emu(const Params& p) {
    float* ada = (float*)(p.ws + WS_ADA);
    for (int l = 0; l < 2; ++l) for (int r = 0; r < NADA; ++r) { std::vector<double> acc(ADA6, 0.0);
        for (int k = 0; k < D; ++k) { const float cv = r < NB ? p.c[(size_t)r * D + k] : p.c_ctx[k]; const double sv = siluf_(cv); const float* wr = p.ada_w + ((size_t)l * D + k) * ADA6; for (int j = 0; j < ADA6; ++j) acc[j] += sv * wr[j]; }
        for (int j = 0; j < ADA6; ++j) ada[((size_t)l * NADA + r) * ADA6 + j] = (float)acc[j] + p.ada_b[(size_t)l * ADA6 + j]; }
}
#endif
__device__ __forceinline__ void ph_tables(const Params& p, long gtid, long gthreads) {
    float* rope = (float*)(p.ws + WS_ROPE);
    for (long it = gtid; it < 64 * 16; it += gthreads) {
        const int pos = (int)(it / 16), i = (int)(it % 16);
        const double inv = pow(10000.0, -(double)i / 16.0); const double a = (double)pos * (double)(float)inv;
        rope[it * 2] = (float)cos(a); rope[it * 2 + 1] = (float)sin(a);
    }
    float* lamb = (float*)(p.ws + WS_S5LAM); float* bb = (float*)(p.ws + WS_S5BB);
    for (long it = gtid; it < 2L * S5G * S5S; it += gthreads) {
        const int g = (int)((it / S5S) % S5G), d = (int)(it / (S5S * S5G));
        const double lr = p.s5_lam_re[it], li = p.s5_lam_im[it], step = exp((double)p.s5_log_step[d * S5G + g]);
        const double mag = exp(lr * step), br = mag * cos(li * step), bi = mag * sin(li * step);
        lamb[it * 2] = (float)br; lamb[it * 2 + 1] = (float)bi;
        const double nr = br - 1.0, ni = bi, den = lr * lr + li * li;
        const double cr = (nr * lr + ni * li) / den, ci = (ni * lr - nr * li) / den;
        float b_r[S5C], b_i[S5C];
#pragma unroll
        for (int c = 0; c < S5C; ++c) { b_r[c] = p.s5_b_re[it * S5C + c]; b_i[c] = p.s5_b_im[it * S5C + c]; }
#pragma unroll
        for (int c = 0; c < S5C; ++c) { bb[(it * S5C + c) * 2] = (float)(cr * (double)b_r[c] - ci * (double)b_i[c]); bb[(it * S5C + c) * 2 + 1] = (float)(cr * (double)b_i[c] + ci * (double)b_r[c]); }
        const double magT = exp(lr * step * S5_CHUNK); float* lt = (float*)(p.ws + WS_S5LAMT);
        lt[it * 2] = (float)(magT * cos(li * step * S5_CHUNK)); lt[it * 2 + 1] = (float)(magT * sin(li * step * S5_CHUNK));
    }
    { bf16_t* rw = (bf16_t*)(p.ws + WS_RWF);
      for (long it = gtid; it < 64L * 64 * 8; it += gthreads) { const int j = (int)(it & 7), lane = (int)((it >> 3) & 63), st = (int)(it >> 9);
          const float wv = p.router_w[(size_t)(32 * st + 8 * (lane >> 4) + j) * NE + (lane & 15)]; const bf16_t hi = f2bf(wv); rw[it] = hi; rw[64L * 64 * 8 + it] = f2bf(wv - bf2f(hi)); } }
    bf16_t* lb = (bf16_t*)(p.ws + WS_LRUBF);
    for (long it = gtid; it < 2L * 16 * 2 * 2 * 4 * 64 * 8; it += gthreads) {
        const int j = (int)(it & 7), lane = (int)((it >> 3) & 63), ks = (int)((it >> 9) & 3), cs = (int)((it >> 11) & 1), gate = (int)((it >> 12) & 1); const long dh = it >> 13;
        const float* w = gate ? p.lru_wi : p.lru_wa;
        lb[it] = f2bf(w[((size_t)dh * 64 + 16 * ks + 8 * (lane >> 5) + j) * 64 + 32 * cs + (lane & 31)]);
    }
    bf16_t* bf = (bf16_t*)(p.ws + WS_S5BF); bf16_t* cf = (bf16_t*)(p.ws + WS_S5CF);
    for (long it = gtid; it < 2L * S5G * 4 * 64 * 8; it += gthreads) {
        const int j = (int)(it & 7), lane = (int)((it >> 3) & 63), ct = (int)((it >> 9) & 3); const long dg = it >> 11;
        { const int st = (lane & 31) + 32 * (ct >> 1), ch = 8 * (lane >> 5) + j; const size_t gi = (size_t)dg * S5S + st;
          const double lr = p.s5_lam_re[gi], li = p.s5_lam_im[gi], step = exp((double)p.s5_log_step[dg]);
          const double mag = exp(lr * step), br = mag * cos(li * step), bi = mag * sin(li * step), nr = br - 1.0, ni = bi, den = lr * lr + li * li;
          const double cr = (nr * lr + ni * li) / den, ci = (ni * lr - nr * li) / den, b_r = p.s5_b_re[gi * S5C + ch], b_i = p.s5_b_im[gi * S5C + ch];
          bf[it] = f2bf((float)((ct & 1) ? (cr * b_i + ci * b_r) : (cr * b_r - ci * b_i))); }
        { const int ks = ct, q = 32 * ks + 8 * (lane >> 4) + j, st = q >> 1, ch = lane & 15; const size_t ci_ = ((size_t)dg * S5C + ch) * S5S + st;
          cf[it] = f2bf((q & 1) ? -p.s5_c_im[ci_] : p.s5_c_re[ci_]); }
    }
}
__device__ __forceinline__ void ph_norm(const Params& p, int l, int rows, long gtid, long gthreads) {
    bf16_t* h = (bf16_t*)(p.ws + WS_H);
    for (long r = gtid; r < rows; r += gthreads) {
        const float* xr = xin_row(p, l, (int)r); const int ar = ada_row((int)r);
        const float* sh = ada_ptr(p, l, ar, 0); const float* sc = ada_ptr(p, l, ar, 1); const float* g = p.norm_mix + (size_t)l * D;
        float ss = 0.f; for (int k = 0; k < D; ++k) ss += xr[k] * xr[k];
        const float rstd = 1.0f / sqrtf(ss / D + 1e-6f);
        for (int k = 0; k < D; ++k) h[(size_t)r * D + k] = f2bf(xr[k] * rstd * g[k] * (1.0f + sc[k]) + sh[k]);
    }
}
__device__ __forceinline__ void ph_conv(const Params& p, long gtid, long gthreads) {
    const bf16_t* qkv = (const bf16_t*)(p.ws + WS_QKV); float* u = (float*)(p.ws + WS_UCONV);
    for (long it = gtid; it < (long)MT * LW; it += gthreads) {
        const int r = (int)(it / LW), ch = (int)(it % LW);
        int base, t, n; if (r < ML) { base = (r / NSEQ) * NSEQ; t = r % NSEQ; n = NSEQ; } else { const int rc = r - ML; base = ML + (rc / NCTX) * NCTX; t = rc % NCTX; n = NCTX; }
        float acc = p.lru_conv_b[ch];
        for (int tap = 0; tap < 4; ++tap) { const int tt = t + tap - 2; if (tt >= 0 && tt < n) acc += p.lru_conv_w[tap * LW + ch] * bf2f(qkv[(size_t)(base + tt) * EVIN + COL_XR + ch]); }
        u[it] = acc;
    }
}
__device__ __forceinline__ void ph_lru(const Params& p, long gtid, long gthreads) {
    const bf16_t* qkv = (const bf16_t*)(p.ws + WS_QKV); const float* u = (const float*)(p.ws + WS_UCONV); float* hs = (float*)(p.ws + WS_HSUM); bf16_t* mix = (bf16_t*)(p.ws + WS_MIX);
    for (long it = gtid; it < (long)NB * LW; it += gthreads) {
        const int b = (int)(it / LW), ch = (int)(it % LW), hh = ch / 64, j = ch % 64;
        for (int d = 0; d < 2; ++d) {
            const float lamv = softplusf_(-p.lru_lam[d * LW + ch]), ba = p.lru_ba[d * LW + ch], bi = p.lru_bi[d * LW + ch];
            const float* wa = p.lru_wa + ((size_t)(d * 16 + hh) * 64) * 64 + j; const float* wi = p.lru_wi + ((size_t)(d * 16 + hh) * 64) * 64 + j;
            float state = 0.f;
            for (int seg = 0; seg < 2; ++seg) {
                const int n = seg ? NSEQ : NCTX, base = seg ? b * NSEQ : ML + b * NCTX;
                for (int stp = 0; stp < n; ++stp) {
                    const int row = base + (d ? n - 1 - stp : stp); const float* ur = u + (size_t)row * LW + hh * 64;
                    float ra = ba, ia = bi;
                    for (int i = 0; i < 64; ++i) { ra += ur[i] * wa[(size_t)i * 64]; ia += ur[i] * wi[(size_t)i * 64]; }
                    const float rg = sigmoidf_(ra), ig = sigmoidf_(ia), log_a = -8.0f * rg * lamv, a = __expf(log_a), mult = sqrtf(-expm1f(2.0f * log_a));
                    state = a * state + mult * (ig * ur[j]);
                    if (d == 0) hs[(size_t)row * LW + ch] = state;
                    else { const float tot = hs[(size_t)row * LW + ch] + state; mix[(size_t)row * D + QW + ch] = f2bf(tot * geluf_(bf2f(qkv[(size_t)row * EVIN + COL_GR + ch]))); }
                }
            }
        }
    }
}
__device__ __forceinline__ void ph_attn(const Params& p, long gtid, long gthreads) {
    const bf16_t* qkv = (const bf16_t*)(p.ws + WS_QKV); bf16_t* mix = (bf16_t*)(p.ws + WS_MIX);
    for (long it = gtid; it < (long)MT * 16; it += gthreads) {
        const int r = (int)(it / 16), hd = (int)(it % 16), kvh = hd / 4;
        float q[64], o[64];
        for (int d = 0; d < 64; ++d) { q[d] = bf2f(qkv[(size_t)r * EVIN + COL_Q + hd * 64 + d]); o[d] = 0.f; }
        float m = p.attn_sink[hd], lsum = 1.0f;
        const int b = r < ML ? r / NSEQ : (r - ML) / NCTX;
        for (int seg = 0; seg < 2; ++seg) {
            int k0, k1;
            if (seg == 0) { if (r >= ML) continue; const int t = r % NSEQ; const int lo = t - 128 < 0 ? 0 : t - 128, hi = t + 128 > NSEQ - 1 ? NSEQ - 1 : t + 128; k0 = b * NSEQ + lo; k1 = b * NSEQ + hi + 1; }
            else { k0 = ML + b * NCTX; k1 = k0 + NCTX; }
            for (int kr = k0; kr < k1; ++kr) {
                const bf16_t* kp = qkv + (size_t)kr * EVIN + COL_K + kvh * 64; const bf16_t* vp = qkv + (size_t)kr * EVIN + COL_V + kvh * 64;
                float s = 0.f; for (int d = 0; d < 64; ++d) s += q[d] * bf2f(kp[d]);
                if (s > m) { const float f = __expf(m - s); lsum *= f; for (int d = 0; d < 64; ++d) o[d] *= f; m = s; }
                const float pe = __expf(s - m); lsum += pe;
                for (int d = 0; d < 64; ++d) o[d] += pe * bf2f(vp[d]);
            }
        }
        const float inv = 1.0f / lsum;
        for (int d = 0; d < 64; ++d) mix[(size_t)r * D + hd * 64 + d] = f2bf(o[d] * inv);
    }
}
__device__ __forceinline__ void ph_router(const Params& p, int l, int rows, long gtid, long gthreads) {
    bf16_t* h = (bf16_t*)(p.ws + WS_H); const float* xres = (const float*)(p.ws + WS_XRES);
    int* tok_e = (int*)(p.ws + WS_TOK); float* tok_w = (float*)(p.ws + WS_TOK) + (size_t)MT * 2; int* tok_slot = (int*)(p.ws + WS_TOK) + (size_t)MT * 4;
    int* cnt = (int*)(p.ws + WS_CNT) + l * 64;
    for (long r = gtid; r < rows; r += gthreads) {
        const float* xr = xres + (size_t)r * D; const int ar = ada_row((int)r);
        const float* sh = ada_ptr(p, l, ar, 3); const float* sc = ada_ptr(p, l, ar, 4); const float* g = p.norm_ffn + (size_t)l * D;
        float ss = 0.f; for (int k = 0; k < D; ++k) ss += xr[k] * xr[k];
        const float rstd = 1.0f / sqrtf(ss / D + 1e-6f);
        float lg[NE];
#pragma unroll
        for (int e = 0; e < NE; ++e) lg[e] = p.router_b[e];
        for (int k = 0; k < D; ++k) { const float hv = xr[k] * rstd * g[k] * (1.0f + sc[k]) + sh[k]; h[(size_t)r * D + k] = f2bf(hv);
#pragma unroll
            for (int e = 0; e < NE; ++e) lg[e] += hv * p.router_w[(size_t)k * NE + e]; }
        float mx = lg[0];
#pragma unroll
        for (int e = 1; e < NE; ++e) mx = lg[e] > mx ? lg[e] : mx;
        float pr[NE], sum = 0.f;
#pragma unroll
        for (int e = 0; e < NE; ++e) { pr[e] = __expf(lg[e] - mx); sum += pr[e]; }
#pragma unroll
        for (int e = 0; e < NE; ++e) pr[e] /= sum;
        float best = -1.f, w1 = 0.f, w2 = 0.f; int e1 = 0, e2 = 0;
#pragma unroll
        for (int gi = 0; gi < 4; ++gi) { float a1 = -1.f, a2 = -1.f; int j1 = 0, j2 = 0;
#pragma unroll
            for (int j = 0; j < 4; ++j) { const float v = pr[gi * 4 + j]; if (v > a1) { a2 = a1; j2 = j1; a1 = v; j1 = j; } else if (v > a2) { a2 = v; j2 = j; } }
            if (a1 + a2 > best) { best = a1 + a2; e1 = gi * 4 + j1; e2 = gi * 4 + j2; w1 = a1; w2 = a2; } }
        const float ws = w1 + w2;
        tok_e[r * 2] = e1; tok_e[r * 2 + 1] = e2; tok_w[r * 2] = w1 / ws; tok_w[r * 2 + 1] = w2 / ws;
        tok_slot[r * 2] = atomicAdd(cnt + e1, 1); tok_slot[r * 2 + 1] = atomicAdd(cnt + e2, 1);
    }
}
__device__ __forceinline__ int moe_pad_start(const int* cnt, int e) { int acc = 0;
#pragma unroll
    for (int j = 0; j < NE; ++j) { const int pj = (cnt[j] + 255) / 256 * 256; acc += (j < e) ? pj : 0; } return acc; }
__device__ __forceinline__ void ph_dispatch(const Params& p, int l, int rows, long gtid, long gthreads) {
    const int* tok_e = (const int*)(p.ws + WS_TOK); const int* tok_slot = (const int*)(p.ws + WS_TOK) + (size_t)MT * 4; int* tok_dest = (int*)(p.ws + WS_TOK) + (size_t)MT * 6;
    int* rowidx = (int*)(p.ws + WS_ROWIDX); const int* cnt = (const int*)(p.ws + WS_CNT) + l * 64;
    for (long it = gtid; it < (long)rows * 2; it += gthreads) { const int e = tok_e[it], dest = moe_pad_start(cnt, e) + tok_slot[it]; tok_dest[it] = dest; st_coh(rowidx + dest, (int)(it / 2)); }
    const int total = moe_pad_start(cnt, NE);
    for (long it = gtid; it < total; it += gthreads) { int acc = 0, st = 0, ce = 0;
#pragma unroll
        for (int j = 0; j < NE; ++j) { const int pj = (cnt[j] + 255) / 256 * 256; if (it >= acc && it < acc + pj) { st = acc; ce = cnt[j]; } acc += pj; }
        if (it - st >= ce) st_coh(rowidx + it, 0); }
}
__device__ __forceinline__ void ph_combine(const Params& p, int l, int rows, long gtid, long gthreads) {
    float* xres = (float*)(p.ws + WS_XRES); const bf16_t* yb = (const bf16_t*)(p.ws + WS_YBUF);
    const float* tok_w = (const float*)(p.ws + WS_TOK) + (size_t)MT * 2; const int* tok_dest = (const int*)(p.ws + WS_TOK) + (size_t)MT * 6;
    for (long it = gtid; it < (long)rows * (D / 4); it += gthreads) {
        const int r = (int)(it / (D / 4)), c = (int)(it % (D / 4)) * 4; const float* g2 = ada_ptr(p, l, ada_row(r), 5);
        const int d0 = tok_dest[r * 2], d1 = tok_dest[r * 2 + 1]; const float w0 = tok_w[r * 2], w1 = tok_w[r * 2 + 1];
        for (int j = 0; j < 4; ++j) xres[(size_t)r * D + c + j] += g2[c + j] * (w0 * bf2f(yb[(size_t)d0 * D + c + j]) + w1 * bf2f(yb[(size_t)d1 * D + c + j]));
    }
}
__device__ __forceinline__ void ph_s5(const Params& p, long gtid, long gthreads) {
    const bf16_t* u1 = (const bf16_t*)(p.ws + WS_U1); float* ys = (float*)(p.ws + WS_YS5); bf16_t* z = (bf16_t*)(p.ws + WS_Z);
    const float* lamb = (const float*)(p.ws + WS_S5LAM); const float* bb = (const float*)(p.ws + WS_S5BB);
    for (long it = gtid; it < (long)NB * S5W; it += gthreads) {
        const int b = (int)(it / S5W), col = (int)(it % S5W), g = col / S5C, c = col % S5C;
        for (int t = 0; t < NSEQ; ++t) { const size_t row = (size_t)b * NSEQ + t; ys[row * S5W + col] = p.s5_d[col] * bf2f(u1[row * S5W + col]); }
        for (int d = 0; d < 2; ++d)
            for (int s = 0; s < S5S; ++s) {
                const size_t gi = ((size_t)d * S5G + g) * S5S + s;
                const float lr = lamb[gi * 2], li = lamb[gi * 2 + 1];
                const float cr = p.s5_c_re[(((size_t)d * S5G + g) * S5C + c) * S5S + s], ci = p.s5_c_im[(((size_t)d * S5G + g) * S5C + c) * S5S + s];
                float br[S5C], bi[S5C]; for (int cc = 0; cc < S5C; ++cc) { br[cc] = bb[(gi * S5C + cc) * 2]; bi[cc] = bb[(gi * S5C + cc) * 2 + 1]; }
                float xr = 0.f, xi = 0.f;
                for (int seg = 0; seg < 2; ++seg) {
                    const int n = seg ? NSEQ : NCTX, base = seg ? b * NSEQ : ML + b * NCTX;
                    for (int stp = 0; stp < n; ++stp) {
                        const size_t row = (size_t)base + (d ? n - 1 - stp : stp); const bf16_t* ur = u1 + row * S5W + g * S5C;
                        float bur = 0.f, bui = 0.f; for (int cc = 0; cc < S5C; ++cc) { const float uv = bf2f(ur[cc]); bur += br[cc] * uv; bui += bi[cc] * uv; }
                        const float nr = lr * xr - li * xi + bur, ni = lr * xi + li * xr + bui; xr = nr; xi = ni;
                        if (seg) ys[row * S5W + col] += cr * xr - ci * xi;
                    }
                }
            }
        for (int t = 0; t < NSEQ; ++t) { const size_t row = (size_t)b * NSEQ + t; z[row * S5W + col] = f2bf(geluf_(ys[row * S5W + col])); }
    }
}
#ifndef CPU_EMU
typedef float s5_f32x16 __attribute__((ext_vector_type(16)));
constexpr int S5_XPITCH = 272, S5_XBYTES = 32 * S5_XPITCH, S5_ABYTES = 1024  , S5_WAVE_LDS = S5_XBYTES + S5_ABYTES + 8 * 2 * 64 * 8;
static_assert(8 * S5_WAVE_LDS <= 147456 - 64, "S5 LDS");
__device__ __forceinline__ int s5_chunk_row0(int b, int k) { return k < S5_NCC ? ML + b * NCTX + k * S5_CHUNK : b * NSEQ + (k - S5_NCC) * S5_CHUNK; }
__device__ __forceinline__ int s5_order(int d, int k) { return d == 0 ? k : (k < S5_NCC ? S5_NCC - 1 - k : S5_NCC + (S5_NLC - 1 - (k - S5_NCC))); }
template <int PASS> __device__ __forceinline__ void ph_s5_fast(const Params& p, LAS unsigned char* lds, int gwave, int nwaves, int wv_) {
    const int lane = tid_of(wv_) & 63, wv = wv_;
    LAS unsigned char* xl = lds + wv * S5_WAVE_LDS;
    const int r = lane & 31, hh = lane >> 5, a_half = (r >> 2) & 1, a_n = (r & 3) + 4 * (r >> 3), tk = lane & 15, q4 = lane >> 4;
    const bf16_t* u1 = (const bf16_t*)(p.ws + WS_U1); bf16_t* z = (bf16_t*)(p.ws + WS_Z); float* ys = (float*)(p.ws + WS_YS5);
    const float* lamb = (const float*)(p.ws + WS_S5LAM); const float* lamt = (const float*)(p.ws + WS_S5LAMT);
    const s5_bf16x8* BF = (const s5_bf16x8*)(p.ws + WS_S5BF); const s5_bf16x8* CF = (const s5_bf16x8*)(p.ws + WS_S5CF);
    float* E = (float*)(p.ws + WS_S5E);
    constexpr int P0 = PASS == 2 ? S5_NCC / 2 : 0, NPAIR = S5_NCH / 2 - P0;
    for (int rd = 0; rd <= (NB * S5G * NPAIR) / nwaves; ++rd) {
        const int it = deal_item(rd, gwave, nwaves, NB * S5G * NPAIR); if (it < 0) continue;
        const int g = it % S5G, pr = P0 + (it / S5G) % NPAIR, b = it / (NPAIR * S5G);
        const int k_s = 2 * pr + hh, k_a = 2 * pr + a_half;
        const int rb_a = s5_chunk_row0(b, k_a);
#pragma unroll
        for (int d = 0; d < 2; ++d) {
            const size_t dg = (size_t)d * S5G + g;
            s5_bf16x8 bfr[4], cfr[4];
#pragma unroll
            for (int ct = 0; ct < 4; ++ct) { bfr[ct] = BF[(dg * 4 + ct) * 64 + lane]; if (PASS == 2) cfr[ct] = CF[(dg * 4 + ct) * 64 + lane]; }
            const float l0r = lamb[(dg * S5S + r) * 2], l0i = lamb[(dg * S5S + r) * 2 + 1], l1r = lamb[(dg * S5S + r + 32) * 2], l1i = lamb[(dg * S5S + r + 32) * 2 + 1];
            LAS unsigned char* aslot = xl + S5_XBYTES;
#define S5_DMA(tile_) __builtin_amdgcn_global_load_lds((const unsigned*)(u1 + (size_t)(rb_a + (tile_) * 16 + a_n) * S5W + g * S5C + 8 * hh), (LAS unsigned*)aslot, 16, 0, 0)
            asm volatile("s_waitcnt lgkmcnt(0)" ::: "memory");
            S5_DMA(d ? 7 : 0);
            const int uL = ((tk & 3) | ((tk >> 2) << 3)) + 32 * (q4 >> 1);
            const f32x4 dsk = *(const f32x4*)(p.s5_d + g * S5C + 4 * q4);
            float x0r = 0.f, x0i = 0.f, x1r = 0.f, x1i = 0.f;
            float* Eb = E + (((size_t)(b * S5G + g) * 2 + d) * S5_NCH) * S5S * 2;
            if (PASS == 2) {
                const float t0r = lamt[(dg * S5S + r) * 2], t0i = lamt[(dg * S5S + r) * 2 + 1], t1r = lamt[(dg * S5S + r + 32) * 2], t1i = lamt[(dg * S5S + r + 32) * 2 + 1];
                const int oi = s5_order(d, k_s);
                const int oa = s5_order(d, 2 * pr), ob = s5_order(d, 2 * pr + 1), oimax = oa > ob ? oa : ob;
                for (int j0 = 0; j0 < oimax; j0 += 4) { float e0r[4], e0i[4], e1r[4], e1i[4];
#pragma unroll
                    for (int k = 0; k < 4; ++k) { const int jc = j0 + k < S5_NCH ? j0 + k : S5_NCH - 1; e0r[k] = Eb[(jc * S5S + r) * 2]; e0i[k] = Eb[(jc * S5S + r) * 2 + 1]; e1r[k] = Eb[(jc * S5S + r + 32) * 2]; e1i[k] = Eb[(jc * S5S + r + 32) * 2 + 1]; }
                    asm volatile("" : "+v"(e0r[0]), "+v"(e0r[1]), "+v"(e0r[2]), "+v"(e0r[3]), "+v"(e0i[0]), "+v"(e0i[1]), "+v"(e0i[2]), "+v"(e0i[3]), "+v"(e1r[0]), "+v"(e1r[1]), "+v"(e1r[2]), "+v"(e1r[3]), "+v"(e1i[0]), "+v"(e1i[1]), "+v"(e1i[2]), "+v"(e1i[3]));
#pragma unroll
                    for (int k = 0; k < 4; ++k) { const float n0r = t0r * x0r - t0i * x0i + e0r[k], n0i = t0r * x0i + t0i * x0r + e0i[k], n1r = t1r * x1r - t1i * x1i + e1r[k], n1i = t1r * x1i + t1i * x1r + e1i[k];
                        if (j0 + k < oi) { x0r = n0r; x0i = n0i; x1r = n1r; x1i = n1i; } } }
            }
#pragma unroll 1
            for (int i = 0; i < 8; ++i) {
                const int tile = d ? 7 - i : i;
                if (PASS == 2 && d == 1 && i > 0) asm volatile("s_waitcnt vmcnt(2)" ::: "memory"); else asm volatile("s_waitcnt vmcnt(0)" ::: "memory");
                const s5_bf16x8 a = *(const LAS s5_bf16x8*)(aslot + lane * 16);
                typedef unsigned s5_u2v __attribute__((ext_vector_type(2))); u32x2_t uu0, uu1; if (PASS == 2 && d == 0) { const s5_u2v t0 = *(const LAS s5_u2v*)(aslot + uL * 16 + (q4 & 1) * 8), t1 = *(const LAS s5_u2v*)(aslot + (uL + 4) * 16 + (q4 & 1) * 8); uu0.x = t0[0]; uu0.y = t0[1]; uu1.x = t1[0]; uu1.y = t1[1]; }
                asm volatile("s_waitcnt lgkmcnt(0)" ::: "memory");
                if (i + 1 < 8) S5_DMA(d ? tile - 1 : tile + 1);
                s5_f32x16 acc[4];
#pragma unroll
                for (int ct = 0; ct < 4; ++ct) { const float z0 = opaque_zero(); s5_f32x16 zz;
#pragma unroll
                    for (int e = 0; e < 16; ++e) zz[e] = z0;
                    acc[ct] = __builtin_amdgcn_mfma_f32_32x32x16_bf16(a, bfr[ct], zz, 0, 0, 0); }
                MFMA_KEEP(acc[3], a);
#pragma unroll
                for (int nn = 0; nn < 16; ++nn) {
                    const int n = d ? 15 - nn : nn;
                    float n0r = __builtin_fmaf(l0r, x0r, __builtin_fmaf(-l0i, x0i, acc[0][n])), n0i = __builtin_fmaf(l0r, x0i, __builtin_fmaf(l0i, x0r, acc[1][n])), n1r = __builtin_fmaf(l1r, x1r, __builtin_fmaf(-l1i, x1i, acc[2][n])), n1i = __builtin_fmaf(l1r, x1i, __builtin_fmaf(l1i, x1r, acc[3][n]));
                    asm volatile("" : "+v"(n0r), "+v"(n0i), "+v"(n1r), "+v"(n1i));
                    x0r = n0r; x0i = n0i; x1r = n1r; x1i = n1i;
                    if (PASS == 2) { *(LAS unsigned*)(xl + (hh * 16 + n) * S5_XPITCH + 4 * r) = pack2bf(x0r, x0i); *(LAS unsigned*)(xl + (hh * 16 + n) * S5_XPITCH + 4 * (r + 32)) = pack2bf(x1r, x1i); }
                }
                if (PASS == 2) asm volatile("" ::: "memory");
                if (PASS == 2) {
#pragma unroll
                    for (int rg = 0; rg < 2; ++rg) {
                        const size_t row = (size_t)s5_chunk_row0(b, 2 * pr + rg) + tile * 16 + tk; const size_t off = row * S5W + g * S5C + 4 * q4;
                        f32x4 yv; LAS u32x2_t* ypark = (LAS u32x2_t*)(xl + S5_XBYTES + S5_ABYTES) + (tile * 2 + rg) * 64 + lane;
                        if (d == 0) { const u32x2_t uu = rg ? uu1 : uu0;
                            yv = (f32x4){dsk[0] * __uint_as_float(uu.x << 16), dsk[1] * __uint_as_float(uu.x & 0xffff0000u), dsk[2] * __uint_as_float(uu.y << 16), dsk[3] * __uint_as_float(uu.y & 0xffff0000u)}; }
                        else { const unsigned y01 = ypark->x, y23 = ypark->y; yv = (f32x4){__uint_as_float(y01 << 16), __uint_as_float(y01 & 0xffff0000u), __uint_as_float(y23 << 16), __uint_as_float(y23 & 0xffff0000u)}; }
#pragma unroll
                        for (int ks = 0; ks < 4; ++ks) { const s5_bf16x8 xb = *(const LAS s5_bf16x8*)(xl + (rg * 16 + tk) * S5_XPITCH + (32 * ks + 8 * q4) * 2);
                            yv = __builtin_amdgcn_mfma_f32_16x16x32_bf16(cfr[ks], xb, yv, 0, 0, 0); MFMA_KEEP(yv, xb); }
                        if (d == 0) { ypark->x = pack2bf(yv[0], yv[1]); ypark->y = pack2bf(yv[2], yv[3]); }
                        else if (DENSE1_FP8) *(unsigned*)((unsigned char*)z + off) = pack4_fp8(geluf_(yv[0]) * Z8_SCALE, geluf_(yv[1]) * Z8_SCALE, geluf_(yv[2]) * Z8_SCALE, geluf_(yv[3]) * Z8_SCALE);
                        else { u32x2_t w; w.x = pack2bf(geluf_(yv[0]), geluf_(yv[1])); w.y = pack2bf(geluf_(yv[2]), geluf_(yv[3])); *(u32x2_t*)(z + off) = w; }
                    }
                    asm volatile("" ::: "memory");
                }
            }
            if (PASS == 1) { const int oi = s5_order(d, k_s); float* ep = Eb + (size_t)oi * S5S * 2;
                ep[r * 2] = x0r; ep[r * 2 + 1] = x0i; ep[(r + 32) * 2] = x1r; ep[(r + 32) * 2 + 1] = x1i; }
#undef S5_DMA
        }
    }
}
#endif
#ifndef CPU_EMU
__device__ __forceinline__ void ph_conv_fast(const Params& p, long gtid, long gthreads) {
    const bf16_t* qkv = (const bf16_t*)(p.ws + WS_QKV); bf16_t* ub = (bf16_t*)(p.ws + WS_UBF);
    const int ch = (int)(gtid % (LW / 8)) * 8;
    float wt[4][8], bs[8];
#pragma unroll
    for (int j = 0; j < 8; ++j) bs[j] = p.lru_conv_b[ch + j];
#pragma unroll
    for (int tap = 0; tap < 4; ++tap)
#pragma unroll
        for (int j = 0; j < 8; ++j) wt[tap][j] = p.lru_conv_w[tap * LW + ch + j];
    for (long it = gtid; it < (long)MT * (LW / 8); it += gthreads) {
        const int rr = (int)(it / (LW / 8));
        int base, t, n; if (rr < ML) { base = (rr / NSEQ) * NSEQ; t = rr % NSEQ; n = NSEQ; } else { const int rc = rr - ML; base = ML + (rc / NCTX) * NCTX; t = rc % NCTX; n = NCTX; }
        u32x4_t xv[4];
#pragma unroll
        for (int tap = 0; tap < 4; ++tap) { int tt = t + tap - 2; tt = tt < 0 ? 0 : (tt > n - 1 ? n - 1 : tt); xv[tap] = *(const u32x4_t*)(qkv + (size_t)(base + tt) * EVIN + COL_XR + ch); }
        float acc[8];
#pragma unroll
        for (int j = 0; j < 8; ++j) acc[j] = bs[j];
#pragma unroll
        for (int tap = 0; tap < 4; ++tap) { const int tt = t + tap - 2; const float ok = (tt >= 0 && tt < n) ? 1.0f : 0.0f; const unsigned vw[4] = {xv[tap].x, xv[tap].y, xv[tap].z, xv[tap].w};
#pragma unroll
            for (int j = 0; j < 8; ++j) acc[j] += (wt[tap][j] * ok) * __uint_as_float((j & 1) ? (vw[j >> 1] & 0xffff0000u) : (vw[j >> 1] << 16)); }
        u32x4_t w; w.x = pack2bf(acc[0], acc[1]); w.y = pack2bf(acc[2], acc[3]); w.z = pack2bf(acc[4], acc[5]); w.w = pack2bf(acc[6], acc[7]);
        *(u32x4_t*)(ub + (size_t)rr * LW + ch) = w;
    }
}
__device__ __forceinline__ int lru_chunk_row0(int b, int k) { return k < LRU_NCC ? ML + b * NCTX + k * LRU_CH : b * NSEQ + (k - LRU_NCC) * LRU_CH; }
__device__ __forceinline__ int lru_order(int d, int k) { return d == 0 ? k : (k < LRU_NCC ? LRU_NCC - 1 - k : LRU_NCC + (LRU_NLC - 1 - (k - LRU_NCC))); }
#define LRU_ZERO16(v) do { const float z0_ = opaque_zero(); _Pragma("unroll") for (int e_ = 0; e_ < 16; ++e_) v[e_] = z0_; } while (0)
template <int PASS> __device__ __forceinline__ void ph_lru_fast(const Params& p, LAS unsigned char* lds, int gwave, int nwaves, int wv_) {
    const int lane = tid_of(wv_) & 63; LAS float* hfl = (LAS float*)(lds + wv_ * (LRU_CH * 64 * 4)) + lane;
    const int r = lane & 31, hh = lane >> 5, a_half = (r >> 2) & 1, a_n = (r & 3) + 4 * (r >> 3);
    const bf16_t* ub = (const bf16_t*)(p.ws + WS_UBF); const bf16_t* qkv = (const bf16_t*)(p.ws + WS_QKV); bf16_t* mix = (bf16_t*)(p.ws + WS_MIX);
    const s5_bf16x8* LB = (const s5_bf16x8*)(p.ws + WS_LRUBF); float* AGG = (float*)(p.ws + WS_LRUAGG);
    constexpr int NPAIR = LRU_NCH / 2, NT = LRU_CH / 16;
    s5_bf16x8 idf[2];
#pragma unroll
    for (int kk = 0; kk < 2; ++kk) { const int jj = r - 16 * kk - 8 * hh;
#pragma unroll
        for (int e = 0; e < 8; ++e) idf[kk][e] = (e == jj) ? (short)0x3F80 : (short)0; }
    for (int rd = 0; rd <= (NB * 16 * 2 * NPAIR) / nwaves; ++rd) {
        const int it = deal_item(rd, gwave, nwaves, NB * 16 * 2 * NPAIR, OUT0_FP8 ? 4 : 2); if (it < 0) continue;
        const int cs = it & 1, pr = OUT0_FP8 ? (it >> 2) % NPAIR : (it >> 1) % NPAIR, h = OUT0_FP8 ? 2 * ((it / (4 * NPAIR)) % 8) + ((it >> 1) & 1) : (it / (2 * NPAIR)) % 16, b = it / (32 * NPAIR);
        const int k_s = 2 * pr + hh, k_a = 2 * pr + a_half, rb_a = lru_chunk_row0(b, k_a), rb_s = lru_chunk_row0(b, k_s);
        const int ch = h * 64 + 32 * cs + r;
#pragma unroll
        for (int d = 0; d < 2; ++d) {
            const int oi = lru_order(d, k_s);
            s5_bf16x8 br[4], bi[4];
#pragma unroll
            for (int ks = 0; ks < 4; ++ks) { br[ks] = LB[(((size_t)(d * 16 + h) * 2 + 0) * 2 + cs) * 4 * 64 + ks * 64 + lane]; bi[ks] = LB[(((size_t)(d * 16 + h) * 2 + 1) * 2 + cs) * 4 * 64 + ks * 64 + lane]; }
            const float lamv = softplusf_(-p.lru_lam[d * LW + ch]), bav = p.lru_ba[d * LW + ch], biv = p.lru_bi[d * LW + ch];
            const float nba = -1.44269504089f * bav, nbi = -1.44269504089f * biv, c2 = -8.0f * 1.44269504089f * lamv;
            float state = 0.f, aprod = 1.f;
            float* ag = AGG + (((size_t)b * 2 + d) * LRU_NCH) * LW * 2;
            if (PASS == 2) { const int oa = lru_order(d, 2 * pr), ob = lru_order(d, 2 * pr + 1), oimax = oa > ob ? oa : ob;
                for (int j0 = 0; j0 < oimax; j0 += 8) { float aj[8], bj[8];
#pragma unroll
                    for (int k = 0; k < 8; ++k) { const int jc = j0 + k < LRU_NCH ? j0 + k : LRU_NCH - 1; aj[k] = ag[((size_t)jc * LW + ch) * 2]; bj[k] = ag[((size_t)jc * LW + ch) * 2 + 1]; }
                    asm volatile("" : "+v"(aj[0]), "+v"(aj[1]), "+v"(aj[2]), "+v"(aj[3]), "+v"(aj[4]), "+v"(aj[5]), "+v"(aj[6]), "+v"(aj[7]), "+v"(bj[0]), "+v"(bj[1]), "+v"(bj[2]), "+v"(bj[3]), "+v"(bj[4]), "+v"(bj[5]), "+v"(bj[6]), "+v"(bj[7]));
#pragma unroll
                    for (int k = 0; k < 8; ++k) if (j0 + k < oi) state = aj[k] * state + bj[k]; } }
            s5_bf16x8 an[4], gn0, gn1;
            { const int tile0 = d ? NT - 1 : 0; const bf16_t* up = ub + (size_t)(rb_a + tile0 * 16 + a_n) * LW + h * 64 + 8 * hh;
#pragma unroll
              for (int ks = 0; ks < 4; ++ks) an[ks] = *(const s5_bf16x8*)(up + 16 * ks);
              if (PASS == 2 && d == 1) { const bf16_t* gp = qkv + (size_t)(rb_a + tile0 * 16 + a_n) * EVIN + COL_GR + h * 64 + 32 * cs + 8 * hh; gn0 = *(const s5_bf16x8*)gp; gn1 = *(const s5_bf16x8*)(gp + 16); } }
#pragma unroll 1
            for (int i = 0; i < NT; ++i) {
                const int tile = d ? NT - 1 - i : i;
                s5_bf16x8 a[4], g0, g1;
#pragma unroll
                for (int ks = 0; ks < 4; ++ks) a[ks] = an[ks];
                if (PASS == 2 && d == 1) { g0 = gn0; g1 = gn1; }
                if (i + 1 < NT) { const int tl = d ? tile - 1 : tile + 1; const bf16_t* up = ub + (size_t)(rb_a + tl * 16 + a_n) * LW + h * 64 + 8 * hh;
#pragma unroll
                    for (int ks = 0; ks < 4; ++ks) an[ks] = *(const s5_bf16x8*)(up + 16 * ks);
                    if (PASS == 2 && d == 1) { const bf16_t* gp = qkv + (size_t)(rb_a + tl * 16 + a_n) * EVIN + COL_GR + h * 64 + 32 * cs + 8 * hh; gn0 = *(const s5_bf16x8*)gp; gn1 = *(const s5_bf16x8*)(gp + 16); } }
                s5_f32x16 ar, ai, au, agr; LRU_ZERO16(ar); LRU_ZERO16(ai); LRU_ZERO16(au); LRU_ZERO16(agr);
#pragma unroll
                for (int ks = 0; ks < 4; ++ks) { ar = __builtin_amdgcn_mfma_f32_32x32x16_bf16(a[ks], br[ks], ar, 0, 0, 0); ai = __builtin_amdgcn_mfma_f32_32x32x16_bf16(a[ks], bi[ks], ai, 0, 0, 0); }
                au = __builtin_amdgcn_mfma_f32_32x32x16_bf16(cs ? a[2] : a[0], idf[0], au, 0, 0, 0); au = __builtin_amdgcn_mfma_f32_32x32x16_bf16(cs ? a[3] : a[1], idf[1], au, 0, 0, 0);
                if (PASS == 2 && d == 1) { agr = __builtin_amdgcn_mfma_f32_32x32x16_bf16(g0, idf[0], agr, 0, 0, 0); agr = __builtin_amdgcn_mfma_f32_32x32x16_bf16(g1, idf[1], agr, 0, 0, 0); }
                MFMA_KEEP(au, a[0]); MFMA_KEEP(au, a[1]); MFMA_KEEP(au, a[2]); MFMA_KEEP(au, a[3]); MFMA_KEEP(ai, a[3]); if (PASS == 2 && d == 1) { MFMA_KEEP(agr, g0); MFMA_KEEP(agr, g1); }
#pragma unroll
                for (int nn = 0; nn < 16; ++nn) {
                    const int n = d ? 15 - nn : nn;
                    const float rg = fast_rcp(1.0f + __builtin_amdgcn_exp2f(__builtin_fmaf(ar[n], -1.44269504089f, nba))), ig = fast_rcp(1.0f + __builtin_amdgcn_exp2f(__builtin_fmaf(ai[n], -1.44269504089f, nbi))), av = __builtin_amdgcn_exp2f(rg * c2), mult = fast_sqrt(__builtin_fmaf(-av, av, 1.0f));
                    state = av * state + mult * (ig * au[n]);
                    if (PASS == 1) aprod *= av;
                    if (PASS == 2) { if (d == 0) hfl[(tile * 16 + n) * 64] = state; else { const float mv = (hfl[(tile * 16 + n) * 64] + state) * geluf_(agr[n]);
                        if (OUT0_FP8) ((unsigned char*)mix)[(size_t)(rb_s + tile * 16 + n) * D + QW + ch] = (unsigned char)(pack4_fp8(mv, 0.f, 0.f, 0.f) & 0xffu); else mix[(size_t)(rb_s + tile * 16 + n) * D + QW + ch] = f2bf(mv); } }
                }
            }
            if (PASS == 1) { ag[((size_t)oi * LW + ch) * 2] = aprod; ag[((size_t)oi * LW + ch) * 2 + 1] = state; }
        }
    }
}
#endif
#ifndef CPU_EMU
constexpr int AT_KROWS = 320, AT_LDS_K = 0, AT_LDS_V = AT_KROWS * 128, AT_LDS_BYTES = 2 * AT_KROWS * 128;
static_assert(NCTX == 256, "attention key halves assume 256 context keys");
__device__ __forceinline__ void ph_attn_fast(const Params& p, LAS unsigned char* lds, int bid, int nblocks, int wv_) {
    const int tid = tid_of(wv_), lane = tid & 63, w = wv_, r = lane & 31, hh = lane >> 5;
    const bf16_t* qkv = (const bf16_t*)(p.ws + WS_QKV); const bf16_t* vt = (const bf16_t*)(p.ws + WS_VT); bf16_t* mix = (bf16_t*)(p.ws + WS_MIX);
    constexpr int NQB = NSEQ / 128, NCB = NCTX / 128, UNITS = NB * 4 * (NQB + NCB);
    for (int un = bid; un < UNITS; un += nblocks) {
        const int kvh = un & 3, rest = un >> 2; int b, qb; if (rest < NB * NQB) { b = rest / NQB; qb = rest % NQB; } else { b = (rest - NB * NQB) / NCB; qb = NQB + (rest - NB * NQB) % NCB; }
        const bool isc = qb >= NQB;
        const int q0 = isc ? (qb - NQB) * 128 : qb * 128, qrow0 = isc ? ML + b * NCTX + q0 : b * NSEQ + q0, head = 4 * kvh + (w >> 1);
        s5_bf16x8 qf[2][4];
#pragma unroll
        for (int qt = 0; qt < 2; ++qt)
#pragma unroll
            for (int ds = 0; ds < 4; ++ds) qf[qt][ds] = *(const s5_bf16x8*)(qkv + (size_t)(qrow0 + 64 * (w & 1) + 32 * qt + r) * EVIN + COL_Q + head * 64 + 16 * ds + 8 * hh);
        s5_f32x16 oacc[2][2];
#pragma unroll
        for (int qt = 0; qt < 2; ++qt)
#pragma unroll
            for (int dt = 0; dt < 2; ++dt)
#pragma unroll
                for (int e = 0; e < 16; ++e) oacc[qt][dt][e] = 0.f;
        const float sk = p.attn_sink[head];
        float mrun[2] = {sk, sk}, lrun[2] = {hh == 0 ? 1.0f : 0.f, hh == 0 ? 1.0f : 0.f};
#pragma unroll 1
        for (int half = isc ? 1 : 0; half < 2; ++half) {
            __syncthreads();
            static_assert(AT_KROWS * 8 == 5 * 512 && 64 * 40 == 5 * 512, "staging: five 16-byte pieces per thread and operand");
            u4v_t stK[5], stV[5];
#pragma unroll
            for (int k5 = 0; k5 < 5; ++k5) {
                const int i = tid + 512 * k5, row = i >> 3, cc = i & 7; int grow;
                if (half == 1 && row >= 64) grow = ML + b * NCTX + (row - 64);
                else { int kpos = q0 - 128 + 320 * half + row; kpos = kpos < 0 ? 0 : (kpos > NSEQ - 1 ? NSEQ - 1 : kpos); grow = b * NSEQ + kpos; }
                stK[k5] = *(const u4v_t*)(qkv + (size_t)grow * EVIN + COL_K + kvh * 64 + cc * 8);
            }
#pragma unroll
            for (int k5 = 0; k5 < 5; ++k5) {
                const int i = tid + 512 * k5, d = i / 40, pc = i % 40;
                const int pos = (half == 0) ? q0 + pc * 8 : (pc < 8 ? q0 + 320 + pc * 8 : 128 + NSEQ + 128 + (pc - 8) * 8);
                stV[k5] = *(const u4v_t*)(vt + ((size_t)(b * 4 + kvh) * 64 + d) * VT_T + pos);
            }
#pragma unroll
            for (int k5 = 0; k5 < 5; ++k5) { const int i = tid + 512 * k5, row = i >> 3, cc = i & 7; *(LAS u4v_t*)(lds + AT_LDS_K + row * 128 + ((cc ^ (row & 7)) << 4)) = stK[k5]; }
#pragma unroll
            for (int k5 = 0; k5 < 5; ++k5) { const int i = tid + 512 * k5, d = i / 40, pc = i % 40, kt = pc >> 2, cc = pc & 3; *(LAS u4v_t*)(lds + AT_LDS_V + kt * 4096 + d * 64 + ((cc ^ ((d >> 2) & 3)) << 4)) = stV[k5]; }
            __syncthreads();
#pragma unroll 1
            for (int kt = (isc ? 2 : 0); kt < 10; ++kt) {
                const bool local = !(half == 1 && kt >= 2);
                const int Kb = q0 - 128 + 320 * half + 32 * kt;
                s5_bf16x8 kf[4], vf[2][2];
#pragma unroll
                for (int ds = 0; ds < 4; ++ds) kf[ds] = *(const LAS s5_bf16x8*)(lds + AT_LDS_K + (32 * kt + r) * 128 + (((2 * ds + hh) ^ (r & 7)) << 4));
#pragma unroll
                for (int dt = 0; dt < 2; ++dt)
#pragma unroll
                    for (int s2 = 0; s2 < 2; ++s2) vf[dt][s2] = *(const LAS s5_bf16x8*)(lds + AT_LDS_V + kt * 4096 + (32 * dt + r) * 64 + (((2 * s2 + hh) ^ (((32 * dt + r) >> 2) & 3)) << 4));
#pragma unroll
                for (int qt = 0; qt < 2; ++qt) {
                    const int Qb = q0 + 64 * (w & 1) + 32 * qt;
                    bool need_mask = false;
                    if (local) {
                        if (Kb - (Qb + 31) > 128 || Qb - (Kb + 31) > 128 || Kb + 31 < 0 || Kb >= NSEQ) continue;
                        need_mask = !(Kb + 31 - Qb <= 128 && Qb + 31 - Kb <= 128 && Kb >= 0 && Kb + 31 < NSEQ);
                    }
                    s5_f32x16 sc; const float z0 = opaque_zero();
#pragma unroll
                    for (int e = 0; e < 16; ++e) sc[e] = z0;
#pragma unroll
                    for (int ds = 0; ds < 4; ++ds) sc = __builtin_amdgcn_mfma_f32_32x32x16_bf16(kf[ds], qf[qt][ds], sc, 0, 0, 0);
                    MFMA_KEEP(sc, kf[0]); MFMA_KEEP(sc, kf[1]); MFMA_KEEP(sc, kf[2]); MFMA_KEEP(sc, kf[3]);
                    if (need_mask) {
                        const int qpos = Qb + r;
#pragma unroll
                        for (int e = 0; e < 16; ++e) { const int kpos = Kb + (e & 3) + 8 * (e >> 2) + 4 * hh, rel = kpos - qpos; if (rel > 128 || rel < -128 || kpos < 0 || kpos >= NSEQ) sc[e] = -1e30f; }
                    }
                    float tmax = sc[0];
#pragma unroll
                    for (int e = 1; e < 16; ++e) tmax = fmaxf(tmax, sc[e]);
                    tmax = fmaxf(tmax, __shfl_xor(tmax, 32));
                    const float mnew = fmaxf(mrun[qt], tmax), scl = __expf(mrun[qt] - mnew), mneg = -mnew * 1.44269504089f; mrun[qt] = mnew;
                    float psum = 0.f; float pv[16];
#pragma unroll
                    for (int e = 0; e < 16; ++e) { pv[e] = __builtin_amdgcn_exp2f(__builtin_fmaf(sc[e], 1.44269504089f, mneg)); psum += pv[e]; }
                    lrun[qt] = lrun[qt] * scl + psum;
                    if (__ballot(scl != 1.0f) != 0ull) {
#pragma unroll
                    for (int dt = 0; dt < 2; ++dt)
#pragma unroll
                        for (int e = 0; e < 16; ++e) oacc[qt][dt][e] *= scl; }
                    s5_bf16x8 pf[2];
#pragma unroll
                    for (int s2 = 0; s2 < 2; ++s2) { unsigned w0 = pack2bf(pv[8 * s2], pv[8 * s2 + 1]), w1 = pack2bf(pv[8 * s2 + 2], pv[8 * s2 + 3]), w2 = pack2bf(pv[8 * s2 + 4], pv[8 * s2 + 5]), w3 = pack2bf(pv[8 * s2 + 6], pv[8 * s2 + 7]);
                        u4v_t t4 = {w0, w1, w2, w3}; pf[s2] = __builtin_bit_cast(s5_bf16x8, t4); }
#pragma unroll
                    for (int dt = 0; dt < 2; ++dt)
#pragma unroll
                        for (int s2 = 0; s2 < 2; ++s2) oacc[qt][dt] = __builtin_amdgcn_mfma_f32_32x32x16_bf16(vf[dt][s2], pf[s2], oacc[qt][dt], 0, 0, 0);
                    MFMA_KEEP(oacc[qt][1], pf[0]); MFMA_KEEP(oacc[qt][1], pf[1]);
                }
            }
        }
#pragma unroll
        for (int qt = 0; qt < 2; ++qt) {
            const float ltot = lrun[qt] + __shfl_xor(lrun[qt], 32), inv = 1.0f / ltot;
            bf16_t* op = mix + (size_t)(qrow0 + 64 * (w & 1) + 32 * qt + r) * D + head * 64; unsigned char* op8 = (unsigned char*)mix + (size_t)(qrow0 + 64 * (w & 1) + 32 * qt + r) * D + head * 64; const float inv8 = inv * MIX8_SCALE;
#pragma unroll
            for (int dt = 0; dt < 2; ++dt)
#pragma unroll
                for (int g4 = 0; g4 < 4; ++g4) {
                    if (OUT0_FP8) { *(unsigned*)(op8 + 32 * dt + 8 * g4 + 4 * hh) = pack4_fp8(oacc[qt][dt][4 * g4] * inv8, oacc[qt][dt][4 * g4 + 1] * inv8, oacc[qt][dt][4 * g4 + 2] * inv8, oacc[qt][dt][4 * g4 + 3] * inv8); continue; }
                    u32x2_t wv2; wv2.x = pack2bf(oacc[qt][dt][4 * g4] * inv, oacc[qt][dt][4 * g4 + 1] * inv); wv2.y = pack2bf(oacc[qt][dt][4 * g4 + 2] * inv, oacc[qt][dt][4 * g4 + 3] * inv);
                    *(u32x2_t*)(op + 32 * dt + 8 * g4 + 4 * hh) = wv2; }
        }
    }
}
#endif
#ifndef CPU_EMU
__device__ __forceinline__ float wave_sum(float v) {
#pragma unroll
    for (int o = 32; o >= 1; o >>= 1) v += __shfl_xor(v, o);
    return v; }
template <int MODE> __device__ __forceinline__ void ph_norm_fast(const Params& p, int l, int rows, int gwave, int nwaves, int wv_) {
    const int lane = tid_of(wv_) & 63;
    bf16_t* h = (bf16_t*)(p.ws + WS_H); float* xres = (float*)(p.ws + WS_XRES); const bf16_t* yb = (const bf16_t*)(p.ws + WS_YBUF);
    const float* tok_w = (const float*)(p.ws + WS_TOK) + (size_t)MT * 2; const int* tok_dest = (const int*)(p.ws + WS_TOK) + (size_t)MT * 6;
    for (int r = gwave; r < rows; r += nwaves) {
        const int ar = ada_row(r);
        f32x4 xv[8];
        f32x4 cg[8], cs[8], ch[8];
        if (MODE == 2) {
#pragma unroll
            for (int i = 0; i < 8; ++i) cg[i] = *(const f32x4*)(p.norm_final + 4 * lane + 256 * i);
        } else { const float* sh = ada_ptr(p, l, ar, 0); const float* sc = ada_ptr(p, l, ar, 1); const float* g = p.norm_mix + (size_t)l * D;
#pragma unroll
            for (int i = 0; i < 8; ++i) { const int c = 4 * lane + 256 * i; cg[i] = *(const f32x4*)(g + c); cs[i] = *(const f32x4*)(sc + c); ch[i] = *(const f32x4*)(sh + c); } }
        if (MODE == 0) { const float* xr = xin_row(p, l, r);
#pragma unroll
            for (int i = 0; i < 8; ++i) xv[i] = *(const f32x4*)(xr + 4 * lane + 256 * i); }
        else { const int lm = (MODE == 1) ? l - 1 : 1; const float* g2 = ada_ptr(p, lm, ar, 5); float* xr = xres + (size_t)r * D;
            const int d0 = tok_dest[r * 2], d1 = tok_dest[r * 2 + 1]; const float w0 = tok_w[r * 2], w1 = tok_w[r * 2 + 1];
            f32x4 xo[8], gg[8]; unsigned ya8[8], yc8[8]; u32x2_t ya16[8], yc16[8];
#pragma unroll
            for (int i = 0; i < 8; ++i) { const int c = 4 * lane + 256 * i;
                if (RES_BF16) { const u32x2_t t = *(const u32x2_t*)((const bf16_t*)xres + (size_t)r * D + c); xo[i] = unpack4bf(t.x, t.y); } else xo[i] = *(const f32x4*)(xr + c);
                gg[i] = *(const f32x4*)(g2 + c);
                if (Y8) { ya8[i] = *(const unsigned*)((const unsigned char*)yb + (size_t)d0 * D + c); yc8[i] = *(const unsigned*)((const unsigned char*)yb + (size_t)d1 * D + c); }
                else { ya16[i] = *(const u32x2_t*)(yb + (size_t)d0 * D + c); yc16[i] = *(const u32x2_t*)(yb + (size_t)d1 * D + c); } }
#pragma unroll
            for (int i = 0; i < 8; ++i) { f32x4 m;
                if (Y8) { const unsigned ya = ya8[i], yc = yc8[i]; const float u0 = w0 * (1.0f / Y8_SCALE), u1 = w1 * (1.0f / Y8_SCALE);
                    m[0] = u0 * __builtin_amdgcn_cvt_f32_fp8(ya, 0) + u1 * __builtin_amdgcn_cvt_f32_fp8(yc, 0); m[1] = u0 * __builtin_amdgcn_cvt_f32_fp8(ya, 1) + u1 * __builtin_amdgcn_cvt_f32_fp8(yc, 1);
                    m[2] = u0 * __builtin_amdgcn_cvt_f32_fp8(ya, 2) + u1 * __builtin_amdgcn_cvt_f32_fp8(yc, 2); m[3] = u0 * __builtin_amdgcn_cvt_f32_fp8(ya, 3) + u1 * __builtin_amdgcn_cvt_f32_fp8(yc, 3); }
                else { const u32x2_t ya = ya16[i], yc = yc16[i];
                    m[0] = w0 * __uint_as_float(ya.x << 16) + w1 * __uint_as_float(yc.x << 16); m[1] = w0 * __uint_as_float(ya.x & 0xffff0000u) + w1 * __uint_as_float(yc.x & 0xffff0000u);
                    m[2] = w0 * __uint_as_float(ya.y << 16) + w1 * __uint_as_float(yc.y << 16); m[3] = w0 * __uint_as_float(ya.y & 0xffff0000u) + w1 * __uint_as_float(yc.y & 0xffff0000u); }
                xv[i] = xo[i] + gg[i] * m; } }
        float ss = 0.f;
#pragma unroll
        for (int i = 0; i < 8; ++i) ss += (xv[i][0] * xv[i][0] + xv[i][1] * xv[i][1]) + (xv[i][2] * xv[i][2] + xv[i][3] * xv[i][3]);
        ss = wave_sum(ss);
        const float rstd = 1.0f / sqrtf(ss * (1.0f / D) + 1e-6f);
#ifndef CPU_EMU
        asm volatile("" ::: "memory");
#endif
        if (MODE == 2) {
#pragma unroll
            for (int i = 0; i < 8; ++i) { const int c = 4 * lane + 256 * i; *(f32x4*)(p.out + (size_t)r * D + c) = xv[i] * rstd * cg[i]; }
        } else {
#pragma unroll
            for (int i = 0; i < 8; ++i) { const int c = 4 * lane + 256 * i;
                if (MODE == 1) { if (RES_BF16) { u32x2_t t; t.x = pack2bf(xv[i][0], xv[i][1]); t.y = pack2bf(xv[i][2], xv[i][3]); *(u32x2_t*)((bf16_t*)xres + (size_t)r * D + c) = t; } else *(f32x4*)(xres + (size_t)r * D + c) = xv[i]; }
                const f32x4 hv = xv[i] * rstd * cg[i] * (cs[i] + 1.0f) + ch[i];
                if ((MODE == 1 && DENSE1_FP8) || (MODE == 0 && IN0_FP8)) *(unsigned*)((unsigned char*)h + (size_t)r * D + c) = pack4_fp8(hv[0], hv[1], hv[2], hv[3]);
                else { if (MODE == 0 && IN0QKV_FP8) *(unsigned*)(p.ws + WS_H8 + (size_t)r * D + c) = pack4_fp8(hv[0], hv[1], hv[2], hv[3]);
                    u32x2_t w; w.x = pack2bf(hv[0], hv[1]); w.y = pack2bf(hv[2], hv[3]); *(u32x2_t*)(h + (size_t)r * D + c) = w; } } }
    }
}
template <bool H8> __device__ __forceinline__ void ph_router_fast(const Params& p, int l, int rows, LAS unsigned char* lds, int bid, int nblocks, int wv_) {
    const int lane = tid_of(wv_) & 63, rr = lane & 15, q = lane >> 4, w = wv_;
    bf16_t* h = (bf16_t*)(p.ws + WS_H); const float* xres = (const float*)(p.ws + WS_XRES); const s5_bf16x8* RWF = (const s5_bf16x8*)(p.ws + WS_RWF);
    int* tok_e = (int*)(p.ws + WS_TOK); float* tok_w = (float*)(p.ws + WS_TOK) + (size_t)MT * 2; int* tok_slot = (int*)(p.ws + WS_TOK) + (size_t)MT * 4;
    int* hist = (int*)(p.ws + WS_HIST) + (size_t)l * MAXG * HIST_LD;
    int run = 0;
    LAS float* ssq = (LAS float*)lds;
    LAS f32x4* red = (LAS f32x4*)(lds + 1024);
    LAS float* cfA = (LAS float*)(lds + 16384); LAS float* cfB = cfA + D;
    const int tid = w * 64 + lane, ntl = rows / 16, TPW = (ntl + nblocks - 1) / nblocks, t_lo = bid * TPW, t_hi = (t_lo + TPW < ntl) ? t_lo + TPW : ntl;
    s5_bf16x8 rwh[8], rwl[8];
#pragma unroll
    for (int st = 0; st < 8; ++st) { rwh[st] = RWF[(8 * w + st) * 64 + lane]; rwl[st] = RWF[(64 + 8 * w + st) * 64 + lane]; }
    const f32x4 rbias = *(const f32x4*)(p.router_b + 4 * q);
    int ar_cur = -1;
    u4v_t nx[8];
    if (RES_BF16 && t_lo < t_hi) { const bf16_t* xr = (const bf16_t*)xres + (size_t)(t_lo * 16 + rr) * D + 256 * w + 8 * q;
#pragma unroll
        for (int st = 0; st < 8; ++st) nx[st] = *(const u4v_t*)(xr + 32 * st); }
    for (int t16 = t_lo; t16 < t_hi; ++t16) {
        const int r = t16 * 16 + rr, ar = ada_row(t16 * 16);
        if (ar != ar_cur) { ar_cur = ar;
            const f32x4 gv = *(const f32x4*)(p.norm_ffn + (size_t)l * D + 4 * tid), sv = *(const f32x4*)(ada_ptr(p, l, ar, 4) + 4 * tid), hv = *(const f32x4*)(ada_ptr(p, l, ar, 3) + 4 * tid);
            *(LAS f32x4*)(cfA + 4 * tid) = gv * (sv + 1.0f); *(LAS f32x4*)(cfB + 4 * tid) = hv; }
        f32x4 xa[8], xb[8];
        if (RES_BF16) {
#pragma unroll
            for (int st = 0; st < 8; ++st) { xa[st] = unpack4bf(nx[st][0], nx[st][1]); xb[st] = unpack4bf(nx[st][2], nx[st][3]); }
            if (t16 + 1 < t_hi) { const bf16_t* xr = (const bf16_t*)xres + (size_t)((t16 + 1) * 16 + rr) * D + 256 * w + 8 * q;
#pragma unroll
                for (int st = 0; st < 8; ++st) nx[st] = *(const u4v_t*)(xr + 32 * st); } }
        else { const float* xr = xres + (size_t)r * D + 256 * w + 8 * q;
#pragma unroll
            for (int st = 0; st < 8; ++st) { xa[st] = *(const f32x4*)(xr + 32 * st); xb[st] = *(const f32x4*)(xr + 32 * st + 4); } }
        float ss = 0.f;
#pragma unroll
        for (int st = 0; st < 8; ++st) ss += (xa[st][0] * xa[st][0] + xa[st][1] * xa[st][1]) + (xa[st][2] * xa[st][2] + xa[st][3] * xa[st][3]) + (xb[st][0] * xb[st][0] + xb[st][1] * xb[st][1]) + (xb[st][2] * xb[st][2] + xb[st][3] * xb[st][3]);
        ss += __shfl_xor(ss, 16); ss += __shfl_xor(ss, 32);
        if (q == 0) ssq[w * 16 + rr] = ss;
        __syncthreads();
        float tot = 0.f;
#pragma unroll
        for (int ww = 0; ww < 8; ++ww) tot += ssq[ww * 16 + rr];
        const float rstd = 1.0f / sqrtf(tot * (1.0f / D) + 1e-6f);
        const LAS float* cA = cfA + 256 * w + 8 * q; const LAS float* cB = cfB + 256 * w + 8 * q;
        f32x4 lhi, llo; { const float z0 = opaque_zero(); lhi = (f32x4){z0, z0, z0, z0}; llo = lhi; }
#pragma unroll
        for (int st = 0; st < 8; ++st) {
            const f32x4 ga = *(const LAS f32x4*)(cA + 32 * st), gb = *(const LAS f32x4*)(cA + 32 * st + 4), ha = *(const LAS f32x4*)(cB + 32 * st), hb = *(const LAS f32x4*)(cB + 32 * st + 4);
            const f32x4 va = xa[st] * rstd * ga + ha, vb = xb[st] * rstd * gb + hb;
            u4v_t wv4 = {pack2bf(va[0], va[1]), pack2bf(va[2], va[3]), pack2bf(vb[0], vb[1]), pack2bf(vb[2], vb[3])};
            if (H8) { u32x2_t w8; w8.x = pack4_fp8(va[0], va[1], va[2], va[3]); w8.y = pack4_fp8(vb[0], vb[1], vb[2], vb[3]); *(u32x2_t*)((unsigned char*)h + (size_t)r * D + 256 * w + 32 * st + 8 * q) = w8; }
            else *(u4v_t*)(h + (size_t)r * D + 256 * w + 32 * st + 8 * q) = wv4;
            const s5_bf16x8 hf = __builtin_bit_cast(s5_bf16x8, wv4);
            lhi = __builtin_amdgcn_mfma_f32_16x16x32_bf16(rwh[st], hf, lhi, 0, 0, 0); MFMA_KEEP(lhi, rwh[st]);
            llo = __builtin_amdgcn_mfma_f32_16x16x32_bf16(rwl[st], hf, llo, 0, 0, 0); MFMA_KEEP(llo, rwl[st]); MFMA_KEEP(llo, hf);
        }
        red[w * 64 + lane] = lhi + llo;
        __syncthreads();
        if (w == 0) {
            f32x4 lsum = red[lane];
#pragma unroll
            for (int ww = 1; ww < 8; ++ww) lsum += red[ww * 64 + lane];
            float lg[4];
#pragma unroll
            for (int i = 0; i < 4; ++i) lg[i] = lsum[i] + rbias[i];
            float mx = fmaxf(fmaxf(lg[0], lg[1]), fmaxf(lg[2], lg[3])); mx = fmaxf(mx, __shfl_xor(mx, 16)); mx = fmaxf(mx, __shfl_xor(mx, 32));
            float pr[4], sum = 0.f;
#pragma unroll
            for (int i = 0; i < 4; ++i) { pr[i] = __expf(lg[i] - mx); sum += pr[i]; }
            sum += __shfl_xor(sum, 16); sum += __shfl_xor(sum, 32);
            float a1 = -1.f, a2 = -1.f; int j1 = 0, j2 = 0;
#pragma unroll
            for (int i = 0; i < 4; ++i) { const float v = pr[i] / sum; if (v > a1) { a2 = a1; j2 = j1; a1 = v; j1 = i; } else if (v > a2) { a2 = v; j2 = i; } }
            float best = a1 + a2; int bq = q; float w1 = a1, w2 = a2; int e1 = 4 * q + j1, e2 = 4 * q + j2;
#pragma unroll
            for (int o = 16; o <= 32; o <<= 1) {
                const float ob = __shfl_xor(best, o), ow1 = __shfl_xor(w1, o), ow2 = __shfl_xor(w2, o); const int oq = __shfl_xor(bq, o), oe1 = __shfl_xor(e1, o), oe2 = __shfl_xor(e2, o);
                if (ob > best || (ob == best && oq < bq)) { best = ob; bq = oq; w1 = ow1; w2 = ow2; e1 = oe1; e2 = oe2; } }
            int rk1 = 0, rk2 = 0, mine = 0; const unsigned long long below = (1ull << rr) - 1ull;
#pragma unroll
            for (int e = 0; e < NE; ++e) { const unsigned long long m = __ballot(q == 0 && (e1 == e || e2 == e)); const int pc = __popcll(m & below); if (e1 == e) rk1 = pc; if (e2 == e) rk2 = pc; if (rr == e) mine = __popcll(m); }
            const int b1 = __shfl(run, e1), b2 = __shfl(run, e2);
            if (q == 0) { const float ws = w1 + w2; tok_e[r * 2] = e1; tok_e[r * 2 + 1] = e2; tok_w[r * 2] = w1 / ws; tok_w[r * 2 + 1] = w2 / ws;
                tok_slot[r * 2] = b1 + rk1; tok_slot[r * 2 + 1] = b2 + rk2; }
            run += mine;
        }
    }
    if (w == 0 && lane < HIST_LD) hist[bid * HIST_LD + lane] = lane < NE ? run : 0;
}
__device__ __forceinline__ void ph_dispatch_fast(const Params& p, int l, int rows, LAS unsigned char* lds, int bid, int nblocks, int wv_) {
    const int tid = tid_of(wv_); const int* hist = (const int*)(p.ws + WS_HIST) + (size_t)l * MAXG * HIST_LD;
    const int* tok_e = (const int*)(p.ws + WS_TOK); const int* tok_slot = (const int*)(p.ws + WS_TOK) + (size_t)MT * 4; int* tok_dest = (int*)(p.ws + WS_TOK) + (size_t)MT * 6;
    int* rowidx = (int*)(p.ws + WS_ROWIDX); int* cnt = (int*)(p.ws + WS_CNT) + l * 64;
    LAS int* pre = (LAS int*)lds; LAS int* seg = pre + MAXG * NE; LAS int* tot = seg + 32 * NE; LAS int* pst = tot + NE;
    { const int e = tid & 15, sg = tid >> 4; int v[8], sum = 0;
#pragma unroll
        for (int i = 0; i < 8; ++i) { const int wg = 8 * sg + i; v[i] = wg < nblocks ? hist[wg * HIST_LD + e] : 0; sum += v[i]; }
        seg[sg * NE + e] = sum;
        __syncthreads();
        int base = 0; for (int s2 = 0; s2 < sg; ++s2) base += seg[s2 * NE + e];
#pragma unroll
        for (int i = 0; i < 8; ++i) { pre[(8 * sg + i) * NE + e] = base; base += v[i]; }
        if (sg == 31) tot[e] = base;
        __syncthreads();
        if (tid <= NE) { int acc = 0; for (int j = 0; j < tid; ++j) acc += (tot[j] + 255) / 256 * 256; pst[tid] = acc; }
        if (bid == 0 && tid < NE) cnt[tid] = tot[tid];
        __syncthreads(); }
    const long gtid = (long)bid * 512 + tid, gthreads = (long)nblocks * 512; const int tpw = (rows / 16 + nblocks - 1) / nblocks;
    for (long it = gtid; it < (long)rows * 2; it += gthreads) { const int e = tok_e[it], wg = (int)((it >> 5) / tpw), dest = pst[e] + pre[wg * NE + e] + tok_slot[it]; tok_dest[it] = dest; st_coh(rowidx + dest, (int)(it / 2)); }
    const int total = pst[NE];
    for (long it = gtid; it < total; it += gthreads) { int st = 0, ce = 0;
#pragma unroll
        for (int j = 0; j < NE; ++j) { if (it >= pst[j] && it < pst[j + 1]) { st = pst[j]; ce = tot[j]; } }
        if (it - st >= ce) st_coh(rowidx + it, 0); }
}
#endif
__device__ __forceinline__ void ph_final(const Params& p, long gtid, long gthreads) {
    const float* xres = (const float*)(p.ws + WS_XRES);
    for (long r = gtid; r < ML; r += gthreads) {
        const float* xr = xres + (size_t)r * D; float ss = 0.f; for (int k = 0; k < D; ++k) ss += xr[k] * xr[k];
        const float rstd = 1.0f / sqrtf(ss / D + 1e-6f);
        for (int k = 0; k < D; ++k) p.out[(size_t)r * D + k] = xr[k] * rstd * p.norm_final[k];
    }
}

struct CvtJob { const float* src; bf16_t* dst; int K, N, mode, fp8, ld; };
constexpr int NJOBS = 6 + 2 * NE * 3;
constexpr int IN0_NQ = QW + 2 * KVW;
__device__ __forceinline__ CvtJob cvt_job(const Params& p, int j) {
    CvtJob J; unsigned char* ws = p.ws; J.fp8 = 0;
    if (j == 0) { J.src = p.ev_w_in; J.dst = (bf16_t*)(ws + WS_WT_IN0); J.K = D; J.N = IN0_NQ; J.mode = 0; }
    else if (j == 5) { J.src = p.ev_w_in + IN0_NQ; J.dst = (bf16_t*)(ws + WS_WT_IN0) + (size_t)IN0_NQ * D; J.K = D; J.N = EVIN - IN0_NQ; J.mode = 0; }
    else if (j == 1) { J.src = p.ev_w_out; J.dst = (bf16_t*)(ws + WS_WT_OUT0); J.K = D; J.N = D; J.mode = 0; }
    else if (j == 2) { J.src = p.od_w_in; J.dst = (bf16_t*)(ws + WS_WT_IN1); J.K = D; J.N = S5W; J.mode = 0; }
    else if (j == 3) { J.src = p.s5_glu_w; J.dst = (bf16_t*)(ws + WS_WT_GLU); J.K = S5W; J.N = S5W; J.mode = 0; }
    else if (j == 4) { J.src = p.od_w_out; J.dst = (bf16_t*)(ws + WS_WT_OUT1); J.K = S5W; J.N = D; J.mode = 0; }
    else { const int q = j - 6, le = q / 3, kind = q % 3;
        if (kind == 0) { J.src = p.moe_w_gate + (size_t)le * D * FF; J.dst = (bf16_t*)(ws + WS_WT_GU) + (size_t)le * 2 * FF * D; J.K = D; J.N = FF; J.mode = 1; }
        else if (kind == 1) { J.src = p.moe_w_up + (size_t)le * D * FF; J.dst = (bf16_t*)(ws + WS_WT_GU) + (size_t)le * 2 * FF * D; J.K = D; J.N = FF; J.mode = 2; }
        else { J.src = p.moe_w_down + (size_t)le * FF * D; J.dst = (bf16_t*)(ws + WS_WT_DN) + (size_t)le * D * FF; J.K = FF; J.N = D; J.mode = 0; }
        if (le >= NE ? MOE1_FP8 : MOE0_FP8) { const int l8 = le / NE, e = le % NE; J.fp8 = 1;
            J.dst = kind == 2 ? (bf16_t*)(ws + WS_WT_DN + (size_t)l8 * NE * D * FF * 2 + (size_t)e * D * FF) : (bf16_t*)(ws + WS_WT_GU + (size_t)l8 * NE * 2 * FF * D * 2 + (size_t)e * 2 * FF * D); } }
    if (((IN0_FP8 || IN0QKV_FP8) && j == 0) || (IN0_FP8 && j == 5) || (OUT0_FP8 && j == 1)) J.fp8 = 1;
    J.ld = (j == 0 || j == 5) ? EVIN : J.N;
    if (DENSE1_FP8 && j >= 2 && j <= 4) J.fp8 = 1;
    return J;
}
__device__ __forceinline__ int cvt_rowmap(int mode, int n) { return mode == 0 ? n : (n / 128) * 256 + (mode == 2 ? 128 : 0) + n % 128; }
constexpr long cvt_tiles_of(int K, int N) { return (long)(K / 64) * (N / 256); }
constexpr long CVT_TILES = cvt_tiles_of(D, IN0_NQ) + cvt_tiles_of(D, EVIN - IN0_NQ) + cvt_tiles_of(D, D) + cvt_tiles_of(D, S5W) + cvt_tiles_of(S5W, S5W) + cvt_tiles_of(S5W, D) + (long)2 * NE * 3 * cvt_tiles_of(D, FF);
__device__ __forceinline__ void cvt_find(long tile, int& j, long& local) {
    const long t0 = cvt_tiles_of(D, IN0_NQ), t1 = t0 + cvt_tiles_of(D, D), t2 = t1 + cvt_tiles_of(D, S5W), t3 = t2 + cvt_tiles_of(S5W, S5W), t4 = t3 + cvt_tiles_of(S5W, D), t5 = t4 + cvt_tiles_of(D, EVIN - IN0_NQ);
    if (tile < t0) { j = 0; local = tile; } else if (tile < t1) { j = 1; local = tile - t0; } else if (tile < t2) { j = 2; local = tile - t1; } else if (tile < t3) { j = 3; local = tile - t2; }
    else if (tile < t4) { j = 4; local = tile - t3; } else if (tile < t5) { j = 5; local = tile - t4; } else { const long q = tile - t5, per = cvt_tiles_of(D, FF); j = 6 + (int)(q / per); local = q % per; }
}
#ifndef CPU_EMU
constexpr int CVT_PITCH = 257, CVT_LDS_BYTES = 128 * 129 * 4;
struct CvtSrc { const float* src; int N, fp8; };
__device__ __forceinline__ CvtSrc cvt_src(const Params& p, long t) { int j; long loc; cvt_find(t, j, loc); const CvtJob L = cvt_job(p, j); CvtSrc S; S.N = L.ld; S.fp8 = L.fp8;
    if (L.fp8) { const int tn8 = L.N / 128, k0 = (int)(loc / tn8) * 128, n0 = (int)(loc % tn8) * 128; S.src = L.src + (size_t)k0 * L.ld + n0; }
    else { const int tn = L.N / 256, k0 = (int)(loc / tn) * 64, n0 = (int)(loc % tn) * 256; S.src = L.src + (size_t)k0 * L.ld + n0; }
    return S; }
__device__ __forceinline__ f32x4 cvt_load(const CvtSrc& S, int tid, int i) { const int q = tid + 512 * i, kk = S.fp8 ? q >> 5 : q >> 6, n4 = S.fp8 ? (q & 31) * 4 : (q & 63) * 4; return *(const f32x4*)(S.src + (size_t)kk * S.N + n4); }
__device__ __forceinline__ void ph_convert(const Params& p, float* tile, long t_end, int max_tiles, int wv_) {
    const int tid = tid_of(wv_); int* ctr = (int*)(p.ws + WS_CNT) + 128; LAS int* tsh = (LAS int*)((LAS unsigned char*)tile + CVT_LDS_BYTES);
    (void)max_tiles;
    int pend = 0, par = 0;
    __syncthreads();
    if (tid == 0) { const int a0 = atomicAdd(ctr, 1), a1 = atomicAdd(ctr, 1); pend = atomicAdd(ctr, 1); tsh[0] = a0; tsh[1] = a1; }
    __syncthreads();
    long t = tsh[0], tn = tsh[1];
    f32x4 R[8];
    if (t < t_end) { const CvtSrc S = cvt_src(p, t);
#pragma unroll
        for (int i = 0; i < 8; ++i) R[i] = cvt_load(S, tid, i); }
    while (t < t_end) {
        int j; long local; cvt_find(t, j, local); const CvtJob J = cvt_job(p, j);
        const bool more = tn < t_end; const CvtSrc SN = cvt_src(p, more ? tn : t);
#pragma unroll
        for (int i = 0; i < 8; ++i) {
            if (J.fp8) { const int q = tid + 512 * i, kk = q >> 5, n4 = (q & 31) * 4; *(f32x4*)(tile + kk * 128 + (n4 ^ (((kk >> 4) & 3) << 4))) = R[i]; }
            else { const int q = tid + 512 * i, kk = q >> 6, n4 = (q & 63) * 4; tile[kk * CVT_PITCH + n4] = R[i][0]; tile[kk * CVT_PITCH + n4 + 1] = R[i][1]; tile[kk * CVT_PITCH + n4 + 2] = R[i][2]; tile[kk * CVT_PITCH + n4 + 3] = R[i][3]; }
        }
        if (tid == 0) { tsh[2 + par] = pend; pend = atomicAdd(ctr, 1); }
        __syncthreads();
        const long tnn = tsh[2 + par]; par ^= 1;
        if (more) {
#pragma unroll
            for (int i = 0; i < 8; ++i) R[i] = cvt_load(SN, tid, i); }
        if (J.fp8) {
            const int tn8 = J.N / 128, k0 = (int)(local / tn8) * 128, n0 = (int)(local % tn8) * 128;
            const float wsc = (OUT0_FP8 && j == 1 && k0 < QW) ? W8_SCALE / MIX8_SCALE : W8_SCALE;
#pragma unroll
            for (int i = 0; i < 2; ++i) { const int lane = tid & 63, nn = 64 * i + 8 * (tid >> 6) + (lane & 7), kg = lane >> 3, kgl = kg & 3; const float* tp = tile + (16 * kg) * 128 + (nn ^ (kgl << 4)); u4v_t w;
#pragma unroll
                for (int d4 = 0; d4 < 4; ++d4) { int pk = 0; pk = __builtin_amdgcn_cvt_pk_fp8_f32(tp[(4 * d4) * 128] * wsc, tp[(4 * d4 + 1) * 128] * wsc, pk, false);
                    pk = __builtin_amdgcn_cvt_pk_fp8_f32(tp[(4 * d4 + 2) * 128] * wsc, tp[(4 * d4 + 3) * 128] * wsc, pk, true); w[d4] = (unsigned)pk; }
                *(u4v_t*)((unsigned char*)J.dst + (size_t)cvt_rowmap(J.mode, n0 + nn) * J.K + k0 + 16 * kg) = w; }
        } else {
            const int tnn_ = J.N / 256, k0 = (int)(local / tnn_) * 64, n0 = (int)(local % tnn_) * 256;
#pragma unroll
            for (int i = 0; i < 4; ++i) { const int q = tid + 512 * i, nn = q >> 3, k8 = (q & 7) * 8; const float* tp = tile + k8 * CVT_PITCH + nn;
                u4v_t w = {pack2bf(tp[0], tp[CVT_PITCH]), pack2bf(tp[2 * CVT_PITCH], tp[3 * CVT_PITCH]), pack2bf(tp[4 * CVT_PITCH], tp[5 * CVT_PITCH]), pack2bf(tp[6 * CVT_PITCH], tp[7 * CVT_PITCH])};
                *(u4v_t*)(J.dst + (size_t)cvt_rowmap(J.mode, n0 + nn) * J.K + k0 + k8) = w; }
        }
        __syncthreads();
        t = tn; tn = tnn;
    }
}
#else
void ph_convert_emu(const Params& p) {
    for (int j = 0; j < NJOBS; ++j) { const CvtJob J = cvt_job(p, j);
        for (int n = 0; n < J.N; ++n) { bf16_t* dr = J.dst + (size_t)cvt_rowmap(J.mode, n) * J.K; for (int k = 0; k < J.K; ++k) dr[k] = f2bf(J.src[(size_t)k * J.ld + n]); } }
}
#endif

namespace pg8 {
constexpr int BM = 256, BK = 64, HALF = 128, HTB = HALF * BK * 2  , STAGE_BYTES = 8 * HTB, NXCD = 8, WGM = 8;
struct Unit { int pm, pn, e; };
struct Gemm { const bf16_t* A; const bf16_t* Bt; int M, N, K; int sc_w = 0, sc_a = 0; };
__host__ __device__ __forceinline__ int lds_byte(int r, int c) { const int st = (r >> 4) * 2 + (c >> 5), rr = r & 15, cc = c & 31, ob = rr * 64 + cc * 2; return st * 1024 + (ob ^ (((ob >> 9) & 1) << 5)); }
__host__ __device__ __forceinline__ void stage_rc(int b, int& R, int& C) { const int st = b / 1024, sb = b % 1024, swz = sb ^ (((sb >> 9) & 1) << 5); R = (st >> 1) * 16 + swz / 64; C = (st & 1) * 32 + (swz % 64) / 2; }
__host__ __device__ __forceinline__ int perm32(int rho) { const int n = rho >> 4, i = rho & 15; return 8 * (i >> 2) + 4 * n + (i & 3); }

struct StaticOrder {
    static constexpr bool GATHER = false;
    int nM, nN, nwg, G, c;
    __host__ __device__ void init(int M, int N, int G_, int c_) { nM = M / BM; nN = N / BM; nwg = nM * nN; G = G_; c = c_; }
    __host__ __device__ bool next(int i, Unit& u) const {
        const long L = (long)i * G + c; if (L >= nwg) return false;
        int wgid = (int)L; { const int q = nwg / NXCD, r = nwg % NXCD, xcd = wgid % NXCD, off = wgid / NXCD; wgid = (xcd < r ? xcd * (q + 1) : r * (q + 1) + (xcd - r) * q) + off; }
        const int nig = WGM * nN, gid = wgid / nig, fm = gid * WGM, gsz = (nM - fm) < WGM ? (nM - fm) : WGM;
        u.pm = fm + ((wgid % nig) % gsz); u.pn = (wgid % nig) / gsz; u.e = 0; return true;
    }
    __device__ __forceinline__ const char* b_base(const Gemm& g, const Unit& u) const { return (const char*)g.Bt + (size_t)u.pn * ((size_t)BM * g.K * 2); }
    __device__ __forceinline__ int a_row(const Unit& u, int rr) const { return u.pm * BM + rr; }
};
template <bool ROWS> struct MoeOrder {
    static constexpr bool GATHER = ROWS;
    int nN, nwg, G, c; const int* cnt; const int* rowidx; size_t estride;
    __device__ void init(const int* cnt_, int N, int G_, int c_, const int* rowidx_, size_t estride_) { int acc = 0; cnt = cnt_;
#pragma unroll
        for (int e = 0; e < NE; ++e) acc += (cnt[e] + 255) / 256 * 256;
        nN = N / BM; nwg = (acc / 256) * nN; G = G_; c = c_; rowidx = rowidx_; estride = estride_; }
    __device__ bool next(int i, Unit& u) const { const long L = (long)i * G + c; if (L >= nwg) return false; u.pm = (int)(L / nN); u.pn = (int)(L % nN); int e = 0, acc = 0;
#pragma unroll
        for (int j = 0; j < NE - 1; ++j) { acc += (cnt[j] + 255) / 256 * 256; e += (u.pm * 256 >= acc) ? 1 : 0; }
        u.e = e; return true; }
    __device__ __forceinline__ const char* b_base(const Gemm& g, const Unit& u) const { return (const char*)g.Bt + (size_t)u.e * estride + (size_t)u.pn * ((size_t)BM * g.K * 2); }
    __device__ __forceinline__ int a_row(const Unit& u, int rr) const { return ROWS ? ld_coh(rowidx + u.pm * BM + rr) : u.pm * BM + rr; }
};

#ifdef CPU_EMU
typedef unsigned char* LdsPtr;
#else
#define PG8_LAS __attribute__((address_space(3)))
typedef PG8_LAS unsigned char* LdsPtr;
typedef short bf16x8 __attribute__((ext_vector_type(8)));
typedef unsigned u32x4 __attribute__((ext_vector_type(4)));
typedef int pg8_v4i __attribute__((ext_vector_type(4)));
typedef int pg8_v8i __attribute__((ext_vector_type(8)));
template <class Epi, class Sched, bool F8 = false>
__device__ __forceinline__ void gemm_phase(LdsPtr lds, const Gemm g, const Sched& S, const Epi& E, int wv_) {
    const int tid = tid_of(wv_), wid = wv_, lane = tid & 63, wr = wid >> 2, wc = wid & 3, fr = lane & 15, fq = lane >> 4;
    const int K = g.K, nt = K / BK;
    unsigned voffB[2]; int RA[2], CA[2];
#pragma unroll
    for (int i = 0; i < 2; ++i) { int R, C; stage_rc(tid * 16 + i * 8192, R, C); const int Rb = Epi::PERM ? ((R & ~31) + perm32(R & 31)) : R;
        RA[i] = R; CA[i] = C; voffB[i] = (unsigned)(Rb * K + C) * 2u; }
    const size_t kstep = (size_t)(BK * 2);
    const size_t hstep = (size_t)HALF * K * 2;
    const unsigned ldsw = (unsigned)wid * 1024u;
    const int aoff = F8 ? lds_byte(wr * 64 + fr, fq * 16) + ((fq & 1) << 4) : lds_byte(wr * 64 + fr, fq * 8), boff = F8 ? lds_byte(wc * 32 + fr, fq * 16) + ((fq & 1) << 4) : lds_byte(wc * 32 + fr, fq * 8);
    const int sc_both = (g.sc_w & 0xff) | ((g.sc_a & 0xff) << 8);
    const int koff = F8 ? (16 - ((fq & 1) << 5)) : 1024;
#define PG8_SA(b, h) (((b) * 2 + (h)) * HTB)
#define PG8_SB(b, h) ((4 + (b) * 2 + (h)) * HTB)
#define PG8_STAGE(bufoff, gbase, voff) do { _Pragma("unroll") for (int _i = 0; _i < 2; ++_i) \
        __builtin_amdgcn_global_load_lds((const unsigned*)((const char*)(gbase) + (voff)[_i]), (PG8_LAS unsigned*)(lds + (bufoff) + ldsw + _i * 8192), 16, 0, 0); } while (0)
#define PG8_LD8(dst, addr) do { const pg8_v4i lo_ = *(const PG8_LAS pg8_v4i*)(addr), hi_ = *(const PG8_LAS pg8_v4i*)((addr) + koff); dst = __builtin_shufflevector(lo_, hi_, 0, 1, 2, 3, 4, 5, 6, 7); } while (0)
#define PG8_LDA(dst, b, h) do { if constexpr (F8) { _Pragma("unroll") for (int m = 0; m < 4; ++m) PG8_LD8(dst##8[m], lds + PG8_SA(b, h) + aoff + m * 2048); } \
        else { _Pragma("unroll") for (int m = 0; m < 4; ++m) _Pragma("unroll") for (int k = 0; k < 2; ++k) dst[m][k] = *(const PG8_LAS bf16x8*)(lds + PG8_SA(b, h) + aoff + m * 2048 + k * koff); } } while (0)
#define PG8_LDB(dst, b, h) do { if constexpr (F8) { _Pragma("unroll") for (int n = 0; n < 2; ++n) PG8_LD8(dst##8[n], lds + PG8_SB(b, h) + boff + n * 2048); } \
        else { _Pragma("unroll") for (int n = 0; n < 2; ++n) _Pragma("unroll") for (int k = 0; k < 2; ++k) dst[n][k] = *(const PG8_LAS bf16x8*)(lds + PG8_SB(b, h) + boff + n * 2048 + k * koff); } } while (0)
#define PG8_MMA(ai, bj, At, Bt) do { __builtin_amdgcn_s_setprio(1); \
        if constexpr (F8) { _Pragma("unroll") for (int m = 0; m < 4; ++m) _Pragma("unroll") for (int n = 0; n < 2; ++n) \
            acc[ai][bj][m][n] = __builtin_amdgcn_mfma_scale_f32_16x16x128_f8f6f4(Bt##8[n], At##8[m], acc[ai][bj][m][n], 0, 0, 0, sc_both, 1, sc_both); } \
        else { _Pragma("unroll") for (int m = 0; m < 4; ++m) _Pragma("unroll") for (int n = 0; n < 2; ++n) _Pragma("unroll") for (int k = 0; k < 2; ++k) \
            acc[ai][bj][m][n] = __builtin_amdgcn_mfma_f32_16x16x32_bf16(Bt[n][k], At[m][k], acc[ai][bj][m][n], 0, 0, 0); } \
        __builtin_amdgcn_s_setprio(0); } while (0)
#define PG8_WAIT_V(n) asm volatile("s_waitcnt vmcnt(" #n ")" ::: "memory")
#define PG8_WAIT_L(n) asm volatile("s_waitcnt lgkmcnt(" #n ")" ::: "memory")
#define PG8_BAR __builtin_amdgcn_s_barrier()
#define PG8_SCHED __builtin_amdgcn_sched_barrier(0)
#define PG8_VOFFA(dst, U) do { _Pragma("unroll") for (int _h = 0; _h < 2; ++_h) _Pragma("unroll") for (int _i = 0; _i < 2; ++_i) \
        dst[_h][_i] = (unsigned)((size_t)S.a_row(U, _h * HALF + RA[_i]) * K + CA[_i]) * 2u; } while (0)
    Unit cur, nxt; int ui = 0;
    if (!S.next(0, cur)) return;
    f32x4 acc[2][2][4][2];
#pragma unroll
    for (int a = 0; a < 2; ++a)
#pragma unroll
        for (int b = 0; b < 2; ++b)
#pragma unroll
            for (int m = 0; m < 4; ++m)
#pragma unroll
                for (int n = 0; n < 2; ++n) acc[a][b][m][n] = (f32x4){0.f, 0.f, 0.f, 0.f};
    bf16x8 At[4][2], B0[2][2], B1[2][2];
    pg8_v8i At8[4], B08[2], B18[2];
    unsigned vA[2][2];
    PG8_VOFFA(vA, cur);
    const char* cA = (const char*)g.A; const char* cB = S.b_base(g, cur);
    PG8_STAGE(PG8_SB(0, 0), cB, voffB); PG8_STAGE(PG8_SB(0, 1), cB + hstep, voffB); PG8_STAGE(PG8_SA(0, 0), cA, vA[0]); PG8_STAGE(PG8_SA(0, 1), cA, vA[1]);
    if (wr == 1) PG8_BAR;
    PG8_WAIT_V(2); PG8_BAR;
    PG8_STAGE(PG8_SB(1, 0), cB + kstep, voffB); PG8_STAGE(PG8_SA(1, 0), cA + kstep, vA[0]); PG8_STAGE(PG8_SB(1, 1), cB + hstep + kstep, voffB);
    PG8_WAIT_V(6); PG8_BAR;
    for (;;) {
        const bool has_next = S.next(ui + 1, nxt);
        const char* nB = has_next ? S.b_base(g, nxt) : cB;
        for (int t = 0; t < nt; t += 2) {
            const bool last = (t == nt - 2);
            const char* a1 = cA + (size_t)(t + 1) * kstep;
            const char* a2 = last ? cA : cA + (size_t)(t + 2) * kstep; const char* b2 = last ? nB : cB + (size_t)(t + 2) * kstep;
            const char* a3 = a2 + kstep; const char* b3 = b2 + kstep;
            PG8_LDB(B0, 0, 0); PG8_LDB(B1, 0, 1); PG8_SCHED; PG8_LDA(At, 0, 0); PG8_STAGE(PG8_SA(1, 1), a1, vA[1]);
            if (last && has_next) { PG8_VOFFA(vA, nxt); }
            PG8_WAIT_V(8); PG8_WAIT_L(0); PG8_BAR; PG8_MMA(0, 0, At, B0); PG8_MMA(0, 1, At, B1); PG8_BAR; PG8_SCHED;
            PG8_LDA(At, 0, 1); PG8_STAGE(PG8_SB(0, 0), b2, voffB); PG8_STAGE(PG8_SB(0, 1), b2 + hstep, voffB); PG8_STAGE(PG8_SA(0, 0), a2, vA[0]);
            PG8_WAIT_V(8); PG8_WAIT_L(0); PG8_BAR; PG8_MMA(1, 0, At, B0); PG8_MMA(1, 1, At, B1); PG8_BAR; PG8_SCHED;
            PG8_LDB(B0, 1, 0); PG8_LDB(B1, 1, 1); PG8_SCHED; PG8_LDA(At, 1, 0); PG8_STAGE(PG8_SA(0, 1), a2, vA[1]);
            PG8_WAIT_V(8); PG8_WAIT_L(0); PG8_BAR; PG8_MMA(0, 0, At, B0); PG8_MMA(0, 1, At, B1); PG8_BAR; PG8_SCHED;
            PG8_LDA(At, 1, 1); PG8_STAGE(PG8_SB(1, 0), b3, voffB); PG8_STAGE(PG8_SB(1, 1), b3 + hstep, voffB); PG8_STAGE(PG8_SA(1, 0), a3, vA[0]);
            PG8_WAIT_V(8); PG8_WAIT_L(0); PG8_BAR; PG8_MMA(1, 0, At, B0); PG8_MMA(1, 1, At, B1); PG8_BAR; PG8_SCHED;
        }
        if (wr == 0) PG8_BAR;
        E(acc, cur, wr, wc, fr, fq);
        if (!has_next) break;
#pragma unroll
        for (int a = 0; a < 2; ++a)
#pragma unroll
            for (int b = 0; b < 2; ++b)
#pragma unroll
                for (int m = 0; m < 4; ++m)
#pragma unroll
                    for (int n = 0; n < 2; ++n) acc[a][b][m][n] = (f32x4){0.f, 0.f, 0.f, 0.f};
        cur = nxt; cB = nB; ++ui;
        if (wr == 1) PG8_BAR;
    }
    PG8_WAIT_V(0);
    PG8_BAR;
#undef PG8_SA
#undef PG8_SB
#undef PG8_STAGE
#undef PG8_LDA
#undef PG8_LDB
#undef PG8_MMA
#undef PG8_LD8
#undef PG8_WAIT_V
#undef PG8_WAIT_L
#undef PG8_BAR
#undef PG8_SCHED
#undef PG8_VOFFA
}
#endif
}

typedef f32x4 AccT[2][2][4][2];

struct EpiQKV {
    static constexpr bool PERM = false;
    bf16_t* O; const float* rope; bf16_t* VT; int pn0 = 0;
    __device__ __forceinline__ void operator()(const AccT& acc, const pg8::Unit& u, int wr, int wc, int fr, int fq) const {
        const int colt = (u.pn + pn0) * 256; const bool is_q = colt < COL_K, is_k = colt >= COL_K && colt < COL_V, is_v = colt >= COL_V && colt < COL_XR;
#pragma unroll
        for (int ai = 0; ai < 2; ++ai) {
            f32x4 rp[4][2];
            if (is_q || is_k) {
#pragma unroll
                for (int m = 0; m < 4; ++m) { const int r = u.pm * 256 + ai * 128 + wr * 64 + m * 16 + fr, t = r % NSEQ, pos = (wc & 1) ? (t % 64) : (t / 64);
                    rp[m][0] = *(const f32x4*)(rope + (pos * 16 + 4 * fq) * 2); rp[m][1] = *(const f32x4*)(rope + (pos * 16 + 4 * fq) * 2 + 4); }
#ifndef CPU_EMU
                asm volatile("" ::: "memory");
#endif
            }
#pragma unroll
            for (int m = 0; m < 4; ++m) {
                const int r = u.pm * 256 + ai * 128 + wr * 64 + m * 16 + fr; const bool lat = r < ML; const int t = r % NSEQ;
#pragma unroll
                for (int bj = 0; bj < 2; ++bj) {
                    const int cg = colt + bj * 128 + wc * 32;
                    f32x4 v0 = acc[ai][bj][m][0], v1 = acc[ai][bj][m][1];
                    if ((is_q || is_k) && lat) {
#pragma unroll
                        for (int j = 0; j < 4; ++j) { const float cs = rp[m][j >> 1][(j & 1) * 2], sn = rp[m][j >> 1][(j & 1) * 2 + 1]; const float a = v0[j], b = v1[j]; v0[j] = a * cs - b * sn; v1[j] = b * cs + a * sn; }
                    }
                    if (is_q) { v0 *= 0.125f; v1 *= 0.125f; }
                    bf16_t* rowp = O + (size_t)r * EVIN + cg + 4 * fq;
                    u32x2_t w0, w1; w0.x = pack2bf(v0[0], v0[1]); w0.y = pack2bf(v0[2], v0[3]); w1.x = pack2bf(v1[0], v1[1]); w1.y = pack2bf(v1[2], v1[3]);
                    *(u32x2_t*)rowp = w0; *(u32x2_t*)(rowp + 16) = w1;
                    if (is_v) {
                        const int bb = lat ? r / NSEQ : (r - ML) / NCTX, tt = lat ? t : (r - ML) % NCTX, k16 = tt & 15, kp = (k16 & 3) | ((k16 & 4) << 1) | ((k16 & 8) >> 1);
                        const int pos = (lat ? 128 : 128 + NSEQ + 128) + (tt & ~15) + kp, vc = cg - COL_V + 4 * fq;
                        bf16_t* vp = VT + ((size_t)bb * 256 + vc) * VT_T + pos;
#pragma unroll
                        for (int j = 0; j < 4; ++j) { vp[(size_t)j * VT_T] = f2bf(v0[j]); vp[(size_t)(16 + j) * VT_T] = f2bf(v1[j]); }
                    }
                }
            }
        }
    }
};
template <bool IN16, bool OUT16> struct EpiResidT {
    static constexpr bool PERM = false;
    const float* xin_lat; const float* xin_ctx; float* xout; const float* gate;
    __device__ __forceinline__ void operator()(const AccT& acc, const pg8::Unit& u, int wr, int wc, int fr, int fq) const {
        const int row0 = u.pm * 256, arow = row0 < ML ? row0 / NSEQ : NB; const float* gp = gate + (size_t)arow * ADA6;
        const int col0 = u.pn * 256 + wc * 32 + 4 * fq;
        f32x4 gv[2][2];
#pragma unroll
        for (int bj = 0; bj < 2; ++bj)
#pragma unroll
            for (int n = 0; n < 2; ++n) gv[bj][n] = *(const f32x4*)(gp + col0 + bj * 128 + n * 16);
#pragma unroll
        for (int ai = 0; ai < 2; ++ai) {
            f32x4 xi[4][2][2];
#pragma unroll
            for (int m = 0; m < 4; ++m) { const int r = row0 + ai * 128 + wr * 64 + m * 16 + fr;
                const size_t io = (r < ML ? (size_t)r * D : (size_t)(r - ML) * D) + col0; const float* ib = r < ML ? xin_lat : xin_ctx;
#pragma unroll
                for (int bj = 0; bj < 2; ++bj)
#pragma unroll
                    for (int n = 0; n < 2; ++n) {
                        if (IN16) { const u32x2_t t = *(const u32x2_t*)((const bf16_t*)ib + io + bj * 128 + n * 16); xi[m][bj][n] = unpack4bf(t.x, t.y); } else xi[m][bj][n] = *(const f32x4*)(ib + io + bj * 128 + n * 16); } }
#ifndef CPU_EMU
            asm volatile("" ::: "memory");
#endif
#pragma unroll
            for (int m = 0; m < 4; ++m) { const int r = row0 + ai * 128 + wr * 64 + m * 16 + fr; const size_t oo = (size_t)r * D + col0;
#pragma unroll
                for (int bj = 0; bj < 2; ++bj)
#pragma unroll
                    for (int n = 0; n < 2; ++n) { const f32x4 xo = xi[m][bj][n] + gv[bj][n] * acc[ai][bj][m][n];
                        if (OUT16) { u32x2_t t; t.x = pack2bf(xo[0], xo[1]); t.y = pack2bf(xo[2], xo[3]); *(u32x2_t*)((bf16_t*)xout + oo + bj * 128 + n * 16) = t; } else *(f32x4*)(xout + oo + bj * 128 + n * 16) = xo; } }
        }
    }
};
typedef EpiResidT<false, RES_BF16> EpiResid0;
typedef EpiResidT<RES_BF16, RES_BF16> EpiResid;
struct EpiBf16 {
    static constexpr bool PERM = true;
    bf16_t* O; int ldc;
    __device__ __forceinline__ void operator()(const AccT& acc, const pg8::Unit& u, int wr, int wc, int fr, int fq) const {
        const int col0 = u.pn * 256 + wc * 32 + 8 * fq;
#pragma unroll
        for (int ai = 0; ai < 2; ++ai)
#pragma unroll
            for (int m = 0; m < 4; ++m) { bf16_t* rowp = O + (size_t)(u.pm * 256 + ai * 128 + wr * 64 + m * 16 + fr) * ldc + col0;
#pragma unroll
                for (int bj = 0; bj < 2; ++bj) { const f32x4 v0 = acc[ai][bj][m][0], v1 = acc[ai][bj][m][1];
                    u32x4_t w; w.x = pack2bf(v0[0], v0[1]); w.y = pack2bf(v0[2], v0[3]); w.z = pack2bf(v1[0], v1[1]); w.w = pack2bf(v1[2], v1[3]);
                    *(u32x4_t*)(rowp + bj * 128) = w; } }
    }
};
#ifndef CPU_EMU
struct EpiY8 {
    static constexpr bool PERM = true;
    unsigned char* O; int ldc;
    __device__ __forceinline__ void operator()(const AccT& acc, const pg8::Unit& u, int wr, int wc, int fr, int fq) const {
        const int col0 = u.pn * 256 + wc * 32 + 8 * fq;
#pragma unroll
        for (int ai = 0; ai < 2; ++ai)
#pragma unroll
            for (int m = 0; m < 4; ++m) { unsigned char* rowp = O + (size_t)(u.pm * 256 + ai * 128 + wr * 64 + m * 16 + fr) * ldc + col0;
#pragma unroll
                for (int bj = 0; bj < 2; ++bj) { const f32x4 v0 = acc[ai][bj][m][0] * Y8_SCALE, v1 = acc[ai][bj][m][1] * Y8_SCALE;
                    u32x2_t w; w.x = pack4_fp8(v0[0], v0[1], v0[2], v0[3]); w.y = pack4_fp8(v1[0], v1[1], v1[2], v1[3]);
                    *(u32x2_t*)(rowp + bj * 128) = w; } }
    }
};
#endif
struct EpiGU {
    static constexpr bool PERM = true;
    bf16_t* O;
    __device__ __forceinline__ void operator()(const AccT& acc, const pg8::Unit& u, int wr, int wc, int fr, int fq) const {
        const int col0 = u.pn * 128 + wc * 32 + 8 * fq;
#pragma unroll
        for (int ai = 0; ai < 2; ++ai)
#pragma unroll
            for (int m = 0; m < 4; ++m) { bf16_t* rowp = O + (size_t)(u.pm * 256 + ai * 128 + wr * 64 + m * 16 + fr) * FF + col0;
                float o[8];
#pragma unroll
                for (int n = 0; n < 2; ++n)
#pragma unroll
                    for (int j = 0; j < 4; ++j) { const float gt = acc[ai][0][m][n][j], up = acc[ai][1][m][n][j]; o[n * 4 + j] = siluf_(gt) * up; }
                u32x4_t w; w.x = pack2bf(o[0], o[1]); w.y = pack2bf(o[2], o[3]); w.z = pack2bf(o[4], o[5]); w.w = pack2bf(o[6], o[7]);
                *(u32x4_t*)rowp = w; }
    }
};
#ifndef CPU_EMU
struct EpiGU8 {
    static constexpr bool PERM = true;
    unsigned char* O;
    __device__ __forceinline__ void operator()(const AccT& acc, const pg8::Unit& u, int wr, int wc, int fr, int fq) const {
        const int col0 = u.pn * 128 + wc * 32 + 8 * fq;
#pragma unroll
        for (int ai = 0; ai < 2; ++ai)
#pragma unroll
            for (int m = 0; m < 4; ++m) { unsigned char* rowp = O + (size_t)(u.pm * 256 + ai * 128 + wr * 64 + m * 16 + fr) * FF + col0;
                float o[8];
#pragma unroll
                for (int n = 0; n < 2; ++n)
#pragma unroll
                    for (int j = 0; j < 4; ++j) { const float gt = acc[ai][0][m][n][j], up = acc[ai][1][m][n][j]; o[n * 4 + j] = siluf_(gt) * up * ACT8_SCALE; }
                u32x2_t w; w.x = pack4_fp8(o[0], o[1], o[2], o[3]); w.y = pack4_fp8(o[4], o[5], o[6], o[7]);
                *(u32x2_t*)rowp = w; }
    }
};
#endif
struct EpiGLU {
    static constexpr bool PERM = true;
    const bf16_t* Z; bf16_t* O; const float* bias;
    __device__ __forceinline__ void operator()(const AccT& acc, const pg8::Unit& u, int wr, int wc, int fr, int fq) const {
        const int col0 = u.pn * 256 + wc * 32 + 8 * fq;
#pragma unroll
        for (int ai = 0; ai < 2; ++ai)
#pragma unroll
            for (int m = 0; m < 4; ++m) { const size_t ro = (size_t)(u.pm * 256 + ai * 128 + wr * 64 + m * 16 + fr) * S5W + col0;
#pragma unroll
                for (int bj = 0; bj < 2; ++bj) { const u32x4_t zz = *(const u32x4_t*)(Z + ro + bj * 128); const unsigned zw[4] = {zz.x, zz.y, zz.z, zz.w}; float o[8];
#pragma unroll
                    for (int n = 0; n < 2; ++n)
#pragma unroll
                        for (int j = 0; j < 4; ++j) { const int q = n * 4 + j; const float zv = __uint_as_float((q & 1) ? (zw[q >> 1] & 0xffff0000u) : (zw[q >> 1] << 16));
                            o[q] = zv * sigmoidf_(acc[ai][bj][m][n][j] + bias[col0 + bj * 128 + q]); }
                    u32x4_t w; w.x = pack2bf(o[0], o[1]); w.y = pack2bf(o[2], o[3]); w.z = pack2bf(o[4], o[5]); w.w = pack2bf(o[6], o[7]);
                    *(u32x4_t*)(O + ro + bj * 128) = w; } }
    }
};

#ifndef CPU_EMU
struct EpiGLU8 {
    static constexpr bool PERM = true;
    const unsigned char* Z; unsigned char* O; const float* bias;
    __device__ __forceinline__ void operator()(const AccT& acc, const pg8::Unit& u, int wr, int wc, int fr, int fq) const {
        const int col0 = u.pn * 256 + wc * 32 + 8 * fq;
        u32x2_t zall[2][4][2]; f32x4 bv[2][2];
#pragma unroll
        for (int bj = 0; bj < 2; ++bj)
#pragma unroll
            for (int n = 0; n < 2; ++n) bv[bj][n] = *(const f32x4*)(bias + col0 + bj * 128 + n * 4);
#pragma unroll
        for (int ai = 0; ai < 2; ++ai)
#pragma unroll
            for (int m = 0; m < 4; ++m) { const size_t ro = (size_t)(u.pm * 256 + ai * 128 + wr * 64 + m * 16 + fr) * S5W + col0;
#pragma unroll
                for (int bj = 0; bj < 2; ++bj) zall[ai][m][bj] = *(const u32x2_t*)(Z + ro + bj * 128); }
        asm volatile("" ::: "memory");
#pragma unroll
        for (int ai = 0; ai < 2; ++ai)
#pragma unroll
            for (int m = 0; m < 4; ++m) { const size_t ro = (size_t)(u.pm * 256 + ai * 128 + wr * 64 + m * 16 + fr) * S5W + col0;
#pragma unroll
                for (int bj = 0; bj < 2; ++bj) { const u32x2_t zz = zall[ai][m][bj]; float o[8];
#pragma unroll
                    for (int n = 0; n < 2; ++n) { const int zw = (int)(n ? zz.y : zz.x);
                        const float z0 = __builtin_amdgcn_cvt_f32_fp8(zw, 0), z1 = __builtin_amdgcn_cvt_f32_fp8(zw, 1), z2 = __builtin_amdgcn_cvt_f32_fp8(zw, 2), z3 = __builtin_amdgcn_cvt_f32_fp8(zw, 3); const float zv[4] = {z0, z1, z2, z3};
#pragma unroll
                        for (int j = 0; j < 4; ++j) { const int q = n * 4 + j; o[q] = zv[j] * (S8_SCALE / Z8_SCALE) * sigmoidf_(acc[ai][bj][m][n][j] + bv[bj][n][j]); } }
                    u32x2_t w; w.x = pack4_fp8(o[0], o[1], o[2], o[3]); w.y = pack4_fp8(o[4], o[5], o[6], o[7]);
                    *(u32x2_t*)(O + ro + bj * 128) = w; } }
    }
};
#endif

enum { G_IN0 = 0, G_OUT0, G_GU, G_DN, G_IN1, G_GLU, G_OUT1, G_GU8, G_DN8, G_IN18, G_GLU8, G_OUT18, G_IN08, G_OUT08, G_IN0SPLIT };
#ifdef CPU_EMU
namespace pg8 {
template <class Epi, class Sched> void gemm_phase(LdsPtr, const Gemm g, const Sched& S, const Epi& E, int) {
    Unit u; std::vector<float> C(256 * 256), af(g.K), bfv((size_t)256 * g.K);
    for (int i = 0; S.next(i, u); ++i) {
        const bf16_t* Bb = (const bf16_t*)S.b_base(g, u);
        for (size_t q = 0; q < (size_t)256 * g.K; ++q) bfv[q] = bf2f(Bb[q]);
        for (int r = 0; r < 256; ++r) { const bf16_t* a = g.A + (size_t)S.a_row(u, r) * g.K; for (int k = 0; k < g.K; ++k) af[k] = bf2f(a[k]);
            for (int cc = 0; cc < 256; ++cc) { const float* bp = &bfv[(size_t)cc * g.K]; float s = 0.f; for (int k = 0; k < g.K; ++k) s += af[k] * bp[k]; C[r * 256 + cc] = s; } }
        for (int tid = 0; tid < 512; ++tid) { const int wid = tid >> 6, lane = tid & 63, wr = wid >> 2, wc = wid & 3, fr = lane & 15, fq = lane >> 4;
            f32x4 acc[2][2][4][2];
            for (int ai = 0; ai < 2; ++ai) for (int bj = 0; bj < 2; ++bj) for (int m = 0; m < 4; ++m) for (int n = 0; n < 2; ++n) for (int j = 0; j < 4; ++j) {
                const int r = 128 * ai + 64 * wr + 16 * m + fr, cc = Epi::PERM ? 128 * bj + 32 * wc + 8 * fq + 4 * n + j : 128 * bj + 32 * wc + 16 * n + 4 * fq + j;
                acc[ai][bj][m][n][j] = C[r * 256 + cc]; }
            E(acc, u, wr, wc, fr, fq); }
    }
}
}
#endif
#ifndef CPU_EMU
template <class Sched> __device__ __forceinline__ void gemm_stagger(const Sched& S, int tile_us) {
    const int rem = S.nwg % S.G; if (rem == 0 || S.c < rem) return;
    const int units = (int)((long)(S.c - rem) * tile_us * 4 / (5 * (S.G - rem)));
    for (int i = 0; i < units; ++i) __builtin_amdgcn_s_sleep(32);
}
#else
template <class Sched> void gemm_stagger(const Sched&, int) {}
#endif
template <int WHICH> __device__ __forceinline__ void run_gemm(const Params& p, int l, pg8::LdsPtr lds, int G, int c, int wv_ = 0) {
    unsigned char* ws = p.ws; pg8::Gemm g;
    if constexpr (WHICH == G_IN0) { g.A = (const bf16_t*)(ws + WS_H); g.Bt = (const bf16_t*)(ws + WS_WT_IN0); g.M = MT; g.N = EVIN; g.K = D;
        pg8::StaticOrder S; S.init(g.M, g.N, G, c); EpiQKV E; E.O = (bf16_t*)(ws + WS_QKV); E.rope = (const float*)(ws + WS_ROPE); E.VT = (bf16_t*)(ws + WS_VT); pg8::gemm_phase(lds, g, S, E, wv_); }
    else if constexpr (WHICH == G_OUT0) { g.A = (const bf16_t*)(ws + WS_MIX); g.Bt = (const bf16_t*)(ws + WS_WT_OUT0); g.M = MT; g.N = D; g.K = D;
        pg8::StaticOrder S; S.init(g.M, g.N, G, c); EpiResid0 E; E.xin_lat = p.x; E.xin_ctx = p.ctx; E.xout = (float*)(ws + WS_XRES); E.gate = (const float*)(ws + WS_ADA) + 2 * D; pg8::gemm_phase(lds, g, S, E, wv_); }
    else if constexpr (WHICH == G_GU) { g.A = (const bf16_t*)(ws + WS_H); g.Bt = (const bf16_t*)(ws + WS_WT_GU) + (size_t)l * NE * 2 * FF * D; g.M = NBLK * 256; g.N = 2 * FF; g.K = D;
        pg8::MoeOrder<true> S; S.init((const int*)(ws + WS_CNT) + l * 64, g.N, G, c, (const int*)(ws + WS_ROWIDX), (size_t)2 * FF * D * 2); EpiGU E; E.O = (bf16_t*)(ws + WS_ACT); pg8::gemm_phase(lds, g, S, E, wv_); }
    else if constexpr (WHICH == G_DN) { g.A = (const bf16_t*)(ws + WS_ACT); g.Bt = (const bf16_t*)(ws + WS_WT_DN) + (size_t)l * NE * D * FF; g.M = NBLK * 256; g.N = D; g.K = FF;
        pg8::MoeOrder<false> S; S.init((const int*)(ws + WS_CNT) + l * 64, g.N, G, c, nullptr, (size_t)D * FF * 2); EpiBf16 E; E.O = (bf16_t*)(ws + WS_YBUF); E.ldc = D; pg8::gemm_phase(lds, g, S, E, wv_); }
#ifndef CPU_EMU
    else if constexpr (WHICH == G_IN0SPLIT) {
        { g.A = (const bf16_t*)(ws + WS_H); g.Bt = (const bf16_t*)(ws + WS_WT_IN0) + (size_t)IN0_NQ * D; g.M = MT; g.N = EVIN - IN0_NQ; g.K = D;
          pg8::StaticOrder S; S.init(g.M, g.N, G, c); EpiBf16 E; E.O = (bf16_t*)(ws + WS_QKV) + IN0_NQ; E.ldc = EVIN; pg8::gemm_phase(lds, g, S, E, wv_); }
        const int extra = ((MT / 256) * ((EVIN - IN0_NQ) / 256)) % G, G2 = G - extra;
        if (c >= extra) { pg8::Gemm g2; g2.A = (const bf16_t*)(ws + WS_H8); g2.Bt = (const bf16_t*)(ws + WS_WT_IN0); g2.M = MT; g2.N = IN0_NQ; g2.K = D / 2; g2.sc_w = W8_E8M0; g2.sc_a = ONE_E8M0;
          pg8::StaticOrder S; S.init(g2.M, g2.N, G2, c - extra); EpiQKV E; E.O = (bf16_t*)(ws + WS_QKV); E.rope = (const float*)(ws + WS_ROPE); E.VT = (bf16_t*)(ws + WS_VT); pg8::gemm_phase<EpiQKV, pg8::StaticOrder, true>(lds, g2, S, E, wv_); } }
    else if constexpr (WHICH == G_IN08) { g.A = (const bf16_t*)(ws + WS_H); g.Bt = (const bf16_t*)(ws + WS_WT_IN0); g.M = MT; g.N = EVIN; g.K = D / 2; g.sc_w = W8_E8M0; g.sc_a = ONE_E8M0;
        pg8::StaticOrder S; S.init(g.M, g.N, G, c); EpiQKV E; E.O = (bf16_t*)(ws + WS_QKV); E.rope = (const float*)(ws + WS_ROPE); E.VT = (bf16_t*)(ws + WS_VT); pg8::gemm_phase<EpiQKV, pg8::StaticOrder, true>(lds, g, S, E, wv_); }
    else if constexpr (WHICH == G_OUT08) { g.A = (const bf16_t*)(ws + WS_MIX); g.Bt = (const bf16_t*)(ws + WS_WT_OUT0); g.M = MT; g.N = D; g.K = D / 2; g.sc_w = W8_E8M0; g.sc_a = ONE_E8M0;
        pg8::StaticOrder S; S.init(g.M, g.N, G, c); gemm_stagger(S, 30); EpiResid0 E; E.xin_lat = p.x; E.xin_ctx = p.ctx; E.xout = (float*)(ws + WS_XRES); E.gate = (const float*)(ws + WS_ADA) + 2 * D; pg8::gemm_phase<EpiResid0, pg8::StaticOrder, true>(lds, g, S, E, wv_); }
    else if constexpr (WHICH == G_IN18) { g.A = (const bf16_t*)(ws + WS_H); g.Bt = (const bf16_t*)(ws + WS_WT_IN1); g.M = MT; g.N = S5W; g.K = D / 2; g.sc_w = W8_E8M0; g.sc_a = ONE_E8M0;
        pg8::StaticOrder S; S.init(g.M, g.N, G, c); gemm_stagger(S, 16); EpiBf16 E; E.O = (bf16_t*)(ws + WS_U1); E.ldc = S5W; pg8::gemm_phase<EpiBf16, pg8::StaticOrder, true>(lds, g, S, E, wv_); }
    else if constexpr (WHICH == G_GLU8) { g.A = (const bf16_t*)(ws + WS_Z); g.Bt = (const bf16_t*)(ws + WS_WT_GLU); g.M = ML; g.N = S5W; g.K = S5W / 2; g.sc_w = W8_E8M0; g.sc_a = Z8_E8M0;
        pg8::StaticOrder S; S.init(g.M, g.N, G, c); EpiGLU8 E; E.Z = ws + WS_Z; E.O = ws + WS_S; E.bias = p.s5_glu_b; pg8::gemm_phase<EpiGLU8, pg8::StaticOrder, true>(lds, g, S, E, wv_); }
    else if constexpr (WHICH == G_OUT18) { g.A = (const bf16_t*)(ws + WS_S); g.Bt = (const bf16_t*)(ws + WS_WT_OUT1); g.M = ML; g.N = D; g.K = S5W / 2; g.sc_w = W8_E8M0; g.sc_a = S8_E8M0;
        pg8::StaticOrder S; S.init(g.M, g.N, G, c); EpiResid E; E.xin_lat = (const float*)(ws + WS_XRES); E.xin_ctx = (const float*)(ws + WS_XRES + (size_t)ML * D * (RES_BF16 ? 2 : 4)); E.xout = (float*)(ws + WS_XRES);
        E.gate = (const float*)(ws + WS_ADA) + (size_t)NADA * ADA6 + 2 * D; pg8::gemm_phase<EpiResid, pg8::StaticOrder, true>(lds, g, S, E, wv_); }
    else if constexpr (WHICH == G_GU8) { g.A = (const bf16_t*)(ws + WS_H); g.Bt = (const bf16_t*)(ws + WS_WT_GU + (size_t)l * NE * 2 * FF * D * 2); g.M = NBLK * 256; g.N = 2 * FF; g.K = D / 2; g.sc_w = W8_E8M0; g.sc_a = ONE_E8M0;
        pg8::MoeOrder<true> S; S.init((const int*)(ws + WS_CNT) + l * 64, g.N, G, c, (const int*)(ws + WS_ROWIDX), (size_t)2 * FF * D); gemm_stagger(S, 20); EpiGU8 E; E.O = ws + WS_ACT; pg8::gemm_phase<EpiGU8, pg8::MoeOrder<true>, true>(lds, g, S, E, wv_); }
    else if constexpr (WHICH == G_DN8) { g.A = (const bf16_t*)(ws + WS_ACT); g.Bt = (const bf16_t*)(ws + WS_WT_DN + (size_t)l * NE * D * FF * 2); g.M = NBLK * 256; g.N = D; g.K = FF / 2; g.sc_w = W8_E8M0; g.sc_a = ACT8_E8M0;
        pg8::MoeOrder<false> S; S.init((const int*)(ws + WS_CNT) + l * 64, g.N, G, c, nullptr, (size_t)D * FF); gemm_stagger(S, 13);
        if constexpr (Y8) { EpiY8 E; E.O = ws + WS_YBUF; E.ldc = D; pg8::gemm_phase<EpiY8, pg8::MoeOrder<false>, true>(lds, g, S, E, wv_); }
        else { EpiBf16 E; E.O = (bf16_t*)(ws + WS_YBUF); E.ldc = D; pg8::gemm_phase<EpiBf16, pg8::MoeOrder<false>, true>(lds, g, S, E, wv_); } }
#endif
    else if constexpr (WHICH == G_IN1) { g.A = (const bf16_t*)(ws + WS_H); g.Bt = (const bf16_t*)(ws + WS_WT_IN1); g.M = MT; g.N = S5W; g.K = D;
        pg8::StaticOrder S; S.init(g.M, g.N, G, c); EpiBf16 E; E.O = (bf16_t*)(ws + WS_U1); E.ldc = S5W; pg8::gemm_phase(lds, g, S, E, wv_); }
    else if constexpr (WHICH == G_GLU) { g.A = (const bf16_t*)(ws + WS_Z); g.Bt = (const bf16_t*)(ws + WS_WT_GLU); g.M = ML; g.N = S5W; g.K = S5W;
        pg8::StaticOrder S; S.init(g.M, g.N, G, c); EpiGLU E; E.Z = (const bf16_t*)(ws + WS_Z); E.O = (bf16_t*)(ws + WS_S); E.bias = p.s5_glu_b; pg8::gemm_phase(lds, g, S, E, wv_); }
    else { g.A = (const bf16_t*)(ws + WS_S); g.Bt = (const bf16_t*)(ws + WS_WT_OUT1); g.M = ML; g.N = D; g.K = S5W;
        pg8::StaticOrder S; S.init(g.M, g.N, G, c); EpiResid E; E.xin_lat = (const float*)(ws + WS_XRES); E.xin_ctx = (const float*)(ws + WS_XRES + (size_t)ML * D * (RES_BF16 ? 2 : 4)); E.xout = (float*)(ws + WS_XRES);
        E.gate = (const float*)(ws + WS_ADA) + (size_t)NADA * ADA6 + 2 * D; pg8::gemm_phase(lds, g, S, E, wv_); }
}
#ifndef CPU_EMU

#define XB_TMO      128
#define XB_XCNT(j)  (256  + 64 * (j))
#define XB_XSUB(j)  (1280 + 64 * (j))
#define XB_XGEN(j)  (2304 + 64 * (j))
#define XB_TOP      3328
#define XB_TOPGEN   3392
#define XCD_BAR_WORDS 3456
#define XB_SPIN_CAP (1u << 24)

__device__ __forceinline__ unsigned xb_ld(unsigned* p)              { return __hip_atomic_load(p, __ATOMIC_RELAXED, __HIP_MEMORY_SCOPE_AGENT); }
__device__ __forceinline__ unsigned xb_add(unsigned* p, unsigned v) { return __hip_atomic_fetch_add(p, v, __ATOMIC_RELAXED, __HIP_MEMORY_SCOPE_AGENT); }
__device__ __forceinline__ unsigned xb_xcc_id() { return (unsigned)__builtin_amdgcn_s_getreg((3 << 11) | 20) & 0xFu; }
#define XB_SPIN(cond, bar) do { unsigned _sp = 0; while (cond) { __builtin_amdgcn_s_sleep(1); \
    if ((++_sp & 255u) == 0u) { if (xb_ld(&(bar)[XB_TMO])) break; if (_sp > XB_SPIN_CAP) { atomicAdd(&(bar)[XB_TMO], 1u); break; } } } } while (0)

struct XcdBarrier {
    unsigned* bar; unsigned x;
    volatile LAS unsigned* st;
};

__device__ __forceinline__ XcdBarrier xcd_barrier_post(unsigned* bar, volatile LAS unsigned* st, int wv_) {
    XcdBarrier b; b.bar = bar; b.x = xb_xcc_id(); b.st = st;
    if (tid_of(wv_) == 0) (void)xb_add(&bar[XB_XCNT(b.x)], 1u);
    return b;
}
__device__ __forceinline__ void xcd_barrier_complete(unsigned* bar, unsigned x, unsigned& nloc, unsigned& nx) {
    const unsigned G = gridDim.x * gridDim.y * gridDim.z;
    unsigned sum, cnt, mine, sp = 0u;
    for (;;) {
        sum = 0u; cnt = 0u; mine = 0u;
#pragma unroll
        for (unsigned j = 0; j < 16; ++j) { const unsigned c = xb_ld(&bar[XB_XCNT(j)]); sum += c; cnt += (c > 0u) ? 1u : 0u; mine = (j == x) ? c : mine; }
        if (sum == G) break;
        __builtin_amdgcn_s_sleep(1);
        if ((++sp & 255u) == 0u) { if (xb_ld(&bar[XB_TMO])) break; if (sp > XB_SPIN_CAP) { atomicAdd(&bar[XB_TMO], 1u); break; } }
    }
    nloc = mine > 0u ? mine : 1u; nx = cnt > 0u ? cnt : 1u;
}

__device__ __forceinline__ void xcd_barrier(const XcdBarrier& b, int wv_) {
    asm volatile("s_waitcnt vmcnt(0)" ::: "memory");
    __syncthreads();
    if (tid_of(wv_) == 0) {
        unsigned* bar = b.bar;
        __builtin_amdgcn_s_waitcnt(0);
        unsigned nloc = b.st[0], nx = b.st[1];
        if (nloc == 0u) { xcd_barrier_complete(bar, b.x, nloc, nx); b.st[0] = nloc; b.st[1] = nx; }
        const unsigned old = xb_add(&bar[XB_XSUB(b.x)], 1u);
        const unsigned gen = old / nloc;
        if (old + 1u == (gen + 1u) * nloc) {
            __builtin_amdgcn_fence(__ATOMIC_RELEASE, "agent");
            asm volatile("s_waitcnt vmcnt(0)" ::: "memory");
            const unsigned og = xb_add(&bar[XB_TOP], 1u);
            const unsigned tg = og / nx;
            if (og + 1u == (tg + 1u) * nx) xb_add(&bar[XB_TOPGEN], 1u);
            else XB_SPIN(xb_ld(&bar[XB_TOPGEN]) == tg, bar);
            __builtin_amdgcn_fence(__ATOMIC_ACQUIRE, "agent");
            xb_add(&bar[XB_XGEN(b.x)], 1u);
            asm volatile("s_waitcnt vmcnt(0)" ::: "memory");
        } else {
            XB_SPIN(xb_ld(&bar[XB_XGEN(b.x)]) == gen, bar);
            __builtin_amdgcn_fence(__ATOMIC_ACQUIRE, "agent");
            asm volatile("s_waitcnt vmcnt(0)" ::: "memory");
        }
    }
    __syncthreads();
}


#define GT ((long)blockIdx.x * blockDim.x + threadIdx.x)
#define GN ((long)gridDim.x * blockDim.x)
constexpr int MEGA_LDS = 147456;
__device__ __forceinline__ long gt_of(int wv) { return (long)blockIdx.x * 512 + tid_of(wv); }
__global__ void __launch_bounds__(512, 2) k_mega(Params p) {
    extern __shared__ __attribute__((aligned(16))) unsigned char shm[];
    volatile LAS unsigned* st = (volatile LAS unsigned*)(shm + MEGA_LDS - 64);
    const int WV = __builtin_amdgcn_readfirstlane((int)threadIdx.x >> 6);
    if (tid_of(WV) == 0) { st[0] = 0u; st[1] = 0u; st[2] = 0u; st[3] = 0u; }
    __syncthreads();
    const XcdBarrier bar = xcd_barrier_post((unsigned*)(p.ws + WS_BAR), st, WV);
    const long gn = (long)gridDim.x * 512; const int G = (int)gridDim.x, c = (int)blockIdx.x; const pg8::LdsPtr lds = (pg8::LdsPtr)shm;
#define gt gt_of(WV)
    ph_ada(p, (float*)shm, c, G, WV); ph_tables(p, gt, gn); ph_convert(p, (float*)shm, CVT_TILES, -1, WV);
    xcd_barrier(bar, WV);
    ph_norm_fast<0>(p, 0, MT, c * 8 + WV, G * 8, WV);
    xcd_barrier(bar, WV);
    run_gemm<IN0_FP8 ? G_IN08 : (IN0QKV_FP8 ? G_IN0SPLIT : G_IN0)>(p, 0, lds, G, c, WV);
    xcd_barrier(bar, WV);
    ph_attn_fast(p, (LAS unsigned char*)shm, c, G, WV);
    { constexpr int ATT_UNITS = NB * 4 * (NSEQ / 128 + NCTX / 128); const int extra = ATT_UNITS % G;
      if (extra * 2 < G) { if (c >= extra) ph_conv_fast(p, (long)(c - extra) * 512 + tid_of(WV), (long)(G - extra) * 512); } else ph_conv_fast(p, gt, gn); }
    xcd_barrier(bar, WV);
    ph_lru_fast<1>(p, (LAS unsigned char*)shm, c * 8 + WV, G * 8, WV);
    xcd_barrier(bar, WV);
    ph_lru_fast<2>(p, (LAS unsigned char*)shm, c * 8 + WV, G * 8, WV);
    xcd_barrier(bar, WV);
    run_gemm<OUT0_FP8 ? G_OUT08 : G_OUT0>(p, 0, lds, G, c, WV);
    xcd_barrier(bar, WV);
    ph_router_fast<MOE0_FP8>(p, 0, MT, (LAS unsigned char*)shm, c, G, WV);
    xcd_barrier(bar, WV);
    ph_dispatch_fast(p, 0, MT, (LAS unsigned char*)shm, c, G, WV);
    xcd_barrier(bar, WV);
    run_gemm<MOE0_FP8 ? G_GU8 : G_GU>(p, 0, lds, G, c, WV);
    xcd_barrier(bar, WV);
    run_gemm<MOE0_FP8 ? G_DN8 : G_DN>(p, 0, lds, G, c, WV);
    xcd_barrier(bar, WV);
    ph_norm_fast<1>(p, 1, MT, c * 8 + WV, G * 8, WV);
    xcd_barrier(bar, WV);
    run_gemm<DENSE1_FP8 ? G_IN18 : G_IN1>(p, 1, lds, G, c, WV);
    xcd_barrier(bar, WV);
    ph_s5_fast<1>(p, (LAS unsigned char*)shm, c * 8 + WV, G * 8, WV);
    xcd_barrier(bar, WV);
    ph_s5_fast<2>(p, (LAS unsigned char*)shm, c * 8 + WV, G * 8, WV);
    xcd_barrier(bar, WV);
    run_gemm<DENSE1_FP8 ? G_GLU8 : G_GLU>(p, 1, lds, G, c, WV);
    xcd_barrier(bar, WV);
    run_gemm<DENSE1_FP8 ? G_OUT18 : G_OUT1>(p, 1, lds, G, c, WV);
    xcd_barrier(bar, WV);
    ph_router_fast<MOE1_FP8>(p, 1, ML, (LAS unsigned char*)shm, c, G, WV);
    xcd_barrier(bar, WV);
    ph_dispatch_fast(p, 1, ML, (LAS unsigned char*)shm, c, G, WV);
    xcd_barrier(bar, WV);
    run_gemm<MOE1_FP8 ? G_GU8 : G_GU>(p, 1, lds, G, c, WV);
    xcd_barrier(bar, WV);
    run_gemm<MOE1_FP8 ? G_DN8 : G_DN>(p, 1, lds, G, c, WV);
    xcd_barrier(bar, WV);
    ph_norm_fast<2>(p, 1, ML, c * 8 + WV, G * 8, WV);
#undef gt
}

#ifdef MK_MULTI
__global__ void __launch_bounds__(512, 2) k_prologue(Params p) {
    extern __shared__ __attribute__((aligned(16))) unsigned char shm[];
    ph_ada(p, (float*)shm, blockIdx.x, gridDim.x, (int)threadIdx.x >> 6); ph_tables(p, GT, GN); ph_convert(p, (float*)shm, CVT_TILES, -1, (int)threadIdx.x >> 6);
}
template <int WHICH> __global__ void __launch_bounds__(512, 2) k_gemm(Params p, int l) {
    extern __shared__ __attribute__((aligned(16))) unsigned char shm[];
    run_gemm<WHICH>(p, l, (pg8::LdsPtr)shm, (int)gridDim.x, (int)blockIdx.x, __builtin_amdgcn_readfirstlane((int)threadIdx.x >> 6));
}
__global__ void __launch_bounds__(512, 2) k_norm(Params p, int l, int rows) { ph_norm(p, l, rows, GT, GN); }
__global__ void __launch_bounds__(512, 2) k_conv(Params p) { ph_conv(p, GT, GN); }
__global__ void __launch_bounds__(512, 2) k_lru(Params p) { ph_lru(p, GT, GN); }
__global__ void __launch_bounds__(512, 2) k_attn(Params p) { ph_attn(p, GT, GN); }
__global__ void __launch_bounds__(512, 2) k_router(Params p, int l, int rows) { ph_router(p, l, rows, GT, GN); }
__global__ void __launch_bounds__(512, 2) k_dispatch(Params p, int l, int rows) { ph_dispatch(p, l, rows, GT, GN); }
__global__ void __launch_bounds__(512, 2) k_combine(Params p, int l, int rows) { ph_combine(p, l, rows, GT, GN); }
__global__ void __launch_bounds__(512, 2) k_s5(Params p) { ph_s5(p, GT, GN); }
__global__ void __launch_bounds__(512, 2) k_final(Params p) { ph_final(p, GT, GN); }

#endif
static Params make_params(void* const* d_in, void* d_out, void* d_ws) {
    Params p{}; const float* const* in = (const float* const*)d_in;
    p.x = in[0]; p.c = in[1]; p.ctx = in[2]; p.c_ctx = in[3]; p.ada_w = in[4]; p.ada_b = in[5]; p.norm_mix = in[6]; p.norm_ffn = in[7]; p.norm_final = in[8];
    p.ev_w_in = in[9]; p.ev_w_out = in[10]; p.attn_sink = in[11]; p.lru_conv_w = in[12]; p.lru_conv_b = in[13]; p.lru_lam = in[14]; p.lru_wa = in[15]; p.lru_ba = in[16]; p.lru_wi = in[17]; p.lru_bi = in[18];
    p.od_w_in = in[19]; p.s5_lam_re = in[20]; p.s5_lam_im = in[21]; p.s5_log_step = in[22]; p.s5_b_re = in[23]; p.s5_b_im = in[24]; p.s5_c_re = in[25]; p.s5_c_im = in[26]; p.s5_d = in[27];
    p.s5_glu_w = in[28]; p.s5_glu_b = in[29]; p.od_w_out = in[30]; p.router_w = in[31]; p.router_b = in[32]; p.moe_w_gate = in[33]; p.moe_w_up = in[34]; p.moe_w_down = in[35];
    p.out = (float*)d_out; p.ws = (unsigned char*)d_ws; return p;
}

extern "C" void kernel_launch(void* const* d_in, const int* in_sizes, int n_in, void* d_out, int out_size, void* d_ws, size_t ws_size, hipStream_t stream) {
    if (n_in != 36 || ws_size < WS_END || out_size != ML * D) { fprintf(stderr, "kernel_launch: unexpected shapes (n_in %d, out %d, ws %zu < %zu)\n", n_in, out_size, ws_size, (size_t)WS_END); return; }
#ifdef MK_MULTI
    static bool attr_done = false;
    constexpr int GLDS = pg8::STAGE_BYTES;
    if (!attr_done) {
        (void)hipFuncSetAttribute((const void*)k_gemm<G_IN0>, hipFuncAttributeMaxDynamicSharedMemorySize, GLDS); (void)hipFuncSetAttribute((const void*)k_gemm<G_OUT0>, hipFuncAttributeMaxDynamicSharedMemorySize, GLDS);
        (void)hipFuncSetAttribute((const void*)k_gemm<G_GU>, hipFuncAttributeMaxDynamicSharedMemorySize, GLDS); (void)hipFuncSetAttribute((const void*)k_gemm<G_DN>, hipFuncAttributeMaxDynamicSharedMemorySize, GLDS);
        (void)hipFuncSetAttribute((const void*)k_gemm<G_IN1>, hipFuncAttributeMaxDynamicSharedMemorySize, GLDS); (void)hipFuncSetAttribute((const void*)k_gemm<G_GLU>, hipFuncAttributeMaxDynamicSharedMemorySize, GLDS);
        (void)hipFuncSetAttribute((const void*)k_gemm<G_OUT1>, hipFuncAttributeMaxDynamicSharedMemorySize, GLDS);
        attr_done = true;
    }
    const Params p = make_params(d_in, d_out, d_ws);
    (void)hipMemsetAsync(d_ws, 0, CTL_BYTES, stream);
    const dim3 blk(512); const int NG = 256, NW = 1024;
    k_prologue<<<NW, blk, (ADA_LDS_BYTES > CVT_LDS_BYTES + 16 ? ADA_LDS_BYTES : CVT_LDS_BYTES + 16), stream>>>(p);
    k_norm<<<NW, blk, 0, stream>>>(p, 0, MT);
    k_gemm<G_IN0><<<NG, blk, GLDS, stream>>>(p, 0);
    k_attn<<<NW, blk, 0, stream>>>(p);
    k_conv<<<NW, blk, 0, stream>>>(p);
    k_lru<<<NW, blk, 0, stream>>>(p);
    k_gemm<G_OUT0><<<NG, blk, GLDS, stream>>>(p, 0);
    k_router<<<NW, blk, 0, stream>>>(p, 0, MT);
    k_dispatch<<<NW, blk, 0, stream>>>(p, 0, MT);
    k_gemm<G_GU><<<NG, blk, GLDS, stream>>>(p, 0);
    k_gemm<G_DN><<<NG, blk, GLDS, stream>>>(p, 0);
    k_combine<<<NW, blk, 0, stream>>>(p, 0, MT);
    k_norm<<<NW, blk, 0, stream>>>(p, 1, MT);
    k_gemm<G_IN1><<<NG, blk, GLDS, stream>>>(p, 1);
    k_s5<<<NW, blk, 0, stream>>>(p);
    k_gemm<G_GLU><<<NG, blk, GLDS, stream>>>(p, 1);
    k_gemm<G_OUT1><<<NG, blk, GLDS, stream>>>(p, 1);
    k_router<<<NW, blk, 0, stream>>>(p, 1, ML);
    k_dispatch<<<NW, blk, 0, stream>>>(p, 1, ML);
    k_gemm<G_GU><<<NG, blk, GLDS, stream>>>(p, 1);
    k_gemm<G_DN><<<NG, blk, GLDS, stream>>>(p, 1);
    k_combine<<<NW, blk, 0, stream>>>(p, 1, ML);
    k_final<<<NW, blk, 0, stream>>>(p);
#else
    static int grid = 0;
    if (!grid) {
        int dev = 0, cus = 0, per_cu = 0;
        if (hipGetDevice(&dev) != hipSuccess || hipDeviceGetAttribute(&cus, hipDeviceAttributeMultiprocessorCount, dev) != hipSuccess) { fprintf(stderr, "kernel_launch: device query failed\n"); return; }
        if (hipFuncSetAttribute((const void*)k_mega, hipFuncAttributeMaxDynamicSharedMemorySize, MEGA_LDS) != hipSuccess) { fprintf(stderr, "kernel_launch: hipFuncSetAttribute failed\n"); return; }
        if (hipOccupancyMaxActiveBlocksPerMultiprocessor(&per_cu, (const void*)k_mega, 512, MEGA_LDS) != hipSuccess || per_cu < 1) { fprintf(stderr, "kernel_launch: occupancy query says %d\n", per_cu); return; }
        grid = cus < MAXG ? cus : MAXG;
    }
    const Params p = make_params(d_in, d_out, d_ws);
    (void)hipMemsetAsync(d_ws, 0, WS_ADA, stream);
    hipLaunchKernelGGL(k_mega, dim3(grid), dim3(512), MEGA_LDS, stream, p);
#endif
}
#endif
```

```cpp
#ifndef CPU_EMU
#include <hip/hip_runtime.h>
#include <cstdio>
#include <cstdint>
#endif

#ifndef BATCH
#define BATCH 4
#endif
#ifndef SEQ
#define SEQ 4096
#endif
#ifndef CTX_LEN
#define CTX_LEN 256
#endif
constexpr int D = 2048, NB = BATCH, NSEQ = SEQ, NCTX = CTX_LEN;
constexpr int ML = NB * NSEQ, MC = NB * NCTX, MT = ML + MC;
constexpr int NADA = NB + 1;
constexpr int QW = 1024, KVW = 256, LW = 1024, EVIN = 3584;
constexpr int COL_Q = 0, COL_K = 1024, COL_V = 1280, COL_XR = 1536, COL_GR = 2560;
constexpr int S5W = 1024, S5G = 64, S5C = 16, S5S = 64;
constexpr int NE = 16, FF = 1024;
constexpr int NBLK = (2 * MT + 255) / 256 + NE;
constexpr int ADA6 = 6 * D;
static_assert(ML % 256 == 0 && MC % 256 == 0 && NSEQ % 256 == 0 && NCTX % 256 == 0, "tiles must not straddle sequences");

typedef unsigned short bf16_t;
#ifndef CPU_EMU
#define LAS __attribute__((address_space(3)))
__device__ __forceinline__ int tid_of(int wv) { int l; asm volatile("v_mbcnt_lo_u32_b32 %0, -1, 0\n\tv_mbcnt_hi_u32_b32 %0, -1, %0" : "=v"(l)); return wv * 64 + l; }
#endif

#ifdef CPU_EMU
constexpr bool MOE1_FP8 = false, MOE0_FP8 = false, DENSE1_FP8 = false, IN0_FP8 = false, IN0QKV_FP8 = false, OUT0_FP8 = false, RES_BF16 = false, Y8 = false;
#else
constexpr bool Y8 = true;
constexpr bool RES_BF16 = true; constexpr bool IN0_FP8 = false, IN0QKV_FP8 = true, OUT0_FP8 = true;
constexpr bool DENSE1_FP8 = true;
constexpr bool MOE0_FP8 = true;
constexpr bool MOE1_FP8 = true;
#endif
constexpr float W8_SCALE = 64.0f, ACT8_SCALE = 4.0f;
constexpr int W8_E8M0 = 127 - 6, ACT8_E8M0 = 127 - 2, ONE_E8M0 = 127;
constexpr float Z8_SCALE = 8.0f, S8_SCALE = 16.0f, MIX8_SCALE = 16.0f, Y8_SCALE = 16.0f; constexpr int Z8_E8M0 = 127 - 3, S8_E8M0 = 127 - 4, MIX8_E8M0 = 127 - 4;

constexpr size_t al256(size_t x) { return (x + 255) & ~(size_t)255; }
constexpr size_t WS_BAR = 0;
constexpr size_t WS_CNT = 16384;
constexpr size_t WS_ADA = 32768;
constexpr size_t CTL_BYTES = al256(WS_ADA + (size_t)2 * NADA * ADA6 * 4);
constexpr size_t WS_ROPE = CTL_BYTES;
constexpr size_t WS_S5LAM = WS_ROPE + 64 * 16 * 8;
constexpr size_t WS_S5BB = WS_S5LAM + (size_t)2 * S5G * S5S * 8;
constexpr size_t WS_S5LAMT = WS_S5BB + (size_t)2 * S5G * S5S * S5C * 8;
constexpr size_t WS_S5BF = WS_S5LAMT + (size_t)2 * S5G * S5S * 8;
constexpr size_t WS_S5CF = WS_S5BF + (size_t)2 * S5G * 4 * 64 * 16;
constexpr size_t WS_LRUBF = WS_S5CF + (size_t)2 * S5G * 4 * 64 * 16;
constexpr size_t WS_RWF = WS_LRUBF + (size_t)2 * 16 * 2 * 2 * 4 * 64 * 16;
constexpr size_t WS_WT_IN0 = al256(WS_RWF + (size_t)2 * 64 * 64 * 16);
constexpr size_t WS_WT_OUT0 = WS_WT_IN0 + (size_t)EVIN * D * 2;
constexpr size_t WS_WT_IN1 = WS_WT_OUT0 + (size_t)D * D * 2;
constexpr size_t WS_WT_GLU = WS_WT_IN1 + (size_t)S5W * D * 2;
constexpr size_t WS_WT_OUT1 = WS_WT_GLU + (size_t)S5W * S5W * 2;
constexpr size_t WS_WT_GU = WS_WT_OUT1 + (size_t)D * S5W * 2;
constexpr size_t WS_WT_DN = WS_WT_GU + (size_t)2 * NE * 2 * FF * D * 2;
constexpr size_t WS_W8_GU = WS_WT_GU + (size_t)NE * 2 * FF * D * 2;
constexpr size_t WS_W8_DN = WS_WT_DN + (size_t)NE * D * FF * 2;
constexpr size_t WS_XRES = WS_WT_DN + (size_t)2 * NE * D * FF * 2;
constexpr size_t WS_H8 = WS_XRES + (size_t)MT * D * 2;
constexpr size_t WS_H = WS_XRES + (size_t)MT * D * 4;
constexpr size_t WS_TOK = WS_H + (size_t)MT * D * 2;
constexpr size_t WS_ROWIDX = WS_TOK + (size_t)4 * MT * 2 * 4;
constexpr size_t WS_RA = al256(WS_ROWIDX + (size_t)NBLK * 256 * 4);
constexpr size_t WS_QKV = WS_RA;
constexpr size_t WS_MIX = WS_QKV + (size_t)MT * EVIN * 2;
constexpr size_t WS_U1 = WS_RA;
constexpr size_t WS_YS5 = WS_U1 + (size_t)MT * S5W * 2;
constexpr size_t WS_Z = WS_YS5 + (size_t)ML * S5W * 4;
constexpr size_t WS_S = WS_Z + (size_t)ML * S5W * 2;
constexpr int S5_CHUNK = 128, S5_NCC = NCTX / S5_CHUNK, S5_NLC = NSEQ / S5_CHUNK, S5_NCH = S5_NCC + S5_NLC;
static_assert(S5_NCC % 2 == 0 && S5_NLC % 2 == 0, "chunks are processed in pairs");
constexpr size_t WS_S5E = WS_S + (size_t)ML * S5W * 2;
constexpr size_t RA_BYTES = (size_t)MT * EVIN * 2 + (size_t)MT * D * 2;
static_assert(WS_S5E + (size_t)NB * S5G * 2 * S5_NCH * S5S * 8 <= WS_RA + RA_BYTES, "L1 overlay (E)");
static_assert((size_t)MT * S5W * 2 + (size_t)ML * S5W * 4 + 2 * (size_t)ML * S5W * 2 <= RA_BYTES, "L1 overlay");
constexpr size_t WS_RB = al256(WS_RA + RA_BYTES);
constexpr size_t WS_ACT = WS_RB;
constexpr size_t WS_YBUF = WS_ACT + (size_t)NBLK * 256 * FF * 2;
constexpr size_t WS_UCONV = WS_RB;
constexpr size_t WS_HSUM = WS_UCONV + (size_t)MT * LW * 4;
constexpr size_t RB_BYTES = (size_t)NBLK * 256 * FF * 2 + (size_t)NBLK * 256 * D * 2;
static_assert(2 * (size_t)MT * LW * 4 <= RB_BYTES, "LRU overlay");
constexpr size_t WS_UBF = WS_RB;
constexpr int VT_T = 128 + NSEQ + 128 + NCTX;
constexpr size_t WS_VT = WS_UBF + (size_t)MT * LW * 2;
constexpr size_t WS_LRUAGG = al256(WS_VT + (size_t)NB * 4 * 64 * VT_T * 2);
constexpr int LRU_CH = 64, LRU_NCC = NCTX / LRU_CH, LRU_NLC = NSEQ / LRU_CH, LRU_NCH = LRU_NCC + LRU_NLC;
static_assert(LRU_NCC % 2 == 0 && LRU_NLC % 2 == 0, "chunks are processed in pairs");
static_assert(WS_LRUAGG + (size_t)NB * 2 * LRU_NCH * LW * 8 <= WS_RB + RB_BYTES, "RB overlay");
constexpr int MAXG = 256;
constexpr int HIST_LD = 32;
constexpr size_t WS_HIST = al256(WS_RB + RB_BYTES);
constexpr size_t WS_END = WS_HIST + (size_t)2 * MAXG * HIST_LD * 4;

struct Params {
    const float *x, *c, *ctx, *c_ctx, *ada_w, *ada_b, *norm_mix, *norm_ffn, *norm_final;
    const float *ev_w_in, *ev_w_out, *attn_sink, *lru_conv_w, *lru_conv_b, *lru_lam, *lru_wa, *lru_ba, *lru_wi, *lru_bi;
    const float *od_w_in, *s5_lam_re, *s5_lam_im, *s5_log_step, *s5_b_re, *s5_b_im, *s5_c_re, *s5_c_im, *s5_d, *s5_glu_w, *s5_glu_b, *od_w_out;
    const float *router_w, *router_b, *moe_w_gate, *moe_w_up, *moe_w_down;
    float* out;
    unsigned char* ws;
};

#ifdef CPU_EMU
typedef float f32x4 __attribute__((vector_size(16)));
#else
typedef float f32x4 __attribute__((ext_vector_type(4)));
#endif
struct u32x2_t { unsigned x, y; };
struct u32x4_t { unsigned x, y, z, w; };
#ifdef CPU_EMU
__device__ __forceinline__ void st_coh(int* p, int v) { *p = v; }
__device__ __forceinline__ int ld_coh(const int* p) { return *p; }
#else
__device__ __forceinline__ void st_coh(int* p, int v) { __hip_atomic_store(p, v, __ATOMIC_RELAXED, __HIP_MEMORY_SCOPE_AGENT); }
__device__ __forceinline__ int ld_coh(const int* p) { return __hip_atomic_load(p, __ATOMIC_RELAXED, __HIP_MEMORY_SCOPE_AGENT); }
#endif
__device__ __forceinline__ f32x4 unpack4bf(unsigned lo, unsigned hi) { return (f32x4){__uint_as_float(lo << 16), __uint_as_float(lo & 0xffff0000u), __uint_as_float(hi << 16), __uint_as_float(hi & 0xffff0000u)}; }
__device__ __forceinline__ float bf2f(bf16_t b) { return __uint_as_float(((unsigned)b) << 16); }
__device__ __forceinline__ bf16_t f2bf(float f) { unsigned u = __float_as_uint(f); u += 0x7FFFu + ((u >> 16) & 1u); return (bf16_t)(u >> 16); }
#ifdef CPU_EMU
__device__ __forceinline__ unsigned pack2bf(float lo, float hi) { return (unsigned)f2bf(lo) | ((unsigned)f2bf(hi) << 16); }
#else
typedef short s5_bf16x8 __attribute__((ext_vector_type(8)));
typedef unsigned u4v_t __attribute__((ext_vector_type(4)));
__device__ __forceinline__ int deal_item(int round, int gwave, int nwaves, int items, int grp = 2) {
    const int full = items / nwaves; if (round < full) return round * nwaves + gwave; if (round > full) return -1;
    const int rem = items - full * nwaves, blk = gwave >> 3, wv = gwave & 7; if (wv >= grp) return -1; const int j = blk * grp + wv; return j < rem ? full * nwaves + j : -1; }
#ifndef CPU_EMU
__device__ __forceinline__ float clamp_e4m3(float x) { return fminf(fmaxf(x, -448.0f), 448.0f); }
__device__ __forceinline__ unsigned pack4_fp8(float a, float b, float c, float d) { int w = 0; w = __builtin_amdgcn_cvt_pk_fp8_f32(clamp_e4m3(a), clamp_e4m3(b), w, false); w = __builtin_amdgcn_cvt_pk_fp8_f32(clamp_e4m3(c), clamp_e4m3(d), w, true); return (unsigned)w; }
#endif
__device__ __forceinline__ float opaque_zero() { float z = 0.f; asm volatile("" : "+v"(z)); return z; }
#define MFMA_KEEP(acc, x) asm volatile("" : "+v"(acc) : "v"(x))
typedef __bf16 bf16x2_hw __attribute__((ext_vector_type(2)));
typedef float f32x2_hw __attribute__((ext_vector_type(2)));
__device__ __forceinline__ unsigned pack2bf(float lo, float hi) { const f32x2_hw v = {lo, hi}; const bf16x2_hw b = __builtin_convertvector(v, bf16x2_hw); return __builtin_bit_cast(unsigned, b); }
#endif
#ifdef CPU_EMU
__device__ __forceinline__ float sigmoidf_(float x) { return 1.0f / (1.0f + __expf(-x)); }
__device__ __forceinline__ float fast_rcp(float x) { return 1.0f / x; }
__device__ __forceinline__ float fast_sqrt(float x) { return sqrtf(x); }
#else
__device__ __forceinline__ float fast_rcp(float x) { return __builtin_amdgcn_rcpf(x); }
__device__ __forceinline__ float fast_sqrt(float x) { return __builtin_amdgcn_sqrtf(x); }
__device__ __forceinline__ float sigmoidf_(float x) { return __builtin_amdgcn_rcpf(1.0f + __builtin_amdgcn_exp2f(-1.44269504089f * x)); }
#endif
__device__ __forceinline__ float siluf_(float x) { return x * sigmoidf_(x); }
#ifdef CPU_EMU
__device__ __forceinline__ float geluf_(float x) { const float u = 0.7978845608028654f * (x + 0.044715f * x * x * x); return 0.5f * x * (1.0f + tanhf(u)); }
#else
__device__ __forceinline__ float geluf_(float x) { const float t = x * x, e = __builtin_amdgcn_exp2f(x * __builtin_fmaf(t, -0.102943215f, -2.302208198f)); return x * __builtin_amdgcn_rcpf(1.0f + e); }
#endif
__device__ __forceinline__ float softplusf_(float x) { return x > 20.f ? x : log1pf(__expf(x)); }
__device__ __forceinline__ int ada_row(int r) { return r < ML ? r / NSEQ : NB; }
__device__ __forceinline__ const float* ada_ptr(const Params& p, int l, int arow, int which) { return (const float*)(p.ws + WS_ADA) + ((size_t)l * NADA + arow) * ADA6 + (size_t)which * D; }
__device__ __forceinline__ const float* xin_row(const Params& p, int l, int r) {
    if (l == 0) return r < ML ? p.x + (size_t)r * D : p.ctx + (size_t)(r - ML) * D;
    return (const float*)(p.ws + WS_XRES) + (size_t)r * D;
}

#ifndef CPU_EMU
constexpr int ADA_ITEMS = 2 * (ADA6 / 128), ADA_LDS_BYTES = (NADA * D + 16 * NADA * 128) * 4;
__device__ __forceinline__ void ph_ada(const Params& p, float* sil, int bid, int nblocks, int wv_) {
    const int tid = tid_of(wv_), w = wv_, lane = tid & 63, kh = lane >> 5, cq = lane & 31;
    float* ada = (float*)(p.ws + WS_ADA); float* red = sil + NADA * D;
    if (bid < ADA_ITEMS) { for (int i = tid; i < NADA * D; i += 512) { const int r = i / D, k = i % D; sil[i] = siluf_(r < NB ? p.c[(size_t)r * D + k] : p.c_ctx[k]); } }
    __syncthreads();
    for (int item = bid; item < ADA_ITEMS; item += nblocks) {
        const int l = item / (ADA6 / 128), cb = (item % (ADA6 / 128)) * 128, c0 = cb + cq * 4;
        f32x4 acc[NADA];
#pragma unroll
        for (int r = 0; r < NADA; ++r) acc[r] = (f32x4){0.f, 0.f, 0.f, 0.f};
        const float* wp = p.ada_w + (size_t)l * D * ADA6 + c0; const int k0 = w * 256 + kh * 128;
#pragma unroll 16
        for (int k = k0; k < k0 + 128; ++k) {
            const f32x4 wv = *(const f32x4*)(wp + (size_t)k * ADA6);
#pragma unroll
            for (int r = 0; r < NADA; ++r) acc[r] += wv * sil[r * D + k];
        }
        __syncthreads();
#pragma unroll
        for (int r = 0; r < NADA; ++r) *(f32x4*)(red + ((size_t)((w * 2 + kh) * NADA + r) * 128) + cq * 4) = acc[r];
        __syncthreads();
        for (int i = tid; i < NADA * 128; i += 512) { const int r = i / 128, cc = i % 128; float sacc = p.ada_b[(size_t)l * ADA6 + cb + cc];
#pragma unroll
            for (int ww = 0; ww < 16; ++ww) sacc += red[(size_t)(ww * NADA + r) * 128 + cc];
            ada[((size_t)l * NADA + r) * ADA6 + cb + cc] = sacc; }
    }
}
#else
void ph_ada_emu(const Params& p) {
    float* ada = (float*)(p.ws + WS_ADA);
    for (int l = 0; l < 2; ++l) for (int r = 0; r < NADA; ++r) { std::vector<double> acc(ADA6, 0.0);
        for (int k = 0; k < D; ++k) { const float cv = r < NB ? p.c[(size_t)r * D + k] : p.c_ctx[k]; const double sv = siluf_(cv); const float* wr = p.ada_w + ((size_t)l * D + k) * ADA6; for (int j = 0; j < ADA6; ++j) acc[j] += sv * wr[j]; }
        for (int j = 0; j < ADA6; ++j) ada[((size_t)l * NADA + r) * ADA6 + j] = (float)acc[j] + p.ada_b[(size_t)l * ADA6 + j]; }
}
#endif
__device__ __forceinline__ void ph_tables(const Params& p, long gtid, long gthreads) {
    float* rope = (float*)(p.ws + WS_ROPE);
    for (long it = gtid; it < 64 * 16; it += gthreads) {
        const int pos = (int)(it / 16), i = (int)(it % 16);
        const double inv = pow(10000.0, -(double)i / 16.0); const double a = (double)pos * (double)(float)inv;
        rope[it * 2] = (float)cos(a); rope[it * 2 + 1] = (float)sin(a);
    }
    float* lamb = (float*)(p.ws + WS_S5LAM); float* bb = (float*)(p.ws + WS_S5BB);
    for (long it = gtid; it < 2L * S5G * S5S; it += gthreads) {
        const int g = (int)((it / S5S) % S5G), d = (int)(it / (S5S * S5G));
        const double lr = p.s5_lam_re[it], li = p.s5_lam_im[it], step = exp((double)p.s5_log_step[d * S5G + g]);
        const double mag = exp(lr * step), br = mag * cos(li * step), bi = mag * sin(li * step);
        lamb[it * 2] = (float)br; lamb[it * 2 + 1] = (float)bi;
        const double nr = br - 1.0, ni = bi, den = lr * lr + li * li;
        const double cr = (nr * lr + ni * li) / den, ci = (ni * lr - nr * li) / den;
        float b_r[S5C], b_i[S5C];
#pragma unroll
        for (int c = 0; c < S5C; ++c) { b_r[c] = p.s5_b_re[it * S5C + c]; b_i[c] = p.s5_b_im[it * S5C + c]; }
#pragma unroll
        for (int c = 0; c < S5C; ++c) { bb[(it * S5C + c) * 2] = (float)(cr * (double)b_r[c] - ci * (double)b_i[c]); bb[(it * S5C + c) * 2 + 1] = (float)(cr * (double)b_i[c] + ci * (double)b_r[c]); }
        const double magT = exp(lr * step * S5_CHUNK); float* lt = (float*)(p.ws + WS_S5LAMT);
        lt[it * 2] = (float)(magT * cos(li * step * S5_CHUNK)); lt[it * 2 + 1] = (float)(magT * sin(li * step * S5_CHUNK));
    }
    { bf16_t* rw = (bf16_t*)(p.ws + WS_RWF);
      for (long it = gtid; it < 64L * 64 * 8; it += gthreads) { const int j = (int)(it & 7), lane = (int)((it >> 3) & 63), st = (int)(it >> 9);
          const float wv = p.router_w[(size_t)(32 * st + 8 * (lane >> 4) + j) * NE + (lane & 15)]; const bf16_t hi = f2bf(wv); rw[it] = hi; rw[64L * 64 * 8 + it] = f2bf(wv - bf2f(hi)); } }
    bf16_t* lb = (bf16_t*)(p.ws + WS_LRUBF);
    for (long it = gtid; it < 2L * 16 * 2 * 2 * 4 * 64 * 8; it += gthreads) {
        const int j = (int)(it & 7), lane = (int)((it >> 3) & 63), ks = (int)((it >> 9) & 3), cs = (int)((it >> 11) & 1), gate = (int)((it >> 12) & 1); const long dh = it >> 13;
        const float* w = gate ? p.lru_wi : p.lru_wa;
        lb[it] = f2bf(w[((size_t)dh * 64 + 16 * ks + 8 * (lane >> 5) + j) * 64 + 32 * cs + (lane & 31)]);
    }
    bf16_t* bf = (bf16_t*)(p.ws + WS_S5BF); bf16_t* cf = (bf16_t*)(p.ws + WS_S5CF);
    for (long it = gtid; it < 2L * S5G * 4 * 64 * 8; it += gthreads) {
        const int j = (int)(it & 7), lane = (int)((it >> 3) & 63), ct = (int)((it >> 9) & 3); const long dg = it >> 11;
        { const int st = (lane & 31) + 32 * (ct >> 1), ch = 8 * (lane >> 5) + j; const size_t gi = (size_t)dg * S5S + st;
          const double lr = p.s5_lam_re[gi], li = p.s5_lam_im[gi], step = exp((double)p.s5_log_step[dg]);
          const double mag = exp(lr * step), br = mag * cos(li * step), bi = mag * sin(li * step), nr = br - 1.0, ni = bi, den = lr * lr + li * li;
          const double cr = (nr * lr + ni * li) / den, ci = (ni * lr - nr * li) / den, b_r = p.s5_b_re[gi * S5C + ch], b_i = p.s5_b_im[gi * S5C + ch];
          bf[it] = f2bf((float)((ct & 1) ? (cr * b_i + ci * b_r) : (cr * b_r - ci * b_i))); }
        { const int ks = ct, q = 32 * ks + 8 * (lane >> 4) + j, st = q >> 1, ch = lane & 15; const size_t ci_ = ((size_t)dg * S5C + ch) * S5S + st;
          cf[it] = f2bf((q & 1) ? -p.s5_c_im[ci_] : p.s5_c_re[ci_]); }
    }
}
__device__ __forceinline__ void ph_norm(const Params& p, int l, int rows, long gtid, long gthreads) {
    bf16_t* h = (bf16_t*)(p.ws + WS_H);
    for (long r = gtid; r < rows; r += gthreads) {
        const float* xr = xin_row(p, l, (int)r); const int ar = ada_row((int)r);
        const float* sh = ada_ptr(p, l, ar, 0); const float* sc = ada_ptr(p, l, ar, 1); const float* g = p.norm_mix + (size_t)l * D;
        float ss = 0.f; for (int k = 0; k < D; ++k) ss += xr[k] * xr[k];
        const float rstd = 1.0f / sqrtf(ss / D + 1e-6f);
        for (int k = 0; k < D; ++k) h[(size_t)r * D + k] = f2bf(xr[k] * rstd * g[k] * (1.0f + sc[k]) + sh[k]);
    }
}
__device__ __forceinline__ void ph_conv(const Params& p, long gtid, long gthreads) {
    const bf16_t* qkv = (const bf16_t*)(p.ws + WS_QKV); float* u = (float*)(p.ws + WS_UCONV);
    for (long it = gtid; it < (long)MT * LW; it += gthreads) {
        const int r = (int)(it / LW), ch = (int)(it % LW);
        int base, t, n; if (r < ML) { base = (r / NSEQ) * NSEQ; t = r % NSEQ; n = NSEQ; } else { const int rc = r - ML; base = ML + (rc / NCTX) * NCTX; t = rc % NCTX; n = NCTX; }
        float acc = p.lru_conv_b[ch];
        for (int tap = 0; tap < 4; ++tap) { const int tt = t + tap - 2; if (tt >= 0 && tt < n) acc += p.lru_conv_w[tap * LW + ch] * bf2f(qkv[(size_t)(base + tt) * EVIN + COL_XR + ch]); }
        u[it] = acc;
    }
}
__device__ __forceinline__ void ph_lru(const Params& p, long gtid, long gthreads) {
    const bf16_t* qkv = (const bf16_t*)(p.ws + WS_QKV); const float* u = (const float*)(p.ws + WS_UCONV); float* hs = (float*)(p.ws + WS_HSUM); bf16_t* mix = (bf16_t*)(p.ws + WS_MIX);
    for (long it = gtid; it < (long)NB * LW; it += gthreads) {
        const int b = (int)(it / LW), ch = (int)(it % LW), hh = ch / 64, j = ch % 64;
        for (int d = 0; d < 2; ++d) {
            const float lamv = softplusf_(-p.lru_lam[d * LW + ch]), ba = p.lru_ba[d * LW + ch], bi = p.lru_bi[d * LW + ch];
            const float* wa = p.lru_wa + ((size_t)(d * 16 + hh) * 64) * 64 + j; const float* wi = p.lru_wi + ((size_t)(d * 16 + hh) * 64) * 64 + j;
            float state = 0.f;
            for (int seg = 0; seg < 2; ++seg) {
                const int n = seg ? NSEQ : NCTX, base = seg ? b * NSEQ : ML + b * NCTX;
                for (int stp = 0; stp < n; ++stp) {
                    const int row = base + (d ? n - 1 - stp : stp); const float* ur = u + (size_t)row * LW + hh * 64;
                    float ra = ba, ia = bi;
                    for (int i = 0; i < 64; ++i) { ra += ur[i] * wa[(size_t)i * 64]; ia += ur[i] * wi[(size_t)i * 64]; }
                    const float rg = sigmoidf_(ra), ig = sigmoidf_(ia), log_a = -8.0f * rg * lamv, a = __expf(log_a), mult = sqrtf(-expm1f(2.0f * log_a));
                    state = a * state + mult * (ig * ur[j]);
                    if (d == 0) hs[(size_t)row * LW + ch] = state;
                    else { const float tot = hs[(size_t)row * LW + ch] + state; mix[(size_t)row * D + QW + ch] = f2bf(tot * geluf_(bf2f(qkv[(size_t)row * EVIN + COL_GR + ch]))); }
                }
            }
        }
    }
}
__device__ __forceinline__ void ph_attn(const Params& p, long gtid, long gthreads) {
    const bf16_t* qkv = (const bf16_t*)(p.ws + WS_QKV); bf16_t* mix = (bf16_t*)(p.ws + WS_MIX);
    for (long it = gtid; it < (long)MT * 16; it += gthreads) {
        const int r = (int)(it / 16), hd = (int)(it % 16), kvh = hd / 4;
        float q[64], o[64];
        for (int d = 0; d < 64; ++d) { q[d] = bf2f(qkv[(size_t)r * EVIN + COL_Q + hd * 64 + d]); o[d] = 0.f; }
        float m = p.attn_sink[hd], lsum = 1.0f;
        const int b = r < ML ? r / NSEQ : (r - ML) / NCTX;
        for (int seg = 0; seg < 2; ++seg) {
            int k0, k1;
            if (seg == 0) { if (r >= ML) continue; const int t = r % NSEQ; const int lo = t - 128 < 0 ? 0 : t - 128, hi = t + 128 > NSEQ - 1 ? NSEQ - 1 : t + 128; k0 = b * NSEQ + lo; k1 = b * NSEQ + hi + 1; }
            else { k0 = ML + b * NCTX; k1 = k0 + NCTX; }
            for (int kr = k0; kr < k1; ++kr) {
                const bf16_t* kp = qkv + (size_t)kr * EVIN + COL_K + kvh * 64; const bf16_t* vp = qkv + (size_t)kr * EVIN + COL_V + kvh * 64;
                float s = 0.f; for (int d = 0; d < 64; ++d) s += q[d] * bf2f(kp[d]);
                if (s > m) { const float f = __expf(m - s); lsum *= f; for (int d = 0; d < 64; ++d) o[d] *= f; m = s; }
                const float pe = __expf(s - m); lsum += pe;
                for (int d = 0; d < 64; ++d) o[d] += pe * bf2f(vp[d]);
            }
        }
        const float inv = 1.0f / lsum;
        for (int d = 0; d < 64; ++d) mix[(size_t)r * D + hd * 64 + d] = f2bf(o[d] * inv);
    }
}
__device__ __forceinline__ void ph_router(const Params& p, int l, int rows, long gtid, long gthreads) {
    bf16_t* h = (bf16_t*)(p.ws + WS_H); const float* xres = (const float*)(p.ws + WS_XRES);
    int* tok_e = (int*)(p.ws + WS_TOK); float* tok_w = (float*)(p.ws + WS_TOK) + (size_t)MT * 2; int* tok_slot = (int*)(p.ws + WS_TOK) + (size_t)MT * 4;
    int* cnt = (int*)(p.ws + WS_CNT) + l * 64;
    for (long r = gtid; r < rows; r += gthreads) {
        const float* xr = xres + (size_t)r * D; const int ar = ada_row((int)r);
        const float* sh = ada_ptr(p, l, ar, 3); const float* sc = ada_ptr(p, l, ar, 4); const float* g = p.norm_ffn + (size_t)l * D;
        float ss = 0.f; for (int k = 0; k < D; ++k) ss += xr[k] * xr[k];
        const float rstd = 1.0f / sqrtf(ss / D + 1e-6f);
        float lg[NE];
#pragma unroll
        for (int e = 0; e < NE; ++e) lg[e] = p.router_b[e];
        for (int k = 0; k < D; ++k) { const float hv = xr[k] * rstd * g[k] * (1.0f + sc[k]) + sh[k]; h[(size_t)r * D + k] = f2bf(hv);
#pragma unroll
            for (int e = 0; e < NE; ++e) lg[e] += hv * p.router_w[(size_t)k * NE + e]; }
        float mx = lg[0];
#pragma unroll
        for (int e = 1; e < NE; ++e) mx = lg[e] > mx ? lg[e] : mx;
        float pr[NE], sum = 0.f;
#pragma unroll
        for (int e = 0; e < NE; ++e) { pr[e] = __expf(lg[e] - mx); sum += pr[e]; }
#pragma unroll
        for (int e = 0; e < NE; ++e) pr[e] /= sum;
        float best = -1.f, w1 = 0.f, w2 = 0.f; int e1 = 0, e2 = 0;
#pragma unroll
        for (int gi = 0; gi < 4; ++gi) { float a1 = -1.f, a2 = -1.f; int j1 = 0, j2 = 0;
#pragma unroll
            for (int j = 0; j < 4; ++j) { const float v = pr[gi * 4 + j]; if (v > a1) { a2 = a1; j2 = j1; a1 = v; j1 = j; } else if (v > a2) { a2 = v; j2 = j; } }
            if (a1 + a2 > best) { best = a1 + a2; e1 = gi * 4 + j1; e2 = gi * 4 + j2; w1 = a1; w2 = a2; } }
        const float ws = w1 + w2;
        tok_e[r * 2] = e1; tok_e[r * 2 + 1] = e2; tok_w[r * 2] = w1 / ws; tok_w[r * 2 + 1] = w2 / ws;
        tok_slot[r * 2] = atomicAdd(cnt + e1, 1); tok_slot[r * 2 + 1] = atomicAdd(cnt + e2, 1);
    }
}
__device__ __forceinline__ int moe_pad_start(const int* cnt, int e) { int acc = 0;
#pragma unroll
    for (int j = 0; j < NE; ++j) { const int pj = (cnt[j] + 255) / 256 * 256; acc += (j < e) ? pj : 0; } return acc; }
__device__ __forceinline__ void ph_dispatch(const Params& p, int l, int rows, long gtid, long gthreads) {
    const int* tok_e = (const int*)(p.ws + WS_TOK); const int* tok_slot = (const int*)(p.ws + WS_TOK) + (size_t)MT * 4; int* tok_dest = (int*)(p.ws + WS_TOK) + (size_t)MT * 6;
    int* rowidx = (int*)(p.ws + WS_ROWIDX); const int* cnt = (const int*)(p.ws + WS_CNT) + l * 64;
    for (long it = gtid; it < (long)rows * 2; it += gthreads) { const int e = tok_e[it], dest = moe_pad_start(cnt, e) + tok_slot[it]; tok_dest[it] = dest; st_coh(rowidx + dest, (int)(it / 2)); }
    const int total = moe_pad_start(cnt, NE);
    for (long it = gtid; it < total; it += gthreads) { int acc = 0, st = 0, ce = 0;
#pragma unroll
        for (int j = 0; j < NE; ++j) { const int pj = (cnt[j] + 255) / 256 * 256; if (it >= acc && it < acc + pj) { st = acc; ce = cnt[j]; } acc += pj; }
        if (it - st >= ce) st_coh(rowidx + it, 0); }
}
__device__ __forceinline__ void ph_combine(const Params& p, int l, int rows, long gtid, long gthreads) {
    float* xres = (float*)(p.ws + WS_XRES); const bf16_t* yb = (const bf16_t*)(p.ws + WS_YBUF);
    const float* tok_w = (const float*)(p.ws + WS_TOK) + (size_t)MT * 2; const int* tok_dest = (const int*)(p.ws + WS_TOK) + (size_t)MT * 6;
    for (long it = gtid; it < (long)rows * (D / 4); it += gthreads) {
        const int r = (int)(it / (D / 4)), c = (int)(it % (D / 4)) * 4; const float* g2 = ada_ptr(p, l, ada_row(r), 5);
        const int d0 = tok_dest[r * 2], d1 = tok_dest[r * 2 + 1]; const float w0 = tok_w[r * 2], w1 = tok_w[r * 2 + 1];
        for (int j = 0; j < 4; ++j) xres[(size_t)r * D + c + j] += g2[c + j] * (w0 * bf2f(yb[(size_t)d0 * D + c + j]) + w1 * bf2f(yb[(size_t)d1 * D + c + j]));
    }
}
__device__ __forceinline__ void ph_s5(const Params& p, long gtid, long gthreads) {
    const bf16_t* u1 = (const bf16_t*)(p.ws + WS_U1); float* ys = (float*)(p.ws + WS_YS5); bf16_t* z = (bf16_t*)(p.ws + WS_Z);
    const float* lamb = (const float*)(p.ws + WS_S5LAM); const float* bb = (const float*)(p.ws + WS_S5BB);
    for (long it = gtid; it < (long)NB * S5W; it += gthreads) {
        const int b = (int)(it / S5W), col = (int)(it % S5W), g = col / S5C, c = col % S5C;
        for (int t = 0; t < NSEQ; ++t) { const size_t row = (size_t)b * NSEQ + t; ys[row * S5W + col] = p.s5_d[col] * bf2f(u1[row * S5W + col]); }
        for (int d = 0; d < 2; ++d)
            for (int s = 0; s < S5S; ++s) {
                const size_t gi = ((size_t)d * S5G + g) * S5S + s;
                const float lr = lamb[gi * 2], li = lamb[gi * 2 + 1];
                const float cr = p.s5_c_re[(((size_t)d * S5G + g) * S5C + c) * S5S + s], ci = p.s5_c_im[(((size_t)d * S5G + g) * S5C + c) * S5S + s];
                float br[S5C], bi[S5C]; for (int cc = 0; cc < S5C; ++cc) { br[cc] = bb[(gi * S5C + cc) * 2]; bi[cc] = bb[(gi * S5C + cc) * 2 + 1]; }
                float xr = 0.f, xi = 0.f;
                for (int seg = 0; seg < 2; ++seg) {
                    const int n = seg ? NSEQ : NCTX, base = seg ? b * NSEQ : ML + b * NCTX;
                    for (int stp = 0; stp < n; ++stp) {
                        const size_t row = (size_t)base + (d ? n - 1 - stp : stp); const bf16_t* ur = u1 + row * S5W + g * S5C;
                        float bur = 0.f, bui = 0.f; for (int cc = 0; cc < S5C; ++cc) { const float uv = bf2f(ur[cc]); bur += br[cc] * uv; bui += bi[cc] * uv; }
                        const float nr = lr * xr - li * xi + bur, ni = lr * xi + li * xr + bui; xr = nr; xi = ni;
                        if (seg) ys[row * S5W + col] += cr * xr - ci * xi;
                    }
                }
            }
        for (int t = 0; t < NSEQ; ++t) { const size_t row = (size_t)b * NSEQ + t; z[row * S5W + col] = f2bf(geluf_(ys[row * S5W + col])); }
    }
}
#ifndef CPU_EMU
typedef float s5_f32x16 __attribute__((ext_vector_type(16)));
constexpr int S5_XPITCH = 272, S5_XBYTES = 32 * S5_XPITCH, S5_ABYTES = 1024  , S5_WAVE_LDS = S5_XBYTES + S5_ABYTES + 8 * 2 * 64 * 8;
static_assert(8 * S5_WAVE_LDS <= 147456 - 64, "S5 LDS");
__device__ __forceinline__ int s5_chunk_row0(int b, int k) { return k < S5_NCC ? ML + b * NCTX + k * S5_CHUNK : b * NSEQ + (k - S5_NCC) * S5_CHUNK; }
__device__ __forceinline__ int s5_order(int d, int k) { return d == 0 ? k : (k < S5_NCC ? S5_NCC - 1 - k : S5_NCC + (S5_NLC - 1 - (k - S5_NCC))); }
template <int PASS> __device__ __forceinline__ void ph_s5_fast(const Params& p, LAS unsigned char* lds, int gwave, int nwaves, int wv_) {
    const int lane = tid_of(wv_) & 63, wv = wv_;
    LAS unsigned char* xl = lds + wv * S5_WAVE_LDS;
    const int r = lane & 31, hh = lane >> 5, a_half = (r >> 2) & 1, a_n = (r & 3) + 4 * (r >> 3), tk = lane & 15, q4 = lane >> 4;
    const bf16_t* u1 = (const bf16_t*)(p.ws + WS_U1); bf16_t* z = (bf16_t*)(p.ws + WS_Z); float* ys = (float*)(p.ws + WS_YS5);
    const float* lamb = (const float*)(p.ws + WS_S5LAM); const float* lamt = (const float*)(p.ws + WS_S5LAMT);
    const s5_bf16x8* BF = (const s5_bf16x8*)(p.ws + WS_S5BF); const s5_bf16x8* CF = (const s5_bf16x8*)(p.ws + WS_S5CF);
    float* E = (float*)(p.ws + WS_S5E);
    constexpr int P0 = PASS == 2 ? S5_NCC / 2 : 0, NPAIR = S5_NCH / 2 - P0;
    for (int rd = 0; rd <= (NB * S5G * NPAIR) / nwaves; ++rd) {
        const int it = deal_item(rd, gwave, nwaves, NB * S5G * NPAIR); if (it < 0) continue;
        const int g = it % S5G, pr = P0 + (it / S5G) % NPAIR, b = it / (NPAIR * S5G);
        const int k_s = 2 * pr + hh, k_a = 2 * pr + a_half;
        const int rb_a = s5_chunk_row0(b, k_a);
#pragma unroll
        for (int d = 0; d < 2; ++d) {
            const size_t dg = (size_t)d * S5G + g;
            s5_bf16x8 bfr[4], cfr[4];
#pragma unroll
            for (int ct = 0; ct < 4; ++ct) { bfr[ct] = BF[(dg * 4 + ct) * 64 + lane]; if (PASS == 2) cfr[ct] = CF[(dg * 4 + ct) * 64 + lane]; }
            const float l0r = lamb[(dg * S5S + r) * 2], l0i = lamb[(dg * S5S + r) * 2 + 1], l1r = lamb[(dg * S5S + r + 32) * 2], l1i = lamb[(dg * S5S + r + 32) * 2 + 1];
            LAS unsigned char* aslot = xl + S5_XBYTES;
#define S5_DMA(tile_) __builtin_amdgcn_global_load_lds((const unsigned*)(u1 + (size_t)(rb_a + (tile_) * 16 + a_n) * S5W + g * S5C + 8 * hh), (LAS unsigned*)aslot, 16, 0, 0)
            asm volatile("s_waitcnt lgkmcnt(0)" ::: "memory");
            S5_DMA(d ? 7 : 0);
            const int uL = ((tk & 3) | ((tk >> 2) << 3)) + 32 * (q4 >> 1);
            const f32x4 dsk = *(const f32x4*)(p.s5_d + g * S5C + 4 * q4);
            float x0r = 0.f, x0i = 0.f, x1r = 0.f, x1i = 0.f;
            float* Eb = E + (((size_t)(b * S5G + g) * 2 + d) * S5_NCH) * S5S * 2;
            if (PASS == 2) {
                const float t0r = lamt[(dg * S5S + r) * 2], t0i = lamt[(dg * S5S + r) * 2 + 1], t1r = lamt[(dg * S5S + r + 32) * 2], t1i = lamt[(dg * S5S + r + 32) * 2 + 1];
                const int oi = s5_order(d, k_s);
                const int oa = s5_order(d, 2 * pr), ob = s5_order(d, 2 * pr + 1), oimax = oa > ob ? oa : ob;
                for (int j0 = 0; j0 < oimax; j0 += 4) { float e0r[4], e0i[4], e1r[4], e1i[4];
#pragma unroll
                    for (int k = 0; k < 4; ++k) { const int jc = j0 + k < S5_NCH ? j0 + k : S5_NCH - 1; e0r[k] = Eb[(jc * S5S + r) * 2]; e0i[k] = Eb[(jc * S5S + r) * 2 + 1]; e1r[k] = Eb[(jc * S5S + r + 32) * 2]; e1i[k] = Eb[(jc * S5S + r + 32) * 2 + 1]; }
                    asm volatile("" : "+v"(e0r[0]), "+v"(e0r[1]), "+v"(e0r[2]), "+v"(e0r[3]), "+v"(e0i[0]), "+v"(e0i[1]), "+v"(e0i[2]), "+v"(e0i[3]), "+v"(e1r[0]), "+v"(e1r[1]), "+v"(e1r[2]), "+v"(e1r[3]), "+v"(e1i[0]), "+v"(e1i[1]), "+v"(e1i[2]), "+v"(e1i[3]));
#pragma unroll
                    for (int k = 0; k < 4; ++k) { const float n0r = t0r * x0r - t0i * x0i + e0r[k], n0i = t0r * x0i + t0i * x0r + e0i[k], n1r = t1r * x1r - t1i * x1i + e1r[k], n1i = t1r * x1i + t1i * x1r + e1i[k];
                        if (j0 + k < oi) { x0r = n0r; x0i = n0i; x1r = n1r; x1i = n1i; } } }
            }
#pragma unroll 1
            for (int i = 0; i < 8; ++i) {
                const int tile = d ? 7 - i : i;
                if (PASS == 2 && d == 1 && i > 0) asm volatile("s_waitcnt vmcnt(2)" ::: "memory"); else asm volatile("s_waitcnt vmcnt(0)" ::: "memory");
                const s5_bf16x8 a = *(const LAS s5_bf16x8*)(aslot + lane * 16);
                typedef unsigned s5_u2v __attribute__((ext_vector_type(2))); u32x2_t uu0, uu1; if (PASS == 2 && d == 0) { const s5_u2v t0 = *(const LAS s5_u2v*)(aslot + uL * 16 + (q4 & 1) * 8), t1 = *(const LAS s5_u2v*)(aslot + (uL + 4) * 16 + (q4 & 1) * 8); uu0.x = t0[0]; uu0.y = t0[1]; uu1.x = t1[0]; uu1.y = t1[1]; }
                asm volatile("s_waitcnt lgkmcnt(0)" ::: "memory");
                if (i + 1 < 8) S5_DMA(d ? tile - 1 : tile + 1);
                s5_f32x16 acc[4];
#pragma unroll
                for (int ct = 0; ct < 4; ++ct) { const float z0 = opaque_zero(); s5_f32x16 zz;
#pragma unroll
                    for (int e = 0; e < 16; ++e) zz[e] = z0;
                    acc[ct] = __builtin_amdgcn_mfma_f32_32x32x16_bf16(a, bfr[ct], zz, 0, 0, 0); }
                MFMA_KEEP(acc[3], a);
#pragma unroll
                for (int nn = 0; nn < 16; ++nn) {
                    const int n = d ? 15 - nn : nn;
                    float n0r = __builtin_fmaf(l0r, x0r, __builtin_fmaf(-l0i, x0i, acc[0][n])), n0i = __builtin_fmaf(l0r, x0i, __builtin_fmaf(l0i, x0r, acc[1][n])), n1r = __builtin_fmaf(l1r, x1r, __builtin_fmaf(-l1i, x1i, acc[2][n])), n1i = __builtin_fmaf(l1r, x1i, __builtin_fmaf(l1i, x1r, acc[3][n]));
                    asm volatile("" : "+v"(n0r), "+v"(n0i), "+v"(n1r), "+v"(n1i));
                    x0r = n0r; x0i = n0i; x1r = n1r; x1i = n1i;
                    if (PASS == 2) { *(LAS unsigned*)(xl + (hh * 16 + n) * S5_XPITCH + 4 * r) = pack2bf(x0r, x0i); *(LAS unsigned*)(xl + (hh * 16 + n) * S5_XPITCH + 4 * (r + 32)) = pack2bf(x1r, x1i); }
                }
                if (PASS == 2) asm volatile("" ::: "memory");
                if (PASS == 2) {
#pragma unroll
                    for (int rg = 0; rg < 2; ++rg) {
                        const size_t row = (size_t)s5_chunk_row0(b, 2 * pr + rg) + tile * 16 + tk; const size_t off = row * S5W + g * S5C + 4 * q4;
                        f32x4 yv; LAS u32x2_t* ypark = (LAS u32x2_t*)(xl + S5_XBYTES + S5_ABYTES) + (tile * 2 + rg) * 64 + lane;
                        if (d == 0) { const u32x2_t uu = rg ? uu1 : uu0;
                            yv = (f32x4){dsk[0] * __uint_as_float(uu.x << 16), dsk[1] * __uint_as_float(uu.x & 0xffff0000u), dsk[2] * __uint_as_float(uu.y << 16), dsk[3] * __uint_as_float(uu.y & 0xffff0000u)}; }
                        else { const unsigned y01 = ypark->x, y23 = ypark->y; yv = (f32x4){__uint_as_float(y01 << 16), __uint_as_float(y01 & 0xffff0000u), __uint_as_float(y23 << 16), __uint_as_float(y23 & 0xffff0000u)}; }
#pragma unroll
                        for (int ks = 0; ks < 4; ++ks) { const s5_bf16x8 xb = *(const LAS s5_bf16x8*)(xl + (rg * 16 + tk) * S5_XPITCH + (32 * ks + 8 * q4) * 2);
                            yv = __builtin_amdgcn_mfma_f32_16x16x32_bf16(cfr[ks], xb, yv, 0, 0, 0); MFMA_KEEP(yv, xb); }
                        if (d == 0) { ypark->x = pack2bf(yv[0], yv[1]); ypark->y = pack2bf(yv[2], yv[3]); }
                        else if (DENSE1_FP8) *(unsigned*)((unsigned char*)z + off) = pack4_fp8(geluf_(yv[0]) * Z8_SCALE, geluf_(yv[1]) * Z8_SCALE, geluf_(yv[2]) * Z8_SCALE, geluf_(yv[3]) * Z8_SCALE);
                        else { u32x2_t w; w.x = pack2bf(geluf_(yv[0]), geluf_(yv[1])); w.y = pack2bf(geluf_(yv[2]), geluf_(yv[3])); *(u32x2_t*)(z + off) = w; }
                    }
                    asm volatile("" ::: "memory");
                }
            }
            if (PASS == 1) { const int oi = s5_order(d, k_s); float* ep = Eb + (size_t)oi * S5S * 2;
                ep[r * 2] = x0r; ep[r * 2 + 1] = x0i; ep[(r + 32) * 2] = x1r; ep[(r + 32) * 2 + 1] = x1i; }
#undef S5_DMA
        }
    }
}
#endif
#ifndef CPU_EMU
__device__ __forceinline__ void ph_conv_fast(const Params& p, long gtid, long gthreads) {
    const bf16_t* qkv = (const bf16_t*)(p.ws + WS_QKV); bf16_t* ub = (bf16_t*)(p.ws + WS_UBF);
    const int ch = (int)(gtid % (LW / 8)) * 8;
    float wt[4][8], bs[8];
#pragma unroll
    for (int j = 0; j < 8; ++j) bs[j] = p.lru_conv_b[ch + j];
#pragma unroll
    for (int tap = 0; tap < 4; ++tap)
#pragma unroll
        for (int j = 0; j < 8; ++j) wt[tap][j] = p.lru_conv_w[tap * LW + ch + j];
    for (long it = gtid; it < (long)MT * (LW / 8); it += gthreads) {
        const int rr = (int)(it / (LW / 8));
        int base, t, n; if (rr < ML) { base = (rr / NSEQ) * NSEQ; t = rr % NSEQ; n = NSEQ; } else { const int rc = rr - ML; base = ML + (rc / NCTX) * NCTX; t = rc % NCTX; n = NCTX; }
        u32x4_t xv[4];
#pragma unroll
        for (int tap = 0; tap < 4; ++tap) { int tt = t + tap - 2; tt = tt < 0 ? 0 : (tt > n - 1 ? n - 1 : tt); xv[tap] = *(const u32x4_t*)(qkv + (size_t)(base + tt) * EVIN + COL_XR + ch); }
        float acc[8];
#pragma unroll
        for (int j = 0; j < 8; ++j) acc[j] = bs[j];
#pragma unroll
        for (int tap = 0; tap < 4; ++tap) { const int tt = t + tap - 2; const float ok = (tt >= 0 && tt < n) ? 1.0f : 0.0f; const unsigned vw[4] = {xv[tap].x, xv[tap].y, xv[tap].z, xv[tap].w};
#pragma unroll
            for (int j = 0; j < 8; ++j) acc[j] += (wt[tap][j] * ok) * __uint_as_float((j & 1) ? (vw[j >> 1] & 0xffff0000u) : (vw[j >> 1] << 16)); }
        u32x4_t w; w.x = pack2bf(acc[0], acc[1]); w.y = pack2bf(acc[2], acc[3]); w.z = pack2bf(acc[4], acc[5]); w.w = pack2bf(acc[6], acc[7]);
        *(u32x4_t*)(ub + (size_t)rr * LW + ch) = w;
    }
}
__device__ __forceinline__ int lru_chunk_row0(int b, int k) { return k < LRU_NCC ? ML + b * NCTX + k * LRU_CH : b * NSEQ + (k - LRU_NCC) * LRU_CH; }
__device__ __forceinline__ int lru_order(int d, int k) { return d == 0 ? k : (k < LRU_NCC ? LRU_NCC - 1 - k : LRU_NCC + (LRU_NLC - 1 - (k - LRU_NCC))); }
#define LRU_ZERO16(v) do { const float z0_ = opaque_zero(); _Pragma("unroll") for (int e_ = 0; e_ < 16; ++e_) v[e_] = z0_; } while (0)
template <int PASS> __device__ __forceinline__ void ph_lru_fast(const Params& p, LAS unsigned char* lds, int gwave, int nwaves, int wv_) {
    const int lane = tid_of(wv_) & 63; LAS float* hfl = (LAS float*)(lds + wv_ * (LRU_CH * 64 * 4)) + lane;
    const int r = lane & 31, hh = lane >> 5, a_half = (r >> 2) & 1, a_n = (r & 3) + 4 * (r >> 3);
    const bf16_t* ub = (const bf16_t*)(p.ws + WS_UBF); const bf16_t* qkv = (const bf16_t*)(p.ws + WS_QKV); bf16_t* mix = (bf16_t*)(p.ws + WS_MIX);
    const s5_bf16x8* LB = (const s5_bf16x8*)(p.ws + WS_LRUBF); float* AGG = (float*)(p.ws + WS_LRUAGG);
    constexpr int NPAIR = LRU_NCH / 2, NT = LRU_CH / 16;
    s5_bf16x8 idf[2];
#pragma unroll
    for (int kk = 0; kk < 2; ++kk) { const int jj = r - 16 * kk - 8 * hh;
#pragma unroll
        for (int e = 0; e < 8; ++e) idf[kk][e] = (e == jj) ? (short)0x3F80 : (short)0; }
    for (int rd = 0; rd <= (NB * 16 * 2 * NPAIR) / nwaves; ++rd) {
        const int it = deal_item(rd, gwave, nwaves, NB * 16 * 2 * NPAIR, OUT0_FP8 ? 4 : 2); if (it < 0) continue;
        const int cs = it & 1, pr = OUT0_FP8 ? (it >> 2) % NPAIR : (it >> 1) % NPAIR, h = OUT0_FP8 ? 2 * ((it / (4 * NPAIR)) % 8) + ((it >> 1) & 1) : (it / (2 * NPAIR)) % 16, b = it / (32 * NPAIR);
        const int k_s = 2 * pr + hh, k_a = 2 * pr + a_half, rb_a = lru_chunk_row0(b, k_a), rb_s = lru_chunk_row0(b, k_s);
        const int ch = h * 64 + 32 * cs + r;
#pragma unroll
        for (int d = 0; d < 2; ++d) {
            const int oi = lru_order(d, k_s);
            s5_bf16x8 br[4], bi[4];
#pragma unroll
            for (int ks = 0; ks < 4; ++ks) { br[ks] = LB[(((size_t)(d * 16 + h) * 2 + 0) * 2 + cs) * 4 * 64 + ks * 64 + lane]; bi[ks] = LB[(((size_t)(d * 16 + h) * 2 + 1) * 2 + cs) * 4 * 64 + ks * 64 + lane]; }
            const float lamv = softplusf_(-p.lru_lam[d * LW + ch]), bav = p.lru_ba[d * LW + ch], biv = p.lru_bi[d * LW + ch];
            const float nba = -1.44269504089f * bav, nbi = -1.44269504089f * biv, c2 = -8.0f * 1.44269504089f * lamv;
            float state = 0.f, aprod = 1.f;
            float* ag = AGG + (((size_t)b * 2 + d) * LRU_NCH) * LW * 2;
            if (PASS == 2) { const int oa = lru_order(d, 2 * pr), ob = lru_order(d, 2 * pr + 1), oimax = oa > ob ? oa : ob;
                for (int j0 = 0; j0 < oimax; j0 += 8) { float aj[8], bj[8];
#pragma unroll
                    for (int k = 0; k < 8; ++k) { const int jc = j0 + k < LRU_NCH ? j0 + k : LRU_NCH - 1; aj[k] = ag[((size_t)jc * LW + ch) * 2]; bj[k] = ag[((size_t)jc * LW + ch) * 2 + 1]; }
                    asm volatile("" : "+v"(aj[0]), "+v"(aj[1]), "+v"(aj[2]), "+v"(aj[3]), "+v"(aj[4]), "+v"(aj[5]), "+v"(aj[6]), "+v"(aj[7]), "+v"(bj[0]), "+v"(bj[1]), "+v"(bj[2]), "+v"(bj[3]), "+v"(bj[4]), "+v"(bj[5]), "+v"(bj[6]), "+v"(bj[7]));
#pragma unroll
                    for (int k = 0; k < 8; ++k) if (j0 + k < oi) state = aj[k] * state + bj[k]; } }
            s5_bf16x8 an[4], gn0, gn1;
            { const int tile0 = d ? NT - 1 : 0; const bf16_t* up = ub + (size_t)(rb_a + tile0 * 16 + a_n) * LW + h * 64 + 8 * hh;
#pragma unroll
              for (int ks = 0; ks < 4; ++ks) an[ks] = *(const s5_bf16x8*)(up + 16 * ks);
              if (PASS == 2 && d == 1) { const bf16_t* gp = qkv + (size_t)(rb_a + tile0 * 16 + a_n) * EVIN + COL_GR + h * 64 + 32 * cs + 8 * hh; gn0 = *(const s5_bf16x8*)gp; gn1 = *(const s5_bf16x8*)(gp + 16); } }
#pragma unroll 1
            for (int i = 0; i < NT; ++i) {
                const int tile = d ? NT - 1 - i : i;
                s5_bf16x8 a[4], g0, g1;
#pragma unroll
                for (int ks = 0; ks < 4; ++ks) a[ks] = an[ks];
                if (PASS == 2 && d == 1) { g0 = gn0; g1 = gn1; }
                if (i + 1 < NT) { const int tl = d ? tile - 1 : tile + 1; const bf16_t* up = ub + (size_t)(rb_a + tl * 16 + a_n) * LW + h * 64 + 8 * hh;
#pragma unroll
                    for (int ks = 0; ks < 4; ++ks) an[ks] = *(const s5_bf16x8*)(up + 16 * ks);
                    if (PASS == 2 && d == 1) { const bf16_t* gp = qkv + (size_t)(rb_a + tl * 16 + a_n) * EVIN + COL_GR + h * 64 + 32 * cs + 8 * hh; gn0 = *(const s5_bf16x8*)gp; gn1 = *(const s5_bf16x8*)(gp + 16); } }
                s5_f32x16 ar, ai, au, agr; LRU_ZERO16(ar); LRU_ZERO16(ai); LRU_ZERO16(au); LRU_ZERO16(agr);
#pragma unroll
                for (int ks = 0; ks < 4; ++ks) { ar = __builtin_amdgcn_mfma_f32_32x32x16_bf16(a[ks], br[ks], ar, 0, 0, 0); ai = __builtin_amdgcn_mfma_f32_32x32x16_bf16(a[ks], bi[ks], ai, 0, 0, 0); }
                au = __builtin_amdgcn_mfma_f32_32x32x16_bf16(cs ? a[2] : a[0], idf[0], au, 0, 0, 0); au = __builtin_amdgcn_mfma_f32_32x32x16_bf16(cs ? a[3] : a[1], idf[1], au, 0, 0, 0);
                if (PASS == 2 && d == 1) { agr = __builtin_amdgcn_mfma_f32_32x32x16_bf16(g0, idf[0], agr, 0, 0, 0); agr = __builtin_amdgcn_mfma_f32_32x32x16_bf16(g1, idf[1], agr, 0, 0, 0); }
                MFMA_KEEP(au, a[0]); MFMA_KEEP(au, a[1]); MFMA_KEEP(au, a[2]); MFMA_KEEP(au, a[3]); MFMA_KEEP(ai, a[3]); if (PASS == 2 && d == 1) { MFMA_KEEP(agr, g0); MFMA_KEEP(agr, g1); }
#pragma unroll
                for (int nn = 0; nn < 16; ++nn) {
                    const int n = d ? 15 - nn : nn;
                    const float rg = fast_rcp(1.0f + __builtin_amdgcn_exp2f(__builtin_fmaf(ar[n], -1.44269504089f, nba))), ig = fast_rcp(1.0f + __builtin_amdgcn_exp2f(__builtin_fmaf(ai[n], -1.44269504089f, nbi))), av = __builtin_amdgcn_exp2f(rg * c2), mult = fast_sqrt(__builtin_fmaf(-av, av, 1.0f));
                    state = av * state + mult * (ig * au[n]);
                    if (PASS == 1) aprod *= av;
                    if (PASS == 2) { if (d == 0) hfl[(tile * 16 + n) * 64] = state; else { const float mv = (hfl[(tile * 16 + n) * 64] + state) * geluf_(agr[n]);
                        if (OUT0_FP8) ((unsigned char*)mix)[(size_t)(rb_s + tile * 16 + n) * D + QW + ch] = (unsigned char)(pack4_fp8(mv, 0.f, 0.f, 0.f) & 0xffu); else mix[(size_t)(rb_s + tile * 16 + n) * D + QW + ch] = f2bf(mv); } }
                }
            }
            if (PASS == 1) { ag[((size_t)oi * LW + ch) * 2] = aprod; ag[((size_t)oi * LW + ch) * 2 + 1] = state; }
        }
    }
}
#endif
#ifndef CPU_EMU
constexpr int AT_KROWS = 320, AT_LDS_K = 0, AT_LDS_V = AT_KROWS * 128, AT_LDS_BYTES = 2 * AT_KROWS * 128;
static_assert(NCTX == 256, "attention key halves assume 256 context keys");
__device__ __forceinline__ void ph_attn_fast(const Params& p, LAS unsigned char* lds, int bid, int nblocks, int wv_) {
    const int tid = tid_of(wv_), lane = tid & 63, w = wv_, r = lane & 31, hh = lane >> 5;
    const bf16_t* qkv = (const bf16_t*)(p.ws + WS_QKV); const bf16_t* vt = (const bf16_t*)(p.ws + WS_VT); bf16_t* mix = (bf16_t*)(p.ws + WS_MIX);
    constexpr int NQB = NSEQ / 128, NCB = NCTX / 128, UNITS = NB * 4 * (NQB + NCB);
    for (int un = bid; un < UNITS; un += nblocks) {
        const int kvh = un & 3, rest = un >> 2; int b, qb; if (rest < NB * NQB) { b = rest / NQB; qb = rest % NQB; } else { b = (rest - NB * NQB) / NCB; qb = NQB + (rest - NB * NQB) % NCB; }
        const bool isc = qb >= NQB;
        const int q0 = isc ? (qb - NQB) * 128 : qb * 128, qrow0 = isc ? ML + b * NCTX + q0 : b * NSEQ + q0, head = 4 * kvh + (w >> 1);
        s5_bf16x8 qf[2][4];
#pragma unroll
        for (int qt = 0; qt < 2; ++qt)
#pragma unroll
            for (int ds = 0; ds < 4; ++ds) qf[qt][ds] = *(const s5_bf16x8*)(qkv + (size_t)(qrow0 + 64 * (w & 1) + 32 * qt + r) * EVIN + COL_Q + head * 64 + 16 * ds + 8 * hh);
        s5_f32x16 oacc[2][2];
#pragma unroll
        for (int qt = 0; qt < 2; ++qt)
#pragma unroll
            for (int dt = 0; dt < 2; ++dt)
#pragma unroll
                for (int e = 0; e < 16; ++e) oacc[qt][dt][e] = 0.f;
        const float sk = p.attn_sink[head];
        float mrun[2] = {sk, sk}, lrun[2] = {hh == 0 ? 1.0f : 0.f, hh == 0 ? 1.0f : 0.f};
#pragma unroll 1
        for (int half = isc ? 1 : 0; half < 2; ++half) {
            __syncthreads();
            static_assert(AT_KROWS * 8 == 5 * 512 && 64 * 40 == 5 * 512, "staging: five 16-byte pieces per thread and operand");
            u4v_t stK[5], stV[5];
#pragma unroll
            for (int k5 = 0; k5 < 5; ++k5) {
                const int i = tid + 512 * k5, row = i >> 3, cc = i & 7; int grow;
                if (half == 1 && row >= 64) grow = ML + b * NCTX + (row - 64);
                else { int kpos = q0 - 128 + 320 * half + row; kpos = kpos < 0 ? 0 : (kpos > NSEQ - 1 ? NSEQ - 1 : kpos); grow = b * NSEQ + kpos; }
                stK[k5] = *(const u4v_t*)(qkv + (size_t)grow * EVIN + COL_K + kvh * 64 + cc * 8);
            }
#pragma unroll
            for (int k5 = 0; k5 < 5; ++k5) {
                const int i = tid + 512 * k5, d = i / 40, pc = i % 40;
                const int pos = (half == 0) ? q0 + pc * 8 : (pc < 8 ? q0 + 320 + pc * 8 : 128 + NSEQ + 128 + (pc - 8) * 8);
                stV[k5] = *(const u4v_t*)(vt + ((size_t)(b * 4 + kvh) * 64 + d) * VT_T + pos);
            }
#pragma unroll
            for (int k5 = 0; k5 < 5; ++k5) { const int i = tid + 512 * k5, row = i >> 3, cc = i & 7; *(LAS u4v_t*)(lds + AT_LDS_K + row * 128 + ((cc ^ (row & 7)) << 4)) = stK[k5]; }
#pragma unroll
            for (int k5 = 0; k5 < 5; ++k5) { const int i = tid + 512 * k5, d = i / 40, pc = i % 40, kt = pc >> 2, cc = pc & 3; *(LAS u4v_t*)(lds + AT_LDS_V + kt * 4096 + d * 64 + ((cc ^ ((d >> 2) & 3)) << 4)) = stV[k5]; }
            __syncthreads();
#pragma unroll 1
            for (int kt = (isc ? 2 : 0); kt < 10; ++kt) {
                const bool local = !(half == 1 && kt >= 2);
                const int Kb = q0 - 128 + 320 * half + 32 * kt;
                s5_bf16x8 kf[4], vf[2][2];
#pragma unroll
                for (int ds = 0; ds < 4; ++ds) kf[ds] = *(const LAS s5_bf16x8*)(lds + AT_LDS_K + (32 * kt + r) * 128 + (((2 * ds + hh) ^ (r & 7)) << 4));
#pragma unroll
                for (int dt = 0; dt < 2; ++dt)
#pragma unroll
                    for (int s2 = 0; s2 < 2; ++s2) vf[dt][s2] = *(const LAS s5_bf16x8*)(lds + AT_LDS_V + kt * 4096 + (32 * dt + r) * 64 + (((2 * s2 + hh) ^ (((32 * dt + r) >> 2) & 3)) << 4));
#pragma unroll
                for (int qt = 0; qt < 2; ++qt) {
                    const int Qb = q0 + 64 * (w & 1) + 32 * qt;
                    bool need_mask = false;
                    if (local) {
                        if (Kb - (Qb + 31) > 128 || Qb - (Kb + 31) > 128 || Kb + 31 < 0 || Kb >= NSEQ) continue;
                        need_mask = !(Kb + 31 - Qb <= 128 && Qb + 31 - Kb <= 128 && Kb >= 0 && Kb + 31 < NSEQ);
                    }
                    s5_f32x16 sc; const float z0 = opaque_zero();
#pragma unroll
                    for (int e = 0; e < 16; ++e) sc[e] = z0;
#pragma unroll
                    for (int ds = 0; ds < 4; ++ds) sc = __builtin_amdgcn_mfma_f32_32x32x16_bf16(kf[ds], qf[qt][ds], sc, 0, 0, 0);
                    MFMA_KEEP(sc, kf[0]); MFMA_KEEP(sc, kf[1]); MFMA_KEEP(sc, kf[2]); MFMA_KEEP(sc, kf[3]);
                    if (need_mask) {
                        const int qpos = Qb + r;
#pragma unroll
                        for (int e = 0; e < 16; ++e) { const int kpos = Kb + (e & 3) + 8 * (e >> 2) + 4 * hh, rel = kpos - qpos; if (rel > 128 || rel < -128 || kpos < 0 || kpos >= NSEQ) sc[e] = -1e30f; }
                    }
                    float tmax = sc[0];
#pragma unroll
                    for (int e = 1; e < 16; ++e) tmax = fmaxf(tmax, sc[e]);
                    tmax = fmaxf(tmax, __shfl_xor(tmax, 32));
                    const float mnew = fmaxf(mrun[qt], tmax), scl = __expf(mrun[qt] - mnew), mneg = -mnew * 1.44269504089f; mrun[qt] = mnew;
                    float psum = 0.f; float pv[16];
#pragma unroll
                    for (int e = 0; e < 16; ++e) { pv[e] = __builtin_amdgcn_exp2f(__builtin_fmaf(sc[e], 1.44269504089f, mneg)); psum += pv[e]; }
                    lrun[qt] = lrun[qt] * scl + psum;
                    if (__ballot(scl != 1.0f) != 0ull) {
#pragma unroll
                    for (int dt = 0; dt < 2; ++dt)
#pragma unroll
                        for (int e = 0; e < 16; ++e) oacc[qt][dt][e] *= scl; }
                    s5_bf16x8 pf[2];
#pragma unroll
                    for (int s2 = 0; s2 < 2; ++s2) { unsigned w0 = pack2bf(pv[8 * s2], pv[8 * s2 + 1]), w1 = pack2bf(pv[8 * s2 + 2], pv[8 * s2 + 3]), w2 = pack2bf(pv[8 * s2 + 4], pv[8 * s2 + 5]), w3 = pack2bf(pv[8 * s2 + 6], pv[8 * s2 + 7]);
                        u4v_t t4 = {w0, w1, w2, w3}; pf[s2] = __builtin_bit_cast(s5_bf16x8, t4); }
#pragma unroll
                    for (int dt = 0; dt < 2; ++dt)
#pragma unroll
                        for (int s2 = 0; s2 < 2; ++s2) oacc[qt][dt] = __builtin_amdgcn_mfma_f32_32x32x16_bf16(vf[dt][s2], pf[s2], oacc[qt][dt], 0, 0, 0);
                    MFMA_KEEP(oacc[qt][1], pf[0]); MFMA_KEEP(oacc[qt][1], pf[1]);
                }
            }
        }
#pragma unroll
        for (int qt = 0; qt < 2; ++qt) {
            const float ltot = lrun[qt] + __shfl_xor(lrun[qt], 32), inv = 1.0f / ltot;
            bf16_t* op = mix + (size_t)(qrow0 + 64 * (w & 1) + 32 * qt + r) * D + head * 64; unsigned char* op8 = (unsigned char*)mix + (size_t)(qrow0 + 64 * (w & 1) + 32 * qt + r) * D + head * 64; const float inv8 = inv * MIX8_SCALE;
#pragma unroll
            for (int dt = 0; dt < 2; ++dt)
#pragma unroll
                for (int g4 = 0; g4 < 4; ++g4) {
                    if (OUT0_FP8) { *(unsigned*)(op8 + 32 * dt + 8 * g4 + 4 * hh) = pack4_fp8(oacc[qt][dt][4 * g4] * inv8, oacc[qt][dt][4 * g4 + 1] * inv8, oacc[qt][dt][4 * g4 + 2] * inv8, oacc[qt][dt][4 * g4 + 3] * inv8); continue; }
                    u32x2_t wv2; wv2.x = pack2bf(oacc[qt][dt][4 * g4] * inv, oacc[qt][dt][4 * g4 + 1] * inv); wv2.y = pack2bf(oacc[qt][dt][4 * g4 + 2] * inv, oacc[qt][dt][4 * g4 + 3] * inv);
                    *(u32x2_t*)(op + 32 * dt + 8 * g4 + 4 * hh) = wv2; }
        }
    }
}
#endif
#ifndef CPU_EMU
__device__ __forceinline__ float wave_sum(float v) {
#pragma unroll
    for (int o = 32; o >= 1; o >>= 1) v += __shfl_xor(v, o);
    return v; }
template <int MODE> __device__ __forceinline__ void ph_norm_fast(const Params& p, int l, int rows, int gwave, int nwaves, int wv_) {
    const int lane = tid_of(wv_) & 63;
    bf16_t* h = (bf16_t*)(p.ws + WS_H); float* xres = (float*)(p.ws + WS_XRES); const bf16_t* yb = (const bf16_t*)(p.ws + WS_YBUF);
    const float* tok_w = (const float*)(p.ws + WS_TOK) + (size_t)MT * 2; const int* tok_dest = (const int*)(p.ws + WS_TOK) + (size_t)MT * 6;
    for (int r = gwave; r < rows; r += nwaves) {
        const int ar = ada_row(r);
        f32x4 xv[8];
        f32x4 cg[8], cs[8], ch[8];
        if (MODE == 2) {
#pragma unroll
            for (int i = 0; i < 8; ++i) cg[i] = *(const f32x4*)(p.norm_final + 4 * lane + 256 * i);
        } else { const float* sh = ada_ptr(p, l, ar, 0); const float* sc = ada_ptr(p, l, ar, 1); const float* g = p.norm_mix + (size_t)l * D;
#pragma unroll
            for (int i = 0; i < 8; ++i) { const int c = 4 * lane + 256 * i; cg[i] = *(const f32x4*)(g + c); cs[i] = *(const f32x4*)(sc + c); ch[i] = *(const f32x4*)(sh + c); } }
        if (MODE == 0) { const float* xr = xin_row(p, l, r);
#pragma unroll
            for (int i = 0; i < 8; ++i) xv[i] = *(const f32x4*)(xr + 4 * lane + 256 * i); }
        else { const int lm = (MODE == 1) ? l - 1 : 1; const float* g2 = ada_ptr(p, lm, ar, 5); float* xr = xres + (size_t)r * D;
            const int d0 = tok_dest[r * 2], d1 = tok_dest[r * 2 + 1]; const float w0 = tok_w[r * 2], w1 = tok_w[r * 2 + 1];
            f32x4 xo[8], gg[8]; unsigned ya8[8], yc8[8]; u32x2_t ya16[8], yc16[8];
#pragma unroll
            for (int i = 0; i < 8; ++i) { const int c = 4 * lane + 256 * i;
                if (RES_BF16) { const u32x2_t t = *(const u32x2_t*)((const bf16_t*)xres + (size_t)r * D + c); xo[i] = unpack4bf(t.x, t.y); } else xo[i] = *(const f32x4*)(xr + c);
                gg[i] = *(const f32x4*)(g2 + c);
                if (Y8) { ya8[i] = *(const unsigned*)((const unsigned char*)yb + (size_t)d0 * D + c); yc8[i] = *(const unsigned*)((const unsigned char*)yb + (size_t)d1 * D + c); }
                else { ya16[i] = *(const u32x2_t*)(yb + (size_t)d0 * D + c); yc16[i] = *(const u32x2_t*)(yb + (size_t)d1 * D + c); } }
#pragma unroll
            for (int i = 0; i < 8; ++i) { f32x4 m;
                if (Y8) { const unsigned ya = ya8[i], yc = yc8[i]; const float u0 = w0 * (1.0f / Y8_SCALE), u1 = w1 * (1.0f / Y8_SCALE);
                    m[0] = u0 * __builtin_amdgcn_cvt_f32_fp8(ya, 0) + u1 * __builtin_amdgcn_cvt_f32_fp8(yc, 0); m[1] = u0 * __builtin_amdgcn_cvt_f32_fp8(ya, 1) + u1 * __builtin_amdgcn_cvt_f32_fp8(yc, 1);
                    m[2] = u0 * __builtin_amdgcn_cvt_f32_fp8(ya, 2) + u1 * __builtin_amdgcn_cvt_f32_fp8(yc, 2); m[3] = u0 * __builtin_amdgcn_cvt_f32_fp8(ya, 3) + u1 * __builtin_amdgcn_cvt_f32_fp8(yc, 3); }
                else { const u32x2_t ya = ya16[i], yc = yc16[i];
                    m[0] = w0 * __uint_as_float(ya.x << 16) + w1 * __uint_as_float(yc.x << 16); m[1] = w0 * __uint_as_float(ya.x & 0xffff0000u) + w1 * __uint_as_float(yc.x & 0xffff0000u);
                    m[2] = w0 * __uint_as_float(ya.y << 16) + w1 * __uint_as_float(yc.y << 16); m[3] = w0 * __uint_as_float(ya.y & 0xffff0000u) + w1 * __uint_as_float(yc.y & 0xffff0000u); }
                xv[i] = xo[i] + gg[i] * m; } }
        float ss = 0.f;
#pragma unroll
        for (int i = 0; i < 8; ++i) ss += (xv[i][0] * xv[i][0] + xv[i][1] * xv[i][1]) + (xv[i][2] * xv[i][2] + xv[i][3] * xv[i][3]);
        ss = wave_sum(ss);
        const float rstd = 1.0f / sqrtf(ss * (1.0f / D) + 1e-6f);
#ifndef CPU_EMU
        asm volatile("" ::: "memory");
#endif
        if (MODE == 2) {
#pragma unroll
            for (int i = 0; i < 8; ++i) { const int c = 4 * lane + 256 * i; *(f32x4*)(p.out + (size_t)r * D + c) = xv[i] * rstd * cg[i]; }
        } else {
#pragma unroll
            for (int i = 0; i < 8; ++i) { const int c = 4 * lane + 256 * i;
                if (MODE == 1) { if (RES_BF16) { u32x2_t t; t.x = pack2bf(xv[i][0], xv[i][1]); t.y = pack2bf(xv[i][2], xv[i][3]); *(u32x2_t*)((bf16_t*)xres + (size_t)r * D + c) = t; } else *(f32x4*)(xres + (size_t)r * D + c) = xv[i]; }
                const f32x4 hv = xv[i] * rstd * cg[i] * (cs[i] + 1.0f) + ch[i];
                if ((MODE == 1 && DENSE1_FP8) || (MODE == 0 && IN0_FP8)) *(unsigned*)((unsigned char*)h + (size_t)r * D + c) = pack4_fp8(hv[0], hv[1], hv[2], hv[3]);
                else { if (MODE == 0 && IN0QKV_FP8) *(unsigned*)(p.ws + WS_H8 + (size_t)r * D + c) = pack4_fp8(hv[0], hv[1], hv[2], hv[3]);
                    u32x2_t w; w.x = pack2bf(hv[0], hv[1]); w.y = pack2bf(hv[2], hv[3]); *(u32x2_t*)(h + (size_t)r * D + c) = w; } } }
    }
}
template <bool H8> __device__ __forceinline__ void ph_router_fast(const Params& p, int l, int rows, LAS unsigned char* lds, int bid, int nblocks, int wv_) {
    const int lane = tid_of(wv_) & 63, rr = lane & 15, q = lane >> 4, w = wv_;
    bf16_t* h = (bf16_t*)(p.ws + WS_H); const float* xres = (const float*)(p.ws + WS_XRES); const s5_bf16x8* RWF = (const s5_bf16x8*)(p.ws + WS_RWF);
    int* tok_e = (int*)(p.ws + WS_TOK); float* tok_w = (float*)(p.ws + WS_TOK) + (size_t)MT * 2; int* tok_slot = (int*)(p.ws + WS_TOK) + (size_t)MT * 4;
    int* hist = (int*)(p.ws + WS_HIST) + (size_t)l * MAXG * HIST_LD;
    int run = 0;
    LAS float* ssq = (LAS float*)lds;
    LAS f32x4* red = (LAS f32x4*)(lds + 1024);
    LAS float* cfA = (LAS float*)(lds + 16384); LAS float* cfB = cfA + D;
    const int tid = w * 64 + lane, ntl = rows / 16, TPW = (ntl + nblocks - 1) / nblocks, t_lo = bid * TPW, t_hi = (t_lo + TPW < ntl) ? t_lo + TPW : ntl;
    s5_bf16x8 rwh[8], rwl[8];
#pragma unroll
    for (int st = 0; st < 8; ++st) { rwh[st] = RWF[(8 * w + st) * 64 + lane]; rwl[st] = RWF[(64 + 8 * w + st) * 64 + lane]; }
    const f32x4 rbias = *(const f32x4*)(p.router_b + 4 * q);
    int ar_cur = -1;
    u4v_t nx[8];
    if (RES_BF16 && t_lo < t_hi) { const bf16_t* xr = (const bf16_t*)xres + (size_t)(t_lo * 16 + rr) * D + 256 * w + 8 * q;
#pragma unroll
        for (int st = 0; st < 8; ++st) nx[st] = *(const u4v_t*)(xr + 32 * st); }
    for (int t16 = t_lo; t16 < t_hi; ++t16) {
        const int r = t16 * 16 + rr, ar = ada_row(t16 * 16);
        if (ar != ar_cur) { ar_cur = ar;
            const f32x4 gv = *(const f32x4*)(p.norm_ffn + (size_t)l * D + 4 * tid), sv = *(const f32x4*)(ada_ptr(p, l, ar, 4) + 4 * tid), hv = *(const f32x4*)(ada_ptr(p, l, ar, 3) + 4 * tid);
            *(LAS f32x4*)(cfA + 4 * tid) = gv * (sv + 1.0f); *(LAS f32x4*)(cfB + 4 * tid) = hv; }
        f32x4 xa[8], xb[8];
        if (RES_BF16) {
#pragma unroll
            for (int st = 0; st < 8; ++st) { xa[st] = unpack4bf(nx[st][0], nx[st][1]); xb[st] = unpack4bf(nx[st][2], nx[st][3]); }
            if (t16 + 1 < t_hi) { const bf16_t* xr = (const bf16_t*)xres + (size_t)((t16 + 1) * 16 + rr) * D + 256 * w + 8 * q;
#pragma unroll
                for (int st = 0; st < 8; ++st) nx[st] = *(const u4v_t*)(xr + 32 * st); } }
        else { const float* xr = xres + (size_t)r * D + 256 * w + 8 * q;
#pragma unroll
            for (int st = 0; st < 8; ++st) { xa[st] = *(const f32x4*)(xr + 32 * st); xb[st] = *(const f32x4*)(xr + 32 * st + 4); } }
        float ss = 0.f;
#pragma unroll
        for (int st = 0; st < 8; ++st) ss += (xa[st][0] * xa[st][0] + xa[st][1] * xa[st][1]) + (xa[st][2] * xa[st][2] + xa[st][3] * xa[st][3]) + (xb[st][0] * xb[st][0] + xb[st][1] * xb[st][1]) + (xb[st][2] * xb[st][2] + xb[st][3] * xb[st][3]);
        ss += __shfl_xor(ss, 16); ss += __shfl_xor(ss, 32);
        if (q == 0) ssq[w * 16 + rr] = ss;
        __syncthreads();
        float tot = 0.f;
#pragma unroll
        for (int ww = 0; ww < 8; ++ww) tot += ssq[ww * 16 + rr];
        const float rstd = 1.0f / sqrtf(tot * (1.0f / D) + 1e-6f);
        const LAS float* cA = cfA + 256 * w + 8 * q; const LAS float* cB = cfB + 256 * w + 8 * q;
        f32x4 lhi, llo; { const float z0 = opaque_zero(); lhi = (f32x4){z0, z0, z0, z0}; llo = lhi; }
#pragma unroll
        for (int st = 0; st < 8; ++st) {
            const f32x4 ga = *(const LAS f32x4*)(cA + 32 * st), gb = *(const LAS f32x4*)(cA + 32 * st + 4), ha = *(const LAS f32x4*)(cB + 32 * st), hb = *(const LAS f32x4*)(cB + 32 * st + 4);
            const f32x4 va = xa[st] * rstd * ga + ha, vb = xb[st] * rstd * gb + hb;
            u4v_t wv4 = {pack2bf(va[0], va[1]), pack2bf(va[2], va[3]), pack2bf(vb[0], vb[1]), pack2bf(vb[2], vb[3])};
            if (H8) { u32x2_t w8; w8.x = pack4_fp8(va[0], va[1], va[2], va[3]); w8.y = pack4_fp8(vb[0], vb[1], vb[2], vb[3]); *(u32x2_t*)((unsigned char*)h + (size_t)r * D + 256 * w + 32 * st + 8 * q) = w8; }
            else *(u4v_t*)(h + (size_t)r * D + 256 * w + 32 * st + 8 * q) = wv4;
            const s5_bf16x8 hf = __builtin_bit_cast(s5_bf16x8, wv4);
            lhi = __builtin_amdgcn_mfma_f32_16x16x32_bf16(rwh[st], hf, lhi, 0, 0, 0); MFMA_KEEP(lhi, rwh[st]);
            llo = __builtin_amdgcn_mfma_f32_16x16x32_bf16(rwl[st], hf, llo, 0, 0, 0); MFMA_KEEP(llo, rwl[st]); MFMA_KEEP(llo, hf);
        }
        red[w * 64 + lane] = lhi + llo;
        __syncthreads();
        if (w == 0) {
            f32x4 lsum = red[lane];
#pragma unroll
            for (int ww = 1; ww < 8; ++ww) lsum += red[ww * 64 + lane];
            float lg[4];
#pragma unroll
            for (int i = 0; i < 4; ++i) lg[i] = lsum[i] + rbias[i];
            float mx = fmaxf(fmaxf(lg[0], lg[1]), fmaxf(lg[2], lg[3])); mx = fmaxf(mx, __shfl_xor(mx, 16)); mx = fmaxf(mx, __shfl_xor(mx, 32));
            float pr[4], sum = 0.f;
#pragma unroll
            for (int i = 0; i < 4; ++i) { pr[i] = __expf(lg[i] - mx); sum += pr[i]; }
            sum += __shfl_xor(sum, 16); sum += __shfl_xor(sum, 32);
            float a1 = -1.f, a2 = -1.f; int j1 = 0, j2 = 0;
#pragma unroll
            for (int i = 0; i < 4; ++i) { const float v = pr[i] / sum; if (v > a1) { a2 = a1; j2 = j1; a1 = v; j1 = i; } else if (v > a2) { a2 = v; j2 = i; } }
            float best = a1 + a2; int bq = q; float w1 = a1, w2 = a2; int e1 = 4 * q + j1, e2 = 4 * q + j2;
#pragma unroll
            for (int o = 16; o <= 32; o <<= 1) {
                const float ob = __shfl_xor(best, o), ow1 = __shfl_xor(w1, o), ow2 = __shfl_xor(w2, o); const int oq = __shfl_xor(bq, o), oe1 = __shfl_xor(e1, o), oe2 = __shfl_xor(e2, o);
                if (ob > best || (ob == best && oq < bq)) { best = ob; bq = oq; w1 = ow1; w2 = ow2; e1 = oe1; e2 = oe2; } }
            int rk1 = 0, rk2 = 0, mine = 0; const unsigned long long below = (1ull << rr) - 1ull;
#pragma unroll
            for (int e = 0; e < NE; ++e) { const unsigned long long m = __ballot(q == 0 && (e1 == e || e2 == e)); const int pc = __popcll(m & below); if (e1 == e) rk1 = pc; if (e2 == e) rk2 = pc; if (rr == e) mine = __popcll(m); }
            const int b1 = __shfl(run, e1), b2 = __shfl(run, e2);
            if (q == 0) { const float ws = w1 + w2; tok_e[r * 2] = e1; tok_e[r * 2 + 1] = e2; tok_w[r * 2] = w1 / ws; tok_w[r * 2 + 1] = w2 / ws;
                tok_slot[r * 2] = b1 + rk1; tok_slot[r * 2 + 1] = b2 + rk2; }
            run += mine;
        }
    }
    if (w == 0 && lane < HIST_LD) hist[bid * HIST_LD + lane] = lane < NE ? run : 0;
}
__device__ __forceinline__ void ph_dispatch_fast(const Params& p, int l, int rows, LAS unsigned char* lds, int bid, int nblocks, int wv_) {
    const int tid = tid_of(wv_); const int* hist = (const int*)(p.ws + WS_HIST) + (size_t)l * MAXG * HIST_LD;
    const int* tok_e = (const int*)(p.ws + WS_TOK); const int* tok_slot = (const int*)(p.ws + WS_TOK) + (size_t)MT * 4; int* tok_dest = (int*)(p.ws + WS_TOK) + (size_t)MT * 6;
    int* rowidx = (int*)(p.ws + WS_ROWIDX); int* cnt = (int*)(p.ws + WS_CNT) + l * 64;
    LAS int* pre = (LAS int*)lds; LAS int* seg = pre + MAXG * NE; LAS int* tot = seg + 32 * NE; LAS int* pst = tot + NE;
    { const int e = tid & 15, sg = tid >> 4; int v[8], sum = 0;
#pragma unroll
        for (int i = 0; i < 8; ++i) { const int wg = 8 * sg + i; v[i] = wg < nblocks ? hist[wg * HIST_LD + e] : 0; sum += v[i]; }
        seg[sg * NE + e] = sum;
        __syncthreads();
        int base = 0; for (int s2 = 0; s2 < sg; ++s2) base += seg[s2 * NE + e];
#pragma unroll
        for (int i = 0; i < 8; ++i) { pre[(8 * sg + i) * NE + e] = base; base += v[i]; }
        if (sg == 31) tot[e] = base;
        __syncthreads();
        if (tid <= NE) { int acc = 0; for (int j = 0; j < tid; ++j) acc += (tot[j] + 255) / 256 * 256; pst[tid] = acc; }
        if (bid == 0 && tid < NE) cnt[tid] = tot[tid];
        __syncthreads(); }
    const long gtid = (long)bid * 512 + tid, gthreads = (long)nblocks * 512; const int tpw = (rows / 16 + nblocks - 1) / nblocks;
    for (long it = gtid; it < (long)rows * 2; it += gthreads) { const int e = tok_e[it], wg = (int)((it >> 5) / tpw), dest = pst[e] + pre[wg * NE + e] + tok_slot[it]; tok_dest[it] = dest; st_coh(rowidx + dest, (int)(it / 2)); }
    const int total = pst[NE];
    for (long it = gtid; it < total; it += gthreads) { int st = 0, ce = 0;
#pragma unroll
        for (int j = 0; j < NE; ++j) { if (it >= pst[j] && it < pst[j + 1]) { st = pst[j]; ce = tot[j]; } }
        if (it - st >= ce) st_coh(rowidx + it, 0); }
}
#endif
__device__ __forceinline__ void ph_final(const Params& p, long gtid, long gthreads) {
    const float* xres = (const float*)(p.ws + WS_XRES);
    for (long r = gtid; r < ML; r += gthreads) {
        const float* xr = xres + (size_t)r * D; float ss = 0.f; for (int k = 0; k < D; ++k) ss += xr[k] * xr[k];
        const float rstd = 1.0f / sqrtf(ss / D + 1e-6f);
        for (int k = 0; k < D; ++k) p.out[(size_t)r * D + k] = xr[k] * rstd * p.norm_final[k];
    }
}

struct CvtJob { const float* src; bf16_t* dst; int K, N, mode, fp8, ld; };
constexpr int NJOBS = 6 + 2 * NE * 3;
constexpr int IN0_NQ = QW + 2 * KVW;
__device__ __forceinline__ CvtJob cvt_job(const Params& p, int j) {
    CvtJob J; unsigned char* ws = p.ws; J.fp8 = 0;
    if (j == 0) { J.src = p.ev_w_in; J.dst = (bf16_t*)(ws + WS_WT_IN0); J.K = D; J.N = IN0_NQ; J.mode = 0; }
    else if (j == 5) { J.src = p.ev_w_in + IN0_NQ; J.dst = (bf16_t*)(ws + WS_WT_IN0) + (size_t)IN0_NQ * D; J.K = D; J.N = EVIN - IN0_NQ; J.mode = 0; }
    else if (j == 1) { J.src = p.ev_w_out; J.dst = (bf16_t*)(ws + WS_WT_OUT0); J.K = D; J.N = D; J.mode = 0; }
    else if (j == 2) { J.src = p.od_w_in; J.dst = (bf16_t*)(ws + WS_WT_IN1); J.K = D; J.N = S5W; J.mode = 0; }
    else if (j == 3) { J.src = p.s5_glu_w; J.dst = (bf16_t*)(ws + WS_WT_GLU); J.K = S5W; J.N = S5W; J.mode = 0; }
    else if (j == 4) { J.src = p.od_w_out; J.dst = (bf16_t*)(ws + WS_WT_OUT1); J.K = S5W; J.N = D; J.mode = 0; }
    else { const int q = j - 6, le = q / 3, kind = q % 3;
        if (kind == 0) { J.src = p.moe_w_gate + (size_t)le * D * FF; J.dst = (bf16_t*)(ws + WS_WT_GU) + (size_t)le * 2 * FF * D; J.K = D; J.N = FF; J.mode = 1; }
        else if (kind == 1) { J.src = p.moe_w_up + (size_t)le * D * FF; J.dst = (bf16_t*)(ws + WS_WT_GU) + (size_t)le * 2 * FF * D; J.K = D; J.N = FF; J.mode = 2; }
        else { J.src = p.moe_w_down + (size_t)le * FF * D; J.dst = (bf16_t*)(ws + WS_WT_DN) + (size_t)le * D * FF; J.K = FF; J.N = D; J.mode = 0; }
        if (le >= NE ? MOE1_FP8 : MOE0_FP8) { const int l8 = le / NE, e = le % NE; J.fp8 = 1;
            J.dst = kind == 2 ? (bf16_t*)(ws + WS_WT_DN + (size_t)l8 * NE * D * FF * 2 + (size_t)e * D * FF) : (bf16_t*)(ws + WS_WT_GU + (size_t)l8 * NE * 2 * FF * D * 2 + (size_t)e * 2 * FF * D); } }
    if (((IN0_FP8 || IN0QKV_FP8) && j == 0) || (IN0_FP8 && j == 5) || (OUT0_FP8 && j == 1)) J.fp8 = 1;
    J.ld = (j == 0 || j == 5) ? EVIN : J.N;
    if (DENSE1_FP8 && j >= 2 && j <= 4) J.fp8 = 1;
    return J;
}
__device__ __forceinline__ int cvt_rowmap(int mode, int n) { return mode == 0 ? n : (n / 128) * 256 + (mode == 2 ? 128 : 0) + n % 128; }
constexpr long cvt_tiles_of(int K, int N) { return (long)(K / 64) * (N / 256); }
constexpr long CVT_TILES = cvt_tiles_of(D, IN0_NQ) + cvt_tiles_of(D, EVIN - IN0_NQ) + cvt_tiles_of(D, D) + cvt_tiles_of(D, S5W) + cvt_tiles_of(S5W, S5W) + cvt_tiles_of(S5W, D) + (long)2 * NE * 3 * cvt_tiles_of(D, FF);
__device__ __forceinline__ void cvt_find(long tile, int& j, long& local) {
    const long t0 = cvt_tiles_of(D, IN0_NQ), t1 = t0 + cvt_tiles_of(D, D), t2 = t1 + cvt_tiles_of(D, S5W), t3 = t2 + cvt_tiles_of(S5W, S5W), t4 = t3 + cvt_tiles_of(S5W, D), t5 = t4 + cvt_tiles_of(D, EVIN - IN0_NQ);
    if (tile < t0) { j = 0; local = tile; } else if (tile < t1) { j = 1; local = tile - t0; } else if (tile < t2) { j = 2; local = tile - t1; } else if (tile < t3) { j = 3; local = tile - t2; }
    else if (tile < t4) { j = 4; local = tile - t3; } else if (tile < t5) { j = 5; local = tile - t4; } else { const long q = tile - t5, per = cvt_tiles_of(D, FF); j = 6 + (int)(q / per); local = q % per; }
}
#ifndef CPU_EMU
constexpr int CVT_PITCH = 257, CVT_LDS_BYTES = 128 * 129 * 4;
struct CvtSrc { const float* src; int N, fp8; };
__device__ __forceinline__ CvtSrc cvt_src(const Params& p, long t) { int j; long loc; cvt_find(t, j, loc); const CvtJob L = cvt_job(p, j); CvtSrc S; S.N = L.ld; S.fp8 = L.fp8;
    if (L.fp8) { const int tn8 = L.N / 128, k0 = (int)(loc / tn8) * 128, n0 = (int)(loc % tn8) * 128; S.src = L.src + (size_t)k0 * L.ld + n0; }
    else { const int tn = L.N / 256, k0 = (int)(loc / tn) * 64, n0 = (int)(loc % tn) * 256; S.src = L.src + (size_t)k0 * L.ld + n0; }
    return S; }
__device__ __forceinline__ f32x4 cvt_load(const CvtSrc& S, int tid, int i) { const int q = tid + 512 * i, kk = S.fp8 ? q >> 5 : q >> 6, n4 = S.fp8 ? (q & 31) * 4 : (q & 63) * 4; return *(const f32x4*)(S.src + (size_t)kk * S.N + n4); }
__device__ __forceinline__ void ph_convert(const Params& p, float* tile, long t_end, int max_tiles, int wv_) {
    const int tid = tid_of(wv_); int* ctr = (int*)(p.ws + WS_CNT) + 128; LAS int* tsh = (LAS int*)((LAS unsigned char*)tile + CVT_LDS_BYTES);
    (void)max_tiles;
    int pend = 0, par = 0;
    __syncthreads();
    if (tid == 0) { const int a0 = atomicAdd(ctr, 1), a1 = atomicAdd(ctr, 1); pend = atomicAdd(ctr, 1); tsh[0] = a0; tsh[1] = a1; }
    __syncthreads();
    long t = tsh[0], tn = tsh[1];
    f32x4 R[8];
    if (t < t_end) { const CvtSrc S = cvt_src(p, t);
#pragma unroll
        for (int i = 0; i < 8; ++i) R[i] = cvt_load(S, tid, i); }
    while (t < t_end) {
        int j; long local; cvt_find(t, j, local); const CvtJob J = cvt_job(p, j);
        const bool more = tn < t_end; const CvtSrc SN = cvt_src(p, more ? tn : t);
#pragma unroll
        for (int i = 0; i < 8; ++i) {
            if (J.fp8) { const int q = tid + 512 * i, kk = q >> 5, n4 = (q & 31) * 4; *(f32x4*)(tile + kk * 128 + (n4 ^ (((kk >> 4) & 3) << 4))) = R[i]; }
            else { const int q = tid + 512 * i, kk = q >> 6, n4 = (q & 63) * 4; tile[kk * CVT_PITCH + n4] = R[i][0]; tile[kk * CVT_PITCH + n4 + 1] = R[i][1]; tile[kk * CVT_PITCH + n4 + 2] = R[i][2]; tile[kk * CVT_PITCH + n4 + 3] = R[i][3]; }
        }
        if (tid == 0) { tsh[2 + par] = pend; pend = atomicAdd(ctr, 1); }
        __syncthreads();
        const long tnn = tsh[2 + par]; par ^= 1;
        if (more) {
#pragma unroll
            for (int i = 0; i < 8; ++i) R[i] = cvt_load(SN, tid, i); }
        if (J.fp8) {
            const int tn8 = J.N / 128, k0 = (int)(local / tn8) * 128, n0 = (int)(local % tn8) * 128;
            const float wsc = (OUT0_FP8 && j == 1 && k0 < QW) ? W8_SCALE / MIX8_SCALE : W8_SCALE;
#pragma unroll
            for (int i = 0; i < 2; ++i) { const int lane = tid & 63, nn = 64 * i + 8 * (tid >> 6) + (lane & 7), kg = lane >> 3, kgl = kg & 3; const float* tp = tile + (16 * kg) * 128 + (nn ^ (kgl << 4)); u4v_t w;
#pragma unroll
                for (int d4 = 0; d4 < 4; ++d4) { int pk = 0; pk = __builtin_amdgcn_cvt_pk_fp8_f32(tp[(4 * d4) * 128] * wsc, tp[(4 * d4 + 1) * 128] * wsc, pk, false);
                    pk = __builtin_amdgcn_cvt_pk_fp8_f32(tp[(4 * d4 + 2) * 128] * wsc, tp[(4 * d4 + 3) * 128] * wsc, pk, true); w[d4] = (unsigned)pk; }
                *(u4v_t*)((unsigned char*)J.dst + (size_t)cvt_rowmap(J.mode, n0 + nn) * J.K + k0 + 16 * kg) = w; }
        } else {
            const int tnn_ = J.N / 256, k0 = (int)(local / tnn_) * 64, n0 = (int)(local % tnn_) * 256;
#pragma unroll
            for (int i = 0; i < 4; ++i) { const int q = tid + 512 * i, nn = q >> 3, k8 = (q & 7) * 8; const float* tp = tile + k8 * CVT_PITCH + nn;
                u4v_t w = {pack2bf(tp[0], tp[CVT_PITCH]), pack2bf(tp[2 * CVT_PITCH], tp[3 * CVT_PITCH]), pack2bf(tp[4 * CVT_PITCH], tp[5 * CVT_PITCH]), pack2bf(tp[6 * CVT_PITCH], tp[7 * CVT_PITCH])};
                *(u4v_t*)(J.dst + (size_t)cvt_rowmap(J.mode, n0 + nn) * J.K + k0 + k8) = w; }
        }
        __syncthreads();
        t = tn; tn = tnn;
    }
}
#else
void ph_convert_emu(const Params& p) {
    for (int j = 0; j < NJOBS; ++j) { const CvtJob J = cvt_job(p, j);
        for (int n = 0; n < J.N; ++n) { bf16_t* dr = J.dst + (size_t)cvt_rowmap(J.mode, n) * J.K; for (int k = 0; k < J.K; ++k) dr[k] = f2bf(J.src[(size_t)k * J.ld + n]); } }
}
#endif

namespace pg8 {
constexpr int BM = 256, BK = 64, HALF = 128, HTB = HALF * BK * 2  , STAGE_BYTES = 8 * HTB, NXCD = 8, WGM = 8;
struct Unit { int pm, pn, e; };
struct Gemm { const bf16_t* A; const bf16_t* Bt; int M, N, K; int sc_w = 0, sc_a = 0; };
__host__ __device__ __forceinline__ int lds_byte(int r, int c) { const int st = (r >> 4) * 2 + (c >> 5), rr = r & 15, cc = c & 31, ob = rr * 64 + cc * 2; return st * 1024 + (ob ^ (((ob >> 9) & 1) << 5)); }
__host__ __device__ __forceinline__ void stage_rc(int b, int& R, int& C) { const int st = b / 1024, sb = b % 1024, swz = sb ^ (((sb >> 9) & 1) << 5); R = (st >> 1) * 16 + swz / 64; C = (st & 1) * 32 + (swz % 64) / 2; }
__host__ __device__ __forceinline__ int perm32(int rho) { const int n = rho >> 4, i = rho & 15; return 8 * (i >> 2) + 4 * n + (i & 3); }

struct StaticOrder {
    static constexpr bool GATHER = false;
    int nM, nN, nwg, G, c;
    __host__ __device__ void init(int M, int N, int G_, int c_) { nM = M / BM; nN = N / BM; nwg = nM * nN; G = G_; c = c_; }
    __host__ __device__ bool next(int i, Unit& u) const {
        const long L = (long)i * G + c; if (L >= nwg) return false;
        int wgid = (int)L; { const int q = nwg / NXCD, r = nwg % NXCD, xcd = wgid % NXCD, off = wgid / NXCD; wgid = (xcd < r ? xcd * (q + 1) : r * (q + 1) + (xcd - r) * q) + off; }
        const int nig = WGM * nN, gid = wgid / nig, fm = gid * WGM, gsz = (nM - fm) < WGM ? (nM - fm) : WGM;
        u.pm = fm + ((wgid % nig) % gsz); u.pn = (wgid % nig) / gsz; u.e = 0; return true;
    }
    __device__ __forceinline__ const char* b_base(const Gemm& g, const Unit& u) const { return (const char*)g.Bt + (size_t)u.pn * ((size_t)BM * g.K * 2); }
    __device__ __forceinline__ int a_row(const Unit& u, int rr) const { return u.pm * BM + rr; }
};
template <bool ROWS> struct MoeOrder {
    static constexpr bool GATHER = ROWS;
    int nN, nwg, G, c; const int* cnt; const int* rowidx; size_t estride;
    __device__ void init(const int* cnt_, int N, int G_, int c_, const int* rowidx_, size_t estride_) { int acc = 0; cnt = cnt_;
#pragma unroll
        for (int e = 0; e < NE; ++e) acc += (cnt[e] + 255) / 256 * 256;
        nN = N / BM; nwg = (acc / 256) * nN; G = G_; c = c_; rowidx = rowidx_; estride = estride_; }
    __device__ bool next(int i, Unit& u) const { const long L = (long)i * G + c; if (L >= nwg) return false; u.pm = (int)(L / nN); u.pn = (int)(L % nN); int e = 0, acc = 0;
#pragma unroll
        for (int j = 0; j < NE - 1; ++j) { acc += (cnt[j] + 255) / 256 * 256; e += (u.pm * 256 >= acc) ? 1 : 0; }
        u.e = e; return true; }
    __device__ __forceinline__ const char* b_base(const Gemm& g, const Unit& u) const { return (const char*)g.Bt + (size_t)u.e * estride + (size_t)u.pn * ((size_t)BM * g.K * 2); }
    __device__ __forceinline__ int a_row(const Unit& u, int rr) const { return ROWS ? ld_coh(rowidx + u.pm * BM + rr) : u.pm * BM + rr; }
    __device__ __forceinline__ const int* a_row_ptr(const Unit& u, int rr) const { return rowidx + u.pm * BM + rr; }
};

#ifdef CPU_EMU
typedef unsigned char* LdsPtr;
#else
#define PG8_LAS __attribute__((address_space(3)))
typedef PG8_LAS unsigned char* LdsPtr;
typedef short bf16x8 __attribute__((ext_vector_type(8)));
typedef unsigned u32x4 __attribute__((ext_vector_type(4)));
typedef int pg8_v4i __attribute__((ext_vector_type(4)));
typedef int pg8_v8i __attribute__((ext_vector_type(8)));
template <class Epi, class Sched, bool F8 = false>
__device__ __forceinline__ void gemm_phase(LdsPtr lds, const Gemm g, const Sched& S, const Epi& E, int wv_) {
    const int tid = tid_of(wv_), wid = wv_, lane = tid & 63, wr = wid >> 2, wc = wid & 3, fr = lane & 15, fq = lane >> 4;
    const int K = g.K, nt = K / BK;
    unsigned voffB[2]; int RA[2], CA[2];
#pragma unroll
    for (int i = 0; i < 2; ++i) { int R, C; stage_rc(tid * 16 + i * 8192, R, C); const int Rb = Epi::PERM ? ((R & ~31) + perm32(R & 31)) : R;
        RA[i] = R; CA[i] = C; voffB[i] = (unsigned)(Rb * K + C) * 2u; }
    const size_t kstep = (size_t)(BK * 2);
    const size_t hstep = (size_t)HALF * K * 2;
    const unsigned ldsw = (unsigned)wid * 1024u;
    const int aoff = F8 ? lds_byte(wr * 64 + fr, fq * 16) + ((fq & 1) << 4) : lds_byte(wr * 64 + fr, fq * 8), boff = F8 ? lds_byte(wc * 32 + fr, fq * 16) + ((fq & 1) << 4) : lds_byte(wc * 32 + fr, fq * 8);
    const int sc_both = (g.sc_w & 0xff) | ((g.sc_a & 0xff) << 8);
    const int koff = F8 ? (16 - ((fq & 1) << 5)) : 1024;
#define PG8_SA(b, h) (((b) * 2 + (h)) * HTB)
#define PG8_SB(b, h) ((4 + (b) * 2 + (h)) * HTB)
#define PG8_STAGE(bufoff, gbase, voff) do { _Pragma("unroll") for (int _i = 0; _i < 2; ++_i) \
        __builtin_amdgcn_global_load_lds((const unsigned*)((const char*)(gbase) + (voff)[_i]), (PG8_LAS unsigned*)(lds + (bufoff) + ldsw + _i * 8192), 16, 0, 0); } while (0)
#define PG8_LD8(dst, addr) do { const pg8_v4i lo_ = *(const PG8_LAS pg8_v4i*)(addr), hi_ = *(const PG8_LAS pg8_v4i*)((addr) + koff); dst = __builtin_shufflevector(lo_, hi_, 0, 1, 2, 3, 4, 5, 6, 7); } while (0)
#define PG8_LDA(dst, b, h) do { if constexpr (F8) { _Pragma("unroll") for (int m = 0; m < 4; ++m) PG8_LD8(dst##8[m], lds + PG8_SA(b, h) + aoff + m * 2048); } \
        else { _Pragma("unroll") for (int m = 0; m < 4; ++m) _Pragma("unroll") for (int k = 0; k < 2; ++k) dst[m][k] = *(const PG8_LAS bf16x8*)(lds + PG8_SA(b, h) + aoff + m * 2048 + k * koff); } } while (0)
#define PG8_LDB(dst, b, h) do { if constexpr (F8) { _Pragma("unroll") for (int n = 0; n < 2; ++n) PG8_LD8(dst##8[n], lds + PG8_SB(b, h) + boff + n * 2048); } \
        else { _Pragma("unroll") for (int n = 0; n < 2; ++n) _Pragma("unroll") for (int k = 0; k < 2; ++k) dst[n][k] = *(const PG8_LAS bf16x8*)(lds + PG8_SB(b, h) + boff + n * 2048 + k * koff); } } while (0)
#define PG8_MMA(ai, bj, At, Bt) do { __builtin_amdgcn_s_setprio(1); \
        if constexpr (F8) { _Pragma("unroll") for (int m = 0; m < 4; ++m) _Pragma("unroll") for (int n = 0; n < 2; ++n) \
            acc[ai][bj][m][n] = __builtin_amdgcn_mfma_scale_f32_16x16x128_f8f6f4(Bt##8[n], At##8[m], acc[ai][bj][m][n], 0, 0, 0, sc_both, 1, sc_both); } \
        else { _Pragma("unroll") for (int m = 0; m < 4; ++m) _Pragma("unroll") for (int n = 0; n < 2; ++n) _Pragma("unroll") for (int k = 0; k < 2; ++k) \
            acc[ai][bj][m][n] = __builtin_amdgcn_mfma_f32_16x16x32_bf16(Bt[n][k], At[m][k], acc[ai][bj][m][n], 0, 0, 0); } \
        __builtin_amdgcn_s_setprio(0); } while (0)
#define PG8_WAIT_V(n) asm volatile("s_waitcnt vmcnt(" #n ")" ::: "memory")
#define PG8_WAIT_L(n) asm volatile("s_waitcnt lgkmcnt(" #n ")" ::: "memory")
#define PG8_BAR __builtin_amdgcn_s_barrier()
#define PG8_SCHED __builtin_amdgcn_sched_barrier(0)
#define PG8_VOFFA(dst, U) do { _Pragma("unroll") for (int _h = 0; _h < 2; ++_h) _Pragma("unroll") for (int _i = 0; _i < 2; ++_i) \
        dst[_h][_i] = (unsigned)((size_t)S.a_row(U, _h * HALF + RA[_i]) * K + CA[_i]) * 2u; } while (0)
    Unit cur, nxt; int ui = 0;
    if (!S.next(0, cur)) return;
    f32x4 acc[2][2][4][2];
#pragma unroll
    for (int a = 0; a < 2; ++a)
#pragma unroll
        for (int b = 0; b < 2; ++b)
#pragma unroll
            for (int m = 0; m < 4; ++m)
#pragma unroll
                for (int n = 0; n < 2; ++n) acc[a][b][m][n] = (f32x4){0.f, 0.f, 0.f, 0.f};
    bf16x8 At[4][2], B0[2][2], B1[2][2];
    pg8_v8i At8[4], B08[2], B18[2];
    unsigned vA[2][2];
    PG8_VOFFA(vA, cur);
    const char* cA = (const char*)g.A; const char* cB = S.b_base(g, cur);
    PG8_STAGE(PG8_SB(0, 0), cB, voffB); PG8_STAGE(PG8_SB(0, 1), cB + hstep, voffB); PG8_STAGE(PG8_SA(0, 0), cA, vA[0]); PG8_STAGE(PG8_SA(0, 1), cA, vA[1]);
    if (wr == 1) PG8_BAR;
    PG8_WAIT_V(2); PG8_BAR;
    PG8_STAGE(PG8_SB(1, 0), cB + kstep, voffB); PG8_STAGE(PG8_SA(1, 0), cA + kstep, vA[0]); PG8_STAGE(PG8_SB(1, 1), cB + hstep + kstep, voffB);
    PG8_WAIT_V(6); PG8_BAR;
    for (;;) {
        const bool has_next = S.next(ui + 1, nxt);
#ifndef CPU_EMU
        if constexpr (Sched::GATHER) { if (has_next) {
#pragma unroll
            for (int _h = 0; _h < 2; ++_h)
#pragma unroll
                for (int _i = 0; _i < 2; ++_i)
                    __builtin_amdgcn_global_load_lds((const unsigned*)S.a_row_ptr(nxt, _h * HALF + RA[_i]), (PG8_LAS unsigned*)(lds + STAGE_BYTES + 2048 + (_h * 2 + _i) * 2048 + wid * 256), 4, 0, 16); } }
#endif
        const char* nB = has_next ? S.b_base(g, nxt) : cB;
        for (int t = 0; t < nt; t += 2) {
            const bool last = (t == nt - 2);
            const char* a1 = cA + (size_t)(t + 1) * kstep;
            const char* a2 = last ? cA : cA + (size_t)(t + 2) * kstep; const char* b2 = last ? nB : cB + (size_t)(t + 2) * kstep;
            const char* a3 = a2 + kstep; const char* b3 = b2 + kstep;
            PG8_LDB(B0, 0, 0); PG8_LDB(B1, 0, 1); PG8_SCHED; PG8_LDA(At, 0, 0); PG8_STAGE(PG8_SA(1, 1), a1, vA[1]);
            if (last && has_next) {
                if constexpr (Sched::GATHER) { if (nt < 4) PG8_WAIT_V(0);
#pragma unroll
                    for (int _h = 0; _h < 2; ++_h)
#pragma unroll
                        for (int _i = 0; _i < 2; ++_i) { const int row_ = *(const PG8_LAS int*)(lds + STAGE_BYTES + 2048 + (_h * 2 + _i) * 2048 + wid * 256 + lane * 4);
                            vA[_h][_i] = (unsigned)((size_t)row_ * K + CA[_i]) * 2u; } }
                else { PG8_VOFFA(vA, nxt); } }
            PG8_WAIT_V(8); PG8_WAIT_L(0); PG8_BAR; PG8_MMA(0, 0, At, B0); PG8_MMA(0, 1, At, B1); PG8_BAR; PG8_SCHED;
            PG8_LDA(At, 0, 1); PG8_STAGE(PG8_SB(0, 0), b2, voffB); PG8_STAGE(PG8_SB(0, 1), b2 + hstep, voffB); PG8_STAGE(PG8_SA(0, 0), a2, vA[0]);
            PG8_WAIT_V(8); PG8_WAIT_L(0); PG8_BAR; PG8_MMA(1, 0, At, B0); PG8_MMA(1, 1, At, B1); PG8_BAR; PG8_SCHED;
            PG8_LDB(B0, 1, 0); PG8_LDB(B1, 1, 1); PG8_SCHED; PG8_LDA(At, 1, 0); PG8_STAGE(PG8_SA(0, 1), a2, vA[1]);
            PG8_WAIT_V(8); PG8_WAIT_L(0); PG8_BAR; PG8_MMA(0, 0, At, B0); PG8_MMA(0, 1, At, B1); PG8_BAR; PG8_SCHED;
            PG8_LDA(At, 1, 1); PG8_STAGE(PG8_SB(1, 0), b3, voffB); PG8_STAGE(PG8_SB(1, 1), b3 + hstep, voffB); PG8_STAGE(PG8_SA(1, 0), a3, vA[0]);
            PG8_WAIT_V(8); PG8_WAIT_L(0); PG8_BAR; PG8_MMA(1, 0, At, B0); PG8_MMA(1, 1, At, B1); PG8_BAR; PG8_SCHED;
        }
        if (wr == 0) PG8_BAR;
        E(acc, cur, wr, wc, fr, fq);
        if (!has_next) break;
#pragma unroll
        for (int a = 0; a < 2; ++a)
#pragma unroll
            for (int b = 0; b < 2; ++b)
#pragma unroll
                for (int m = 0; m < 4; ++m)
#pragma unroll
                    for (int n = 0; n < 2; ++n) acc[a][b][m][n] = (f32x4){0.f, 0.f, 0.f, 0.f};
        cur = nxt; cB = nB; ++ui;
        if (wr == 1) PG8_BAR;
    }
    PG8_WAIT_V(0);
    PG8_BAR;
#undef PG8_SA
#undef PG8_SB
#undef PG8_STAGE
#undef PG8_LDA
#undef PG8_LDB
#undef PG8_MMA
#undef PG8_LD8
#undef PG8_WAIT_V
#undef PG8_WAIT_L
#undef PG8_BAR
#undef PG8_SCHED
#undef PG8_VOFFA
}
#endif
}

typedef f32x4 AccT[2][2][4][2];

struct EpiQKV {
    static constexpr bool PERM = false;
    bf16_t* O; const float* rope; bf16_t* VT; int pn0 = 0;
    __device__ __forceinline__ void operator()(const AccT& acc, const pg8::Unit& u, int wr, int wc, int fr, int fq) const {
        const int colt = (u.pn + pn0) * 256; const bool is_q = colt < COL_K, is_k = colt >= COL_K && colt < COL_V, is_v = colt >= COL_V && colt < COL_XR;
#pragma unroll
        for (int ai = 0; ai < 2; ++ai) {
            f32x4 rp[4][2];
            if (is_q || is_k) {
#pragma unroll
                for (int m = 0; m < 4; ++m) { const int r = u.pm * 256 + ai * 128 + wr * 64 + m * 16 + fr, t = r % NSEQ, pos = (wc & 1) ? (t % 64) : (t / 64);
                    rp[m][0] = *(const f32x4*)(rope + (pos * 16 + 4 * fq) * 2); rp[m][1] = *(const f32x4*)(rope + (pos * 16 + 4 * fq) * 2 + 4); }
#ifndef CPU_EMU
                asm volatile("" ::: "memory");
#endif
            }
#pragma unroll
            for (int m = 0; m < 4; ++m) {
                const int r = u.pm * 256 + ai * 128 + wr * 64 + m * 16 + fr; const bool lat = r < ML; const int t = r % NSEQ;
#pragma unroll
                for (int bj = 0; bj < 2; ++bj) {
                    const int cg = colt + bj * 128 + wc * 32;
                    f32x4 v0 = acc[ai][bj][m][0], v1 = acc[ai][bj][m][1];
                    if ((is_q || is_k) && lat) {
#pragma unroll
                        for (int j = 0; j < 4; ++j) { const float cs = rp[m][j >> 1][(j & 1) * 2], sn = rp[m][j >> 1][(j & 1) * 2 + 1]; const float a = v0[j], b = v1[j]; v0[j] = a * cs - b * sn; v1[j] = b * cs + a * sn; }
                    }
                    if (is_q) { v0 *= 0.125f; v1 *= 0.125f; }
                    bf16_t* rowp = O + (size_t)r * EVIN + cg + 4 * fq;
                    u32x2_t w0, w1; w0.x = pack2bf(v0[0], v0[1]); w0.y = pack2bf(v0[2], v0[3]); w1.x = pack2bf(v1[0], v1[1]); w1.y = pack2bf(v1[2], v1[3]);
                    *(u32x2_t*)rowp = w0; *(u32x2_t*)(rowp + 16) = w1;
                    if (is_v) {
                        const int bb = lat ? r / NSEQ : (r - ML) / NCTX, tt = lat ? t : (r - ML) % NCTX, k16 = tt & 15, kp = (k16 & 3) | ((k16 & 4) << 1) | ((k16 & 8) >> 1);
                        const int pos = (lat ? 128 : 128 + NSEQ + 128) + (tt & ~15) + kp, vc = cg - COL_V + 4 * fq;
                        bf16_t* vp = VT + ((size_t)bb * 256 + vc) * VT_T + pos;
#pragma unroll
                        for (int j = 0; j < 4; ++j) { vp[(size_t)j * VT_T] = f2bf(v0[j]); vp[(size_t)(16 + j) * VT_T] = f2bf(v1[j]); }
                    }
                }
            }
        }
    }
};
template <bool IN16, bool OUT16> struct EpiResidT {
    static constexpr bool PERM = false;
    const float* xin_lat; const float* xin_ctx; float* xout; const float* gate;
    __device__ __forceinline__ void operator()(const AccT& acc, const pg8::Unit& u, int wr, int wc, int fr, int fq) const {
        const int row0 = u.pm * 256, arow = row0 < ML ? row0 / NSEQ : NB; const float* gp = gate + (size_t)arow * ADA6;
        const int col0 = u.pn * 256 + wc * 32 + 4 * fq;
        f32x4 gv[2][2];
#pragma unroll
        for (int bj = 0; bj < 2; ++bj)
#pragma unroll
            for (int n = 0; n < 2; ++n) gv[bj][n] = *(const f32x4*)(gp + col0 + bj * 128 + n * 16);
#pragma unroll
        for (int ai = 0; ai < 2; ++ai) {
            f32x4 xi[4][2][2];
#pragma unroll
            for (int m = 0; m < 4; ++m) { const int r = row0 + ai * 128 + wr * 64 + m * 16 + fr;
                const size_t io = (r < ML ? (size_t)r * D : (size_t)(r - ML) * D) + col0; const float* ib = r < ML ? xin_lat : xin_ctx;
#pragma unroll
                for (int bj = 0; bj < 2; ++bj)
#pragma unroll
                    for (int n = 0; n < 2; ++n) {
                        if (IN16) { const u32x2_t t = *(const u32x2_t*)((const bf16_t*)ib + io + bj * 128 + n * 16); xi[m][bj][n] = unpack4bf(t.x, t.y); } else xi[m][bj][n] = *(const f32x4*)(ib + io + bj * 128 + n * 16); } }
#ifndef CPU_EMU
            asm volatile("" ::: "memory");
#endif
#pragma unroll
            for (int m = 0; m < 4; ++m) { const int r = row0 + ai * 128 + wr * 64 + m * 16 + fr; const size_t oo = (size_t)r * D + col0;
#pragma unroll
                for (int bj = 0; bj < 2; ++bj)
#pragma unroll
                    for (int n = 0; n < 2; ++n) { const f32x4 xo = xi[m][bj][n] + gv[bj][n] * acc[ai][bj][m][n];
                        if (OUT16) { u32x2_t t; t.x = pack2bf(xo[0], xo[1]); t.y = pack2bf(xo[2], xo[3]); *(u32x2_t*)((bf16_t*)xout + oo + bj * 128 + n * 16) = t; } else *(f32x4*)(xout + oo + bj * 128 + n * 16) = xo; } }
        }
    }
};
typedef EpiResidT<false, RES_BF16> EpiResid0;
typedef EpiResidT<RES_BF16, RES_BF16> EpiResid;
struct EpiBf16 {
    static constexpr bool PERM = true;
    bf16_t* O; int ldc;
    __device__ __forceinline__ void operator()(const AccT& acc, const pg8::Unit& u, int wr, int wc, int fr, int fq) const {
        const int col0 = u.pn * 256 + wc * 32 + 8 * fq;
#pragma unroll
        for (int ai = 0; ai < 2; ++ai)
#pragma unroll
            for (int m = 0; m < 4; ++m) { bf16_t* rowp = O + (size_t)(u.pm * 256 + ai * 128 + wr * 64 + m * 16 + fr) * ldc + col0;
#pragma unroll
                for (int bj = 0; bj < 2; ++bj) { const f32x4 v0 = acc[ai][bj][m][0], v1 = acc[ai][bj][m][1];
                    u32x4_t w; w.x = pack2bf(v0[0], v0[1]); w.y = pack2bf(v0[2], v0[3]); w.z = pack2bf(v1[0], v1[1]); w.w = pack2bf(v1[2], v1[3]);
                    *(u32x4_t*)(rowp + bj * 128) = w; } }
    }
};
#ifndef CPU_EMU
struct EpiY8 {
    static constexpr bool PERM = true;
    unsigned char* O; int ldc;
    __device__ __forceinline__ void operator()(const AccT& acc, const pg8::Unit& u, int wr, int wc, int fr, int fq) const {
        const int col0 = u.pn * 256 + wc * 32 + 8 * fq;
#pragma unroll
        for (int ai = 0; ai < 2; ++ai)
#pragma unroll
            for (int m = 0; m < 4; ++m) { unsigned char* rowp = O + (size_t)(u.pm * 256 + ai * 128 + wr * 64 + m * 16 + fr) * ldc + col0;
#pragma unroll
                for (int bj = 0; bj < 2; ++bj) { const f32x4 v0 = acc[ai][bj][m][0] * Y8_SCALE, v1 = acc[ai][bj][m][1] * Y8_SCALE;
                    u32x2_t w; w.x = pack4_fp8(v0[0], v0[1], v0[2], v0[3]); w.y = pack4_fp8(v1[0], v1[1], v1[2], v1[3]);
                    *(u32x2_t*)(rowp + bj * 128) = w; } }
    }
};
#endif
struct EpiGU {
    static constexpr bool PERM = true;
    bf16_t* O;
    __device__ __forceinline__ void operator()(const AccT& acc, const pg8::Unit& u, int wr, int wc, int fr, int fq) const {
        const int col0 = u.pn * 128 + wc * 32 + 8 * fq;
#pragma unroll
        for (int ai = 0; ai < 2; ++ai)
#pragma unroll
            for (int m = 0; m < 4; ++m) { bf16_t* rowp = O + (size_t)(u.pm * 256 + ai * 128 + wr * 64 + m * 16 + fr) * FF + col0;
                float o[8];
#pragma unroll
                for (int n = 0; n < 2; ++n)
#pragma unroll
                    for (int j = 0; j < 4; ++j) { const float gt = acc[ai][0][m][n][j], up = acc[ai][1][m][n][j]; o[n * 4 + j] = siluf_(gt) * up; }
                u32x4_t w; w.x = pack2bf(o[0], o[1]); w.y = pack2bf(o[2], o[3]); w.z = pack2bf(o[4], o[5]); w.w = pack2bf(o[6], o[7]);
                *(u32x4_t*)rowp = w; }
    }
};
#ifndef CPU_EMU
struct EpiGU8 {
    static constexpr bool PERM = true;
    unsigned char* O;
    __device__ __forceinline__ void operator()(const AccT& acc, const pg8::Unit& u, int wr, int wc, int fr, int fq) const {
        const int col0 = u.pn * 128 + wc * 32 + 8 * fq;
#pragma unroll
        for (int ai = 0; ai < 2; ++ai)
#pragma unroll
            for (int m = 0; m < 4; ++m) { unsigned char* rowp = O + (size_t)(u.pm * 256 + ai * 128 + wr * 64 + m * 16 + fr) * FF + col0;
                float o[8];
#pragma unroll
                for (int n = 0; n < 2; ++n)
#pragma unroll
                    for (int j = 0; j < 4; ++j) { const float gt = acc[ai][0][m][n][j], up = acc[ai][1][m][n][j]; o[n * 4 + j] = siluf_(gt) * up * ACT8_SCALE; }
                u32x2_t w; w.x = pack4_fp8(o[0], o[1], o[2], o[3]); w.y = pack4_fp8(o[4], o[5], o[6], o[7]);
                *(u32x2_t*)rowp = w; }
    }
};
#endif
struct EpiGLU {
    static constexpr bool PERM = true;
    const bf16_t* Z; bf16_t* O; const float* bias;
    __device__ __forceinline__ void operator()(const AccT& acc, const pg8::Unit& u, int wr, int wc, int fr, int fq) const {
        const int col0 = u.pn * 256 + wc * 32 + 8 * fq;
#pragma unroll
        for (int ai = 0; ai < 2; ++ai)
#pragma unroll
            for (int m = 0; m < 4; ++m) { const size_t ro = (size_t)(u.pm * 256 + ai * 128 + wr * 64 + m * 16 + fr) * S5W + col0;
#pragma unroll
                for (int bj = 0; bj < 2; ++bj) { const u32x4_t zz = *(const u32x4_t*)(Z + ro + bj * 128); const unsigned zw[4] = {zz.x, zz.y, zz.z, zz.w}; float o[8];
#pragma unroll
                    for (int n = 0; n < 2; ++n)
#pragma unroll
                        for (int j = 0; j < 4; ++j) { const int q = n * 4 + j; const float zv = __uint_as_float((q & 1) ? (zw[q >> 1] & 0xffff0000u) : (zw[q >> 1] << 16));
                            o[q] = zv * sigmoidf_(acc[ai][bj][m][n][j] + bias[col0 + bj * 128 + q]); }
                    u32x4_t w; w.x = pack2bf(o[0], o[1]); w.y = pack2bf(o[2], o[3]); w.z = pack2bf(o[4], o[5]); w.w = pack2bf(o[6], o[7]);
                    *(u32x4_t*)(O + ro + bj * 128) = w; } }
    }
};

#ifndef CPU_EMU
struct EpiGLU8 {
    static constexpr bool PERM = true;
    const unsigned char* Z; unsigned char* O; const float* bias;
    __device__ __forceinline__ void operator()(const AccT& acc, const pg8::Unit& u, int wr, int wc, int fr, int fq) const {
        const int col0 = u.pn * 256 + wc * 32 + 8 * fq;
        u32x2_t zall[2][4][2]; f32x4 bv[2][2];
#pragma unroll
        for (int bj = 0; bj < 2; ++bj)
#pragma unroll
            for (int n = 0; n < 2; ++n) bv[bj][n] = *(const f32x4*)(bias + col0 + bj * 128 + n * 4);
#pragma unroll
        for (int ai = 0; ai < 2; ++ai)
#pragma unroll
            for (int m = 0; m < 4; ++m) { const size_t ro = (size_t)(u.pm * 256 + ai * 128 + wr * 64 + m * 16 + fr) * S5W + col0;
#pragma unroll
                for (int bj = 0; bj < 2; ++bj) zall[ai][m][bj] = *(const u32x2_t*)(Z + ro + bj * 128); }
        asm volatile("" ::: "memory");
#pragma unroll
        for (int ai = 0; ai < 2; ++ai)
#pragma unroll
            for (int m = 0; m < 4; ++m) { const size_t ro = (size_t)(u.pm * 256 + ai * 128 + wr * 64 + m * 16 + fr) * S5W + col0;
#pragma unroll
                for (int bj = 0; bj < 2; ++bj) { const u32x2_t zz = zall[ai][m][bj]; float o[8];
#pragma unroll
                    for (int n = 0; n < 2; ++n) { const int zw = (int)(n ? zz.y : zz.x);
                        const float z0 = __builtin_amdgcn_cvt_f32_fp8(zw, 0), z1 = __builtin_amdgcn_cvt_f32_fp8(zw, 1), z2 = __builtin_amdgcn_cvt_f32_fp8(zw, 2), z3 = __builtin_amdgcn_cvt_f32_fp8(zw, 3); const float zv[4] = {z0, z1, z2, z3};
#pragma unroll
                        for (int j = 0; j < 4; ++j) { const int q = n * 4 + j; o[q] = zv[j] * (S8_SCALE / Z8_SCALE) * sigmoidf_(acc[ai][bj][m][n][j] + bv[bj][n][j]); } }
                    u32x2_t w; w.x = pack4_fp8(o[0], o[1], o[2], o[3]); w.y = pack4_fp8(o[4], o[5], o[6], o[7]);
                    *(u32x2_t*)(O + ro + bj * 128) = w; } }
    }
};
#endif

enum { G_IN0 = 0, G_OUT0, G_GU, G_DN, G_IN1, G_GLU, G_OUT1, G_GU8, G_DN8, G_IN18, G_GLU8, G_OUT18, G_IN08, G_OUT08, G_IN0SPLIT };
#ifdef CPU_EMU
namespace pg8 {
template <class Epi, class Sched> void gemm_phase(LdsPtr, const Gemm g, const Sched& S, const Epi& E, int) {
    Unit u; std::vector<float> C(256 * 256), af(g.K), bfv((size_t)256 * g.K);
    for (int i = 0; S.next(i, u); ++i) {
        const bf16_t* Bb = (const bf16_t*)S.b_base(g, u);
        for (size_t q = 0; q < (size_t)256 * g.K; ++q) bfv[q] = bf2f(Bb[q]);
        for (int r = 0; r < 256; ++r) { const bf16_t* a = g.A + (size_t)S.a_row(u, r) * g.K; for (int k = 0; k < g.K; ++k) af[k] = bf2f(a[k]);
            for (int cc = 0; cc < 256; ++cc) { const float* bp = &bfv[(size_t)cc * g.K]; float s = 0.f; for (int k = 0; k < g.K; ++k) s += af[k] * bp[k]; C[r * 256 + cc] = s; } }
        for (int tid = 0; tid < 512; ++tid) { const int wid = tid >> 6, lane = tid & 63, wr = wid >> 2, wc = wid & 3, fr = lane & 15, fq = lane >> 4;
            f32x4 acc[2][2][4][2];
            for (int ai = 0; ai < 2; ++ai) for (int bj = 0; bj < 2; ++bj) for (int m = 0; m < 4; ++m) for (int n = 0; n < 2; ++n) for (int j = 0; j < 4; ++j) {
                const int r = 128 * ai + 64 * wr + 16 * m + fr, cc = Epi::PERM ? 128 * bj + 32 * wc + 8 * fq + 4 * n + j : 128 * bj + 32 * wc + 16 * n + 4 * fq + j;
                acc[ai][bj][m][n][j] = C[r * 256 + cc]; }
            E(acc, u, wr, wc, fr, fq); }
    }
}
}
#endif
#ifndef CPU_EMU
template <class Sched> __device__ __forceinline__ void gemm_stagger(const Sched& S, int tile_us) {
    const int rem = S.nwg % S.G; if (rem == 0 || S.c < rem) return;
    const int units = (int)((long)(S.c - rem) * tile_us * 4 / (5 * (S.G - rem)));
    for (int i = 0; i < units; ++i) __builtin_amdgcn_s_sleep(32);
}
#else
template <class Sched> void gemm_stagger(const Sched&, int) {}
#endif
template <int WHICH> __device__ __forceinline__ void run_gemm(const Params& p, int l, pg8::LdsPtr lds, int G, int c, int wv_ = 0) {
    unsigned char* ws = p.ws; pg8::Gemm g;
    if constexpr (WHICH == G_IN0) { g.A = (const bf16_t*)(ws + WS_H); g.Bt = (const bf16_t*)(ws + WS_WT_IN0); g.M = MT; g.N = EVIN; g.K = D;
        pg8::StaticOrder S; S.init(g.M, g.N, G, c); EpiQKV E; E.O = (bf16_t*)(ws + WS_QKV); E.rope = (const float*)(ws + WS_ROPE); E.VT = (bf16_t*)(ws + WS_VT); pg8::gemm_phase(lds, g, S, E, wv_); }
    else if constexpr (WHICH == G_OUT0) { g.A = (const bf16_t*)(ws + WS_MIX); g.Bt = (const bf16_t*)(ws + WS_WT_OUT0); g.M = MT; g.N = D; g.K = D;
        pg8::StaticOrder S; S.init(g.M, g.N, G, c); EpiResid0 E; E.xin_lat = p.x; E.xin_ctx = p.ctx; E.xout = (float*)(ws + WS_XRES); E.gate = (const float*)(ws + WS_ADA) + 2 * D; pg8::gemm_phase(lds, g, S, E, wv_); }
    else if constexpr (WHICH == G_GU) { g.A = (const bf16_t*)(ws + WS_H); g.Bt = (const bf16_t*)(ws + WS_WT_GU) + (size_t)l * NE * 2 * FF * D; g.M = NBLK * 256; g.N = 2 * FF; g.K = D;
        pg8::MoeOrder<true> S; S.init((const int*)(ws + WS_CNT) + l * 64, g.N, G, c, (const int*)(ws + WS_ROWIDX), (size_t)2 * FF * D * 2); EpiGU E; E.O = (bf16_t*)(ws + WS_ACT); pg8::gemm_phase(lds, g, S, E, wv_); }
    else if constexpr (WHICH == G_DN) { g.A = (const bf16_t*)(ws + WS_ACT); g.Bt = (const bf16_t*)(ws + WS_WT_DN) + (size_t)l * NE * D * FF; g.M = NBLK * 256; g.N = D; g.K = FF;
        pg8::MoeOrder<false> S; S.init((const int*)(ws + WS_CNT) + l * 64, g.N, G, c, nullptr, (size_t)D * FF * 2); EpiBf16 E; E.O = (bf16_t*)(ws + WS_YBUF); E.ldc = D; pg8::gemm_phase(lds, g, S, E, wv_); }
#ifndef CPU_EMU
    else if constexpr (WHICH == G_IN0SPLIT) {
        { g.A = (const bf16_t*)(ws + WS_H); g.Bt = (const bf16_t*)(ws + WS_WT_IN0) + (size_t)IN0_NQ * D; g.M = MT; g.N = EVIN - IN0_NQ; g.K = D;
          pg8::StaticOrder S; S.init(g.M, g.N, G, c); EpiBf16 E; E.O = (bf16_t*)(ws + WS_QKV) + IN0_NQ; E.ldc = EVIN; pg8::gemm_phase(lds, g, S, E, wv_); }
        const int extra = ((MT / 256) * ((EVIN - IN0_NQ) / 256)) % G, G2 = G - extra;
        if (c >= extra) { pg8::Gemm g2; g2.A = (const bf16_t*)(ws + WS_H8); g2.Bt = (const bf16_t*)(ws + WS_WT_IN0); g2.M = MT; g2.N = IN0_NQ; g2.K = D / 2; g2.sc_w = W8_E8M0; g2.sc_a = ONE_E8M0;
          pg8::StaticOrder S; S.init(g2.M, g2.N, G2, c - extra); EpiQKV E; E.O = (bf16_t*)(ws + WS_QKV); E.rope = (const float*)(ws + WS_ROPE); E.VT = (bf16_t*)(ws + WS_VT); pg8::gemm_phase<EpiQKV, pg8::StaticOrder, true>(lds, g2, S, E, wv_); } }
    else if constexpr (WHICH == G_IN08) { g.A = (const bf16_t*)(ws + WS_H); g.Bt = (const bf16_t*)(ws + WS_WT_IN0); g.M = MT; g.N = EVIN; g.K = D / 2; g.sc_w = W8_E8M0; g.sc_a = ONE_E8M0;
        pg8::StaticOrder S; S.init(g.M, g.N, G, c); EpiQKV E; E.O = (bf16_t*)(ws + WS_QKV); E.rope = (const float*)(ws + WS_ROPE); E.VT = (bf16_t*)(ws + WS_VT); pg8::gemm_phase<EpiQKV, pg8::StaticOrder, true>(lds, g, S, E, wv_); }
    else if constexpr (WHICH == G_OUT08) { g.A = (const bf16_t*)(ws + WS_MIX); g.Bt = (const bf16_t*)(ws + WS_WT_OUT0); g.M = MT; g.N = D; g.K = D / 2; g.sc_w = W8_E8M0; g.sc_a = ONE_E8M0;
        pg8::StaticOrder S; S.init(g.M, g.N, G, c); gemm_stagger(S, 30); EpiResid0 E; E.xin_lat = p.x; E.xin_ctx = p.ctx; E.xout = (float*)(ws + WS_XRES); E.gate = (const float*)(ws + WS_ADA) + 2 * D; pg8::gemm_phase<EpiResid0, pg8::StaticOrder, true>(lds, g, S, E, wv_); }
    else if constexpr (WHICH == G_IN18) { g.A = (const bf16_t*)(ws + WS_H); g.Bt = (const bf16_t*)(ws + WS_WT_IN1); g.M = MT; g.N = S5W; g.K = D / 2; g.sc_w = W8_E8M0; g.sc_a = ONE_E8M0;
        pg8::StaticOrder S; S.init(g.M, g.N, G, c); gemm_stagger(S, 16); EpiBf16 E; E.O = (bf16_t*)(ws + WS_U1); E.ldc = S5W; pg8::gemm_phase<EpiBf16, pg8::StaticOrder, true>(lds, g, S, E, wv_); }
    else if constexpr (WHICH == G_GLU8) { g.A = (const bf16_t*)(ws + WS_Z); g.Bt = (const bf16_t*)(ws + WS_WT_GLU); g.M = ML; g.N = S5W; g.K = S5W / 2; g.sc_w = W8_E8M0; g.sc_a = Z8_E8M0;
        pg8::StaticOrder S; S.init(g.M, g.N, G, c); EpiGLU8 E; E.Z = ws + WS_Z; E.O = ws + WS_S; E.bias = p.s5_glu_b; pg8::gemm_phase<EpiGLU8, pg8::StaticOrder, true>(lds, g, S, E, wv_); }
    else if constexpr (WHICH == G_OUT18) { g.A = (const bf16_t*)(ws + WS_S); g.Bt = (const bf16_t*)(ws + WS_WT_OUT1); g.M = ML; g.N = D; g.K = S5W / 2; g.sc_w = W8_E8M0; g.sc_a = S8_E8M0;
        pg8::StaticOrder S; S.init(g.M, g.N, G, c); EpiResid E; E.xin_lat = (const float*)(ws + WS_XRES); E.xin_ctx = (const float*)(ws + WS_XRES + (size_t)ML * D * (RES_BF16 ? 2 : 4)); E.xout = (float*)(ws + WS_XRES);
        E.gate = (const float*)(ws + WS_ADA) + (size_t)NADA * ADA6 + 2 * D; pg8::gemm_phase<EpiResid, pg8::StaticOrder, true>(lds, g, S, E, wv_); }
    else if constexpr (WHICH == G_GU8) { g.A = (const bf16_t*)(ws + WS_H); g.Bt = (const bf16_t*)(ws + WS_WT_GU + (size_t)l * NE * 2 * FF * D * 2); g.M = NBLK * 256; g.N = 2 * FF; g.K = D / 2; g.sc_w = W8_E8M0; g.sc_a = ONE_E8M0;
        pg8::MoeOrder<true> S; S.init((const int*)(ws + WS_CNT) + l * 64, g.N, G, c, (const int*)(ws + WS_ROWIDX), (size_t)2 * FF * D); gemm_stagger(S, 20); EpiGU8 E; E.O = ws + WS_ACT; pg8::gemm_phase<EpiGU8, pg8::MoeOrder<true>, true>(lds, g, S, E, wv_); }
    else if constexpr (WHICH == G_DN8) { g.A = (const bf16_t*)(ws + WS_ACT); g.Bt = (const bf16_t*)(ws + WS_WT_DN + (size_t)l * NE * D * FF * 2); g.M = NBLK * 256; g.N = D; g.K = FF / 2; g.sc_w = W8_E8M0; g.sc_a = ACT8_E8M0;
        pg8::MoeOrder<false> S; S.init((const int*)(ws + WS_CNT) + l * 64, g.N, G, c, nullptr, (size_t)D * FF); gemm_stagger(S, 13);
        if constexpr (Y8) { EpiY8 E; E.O = ws + WS_YBUF; E.ldc = D; pg8::gemm_phase<EpiY8, pg8::MoeOrder<false>, true>(lds, g, S, E, wv_); }
        else { EpiBf16 E; E.O = (bf16_t*)(ws + WS_YBUF); E.ldc = D; pg8::gemm_phase<EpiBf16, pg8::MoeOrder<false>, true>(lds, g, S, E, wv_); } }
#endif
    else if constexpr (WHICH == G_IN1) { g.A = (const bf16_t*)(ws + WS_H); g.Bt = (const bf16_t*)(ws + WS_WT_IN1); g.M = MT; g.N = S5W; g.K = D;
        pg8::StaticOrder S; S.init(g.M, g.N, G, c); EpiBf16 E; E.O = (bf16_t*)(ws + WS_U1); E.ldc = S5W; pg8::gemm_phase(lds, g, S, E, wv_); }
    else if constexpr (WHICH == G_GLU) { g.A = (const bf16_t*)(ws + WS_Z); g.Bt = (const bf16_t*)(ws + WS_WT_GLU); g.M = ML; g.N = S5W; g.K = S5W;
        pg8::StaticOrder S; S.init(g.M, g.N, G, c); EpiGLU E; E.Z = (const bf16_t*)(ws + WS_Z); E.O = (bf16_t*)(ws + WS_S); E.bias = p.s5_glu_b; pg8::gemm_phase(lds, g, S, E, wv_); }
    else { g.A = (const bf16_t*)(ws + WS_S); g.Bt = (const bf16_t*)(ws + WS_WT_OUT1); g.M = ML; g.N = D; g.K = S5W;
        pg8::StaticOrder S; S.init(g.M, g.N, G, c); EpiResid E; E.xin_lat = (const float*)(ws + WS_XRES); E.xin_ctx = (const float*)(ws + WS_XRES + (size_t)ML * D * (RES_BF16 ? 2 : 4)); E.xout = (float*)(ws + WS_XRES);
        E.gate = (const float*)(ws + WS_ADA) + (size_t)NADA * ADA6 + 2 * D; pg8::gemm_phase(lds, g, S, E, wv_); }
}
#ifndef CPU_EMU

#define XB_TMO      128
#define XB_XCNT(j)  (256  + 64 * (j))
#define XB_XSUB(j)  (1280 + 64 * (j))
#define XB_XGEN(j)  (2304 + 64 * (j))
#define XB_TOP      3328
#define XB_TOPGEN   3392
#define XCD_BAR_WORDS 3456
#define XB_SPIN_CAP (1u << 24)

__device__ __forceinline__ unsigned xb_ld(unsigned* p)              { return __hip_atomic_load(p, __ATOMIC_RELAXED, __HIP_MEMORY_SCOPE_AGENT); }
__device__ __forceinline__ unsigned xb_add(unsigned* p, unsigned v) { return __hip_atomic_fetch_add(p, v, __ATOMIC_RELAXED, __HIP_MEMORY_SCOPE_AGENT); }
__device__ __forceinline__ unsigned xb_xcc_id() { return (unsigned)__builtin_amdgcn_s_getreg((3 << 11) | 20) & 0xFu; }
#define XB_SPIN(cond, bar) do { unsigned _sp = 0; while (cond) { __builtin_amdgcn_s_sleep(1); \
    if ((++_sp & 255u) == 0u) { if (xb_ld(&(bar)[XB_TMO])) break; if (_sp > XB_SPIN_CAP) { atomicAdd(&(bar)[XB_TMO], 1u); break; } } } } while (0)

struct XcdBarrier {
    unsigned* bar; unsigned x;
    volatile LAS unsigned* st;
};

__device__ __forceinline__ XcdBarrier xcd_barrier_post(unsigned* bar, volatile LAS unsigned* st, int wv_) {
    XcdBarrier b; b.bar = bar; b.x = xb_xcc_id(); b.st = st;
    if (tid_of(wv_) == 0) (void)xb_add(&bar[XB_XCNT(b.x)], 1u);
    return b;
}
__device__ __forceinline__ void xcd_barrier_complete(unsigned* bar, unsigned x, unsigned& nloc, unsigned& nx) {
    const unsigned G = gridDim.x * gridDim.y * gridDim.z;
    unsigned sum, cnt, mine, sp = 0u;
    for (;;) {
        sum = 0u; cnt = 0u; mine = 0u;
#pragma unroll
        for (unsigned j = 0; j < 16; ++j) { const unsigned c = xb_ld(&bar[XB_XCNT(j)]); sum += c; cnt += (c > 0u) ? 1u : 0u; mine = (j == x) ? c : mine; }
        if (sum == G) break;
        __builtin_amdgcn_s_sleep(1);
        if ((++sp & 255u) == 0u) { if (xb_ld(&bar[XB_TMO])) break; if (sp > XB_SPIN_CAP) { atomicAdd(&bar[XB_TMO], 1u); break; } }
    }
    nloc = mine > 0u ? mine : 1u; nx = cnt > 0u ? cnt : 1u;
}

__device__ __forceinline__ void xcd_barrier(const XcdBarrier& b, int wv_) {
    asm volatile("s_waitcnt vmcnt(0)" ::: "memory");
    __syncthreads();
    if (tid_of(wv_) == 0) {
        unsigned* bar = b.bar;
        __builtin_amdgcn_s_waitcnt(0);
        unsigned nloc = b.st[0], nx = b.st[1];
        if (nloc == 0u) { xcd_barrier_complete(bar, b.x, nloc, nx); b.st[0] = nloc; b.st[1] = nx; }
        const unsigned old = xb_add(&bar[XB_XSUB(b.x)], 1u);
        const unsigned gen = old / nloc;
        if (old + 1u == (gen + 1u) * nloc) {
            __builtin_amdgcn_fence(__ATOMIC_RELEASE, "agent");
            asm volatile("s_waitcnt vmcnt(0)" ::: "memory");
            const unsigned og = xb_add(&bar[XB_TOP], 1u);
            const unsigned tg = og / nx;
            if (og + 1u == (tg + 1u) * nx) xb_add(&bar[XB_TOPGEN], 1u);
            else XB_SPIN(xb_ld(&bar[XB_TOPGEN]) == tg, bar);
            __builtin_amdgcn_fence(__ATOMIC_ACQUIRE, "agent");
            xb_add(&bar[XB_XGEN(b.x)], 1u);
            asm volatile("s_waitcnt vmcnt(0)" ::: "memory");
        } else {
            XB_SPIN(xb_ld(&bar[XB_XGEN(b.x)]) == gen, bar);
            __builtin_amdgcn_fence(__ATOMIC_ACQUIRE, "agent");
            asm volatile("s_waitcnt vmcnt(0)" ::: "memory");
        }
    }
    __syncthreads();
}


#define GT ((long)blockIdx.x * blockDim.x + threadIdx.x)
#define GN ((long)gridDim.x * blockDim.x)
constexpr int MEGA_LDS = 147456;
__device__ __forceinline__ long gt_of(int wv) { return (long)blockIdx.x * 512 + tid_of(wv); }
__global__ void __launch_bounds__(512, 2) k_mega(Params p) {
    extern __shared__ __attribute__((aligned(16))) unsigned char shm[];
    volatile LAS unsigned* st = (volatile LAS unsigned*)(shm + MEGA_LDS - 64);
    const int WV = __builtin_amdgcn_readfirstlane((int)threadIdx.x >> 6);
    if (tid_of(WV) == 0) { st[0] = 0u; st[1] = 0u; st[2] = 0u; st[3] = 0u; }
    __syncthreads();
    const XcdBarrier bar = xcd_barrier_post((unsigned*)(p.ws + WS_BAR), st, WV);
    const long gn = (long)gridDim.x * 512; const int G = (int)gridDim.x, c = (int)blockIdx.x; const pg8::LdsPtr lds = (pg8::LdsPtr)shm;
#define gt gt_of(WV)
    ph_ada(p, (float*)shm, c, G, WV); ph_tables(p, gt, gn); ph_convert(p, (float*)shm, CVT_TILES, -1, WV);
    xcd_barrier(bar, WV);
    ph_norm_fast<0>(p, 0, MT, c * 8 + WV, G * 8, WV);
    xcd_barrier(bar, WV);
    run_gemm<IN0_FP8 ? G_IN08 : (IN0QKV_FP8 ? G_IN0SPLIT : G_IN0)>(p, 0, lds, G, c, WV);
    xcd_barrier(bar, WV);
    ph_attn_fast(p, (LAS unsigned char*)shm, c, G, WV);
    { constexpr int ATT_UNITS = NB * 4 * (NSEQ / 128 + NCTX / 128); const int extra = ATT_UNITS % G;
      if (extra * 2 < G) { if (c >= extra) ph_conv_fast(p, (long)(c - extra) * 512 + tid_of(WV), (long)(G - extra) * 512); } else ph_conv_fast(p, gt, gn); }
    xcd_barrier(bar, WV);
    ph_lru_fast<1>(p, (LAS unsigned char*)shm, c * 8 + WV, G * 8, WV);
    xcd_barrier(bar, WV);
    ph_lru_fast<2>(p, (LAS unsigned char*)shm, c * 8 + WV, G * 8, WV);
    xcd_barrier(bar, WV);
    run_gemm<OUT0_FP8 ? G_OUT08 : G_OUT0>(p, 0, lds, G, c, WV);
    xcd_barrier(bar, WV);
    ph_router_fast<MOE0_FP8>(p, 0, MT, (LAS unsigned char*)shm, c, G, WV);
    xcd_barrier(bar, WV);
    ph_dispatch_fast(p, 0, MT, (LAS unsigned char*)shm, c, G, WV);
    xcd_barrier(bar, WV);
    run_gemm<MOE0_FP8 ? G_GU8 : G_GU>(p, 0, lds, G, c, WV);
    xcd_barrier(bar, WV);
    run_gemm<MOE0_FP8 ? G_DN8 : G_DN>(p, 0, lds, G, c, WV);
    xcd_barrier(bar, WV);
    ph_norm_fast<1>(p, 1, MT, c * 8 + WV, G * 8, WV);
    xcd_barrier(bar, WV);
    run_gemm<DENSE1_FP8 ? G_IN18 : G_IN1>(p, 1, lds, G, c, WV);
    xcd_barrier(bar, WV);
    ph_s5_fast<1>(p, (LAS unsigned char*)shm, c * 8 + WV, G * 8, WV);
    xcd_barrier(bar, WV);
    ph_s5_fast<2>(p, (LAS unsigned char*)shm, c * 8 + WV, G * 8, WV);
    xcd_barrier(bar, WV);
    run_gemm<DENSE1_FP8 ? G_GLU8 : G_GLU>(p, 1, lds, G, c, WV);
    xcd_barrier(bar, WV);
    run_gemm<DENSE1_FP8 ? G_OUT18 : G_OUT1>(p, 1, lds, G, c, WV);
    xcd_barrier(bar, WV);
    ph_router_fast<MOE1_FP8>(p, 1, ML, (LAS unsigned char*)shm, c, G, WV);
    xcd_barrier(bar, WV);
    ph_dispatch_fast(p, 1, ML, (LAS unsigned char*)shm, c, G, WV);
    xcd_barrier(bar, WV);
    run_gemm<MOE1_FP8 ? G_GU8 : G_GU>(p, 1, lds, G, c, WV);
    xcd_barrier(bar, WV);
    run_gemm<MOE1_FP8 ? G_DN8 : G_DN>(p, 1, lds, G, c, WV);
    xcd_barrier(bar, WV);
    ph_norm_fast<2>(p, 1, ML, c * 8 + WV, G * 8, WV);
#undef gt
}

#ifdef MK_MULTI
__global__ void __launch_bounds__(512, 2) k_prologue(Params p) {
    extern __shared__ __attribute__((aligned(16))) unsigned char shm[];
    ph_ada(p, (float*)shm, blockIdx.x, gridDim.x, (int)threadIdx.x >> 6); ph_tables(p, GT, GN); ph_convert(p, (float*)shm, CVT_TILES, -1, (int)threadIdx.x >> 6);
}
template <int WHICH> __global__ void __launch_bounds__(512, 2) k_gemm(Params p, int l) {
    extern __shared__ __attribute__((aligned(16))) unsigned char shm[];
    run_gemm<WHICH>(p, l, (pg8::LdsPtr)shm, (int)gridDim.x, (int)blockIdx.x, __builtin_amdgcn_readfirstlane((int)threadIdx.x >> 6));
}
__global__ void __launch_bounds__(512, 2) k_norm(Params p, int l, int rows) { ph_norm(p, l, rows, GT, GN); }
__global__ void __launch_bounds__(512, 2) k_conv(Params p) { ph_conv(p, GT, GN); }
__global__ void __launch_bounds__(512, 2) k_lru(Params p) { ph_lru(p, GT, GN); }
__global__ void __launch_bounds__(512, 2) k_attn(Params p) { ph_attn(p, GT, GN); }
__global__ void __launch_bounds__(512, 2) k_router(Params p, int l, int rows) { ph_router(p, l, rows, GT, GN); }
__global__ void __launch_bounds__(512, 2) k_dispatch(Params p, int l, int rows) { ph_dispatch(p, l, rows, GT, GN); }
__global__ void __launch_bounds__(512, 2) k_combine(Params p, int l, int rows) { ph_combine(p, l, rows, GT, GN); }
__global__ void __launch_bounds__(512, 2) k_s5(Params p) { ph_s5(p, GT, GN); }
__global__ void __launch_bounds__(512, 2) k_final(Params p) { ph_final(p, GT, GN); }

#endif
static Params make_params(void* const* d_in, void* d_out, void* d_ws) {
    Params p{}; const float* const* in = (const float* const*)d_in;
    p.x = in[0]; p.c = in[1]; p.ctx = in[2]; p.c_ctx = in[3]; p.ada_w = in[4]; p.ada_b = in[5]; p.norm_mix = in[6]; p.norm_ffn = in[7]; p.norm_final = in[8];
    p.ev_w_in = in[9]; p.ev_w_out = in[10]; p.attn_sink = in[11]; p.lru_conv_w = in[12]; p.lru_conv_b = in[13]; p.lru_lam = in[14]; p.lru_wa = in[15]; p.lru_ba = in[16]; p.lru_wi = in[17]; p.lru_bi = in[18];
    p.od_w_in = in[19]; p.s5_lam_re = in[20]; p.s5_lam_im = in[21]; p.s5_log_step = in[22]; p.s5_b_re = in[23]; p.s5_b_im = in[24]; p.s5_c_re = in[25]; p.s5_c_im = in[26]; p.s5_d = in[27];
    p.s5_glu_w = in[28]; p.s5_glu_b = in[29]; p.od_w_out = in[30]; p.router_w = in[31]; p.router_b = in[32]; p.moe_w_gate = in[33]; p.moe_w_up = in[34]; p.moe_w_down = in[35];
    p.out = (float*)d_out; p.ws = (unsigned char*)d_ws; return p;
}

extern "C" void kernel_launch(void* const* d_in, const int* in_sizes, int n_in, void* d_out, int out_size, void* d_ws, size_t ws_size, hipStream_t stream) {
    if (n_in != 36 || ws_size < WS_END || out_size != ML * D) { fprintf(stderr, "kernel_launch: unexpected shapes (n_in %d, out %d, ws %zu < %zu)\n", n_in, out_size, ws_size, (size_t)WS_END); return; }
#ifdef MK_MULTI
    static bool attr_done = false;
    constexpr int GLDS = pg8::STAGE_BYTES;
    if (!attr_done) {
        (void)hipFuncSetAttribute((const void*)k_gemm<G_IN0>, hipFuncAttributeMaxDynamicSharedMemorySize, GLDS); (void)hipFuncSetAttribute((const void*)k_gemm<G_OUT0>, hipFuncAttributeMaxDynamicSharedMemorySize, GLDS);
        (void)hipFuncSetAttribute((const void*)k_gemm<G_GU>, hipFuncAttributeMaxDynamicSharedMemorySize, GLDS); (void)hipFuncSetAttribute((const void*)k_gemm<G_DN>, hipFuncAttributeMaxDynamicSharedMemorySize, GLDS);
        (void)hipFuncSetAttribute((const void*)k_gemm<G_IN1>, hipFuncAttributeMaxDynamicSharedMemorySize, GLDS); (void)hipFuncSetAttribute((const void*)k_gemm<G_GLU>, hipFuncAttributeMaxDynamicSharedMemorySize, GLDS);
        (void)hipFuncSetAttribute((const void*)k_gemm<G_OUT1>, hipFuncAttributeMaxDynamicSharedMemorySize, GLDS);
        attr_done = true;
    }
    const Params p = make_params(d_in, d_out, d_ws);
    (void)hipMemsetAsync(d_ws, 0, CTL_BYTES, stream);
    const dim3 blk(512); const int NG = 256, NW = 1024;
    k_prologue<<<NW, blk, (ADA_LDS_BYTES > CVT_LDS_BYTES + 16 ? ADA_LDS_BYTES : CVT_LDS_BYTES + 16), stream>>>(p);
    k_norm<<<NW, blk, 0, stream>>>(p, 0, MT);
    k_gemm<G_IN0><<<NG, blk, GLDS, stream>>>(p, 0);
    k_attn<<<NW, blk, 0, stream>>>(p);
    k_conv<<<NW, blk, 0, stream>>>(p);
    k_lru<<<NW, blk, 0, stream>>>(p);
    k_gemm<G_OUT0><<<NG, blk, GLDS, stream>>>(p, 0);
    k_router<<<NW, blk, 0, stream>>>(p, 0, MT);
    k_dispatch<<<NW, blk, 0, stream>>>(p, 0, MT);
    k_gemm<G_GU><<<NG, blk, GLDS, stream>>>(p, 0);
    k_gemm<G_DN><<<NG, blk, GLDS, stream>>>(p, 0);
    k_combine<<<NW, blk, 0, stream>>>(p, 0, MT);
    k_norm<<<NW, blk, 0, stream>>>(p, 1, MT);
    k_gemm<G_IN1><<<NG, blk, GLDS, stream>>>(p, 1);
    k_s5<<<NW, blk, 0, stream>>>(p);
    k_gemm<G_GLU><<<NG, blk, GLDS, stream>>>(p, 1);
    k_gemm<G_OUT1><<<NG, blk, GLDS, stream>>>(p, 1);
    k_router<<<NW, blk, 0, stream>>>(p, 1, ML);
    k_dispatch<<<NW, blk, 0, stream>>>(p, 1, ML);
    k_gemm<G_GU><<<NG, blk, GLDS, stream>>>(p, 1);
    k_gemm<G_DN><<<NG, blk, GLDS, stream>>>(p, 1);
    k_combine<<<NW, blk, 0, stream>>>(p, 1, ML);
    k_final<<<NW, blk, 0, stream>>>(p);
#else
    static int grid = 0;
    if (!grid) {
        int dev = 0, cus = 0, per_cu = 0;
        if (hipGetDevice(&dev) != hipSuccess || hipDeviceGetAttribute(&cus, hipDeviceAttributeMultiprocessorCount, dev) != hipSuccess) { fprintf(stderr, "kernel_launch: device query failed\n"); return; }
        if (hipFuncSetAttribute((const void*)k_mega, hipFuncAttributeMaxDynamicSharedMemorySize, MEGA_LDS) != hipSuccess) { fprintf(stderr, "kernel_launch: hipFuncSetAttribute failed\n"); return; }
        if (hipOccupancyMaxActiveBlocksPerMultiprocessor(&per_cu, (const void*)k_mega, 512, MEGA_LDS) != hipSuccess || per_cu < 1) { fprintf(stderr, "kernel_launch: occupancy query says %d\n", per_cu); return; }
        grid = cus < MAXG ? cus : MAXG;
    }
    const Params p = make_params(d_in, d_out, d_ws);
    (void)hipMemsetAsync(d_ws, 0, WS_ADA, stream);
    hipLaunchKernelGGL(k_mega, dim3(grid), dim3(512), MEGA_LDS, stream, p);
#endif
}
#endif
```

```cpp
#ifndef CPU_EMU
#include <hip/hip_runtime.h>
#include <cstdio>
#include <cstdint>
#endif

#ifndef BATCH
#define BATCH 4
#endif
#ifndef SEQ
#define SEQ 4096
#endif
#ifndef CTX_LEN
#define CTX_LEN 256
#endif
constexpr int D = 2048, NB = BATCH, NSEQ = SEQ, NCTX = CTX_LEN;
constexpr int ML = NB * NSEQ, MC = NB * NCTX, MT = ML + MC;
constexpr int NADA = NB + 1;
constexpr int QW = 1024, KVW = 256, LW = 1024, EVIN = 3584;
constexpr int COL_Q = 0, COL_K = 1024, COL_V = 1280, COL_XR = 1536, COL_GR = 2560;
constexpr int S5W = 1024, S5G = 64, S5C = 16, S5S = 64;
constexpr int NE = 16, FF = 1024;
constexpr int NBLK = (2 * MT + 255) / 256 + NE;
constexpr int ADA6 = 6 * D;
static_assert(ML % 256 == 0 && MC % 256 == 0 && NSEQ % 256 == 0 && NCTX % 256 == 0, "tiles must not straddle sequences");

typedef unsigned short bf16_t;
#ifndef CPU_EMU
#define LAS __attribute__((address_space(3)))
__device__ __forceinline__ int tid_of(int wv) { int l; asm volatile("v_mbcnt_lo_u32_b32 %0, -1, 0\n\tv_mbcnt_hi_u32_b32 %0, -1, %0" : "=v"(l)); return wv * 64 + l; }
#endif

#ifdef CPU_EMU
constexpr bool MOE1_FP8 = false, MOE0_FP8 = false, DENSE1_FP8 = false, IN0_FP8 = false, IN0QKV_FP8 = false, OUT0_FP8 = false, RES_BF16 = false, Y8 = false;
#else
constexpr bool Y8 = true;
constexpr bool RES_BF16 = true; constexpr bool IN0_FP8 = false, IN0QKV_FP8 = true, OUT0_FP8 = true;
constexpr bool DENSE1_FP8 = true;
constexpr bool MOE0_FP8 = true;
constexpr bool MOE1_FP8 = true;
#endif
constexpr float W8_SCALE = 64.0f, ACT8_SCALE = 4.0f;
constexpr int W8_E8M0 = 127 - 6, ACT8_E8M0 = 127 - 2, ONE_E8M0 = 127;
constexpr float Z8_SCALE = 8.0f, S8_SCALE = 16.0f, MIX8_SCALE = 16.0f, Y8_SCALE = 16.0f; constexpr int Z8_E8M0 = 127 - 3, S8_E8M0 = 127 - 4, MIX8_E8M0 = 127 - 4;

constexpr size_t al256(size_t x) { return (x + 255) & ~(size_t)255; }
constexpr size_t WS_BAR = 0;
constexpr size_t WS_CNT = 16384;
constexpr size_t WS_ADA = 32768;
constexpr size_t CTL_BYTES = al256(WS_ADA + (size_t)2 * NADA * ADA6 * 4);
constexpr size_t WS_ROPE = CTL_BYTES;
constexpr size_t WS_S5LAM = WS_ROPE + 64 * 16 * 8;
constexpr size_t WS_S5BB = WS_S5LAM + (size_t)2 * S5G * S5S * 8;
constexpr size_t WS_S5LAMT = WS_S5BB + (size_t)2 * S5G * S5S * S5C * 8;
constexpr size_t WS_S5BF = WS_S5LAMT + (size_t)2 * S5G * S5S * 8;
constexpr size_t WS_S5CF = WS_S5BF + (size_t)2 * S5G * 4 * 64 * 16;
constexpr size_t WS_LRUBF = WS_S5CF + (size_t)2 * S5G * 4 * 64 * 16;
constexpr size_t WS_RWF = WS_LRUBF + (size_t)2 * 16 * 2 * 2 * 4 * 64 * 16;
constexpr size_t WS_WT_IN0 = al256(WS_RWF + (size_t)2 * 64 * 64 * 16);
constexpr size_t WS_WT_OUT0 = WS_WT_IN0 + (size_t)EVIN * D * 2;
constexpr size_t WS_WT_IN1 = WS_WT_OUT0 + (size_t)D * D * 2;
constexpr size_t WS_WT_GLU = WS_WT_IN1 + (size_t)S5W * D * 2;
constexpr size_t WS_WT_OUT1 = WS_WT_GLU + (size_t)S5W * S5W * 2;
constexpr size_t WS_WT_GU = WS_WT_OUT1 + (size_t)D * S5W * 2;
constexpr size_t WS_WT_DN = WS_WT_GU + (size_t)2 * NE * 2 * FF * D * 2;
constexpr size_t WS_W8_GU = WS_WT_GU + (size_t)NE * 2 * FF * D * 2;
constexpr size_t WS_W8_DN = WS_WT_DN + (size_t)NE * D * FF * 2;
constexpr size_t WS_XRES = WS_WT_DN + (size_t)2 * NE * D * FF * 2;
constexpr size_t WS_H8 = WS_XRES + (size_t)MT * D * 2;
constexpr size_t WS_H = WS_XRES + (size_t)MT * D * 4;
constexpr size_t WS_TOK = WS_H + (size_t)MT * D * 2;
constexpr size_t WS_ROWIDX = WS_TOK + (size_t)4 * MT * 2 * 4;
constexpr size_t WS_RA = al256(WS_ROWIDX + (size_t)NBLK * 256 * 4);
constexpr size_t WS_QKV = WS_RA;
constexpr size_t WS_MIX = WS_QKV + (size_t)MT * EVIN * 2;
constexpr size_t WS_U1 = WS_RA;
constexpr size_t WS_YS5 = WS_U1 + (size_t)MT * S5W * 2;
constexpr size_t WS_Z = WS_YS5 + (size_t)ML * S5W * 4;
constexpr size_t WS_S = WS_Z + (size_t)ML * S5W * 2;
constexpr int S5_CHUNK = 128, S5_NCC = NCTX / S5_CHUNK, S5_NLC = NSEQ / S5_CHUNK, S5_NCH = S5_NCC + S5_NLC;
static_assert(S5_NCC % 2 == 0 && S5_NLC % 2 == 0, "chunks are processed in pairs");
constexpr size_t WS_S5E = WS_S + (size_t)ML * S5W * 2;
constexpr size_t RA_BYTES = (size_t)MT * EVIN * 2 + (size_t)MT * D * 2;
static_assert(WS_S5E + (size_t)NB * S5G * 2 * S5_NCH * S5S * 8 <= WS_RA + RA_BYTES, "L1 overlay (E)");
static_assert((size_t)MT * S5W * 2 + (size_t)ML * S5W * 4 + 2 * (size_t)ML * S5W * 2 <= RA_BYTES, "L1 overlay");
constexpr size_t WS_RB = al256(WS_RA + RA_BYTES);
constexpr size_t WS_ACT = WS_RB;
constexpr size_t WS_YBUF = WS_ACT + (size_t)NBLK * 256 * FF * 2;
constexpr size_t WS_UCONV = WS_RB;
constexpr size_t WS_HSUM = WS_UCONV + (size_t)MT * LW * 4;
constexpr size_t RB_BYTES = (size_t)NBLK * 256 * FF * 2 + (size_t)NBLK * 256 * D * 2;
static_assert(2 * (size_t)MT * LW * 4 <= RB_BYTES, "LRU overlay");
constexpr size_t WS_UBF = WS_RB;
constexpr int VT_T = 128 + NSEQ + 128 + NCTX;
constexpr size_t WS_VT = WS_UBF + (size_t)MT * LW * 2;
constexpr size_t WS_LRUAGG = al256(WS_VT + (size_t)NB * 4 * 64 * VT_T * 2);
constexpr int LRU_CH = 64, LRU_NCC = NCTX / LRU_CH, LRU_NLC = NSEQ / LRU_CH, LRU_NCH = LRU_NCC + LRU_NLC;
static_assert(LRU_NCC % 2 == 0 && LRU_NLC % 2 == 0, "chunks are processed in pairs");
static_assert(WS_LRUAGG + (size_t)NB * 2 * LRU_NCH * LW * 8 <= WS_RB + RB_BYTES, "RB overlay");
constexpr int MAXG = 256;
constexpr int HIST_LD = 32;
constexpr size_t WS_HIST = al256(WS_RB + RB_BYTES);
constexpr size_t WS_END = WS_HIST + (size_t)2 * MAXG * HIST_LD * 4;

struct Params {
    const float *x, *c, *ctx, *c_ctx, *ada_w, *ada_b, *norm_mix, *norm_ffn, *norm_final;
    const float *ev_w_in, *ev_w_out, *attn_sink, *lru_conv_w, *lru_conv_b, *lru_lam, *lru_wa, *lru_ba, *lru_wi, *lru_bi;
    const float *od_w_in, *s5_lam_re, *s5_lam_im, *s5_log_step, *s5_b_re, *s5_b_im, *s5_c_re, *s5_c_im, *s5_d, *s5_glu_w, *s5_glu_b, *od_w_out;
    const float *router_w, *router_b, *moe_w_gate, *moe_w_up, *moe_w_down;
    float* out;
    unsigned char* ws;
};

#ifdef CPU_EMU
typedef float f32x4 __attribute__((vector_size(16)));
#else
typedef float f32x4 __attribute__((ext_vector_type(4)));
#endif
struct u32x2_t { unsigned x, y; };
struct u32x4_t { unsigned x, y, z, w; };
#ifdef CPU_EMU
__device__ __forceinline__ void st_coh(int* p, int v) { *p = v; }
__device__ __forceinline__ int ld_coh(const int* p) { return *p; }
#else
__device__ __forceinline__ void st_coh(int* p, int v) { __hip_atomic_store(p, v, __ATOMIC_RELAXED, __HIP_MEMORY_SCOPE_AGENT); }
__device__ __forceinline__ int ld_coh(const int* p) { return __hip_atomic_load(p, __ATOMIC_RELAXED, __HIP_MEMORY_SCOPE_AGENT); }
#endif
__device__ __forceinline__ f32x4 unpack4bf(unsigned lo, unsigned hi) { return (f32x4){__uint_as_float(lo << 16), __uint_as_float(lo & 0xffff0000u), __uint_as_float(hi << 16), __uint_as_float(hi & 0xffff0000u)}; }
__device__ __forceinline__ float bf2f(bf16_t b) { return __uint_as_float(((unsigned)b) << 16); }
__device__ __forceinline__ bf16_t f2bf(float f) { unsigned u = __float_as_uint(f); u += 0x7FFFu + ((u >> 16) & 1u); return (bf16_t)(u >> 16); }
#ifdef CPU_EMU
__device__ __forceinline__ unsigned pack2bf(float lo, float hi) { return (unsigned)f2bf(lo) | ((unsigned)f2bf(hi) << 16); }
#else
typedef short s5_bf16x8 __attribute__((ext_vector_type(8)));
typedef unsigned u4v_t __attribute__((ext_vector_type(4)));
__device__ __forceinline__ int deal_item(int round, int gwave, int nwaves, int items, int grp = 2) {
    const int full = items / nwaves; if (round < full) return round * nwaves + gwave; if (round > full) return -1;
    const int rem = items - full * nwaves, blk = gwave >> 3, wv = gwave & 7; if (wv >= grp) return -1; const int j = blk * grp + wv; return j < rem ? full * nwaves + j : -1; }
#ifndef CPU_EMU
__device__ __forceinline__ float clamp_e4m3(float x) { return fminf(fmaxf(x, -448.0f), 448.0f); }
__device__ __forceinline__ unsigned pack4_fp8(float a, float b, float c, float d) { int w = 0; w = __builtin_amdgcn_cvt_pk_fp8_f32(clamp_e4m3(a), clamp_e4m3(b), w, false); w = __builtin_amdgcn_cvt_pk_fp8_f32(clamp_e4m3(c), clamp_e4m3(d), w, true); return (unsigned)w; }
#endif
__device__ __forceinline__ float opaque_zero() { float z = 0.f; asm volatile("" : "+v"(z)); return z; }
#define MFMA_KEEP(acc, x) asm volatile("" : "+v"(acc) : "v"(x))
typedef __bf16 bf16x2_hw __attribute__((ext_vector_type(2)));
typedef float f32x2_hw __attribute__((ext_vector_type(2)));
__device__ __forceinline__ unsigned pack2bf(float lo, float hi) { const f32x2_hw v = {lo, hi}; const bf16x2_hw b = __builtin_convertvector(v, bf16x2_hw); return __builtin_bit_cast(unsigned, b); }
#endif
#ifdef CPU_EMU
__device__ __forceinline__ float sigmoidf_(float x) { return 1.0f / (1.0f + __expf(-x)); }
__device__ __forceinline__ float fast_rcp(float x) { return 1.0f / x; }
__device__ __forceinline__ float fast_sqrt(float x) { return sqrtf(x); }
#else
__device__ __forceinline__ float fast_rcp(float x) { return __builtin_amdgcn_rcpf(x); }
__device__ __forceinline__ float fast_sqrt(float x) { return __builtin_amdgcn_sqrtf(x); }
__device__ __forceinline__ float sigmoidf_(float x) { return __builtin_amdgcn_rcpf(1.0f + __builtin_amdgcn_exp2f(-1.44269504089f * x)); }
#endif
__device__ __forceinline__ float siluf_(float x) { return x * sigmoidf_(x); }
#ifdef CPU_EMU
__device__ __forceinline__ float geluf_(float x) { const float u = 0.7978845608028654f * (x + 0.044715f * x * x * x); return 0.5f * x * (1.0f + tanhf(u)); }
#else
__device__ __forceinline__ float geluf_(float x) { const float t = x * x, e = __builtin_amdgcn_exp2f(x * __builtin_fmaf(t, -0.102943215f, -2.302208198f)); return x * __builtin_amdgcn_rcpf(1.0f + e); }
#endif
__device__ __forceinline__ float softplusf_(float x) { return x > 20.f ? x : log1pf(__expf(x)); }
__device__ __forceinline__ int ada_row(int r) { return r < ML ? r / NSEQ : NB; }
__device__ __forceinline__ const float* ada_ptr(const Params& p, int l, int arow, int which) { return (const float*)(p.ws + WS_ADA) + ((size_t)l * NADA + arow) * ADA6 + (size_t)which * D; }
__device__ __forceinline__ const float* xin_row(const Params& p, int l, int r) {
    if (l == 0) return r < ML ? p.x + (size_t)r * D : p.ctx + (size_t)(r - ML) * D;
    return (const float*)(p.ws + WS_XRES) + (size_t)r * D;
}

#ifndef CPU_EMU
constexpr int ADA_ITEMS = 2 * (ADA6 / 128), ADA_LDS_BYTES = (NADA * D + 16 * NADA * 128) * 4;
__device__ __forceinline__ void ph_ada(const Params& p, float* sil, int bid, int nblocks, int wv_) {
    const int tid = tid_of(wv_), w = wv_, lane = tid & 63, kh = lane >> 5, cq = lane & 31;
    float* ada = (float*)(p.ws + WS_ADA); float* red = sil + NADA * D;
    if (bid < ADA_ITEMS) { for (int i = tid; i < NADA * D; i += 512) { const int r = i / D, k = i % D; sil[i] = siluf_(r < NB ? p.c[(size_t)r * D + k] : p.c_ctx[k]); } }
    __syncthreads();
    for (int item = bid; item < ADA_ITEMS; item += nblocks) {
        const int l = item / (ADA6 / 128), cb = (item % (ADA6 / 128)) * 128, c0 = cb + cq * 4;
        f32x4 acc[NADA];
#pragma unroll
        for (int r = 0; r < NADA; ++r) acc[r] = (f32x4){0.f, 0.f, 0.f, 0.f};
        const float* wp = p.ada_w + (size_t)l * D * ADA6 + c0; const int k0 = w * 256 + kh * 128;
#pragma unroll 16
        for (int k = k0; k < k0 + 128; ++k) {
            const f32x4 wv = *(const f32x4*)(wp + (size_t)k * ADA6);
#pragma unroll
            for (int r = 0; r < NADA; ++r) acc[r] += wv * sil[r * D + k];
        }
        __syncthreads();
#pragma unroll
        for (int r = 0; r < NADA; ++r) *(f32x4*)(red + ((size_t)((w * 2 + kh) * NADA + r) * 128) + cq * 4) = acc[r];
        __syncthreads();
        for (int i = tid; i < NADA * 128; i += 512) { const int r = i / 128, cc = i % 128; float sacc = p.ada_b[(size_t)l * ADA6 + cb + cc];
#pragma unroll
            for (int ww = 0; ww < 16; ++ww) sacc += red[(size_t)(ww * NADA + r) * 128 + cc];
            ada[((size_t)l * NADA + r) * ADA6 + cb + cc] = sacc; }
    }
}
#else
void ph_ada_emu(const Params& p) {
    float* ada = (float*)(p.ws + WS_ADA);
    for (int l = 0; l < 2; ++l) for (int r = 0; r < NADA; ++r) { std::vector<double> acc(ADA6, 0.0);
        for (int k = 0; k < D; ++k) { const float cv = r < NB ? p.c[(size_t)r * D + k] : p.c_ctx[k]; const double sv = siluf_(cv); const float* wr = p.ada_w + ((size_t)l * D + k) * ADA6; for (int j = 0; j < ADA6; ++j) acc[j] += sv * wr[j]; }
        for (int j = 0; j < ADA6; ++j) ada[((size_t)l * NADA + r) * ADA6 + j] = (float)acc[j] + p.ada_b[(size_t)l * ADA6 + j]; }
}
#endif
__device__ __forceinline__ void ph_tables(const Params& p, long gtid, long gthreads) {
    float* rope = (float*)(p.ws + WS_ROPE);
    for (long it = gtid; it < 64 * 16; it += gthreads) {
        const int pos = (int)(it / 16), i = (int)(it % 16);
        const double inv = pow(10000.0, -(double)i / 16.0); const double a = (double)pos * (double)(float)inv;
        rope[it * 2] = (float)cos(a); rope[it * 2 + 1] = (float)sin(a);
    }
    float* lamb = (float*)(p.ws + WS_S5LAM); float* bb = (float*)(p.ws + WS_S5BB);
    for (long it = gtid; it < 2L * S5G * S5S; it += gthreads) {
        const int g = (int)((it / S5S) % S5G), d = (int)(it / (S5S * S5G));
        const double lr = p.s5_lam_re[it], li = p.s5_lam_im[it], step = exp((double)p.s5_log_step[d * S5G + g]);
        const double mag = exp(lr * step), br = mag * cos(li * step), bi = mag * sin(li * step);
        lamb[it * 2] = (float)br; lamb[it * 2 + 1] = (float)bi;
        const double nr = br - 1.0, ni = bi, den = lr * lr + li * li;
        const double cr = (nr * lr + ni * li) / den, ci = (ni * lr - nr * li) / den;
        float b_r[S5C], b_i[S5C];
#pragma unroll
        for (int c = 0; c < S5C; ++c) { b_r[c] = p.s5_b_re[it * S5C + c]; b_i[c] = p.s5_b_im[it * S5C + c]; }
#pragma unroll
        for (int c = 0; c < S5C; ++c) { bb[(it * S5C + c) * 2] = (float)(cr * (double)b_r[c] - ci * (double)b_i[c]); bb[(it * S5C + c) * 2 + 1] = (float)(cr * (double)b_i[c] + ci * (double)b_r[c]); }
        const double magT = exp(lr * step * S5_CHUNK); float* lt = (float*)(p.ws + WS_S5LAMT);
        lt[it * 2] = (float)(magT * cos(li * step * S5_CHUNK)); lt[it * 2 + 1] = (float)(magT * sin(li * step * S5_CHUNK));
    }
    { bf16_t* rw = (bf16_t*)(p.ws + WS_RWF);
      for (long it = gtid; it < 64L * 64 * 8; it += gthreads) { const int j = (int)(it & 7), lane = (int)((it >> 3) & 63), st = (int)(it >> 9);
          const float wv = p.router_w[(size_t)(32 * st + 8 * (lane >> 4) + j) * NE + (lane & 15)]; const bf16_t hi = f2bf(wv); rw[it] = hi; rw[64L * 64 * 8 + it] = f2bf(wv - bf2f(hi)); } }
    bf16_t* lb = (bf16_t*)(p.ws + WS_LRUBF);
    for (long it = gtid; it < 2L * 16 * 2 * 2 * 4 * 64 * 8; it += gthreads) {
        const int j = (int)(it & 7), lane = (int)((it >> 3) & 63), ks = (int)((it >> 9) & 3), cs = (int)((it >> 11) & 1), gate = (int)((it >> 12) & 1); const long dh = it >> 13;
        const float* w = gate ? p.lru_wi : p.lru_wa;
        lb[it] = f2bf(w[((size_t)dh * 64 + 16 * ks + 8 * (lane >> 5) + j) * 64 + 32 * cs + (lane & 31)]);
    }
    bf16_t* bf = (bf16_t*)(p.ws + WS_S5BF); bf16_t* cf = (bf16_t*)(p.ws + WS_S5CF);
    for (long it = gtid; it < 2L * S5G * 4 * 64 * 8; it += gthreads) {
        const int j = (int)(it & 7), lane = (int)((it >> 3) & 63), ct = (int)((it >> 9) & 3); const long dg = it >> 11;
        { const int st = (lane & 31) + 32 * (ct >> 1), ch = 8 * (lane >> 5) + j; const size_t gi = (size_t)dg * S5S + st;
          const double lr = p.s5_lam_re[gi], li = p.s5_lam_im[gi], step = exp((double)p.s5_log_step[dg]);
          const double mag = exp(lr * step), br = mag * cos(li * step), bi = mag * sin(li * step), nr = br - 1.0, ni = bi, den = lr * lr + li * li;
          const double cr = (nr * lr + ni * li) / den, ci = (ni * lr - nr * li) / den, b_r = p.s5_b_re[gi * S5C + ch], b_i = p.s5_b_im[gi * S5C + ch];
          bf[it] = f2bf((float)((ct & 1) ? (cr * b_i + ci * b_r) : (cr * b_r - ci * b_i))); }
        { const int ks = ct, q = 32 * ks + 8 * (lane >> 4) + j, st = q >> 1, ch = lane & 15; const size_t ci_ = ((size_t)dg * S5C + ch) * S5S + st;
          cf[it] = f2bf((q & 1) ? -p.s5_c_im[ci_] : p.s5_c_re[ci_]); }
    }
}
__device__ __forceinline__ void ph_norm(const Params& p, int l, int rows, long gtid, long gthreads) {
    bf16_t* h = (bf16_t*)(p.ws + WS_H);
    for (long r = gtid; r < rows; r += gthreads) {
        const float* xr = xin_row(p, l, (int)r); const int ar = ada_row((int)r);
        const float* sh = ada_ptr(p, l, ar, 0); const float* sc = ada_ptr(p, l, ar, 1); const float* g = p.norm_mix + (size_t)l * D;
        float ss = 0.f; for (int k = 0; k < D; ++k) ss += xr[k] * xr[k];
        const float rstd = 1.0f / sqrtf(ss / D + 1e-6f);
        for (int k = 0; k < D; ++k) h[(size_t)r * D + k] = f2bf(xr[k] * rstd * g[k] * (1.0f + sc[k]) + sh[k]);
    }
}
__device__ __forceinline__ void ph_conv(const Params& p, long gtid, long gthreads) {
    const bf16_t* qkv = (const bf16_t*)(p.ws + WS_QKV); float* u = (float*)(p.ws + WS_UCONV);
    for (long it = gtid; it < (long)MT * LW; it += gthreads) {
        const int r = (int)(it / LW), ch = (int)(it % LW);
        int base, t, n; if (r < ML) { base = (r / NSEQ) * NSEQ; t = r % NSEQ; n = NSEQ; } else { const int rc = r - ML; base = ML + (rc / NCTX) * NCTX; t = rc % NCTX; n = NCTX; }
        float acc = p.lru_conv_b[ch];
        for (int tap = 0; tap < 4; ++tap) { const int tt = t + tap - 2; if (tt >= 0 && tt < n) acc += p.lru_conv_w[tap * LW + ch] * bf2f(qkv[(size_t)(base + tt) * EVIN + COL_XR + ch]); }
        u[it] = acc;
    }
}
__device__ __forceinline__ void ph_lru(const Params& p, long gtid, long gthreads) {
    const bf16_t* qkv = (const bf16_t*)(p.ws + WS_QKV); const float* u = (const float*)(p.ws + WS_UCONV); float* hs = (float*)(p.ws + WS_HSUM); bf16_t* mix = (bf16_t*)(p.ws + WS_MIX);
    for (long it = gtid; it < (long)NB * LW; it += gthreads) {
        const int b = (int)(it / LW), ch = (int)(it % LW), hh = ch / 64, j = ch % 64;
        for (int d = 0; d < 2; ++d) {
            const float lamv = softplusf_(-p.lru_lam[d * LW + ch]), ba = p.lru_ba[d * LW + ch], bi = p.lru_bi[d * LW + ch];
            const float* wa = p.lru_wa + ((size_t)(d * 16 + hh) * 64) * 64 + j; const float* wi = p.lru_wi + ((size_t)(d * 16 + hh) * 64) * 64 + j;
            float state = 0.f;
            for (int seg = 0; seg < 2; ++seg) {
                const int n = seg ? NSEQ : NCTX, base = seg ? b * NSEQ : ML + b * NCTX;
                for (int stp = 0; stp < n; ++stp) {
                    const int row = base + (d ? n - 1 - stp : stp); const float* ur = u + (size_t)row * LW + hh * 64;
                    float ra = ba, ia = bi;
                    for (int i = 0; i < 64; ++i) { ra += ur[i] * wa[(size_t)i * 64]; ia += ur[i] * wi[(size_t)i * 64]; }
                    const float rg = sigmoidf_(ra), ig = sigmoidf_(ia), log_a = -8.0f * rg * lamv, a = __expf(log_a), mult = sqrtf(-expm1f(2.0f * log_a));
                    state = a * state + mult * (ig * ur[j]);
                    if (d == 0) hs[(size_t)row * LW + ch] = state;
                    else { const float tot = hs[(size_t)row * LW + ch] + state; mix[(size_t)row * D + QW + ch] = f2bf(tot * geluf_(bf2f(qkv[(size_t)row * EVIN + COL_GR + ch]))); }
                }
            }
        }
    }
}
__device__ __forceinline__ void ph_attn(const Params& p, long gtid, long gthreads) {
    const bf16_t* qkv = (const bf16_t*)(p.ws + WS_QKV); bf16_t* mix = (bf16_t*)(p.ws + WS_MIX);
    for (long it = gtid; it < (long)MT * 16; it += gthreads) {
        const int r = (int)(it / 16), hd = (int)(it % 16), kvh = hd / 4;
        float q[64], o[64];
        for (int d = 0; d < 64; ++d) { q[d] = bf2f(qkv[(size_t)r * EVIN + COL_Q + hd * 64 + d]); o[d] = 0.f; }
        float m = p.attn_sink[hd], lsum = 1.0f;
        const int b = r < ML ? r / NSEQ : (r - ML) / NCTX;
        for (int seg = 0; seg < 2; ++seg) {
            int k0, k1;
            if (seg == 0) { if (r >= ML) continue; const int t = r % NSEQ; const int lo = t - 128 < 0 ? 0 : t - 128, hi = t + 128 > NSEQ - 1 ? NSEQ - 1 : t + 128; k0 = b * NSEQ + lo; k1 = b * NSEQ + hi + 1; }
            else { k0 = ML + b * NCTX; k1 = k0 + NCTX; }
            for (int kr = k0; kr < k1; ++kr) {
                const bf16_t* kp = qkv + (size_t)kr * EVIN + COL_K + kvh * 64; const bf16_t* vp = qkv + (size_t)kr * EVIN + COL_V + kvh * 64;
                float s = 0.f; for (int d = 0; d < 64; ++d) s += q[d] * bf2f(kp[d]);
                if (s > m) { const float f = __expf(m - s); lsum *= f; for (int d = 0; d < 64; ++d) o[d] *= f; m = s; }
                const float pe = __expf(s - m); lsum += pe;
                for (int d = 0; d < 64; ++d) o[d] += pe * bf2f(vp[d]);
            }
        }
        const float inv = 1.0f / lsum;
        for (int d = 0; d < 64; ++d) mix[(size_t)r * D + hd * 64 + d] = f2bf(o[d] * inv);
    }
}
__device__ __forceinline__ void ph_router(const Params& p, int l, int rows, long gtid, long gthreads) {
    bf16_t* h = (bf16_t*)(p.ws + WS_H); const float* xres = (const float*)(p.ws + WS_XRES);
    int* tok_e = (int*)(p.ws + WS_TOK); float* tok_w = (float*)(p.ws + WS_TOK) + (size_t)MT * 2; int* tok_slot = (int*)(p.ws + WS_TOK) + (size_t)MT * 4;
    int* cnt = (int*)(p.ws + WS_CNT) + l * 64;
    for (long r = gtid; r < rows; r += gthreads) {
        const float* xr = xres + (size_t)r * D; const int ar = ada_row((int)r);
        const float* sh = ada_ptr(p, l, ar, 3); const float* sc = ada_ptr(p, l, ar, 4); const float* g = p.norm_ffn + (size_t)l * D;
        float ss = 0.f; for (int k = 0; k < D; ++k) ss += xr[k] * xr[k];
        const float rstd = 1.0f / sqrtf(ss / D + 1e-6f);
        float lg[NE];
#pragma unroll
        for (int e = 0; e < NE; ++e) lg[e] = p.router_b[e];
        for (int k = 0; k < D; ++k) { const float hv = xr[k] * rstd * g[k] * (1.0f + sc[k]) + sh[k]; h[(size_t)r * D + k] = f2bf(hv);
#pragma unroll
            for (int e = 0; e < NE; ++e) lg[e] += hv * p.router_w[(size_t)k * NE + e]; }
        float mx = lg[0];
#pragma unroll
        for (int e = 1; e < NE; ++e) mx = lg[e] > mx ? lg[e] : mx;
        float pr[NE], sum = 0.f;
#pragma unroll
        for (int e = 0; e < NE; ++e) { pr[e] = __expf(lg[e] - mx); sum += pr[e]; }
#pragma unroll
        for (int e = 0; e < NE; ++e) pr[e] /= sum;
        float best = -1.f, w1 = 0.f, w2 = 0.f; int e1 = 0, e2 = 0;
#pragma unroll
        for (int gi = 0; gi < 4; ++gi) { float a1 = -1.f, a2 = -1.f; int j1 = 0, j2 = 0;
#pragma unroll
            for (int j = 0; j < 4; ++j) { const float v = pr[gi * 4 + j]; if (v > a1) { a2 = a1; j2 = j1; a1 = v; j1 = j; } else if (v > a2) { a2 = v; j2 = j; } }
            if (a1 + a2 > best) { best = a1 + a2; e1 = gi * 4 + j1; e2 = gi * 4 + j2; w1 = a1; w2 = a2; } }
        const float ws = w1 + w2;
        tok_e[r * 2] = e1; tok_e[r * 2 + 1] = e2; tok_w[r * 2] = w1 / ws; tok_w[r * 2 + 1] = w2 / ws;
        tok_slot[r * 2] = atomicAdd(cnt + e1, 1); tok_slot[r * 2 + 1] = atomicAdd(cnt + e2, 1);
    }
}
__device__ __forceinline__ int moe_pad_start(const int* cnt, int e) { int acc = 0;
#pragma unroll
    for (int j = 0; j < NE; ++j) { const int pj = (cnt[j] + 255) / 256 * 256; acc += (j < e) ? pj : 0; } return acc; }
__device__ __forceinline__ void ph_dispatch(const Params& p, int l, int rows, long gtid, long gthreads) {
    const int* tok_e = (const int*)(p.ws + WS_TOK); const int* tok_slot = (const int*)(p.ws + WS_TOK) + (size_t)MT * 4; int* tok_dest = (int*)(p.ws + WS_TOK) + (size_t)MT * 6;
    int* rowidx = (int*)(p.ws + WS_ROWIDX); const int* cnt = (const int*)(p.ws + WS_CNT) + l * 64;
    for (long it = gtid; it < (long)rows * 2; it += gthreads) { const int e = tok_e[it], dest = moe_pad_start(cnt, e) + tok_slot[it]; tok_dest[it] = dest; st_coh(rowidx + dest, (int)(it / 2)); }
    const int total = moe_pad_start(cnt, NE);
    for (long it = gtid; it < total; it += gthreads) { int acc = 0, st = 0, ce = 0;
#pragma unroll
        for (int j = 0; j < NE; ++j) { const int pj = (cnt[j] + 255) / 256 * 256; if (it >= acc && it < acc + pj) { st = acc; ce = cnt[j]; } acc += pj; }
        if (it - st >= ce) st_coh(rowidx + it, 0); }
}
__device__ __forceinline__ void ph_combine(const Params& p, int l, int rows, long gtid, long gthreads) {
    float* xres = (float*)(p.ws + WS_XRES); const bf16_t* yb = (const bf16_t*)(p.ws + WS_YBUF);
    const float* tok_w = (const float*)(p.ws + WS_TOK) + (size_t)MT * 2; const int* tok_dest = (const int*)(p.ws + WS_TOK) + (size_t)MT * 6;
    for (long it = gtid; it < (long)rows * (D / 4); it += gthreads) {
        const int r = (int)(it / (D / 4)), c = (int)(it % (D / 4)) * 4; const float* g2 = ada_ptr(p, l, ada_row(r), 5);
        const int d0 = tok_dest[r * 2], d1 = tok_dest[r * 2 + 1]; const float w0 = tok_w[r * 2], w1 = tok_w[r * 2 + 1];
        for (int j = 0; j < 4; ++j) xres[(size_t)r * D + c + j] += g2[c + j] * (w0 * bf2f(yb[(size_t)d0 * D + c + j]) + w1 * bf2f(yb[(size_t)d1 * D + c + j]));
    }
}
__device__ __forceinline__ void ph_s5(const Params& p, long gtid, long gthreads) {
    const bf16_t* u1 = (const bf16_t*)(p.ws + WS_U1); float* ys = (float*)(p.ws + WS_YS5); bf16_t* z = (bf16_t*)(p.ws + WS_Z);
    const float* lamb = (const float*)(p.ws + WS_S5LAM); const float* bb = (const float*)(p.ws + WS_S5BB);
    for (long it = gtid; it < (long)NB * S5W; it += gthreads) {
        const int b = (int)(it / S5W), col = (int)(it % S5W), g = col / S5C, c = col % S5C;
        for (int t = 0; t < NSEQ; ++t) { const size_t row = (size_t)b * NSEQ + t; ys[row * S5W + col] = p.s5_d[col] * bf2f(u1[row * S5W + col]); }
        for (int d = 0; d < 2; ++d)
            for (int s = 0; s < S5S; ++s) {
                const size_t gi = ((size_t)d * S5G + g) * S5S + s;
                const float lr = lamb[gi * 2], li = lamb[gi * 2 + 1];
                const float cr = p.s5_c_re[(((size_t)d * S5G + g) * S5C + c) * S5S + s], ci = p.s5_c_im[(((size_t)d * S5G + g) * S5C + c) * S5S + s];
                float br[S5C], bi[S5C]; for (int cc = 0; cc < S5C; ++cc) { br[cc] = bb[(gi * S5C + cc) * 2]; bi[cc] = bb[(gi * S5C + cc) * 2 + 1]; }
                float xr = 0.f, xi = 0.f;
                for (int seg = 0; seg < 2; ++seg) {
                    const int n = seg ? NSEQ : NCTX, base = seg ? b * NSEQ : ML + b * NCTX;
                    for (int stp = 0; stp < n; ++stp) {
                        const size_t row = (size_t)base + (d ? n - 1 - stp : stp); const bf16_t* ur = u1 + row * S5W + g * S5C;
                        float bur = 0.f, bui = 0.f; for (int cc = 0; cc < S5C; ++cc) { const float uv = bf2f(ur[cc]); bur += br[cc] * uv; bui += bi[cc] * uv; }
                        const float nr = lr * xr - li * xi + bur, ni = lr * xi + li * xr + bui; xr = nr; xi = ni;
                        if (seg) ys[row * S5W + col] += cr * xr - ci * xi;
                    }
                }
            }
        for (int t = 0; t < NSEQ; ++t) { const size_t row = (size_t)b * NSEQ + t; z[row * S5W + col] = f2bf(geluf_(ys[row * S5W + col])); }
    }
}
#ifndef CPU_EMU
typedef float s5_f32x16 __attribute__((ext_vector_type(16)));
constexpr int S5_XPITCH = 272, S5_XBYTES = 32 * S5_XPITCH, S5_ABYTES = 1024  , S5_WAVE_LDS = S5_XBYTES + S5_ABYTES + 8 * 2 * 64 * 8;
static_assert(8 * S5_WAVE_LDS <= 147456 - 64, "S5 LDS");
__device__ __forceinline__ int s5_chunk_row0(int b, int k) { return k < S5_NCC ? ML + b * NCTX + k * S5_CHUNK : b * NSEQ + (k - S5_NCC) * S5_CHUNK; }
__device__ __forceinline__ int s5_order(int d, int k) { return d == 0 ? k : (k < S5_NCC ? S5_NCC - 1 - k : S5_NCC + (S5_NLC - 1 - (k - S5_NCC))); }
template <int PASS> __device__ __forceinline__ void ph_s5_fast(const Params& p, LAS unsigned char* lds, int gwave, int nwaves, int wv_) {
    const int lane = tid_of(wv_) & 63, wv = wv_;
    LAS unsigned char* xl = lds + wv * S5_WAVE_LDS;
    const int r = lane & 31, hh = lane >> 5, a_half = (r >> 2) & 1, a_n = (r & 3) + 4 * (r >> 3), tk = lane & 15, q4 = lane >> 4;
    const bf16_t* u1 = (const bf16_t*)(p.ws + WS_U1); bf16_t* z = (bf16_t*)(p.ws + WS_Z); float* ys = (float*)(p.ws + WS_YS5);
    const float* lamb = (const float*)(p.ws + WS_S5LAM); const float* lamt = (const float*)(p.ws + WS_S5LAMT);
    const s5_bf16x8* BF = (const s5_bf16x8*)(p.ws + WS_S5BF); const s5_bf16x8* CF = (const s5_bf16x8*)(p.ws + WS_S5CF);
    float* E = (float*)(p.ws + WS_S5E);
    constexpr int P0 = PASS == 2 ? S5_NCC / 2 : 0, NPAIR = S5_NCH / 2 - P0;
    for (int rd = 0; rd <= (NB * S5G * NPAIR) / nwaves; ++rd) {
        const int it = deal_item(rd, gwave, nwaves, NB * S5G * NPAIR); if (it < 0) continue;
        const int g = it % S5G, pr = P0 + (it / S5G) % NPAIR, b = it / (NPAIR * S5G);
        const int k_s = 2 * pr + hh, k_a = 2 * pr + a_half;
        const int rb_a = s5_chunk_row0(b, k_a);
#pragma unroll
        for (int d = 0; d < 2; ++d) {
            const size_t dg = (size_t)d * S5G + g;
            s5_bf16x8 bfr[4], cfr[4];
#pragma unroll
            for (int ct = 0; ct < 4; ++ct) { bfr[ct] = BF[(dg * 4 + ct) * 64 + lane]; if (PASS == 2) cfr[ct] = CF[(dg * 4 + ct) * 64 + lane]; }
            const float l0r = lamb[(dg * S5S + r) * 2], l0i = lamb[(dg * S5S + r) * 2 + 1], l1r = lamb[(dg * S5S + r + 32) * 2], l1i = lamb[(dg * S5S + r + 32) * 2 + 1];
            LAS unsigned char* aslot = xl + S5_XBYTES;
#define S5_DMA(tile_) __builtin_amdgcn_global_load_lds((const unsigned*)(u1 + (size_t)(rb_a + (tile_) * 16 + a_n) * S5W + g * S5C + 8 * hh), (LAS unsigned*)aslot, 16, 0, 0)
            asm volatile("s_waitcnt lgkmcnt(0)" ::: "memory");
            S5_DMA(d ? 7 : 0);
            const int uL = ((tk & 3) | ((tk >> 2) << 3)) + 32 * (q4 >> 1);
            const f32x4 dsk = *(const f32x4*)(p.s5_d + g * S5C + 4 * q4);
            float x0r = 0.f, x0i = 0.f, x1r = 0.f, x1i = 0.f;
            float* Eb = E + (((size_t)(b * S5G + g) * 2 + d) * S5_NCH) * S5S * 2;
            if (PASS == 2) {
                const float t0r = lamt[(dg * S5S + r) * 2], t0i = lamt[(dg * S5S + r) * 2 + 1], t1r = lamt[(dg * S5S + r + 32) * 2], t1i = lamt[(dg * S5S + r + 32) * 2 + 1];
                const int oi = s5_order(d, k_s);
                const int oa = s5_order(d, 2 * pr), ob = s5_order(d, 2 * pr + 1), oimax = oa > ob ? oa : ob;
                for (int j0 = 0; j0 < oimax; j0 += 8) { float e0r[8], e0i[8], e1r[8], e1i[8];
#pragma unroll
                    for (int k = 0; k < 8; ++k) { const int jc = j0 + k < S5_NCH ? j0 + k : S5_NCH - 1; e0r[k] = Eb[(jc * S5S + r) * 2]; e0i[k] = Eb[(jc * S5S + r) * 2 + 1]; e1r[k] = Eb[(jc * S5S + r + 32) * 2]; e1i[k] = Eb[(jc * S5S + r + 32) * 2 + 1]; }
                    asm volatile("" : "+v"(e0r[0]), "+v"(e0r[1]), "+v"(e0r[2]), "+v"(e0r[3]), "+v"(e0i[0]), "+v"(e0i[1]), "+v"(e0i[2]), "+v"(e0i[3]), "+v"(e1r[0]), "+v"(e1r[1]), "+v"(e1r[2]), "+v"(e1r[3]), "+v"(e1i[0]), "+v"(e1i[1]), "+v"(e1i[2]), "+v"(e1i[3]));
                    asm volatile("" : "+v"(e0r[4]), "+v"(e0r[5]), "+v"(e0r[6]), "+v"(e0r[7]), "+v"(e0i[4]), "+v"(e0i[5]), "+v"(e0i[6]), "+v"(e0i[7]), "+v"(e1r[4]), "+v"(e1r[5]), "+v"(e1r[6]), "+v"(e1r[7]), "+v"(e1i[4]), "+v"(e1i[5]), "+v"(e1i[6]), "+v"(e1i[7]));
#pragma unroll
                    for (int k = 0; k < 8; ++k) { const float n0r = t0r * x0r - t0i * x0i + e0r[k], n0i = t0r * x0i + t0i * x0r + e0i[k], n1r = t1r * x1r - t1i * x1i + e1r[k], n1i = t1r * x1i + t1i * x1r + e1i[k];
                        if (j0 + k < oi) { x0r = n0r; x0i = n0i; x1r = n1r; x1i = n1i; } } }
            }
#pragma unroll 1
            for (int i = 0; i < 8; ++i) {
                const int tile = d ? 7 - i : i;
                if (PASS == 2 && d == 1 && i > 0) asm volatile("s_waitcnt vmcnt(2)" ::: "memory"); else asm volatile("s_waitcnt vmcnt(0)" ::: "memory");
                const s5_bf16x8 a = *(const LAS s5_bf16x8*)(aslot + lane * 16);
                typedef unsigned s5_u2v __attribute__((ext_vector_type(2))); u32x2_t uu0, uu1; if (PASS == 2 && d == 0) { const s5_u2v t0 = *(const LAS s5_u2v*)(aslot + uL * 16 + (q4 & 1) * 8), t1 = *(const LAS s5_u2v*)(aslot + (uL + 4) * 16 + (q4 & 1) * 8); uu0.x = t0[0]; uu0.y = t0[1]; uu1.x = t1[0]; uu1.y = t1[1]; }
                asm volatile("s_waitcnt lgkmcnt(0)" ::: "memory");
                if (i + 1 < 8) S5_DMA(d ? tile - 1 : tile + 1);
                s5_f32x16 acc[4];
#pragma unroll
                for (int ct = 0; ct < 4; ++ct) { const float z0 = opaque_zero(); s5_f32x16 zz;
#pragma unroll
                    for (int e = 0; e < 16; ++e) zz[e] = z0;
                    acc[ct] = __builtin_amdgcn_mfma_f32_32x32x16_bf16(a, bfr[ct], zz, 0, 0, 0); }
                MFMA_KEEP(acc[3], a);
#pragma unroll
                for (int nn = 0; nn < 16; ++nn) {
                    const int n = d ? 15 - nn : nn;
                    float n0r = __builtin_fmaf(l0r, x0r, __builtin_fmaf(-l0i, x0i, acc[0][n])), n0i = __builtin_fmaf(l0r, x0i, __builtin_fmaf(l0i, x0r, acc[1][n])), n1r = __builtin_fmaf(l1r, x1r, __builtin_fmaf(-l1i, x1i, acc[2][n])), n1i = __builtin_fmaf(l1r, x1i, __builtin_fmaf(l1i, x1r, acc[3][n]));
                    asm volatile("" : "+v"(n0r), "+v"(n0i), "+v"(n1r), "+v"(n1i));
                    x0r = n0r; x0i = n0i; x1r = n1r; x1i = n1i;
                    if (PASS == 2) { *(LAS unsigned*)(xl + (hh * 16 + n) * S5_XPITCH + 4 * r) = pack2bf(x0r, x0i); *(LAS unsigned*)(xl + (hh * 16 + n) * S5_XPITCH + 4 * (r + 32)) = pack2bf(x1r, x1i); }
                }
                if (PASS == 2) asm volatile("" ::: "memory");
                if (PASS == 2) {
#pragma unroll
                    for (int rg = 0; rg < 2; ++rg) {
                        const size_t row = (size_t)s5_chunk_row0(b, 2 * pr + rg) + tile * 16 + tk; const size_t off = row * S5W + g * S5C + 4 * q4;
                        f32x4 yv; LAS u32x2_t* ypark = (LAS u32x2_t*)(xl + S5_XBYTES + S5_ABYTES) + (tile * 2 + rg) * 64 + lane;
                        if (d == 0) { const u32x2_t uu = rg ? uu1 : uu0;
                            yv = (f32x4){dsk[0] * __uint_as_float(uu.x << 16), dsk[1] * __uint_as_float(uu.x & 0xffff0000u), dsk[2] * __uint_as_float(uu.y << 16), dsk[3] * __uint_as_float(uu.y & 0xffff0000u)}; }
                        else { const unsigned y01 = ypark->x, y23 = ypark->y; yv = (f32x4){__uint_as_float(y01 << 16), __uint_as_float(y01 & 0xffff0000u), __uint_as_float(y23 << 16), __uint_as_float(y23 & 0xffff0000u)}; }
#pragma unroll
                        for (int ks = 0; ks < 4; ++ks) { const s5_bf16x8 xb = *(const LAS s5_bf16x8*)(xl + (rg * 16 + tk) * S5_XPITCH + (32 * ks + 8 * q4) * 2);
                            yv = __builtin_amdgcn_mfma_f32_16x16x32_bf16(cfr[ks], xb, yv, 0, 0, 0); MFMA_KEEP(yv, xb); }
                        if (d == 0) { ypark->x = pack2bf(yv[0], yv[1]); ypark->y = pack2bf(yv[2], yv[3]); }
                        else if (DENSE1_FP8) *(unsigned*)((unsigned char*)z + off) = pack4_fp8(geluf_(yv[0]) * Z8_SCALE, geluf_(yv[1]) * Z8_SCALE, geluf_(yv[2]) * Z8_SCALE, geluf_(yv[3]) * Z8_SCALE);
                        else { u32x2_t w; w.x = pack2bf(geluf_(yv[0]), geluf_(yv[1])); w.y = pack2bf(geluf_(yv[2]), geluf_(yv[3])); *(u32x2_t*)(z + off) = w; }
                    }
                    asm volatile("" ::: "memory");
                }
            }
            if (PASS == 1) { const int oi = s5_order(d, k_s); float* ep = Eb + (size_t)oi * S5S * 2;
                ep[r * 2] = x0r; ep[r * 2 + 1] = x0i; ep[(r + 32) * 2] = x1r; ep[(r + 32) * 2 + 1] = x1i; }
#undef S5_DMA
        }
    }
}
#endif
#ifndef CPU_EMU
__device__ __forceinline__ void ph_conv_fast(const Params& p, long gtid, long gthreads) {
    const bf16_t* qkv = (const bf16_t*)(p.ws + WS_QKV); bf16_t* ub = (bf16_t*)(p.ws + WS_UBF);
    const int ch = (int)(gtid % (LW / 8)) * 8;
    float wt[4][8], bs[8];
#pragma unroll
    for (int j = 0; j < 8; ++j) bs[j] = p.lru_conv_b[ch + j];
#pragma unroll
    for (int tap = 0; tap < 4; ++tap)
#pragma unroll
        for (int j = 0; j < 8; ++j) wt[tap][j] = p.lru_conv_w[tap * LW + ch + j];
    for (long it = gtid; it < (long)MT * (LW / 8); it += gthreads) {
        const int rr = (int)(it / (LW / 8));
        int base, t, n; if (rr < ML) { base = (rr / NSEQ) * NSEQ; t = rr % NSEQ; n = NSEQ; } else { const int rc = rr - ML; base = ML + (rc / NCTX) * NCTX; t = rc % NCTX; n = NCTX; }
        u32x4_t xv[4];
#pragma unroll
        for (int tap = 0; tap < 4; ++tap) { int tt = t + tap - 2; tt = tt < 0 ? 0 : (tt > n - 1 ? n - 1 : tt); xv[tap] = *(const u32x4_t*)(qkv + (size_t)(base + tt) * EVIN + COL_XR + ch); }
        float acc[8];
#pragma unroll
        for (int j = 0; j < 8; ++j) acc[j] = bs[j];
#pragma unroll
        for (int tap = 0; tap < 4; ++tap) { const int tt = t + tap - 2; const float ok = (tt >= 0 && tt < n) ? 1.0f : 0.0f; const unsigned vw[4] = {xv[tap].x, xv[tap].y, xv[tap].z, xv[tap].w};
#pragma unroll
            for (int j = 0; j < 8; ++j) acc[j] += (wt[tap][j] * ok) * __uint_as_float((j & 1) ? (vw[j >> 1] & 0xffff0000u) : (vw[j >> 1] << 16)); }
        u32x4_t w; w.x = pack2bf(acc[0], acc[1]); w.y = pack2bf(acc[2], acc[3]); w.z = pack2bf(acc[4], acc[5]); w.w = pack2bf(acc[6], acc[7]);
        *(u32x4_t*)(ub + (size_t)rr * LW + ch) = w;
    }
}
__device__ __forceinline__ int lru_chunk_row0(int b, int k) { return k < LRU_NCC ? ML + b * NCTX + k * LRU_CH : b * NSEQ + (k - LRU_NCC) * LRU_CH; }
__device__ __forceinline__ int lru_order(int d, int k) { return d == 0 ? k : (k < LRU_NCC ? LRU_NCC - 1 - k : LRU_NCC + (LRU_NLC - 1 - (k - LRU_NCC))); }
#define LRU_ZERO16(v) do { const float z0_ = opaque_zero(); _Pragma("unroll") for (int e_ = 0; e_ < 16; ++e_) v[e_] = z0_; } while (0)
template <int PASS> __device__ __forceinline__ void ph_lru_fast(const Params& p, LAS unsigned char* lds, int gwave, int nwaves, int wv_) {
    const int lane = tid_of(wv_) & 63; LAS float* hfl = (LAS float*)(lds + wv_ * (LRU_CH * 64 * 4)) + lane;
    const int r = lane & 31, hh = lane >> 5, a_half = (r >> 2) & 1, a_n = (r & 3) + 4 * (r >> 3);
    const bf16_t* ub = (const bf16_t*)(p.ws + WS_UBF); const bf16_t* qkv = (const bf16_t*)(p.ws + WS_QKV); bf16_t* mix = (bf16_t*)(p.ws + WS_MIX);
    const s5_bf16x8* LB = (const s5_bf16x8*)(p.ws + WS_LRUBF); float* AGG = (float*)(p.ws + WS_LRUAGG);
    constexpr int NPAIR = LRU_NCH / 2, NT = LRU_CH / 16;
    s5_bf16x8 idf[2];
#pragma unroll
    for (int kk = 0; kk < 2; ++kk) { const int jj = r - 16 * kk - 8 * hh;
#pragma unroll
        for (int e = 0; e < 8; ++e) idf[kk][e] = (e == jj) ? (short)0x3F80 : (short)0; }
    for (int rd = 0; rd <= (NB * 16 * 2 * NPAIR) / nwaves; ++rd) {
        const int it = deal_item(rd, gwave, nwaves, NB * 16 * 2 * NPAIR, OUT0_FP8 ? 4 : 2); if (it < 0) continue;
        const int cs = it & 1, pr = OUT0_FP8 ? (it >> 2) % NPAIR : (it >> 1) % NPAIR, h = OUT0_FP8 ? 2 * ((it / (4 * NPAIR)) % 8) + ((it >> 1) & 1) : (it / (2 * NPAIR)) % 16, b = it / (32 * NPAIR);
        const int k_s = 2 * pr + hh, k_a = 2 * pr + a_half, rb_a = lru_chunk_row0(b, k_a), rb_s = lru_chunk_row0(b, k_s);
        const int ch = h * 64 + 32 * cs + r;
#pragma unroll
        for (int d = 0; d < 2; ++d) {
            const int oi = lru_order(d, k_s);
            s5_bf16x8 br[4], bi[4];
#pragma unroll
            for (int ks = 0; ks < 4; ++ks) { br[ks] = LB[(((size_t)(d * 16 + h) * 2 + 0) * 2 + cs) * 4 * 64 + ks * 64 + lane]; bi[ks] = LB[(((size_t)(d * 16 + h) * 2 + 1) * 2 + cs) * 4 * 64 + ks * 64 + lane]; }
            const float lamv = softplusf_(-p.lru_lam[d * LW + ch]), bav = p.lru_ba[d * LW + ch], biv = p.lru_bi[d * LW + ch];
            const float nba = -1.44269504089f * bav, nbi = -1.44269504089f * biv, c2 = -8.0f * 1.44269504089f * lamv;
            float state = 0.f, aprod = 1.f;
            float* ag = AGG + (((size_t)b * 2 + d) * LRU_NCH) * LW * 2;
            if (PASS == 2) { const int oa = lru_order(d, 2 * pr), ob = lru_order(d, 2 * pr + 1), oimax = oa > ob ? oa : ob;
                for (int j0 = 0; j0 < oimax; j0 += 16) { float aj[16], bj[16];
#pragma unroll
                    for (int k = 0; k < 16; ++k) { const int jc = j0 + k < LRU_NCH ? j0 + k : LRU_NCH - 1; aj[k] = ag[((size_t)jc * LW + ch) * 2]; bj[k] = ag[((size_t)jc * LW + ch) * 2 + 1]; }
                    asm volatile("" : "+v"(aj[0]), "+v"(aj[1]), "+v"(aj[2]), "+v"(aj[3]), "+v"(aj[4]), "+v"(aj[5]), "+v"(aj[6]), "+v"(aj[7]), "+v"(bj[0]), "+v"(bj[1]), "+v"(bj[2]), "+v"(bj[3]), "+v"(bj[4]), "+v"(bj[5]), "+v"(bj[6]), "+v"(bj[7]));
                    asm volatile("" : "+v"(aj[8]), "+v"(aj[9]), "+v"(aj[10]), "+v"(aj[11]), "+v"(aj[12]), "+v"(aj[13]), "+v"(aj[14]), "+v"(aj[15]), "+v"(bj[8]), "+v"(bj[9]), "+v"(bj[10]), "+v"(bj[11]), "+v"(bj[12]), "+v"(bj[13]), "+v"(bj[14]), "+v"(bj[15]));
#pragma unroll
                    for (int k = 0; k < 16; ++k) if (j0 + k < oi) state = aj[k] * state + bj[k]; } }
            s5_bf16x8 an[4], gn0, gn1;
            { const int tile0 = d ? NT - 1 : 0; const bf16_t* up = ub + (size_t)(rb_a + tile0 * 16 + a_n) * LW + h * 64 + 8 * hh;
#pragma unroll
              for (int ks = 0; ks < 4; ++ks) an[ks] = *(const s5_bf16x8*)(up + 16 * ks);
              if (PASS == 2 && d == 1) { const bf16_t* gp = qkv + (size_t)(rb_a + tile0 * 16 + a_n) * EVIN + COL_GR + h * 64 + 32 * cs + 8 * hh; gn0 = *(const s5_bf16x8*)gp; gn1 = *(const s5_bf16x8*)(gp + 16); } }
#pragma unroll 1
            for (int i = 0; i < NT; ++i) {
                const int tile = d ? NT - 1 - i : i;
                s5_bf16x8 a[4], g0, g1;
#pragma unroll
                for (int ks = 0; ks < 4; ++ks) a[ks] = an[ks];
                if (PASS == 2 && d == 1) { g0 = gn0; g1 = gn1; }
                if (i + 1 < NT) { const int tl = d ? tile - 1 : tile + 1; const bf16_t* up = ub + (size_t)(rb_a + tl * 16 + a_n) * LW + h * 64 + 8 * hh;
#pragma unroll
                    for (int ks = 0; ks < 4; ++ks) an[ks] = *(const s5_bf16x8*)(up + 16 * ks);
                    if (PASS == 2 && d == 1) { const bf16_t* gp = qkv + (size_t)(rb_a + tl * 16 + a_n) * EVIN + COL_GR + h * 64 + 32 * cs + 8 * hh; gn0 = *(const s5_bf16x8*)gp; gn1 = *(const s5_bf16x8*)(gp + 16); } }
                s5_f32x16 ar, ai, au, agr; LRU_ZERO16(ar); LRU_ZERO16(ai); LRU_ZERO16(au); LRU_ZERO16(agr);
#pragma unroll
                for (int ks = 0; ks < 4; ++ks) { ar = __builtin_amdgcn_mfma_f32_32x32x16_bf16(a[ks], br[ks], ar, 0, 0, 0); ai = __builtin_amdgcn_mfma_f32_32x32x16_bf16(a[ks], bi[ks], ai, 0, 0, 0); }
                au = __builtin_amdgcn_mfma_f32_32x32x16_bf16(cs ? a[2] : a[0], idf[0], au, 0, 0, 0); au = __builtin_amdgcn_mfma_f32_32x32x16_bf16(cs ? a[3] : a[1], idf[1], au, 0, 0, 0);
                if (PASS == 2 && d == 1) { agr = __builtin_amdgcn_mfma_f32_32x32x16_bf16(g0, idf[0], agr, 0, 0, 0); agr = __builtin_amdgcn_mfma_f32_32x32x16_bf16(g1, idf[1], agr, 0, 0, 0); }
                MFMA_KEEP(au, a[0]); MFMA_KEEP(au, a[1]); MFMA_KEEP(au, a[2]); MFMA_KEEP(au, a[3]); MFMA_KEEP(ai, a[3]); if (PASS == 2 && d == 1) { MFMA_KEEP(agr, g0); MFMA_KEEP(agr, g1); }
#pragma unroll
                for (int nn = 0; nn < 16; ++nn) {
                    const int n = d ? 15 - nn : nn;
                    const float rg = fast_rcp(1.0f + __builtin_amdgcn_exp2f(__builtin_fmaf(ar[n], -1.44269504089f, nba))), ig = fast_rcp(1.0f + __builtin_amdgcn_exp2f(__builtin_fmaf(ai[n], -1.44269504089f, nbi))), av = __builtin_amdgcn_exp2f(rg * c2), mult = fast_sqrt(__builtin_fmaf(-av, av, 1.0f));
                    state = av * state + mult * (ig * au[n]);
                    if (PASS == 1) aprod *= av;
                    if (PASS == 2) { if (d == 0) hfl[(tile * 16 + n) * 64] = state; else { const float mv = (hfl[(tile * 16 + n) * 64] + state) * geluf_(agr[n]);
                        if (OUT0_FP8) ((unsigned char*)mix)[(size_t)(rb_s + tile * 16 + n) * D + QW + ch] = (unsigned char)(pack4_fp8(mv, 0.f, 0.f, 0.f) & 0xffu); else mix[(size_t)(rb_s + tile * 16 + n) * D + QW + ch] = f2bf(mv); } }
                }
            }
            if (PASS == 1) { ag[((size_t)oi * LW + ch) * 2] = aprod; ag[((size_t)oi * LW + ch) * 2 + 1] = state; }
        }
    }
}
#endif
#ifndef CPU_EMU
constexpr int AT_KROWS = 320, AT_LDS_K = 0, AT_LDS_V = AT_KROWS * 128, AT_LDS_BYTES = 2 * AT_KROWS * 128;
static_assert(NCTX == 256, "attention key halves assume 256 context keys");
__device__ __forceinline__ void ph_attn_fast(const Params& p, LAS unsigned char* lds, int bid, int nblocks, int wv_) {
    const int tid = tid_of(wv_), lane = tid & 63, w = wv_, r = lane & 31, hh = lane >> 5;
    const bf16_t* qkv = (const bf16_t*)(p.ws + WS_QKV); const bf16_t* vt = (const bf16_t*)(p.ws + WS_VT); bf16_t* mix = (bf16_t*)(p.ws + WS_MIX);
    constexpr int NQB = NSEQ / 128, NCB = NCTX / 128, UNITS = NB * 4 * (NQB + NCB);
    for (int un = bid; un < UNITS; un += nblocks) {
        const int kvh = un & 3, rest = un >> 2; int b, qb; if (rest < NB * NQB) { b = rest / NQB; qb = rest % NQB; } else { b = (rest - NB * NQB) / NCB; qb = NQB + (rest - NB * NQB) % NCB; }
        const bool isc = qb >= NQB;
        const int q0 = isc ? (qb - NQB) * 128 : qb * 128, qrow0 = isc ? ML + b * NCTX + q0 : b * NSEQ + q0, head = 4 * kvh + (w >> 1);
        s5_bf16x8 qf[2][4];
#pragma unroll
        for (int qt = 0; qt < 2; ++qt)
#pragma unroll
            for (int ds = 0; ds < 4; ++ds) qf[qt][ds] = *(const s5_bf16x8*)(qkv + (size_t)(qrow0 + 64 * (w & 1) + 32 * qt + r) * EVIN + COL_Q + head * 64 + 16 * ds + 8 * hh);
        s5_f32x16 oacc[2][2];
#pragma unroll
        for (int qt = 0; qt < 2; ++qt)
#pragma unroll
            for (int dt = 0; dt < 2; ++dt)
#pragma unroll
                for (int e = 0; e < 16; ++e) oacc[qt][dt][e] = 0.f;
        const float sk = p.attn_sink[head];
        float mrun[2] = {sk, sk}, lrun[2] = {hh == 0 ? 1.0f : 0.f, hh == 0 ? 1.0f : 0.f};
#pragma unroll 1
        for (int half = isc ? 1 : 0; half < 2; ++half) {
            __syncthreads();
            static_assert(AT_KROWS * 8 == 5 * 512 && 64 * 40 == 5 * 512, "staging: five 16-byte pieces per thread and operand");
            u4v_t stK[5], stV[5];
#pragma unroll
            for (int k5 = 0; k5 < 5; ++k5) {
                const int i = tid + 512 * k5, row = i >> 3, cc = i & 7; int grow;
                if (half == 1 && row >= 64) grow = ML + b * NCTX + (row - 64);
                else { int kpos = q0 - 128 + 320 * half + row; kpos = kpos < 0 ? 0 : (kpos > NSEQ - 1 ? NSEQ - 1 : kpos); grow = b * NSEQ + kpos; }
                stK[k5] = *(const u4v_t*)(qkv + (size_t)grow * EVIN + COL_K + kvh * 64 + cc * 8);
            }
#pragma unroll
            for (int k5 = 0; k5 < 5; ++k5) {
                const int i = tid + 512 * k5, d = i / 40, pc = i % 40;
                const int pos = (half == 0) ? q0 + pc * 8 : (pc < 8 ? q0 + 320 + pc * 8 : 128 + NSEQ + 128 + (pc - 8) * 8);
                stV[k5] = *(const u4v_t*)(vt + ((size_t)(b * 4 + kvh) * 64 + d) * VT_T + pos);
            }
#pragma unroll
            for (int k5 = 0; k5 < 5; ++k5) { const int i = tid + 512 * k5, row = i >> 3, cc = i & 7; *(LAS u4v_t*)(lds + AT_LDS_K + row * 128 + ((cc ^ (row & 7)) << 4)) = stK[k5]; }
#pragma unroll
            for (int k5 = 0; k5 < 5; ++k5) { const int i = tid + 512 * k5, d = i / 40, pc = i % 40, kt = pc >> 2, cc = pc & 3; *(LAS u4v_t*)(lds + AT_LDS_V + kt * 4096 + d * 64 + ((cc ^ ((d >> 2) & 3)) << 4)) = stV[k5]; }
            __syncthreads();
#pragma unroll 1
            for (int kt = (isc ? 2 : 0); kt < 10; ++kt) {
                const bool local = !(half == 1 && kt >= 2);
                const int Kb = q0 - 128 + 320 * half + 32 * kt;
                s5_bf16x8 kf[4], vf[2][2];
#pragma unroll
                for (int ds = 0; ds < 4; ++ds) kf[ds] = *(const LAS s5_bf16x8*)(lds + AT_LDS_K + (32 * kt + r) * 128 + (((2 * ds + hh) ^ (r & 7)) << 4));
#pragma unroll
                for (int dt = 0; dt < 2; ++dt)
#pragma unroll
                    for (int s2 = 0; s2 < 2; ++s2) vf[dt][s2] = *(const LAS s5_bf16x8*)(lds + AT_LDS_V + kt * 4096 + (32 * dt + r) * 64 + (((2 * s2 + hh) ^ (((32 * dt + r) >> 2) & 3)) << 4));
#pragma unroll
                for (int qt = 0; qt < 2; ++qt) {
                    const int Qb = q0 + 64 * (w & 1) + 32 * qt;
                    bool need_mask = false;
                    if (local) {
                        if (Kb - (Qb + 31) > 128 || Qb - (Kb + 31) > 128 || Kb + 31 < 0 || Kb >= NSEQ) continue;
                        need_mask = !(Kb + 31 - Qb <= 128 && Qb + 31 - Kb <= 128 && Kb >= 0 && Kb + 31 < NSEQ);
                    }
                    s5_f32x16 sc; const float z0 = opaque_zero();
#pragma unroll
                    for (int e = 0; e < 16; ++e) sc[e] = z0;
#pragma unroll
                    for (int ds = 0; ds < 4; ++ds) sc = __builtin_amdgcn_mfma_f32_32x32x16_bf16(kf[ds], qf[qt][ds], sc, 0, 0, 0);
                    MFMA_KEEP(sc, kf[0]); MFMA_KEEP(sc, kf[1]); MFMA_KEEP(sc, kf[2]); MFMA_KEEP(sc, kf[3]);
                    if (need_mask) {
                        const int qpos = Qb + r;
#pragma unroll
                        for (int e = 0; e < 16; ++e) { const int kpos = Kb + (e & 3) + 8 * (e >> 2) + 4 * hh, rel = kpos - qpos; if (rel > 128 || rel < -128 || kpos < 0 || kpos >= NSEQ) sc[e] = -1e30f; }
                    }
                    float tmax = sc[0];
#pragma unroll
                    for (int e = 1; e < 16; ++e) tmax = fmaxf(tmax, sc[e]);
                    tmax = fmaxf(tmax, __shfl_xor(tmax, 32));
                    const float mnew = fmaxf(mrun[qt], tmax), scl = __expf(mrun[qt] - mnew), mneg = -mnew * 1.44269504089f; mrun[qt] = mnew;
                    float psum = 0.f; float pv[16];
#pragma unroll
                    for (int e = 0; e < 16; ++e) { pv[e] = __builtin_amdgcn_exp2f(__builtin_fmaf(sc[e], 1.44269504089f, mneg)); psum += pv[e]; }
                    lrun[qt] = lrun[qt] * scl + psum;
                    if (__ballot(scl != 1.0f) != 0ull) {
#pragma unroll
                    for (int dt = 0; dt < 2; ++dt)
#pragma unroll
                        for (int e = 0; e < 16; ++e) oacc[qt][dt][e] *= scl; }
                    s5_bf16x8 pf[2];
#pragma unroll
                    for (int s2 = 0; s2 < 2; ++s2) { unsigned w0 = pack2bf(pv[8 * s2], pv[8 * s2 + 1]), w1 = pack2bf(pv[8 * s2 + 2], pv[8 * s2 + 3]), w2 = pack2bf(pv[8 * s2 + 4], pv[8 * s2 + 5]), w3 = pack2bf(pv[8 * s2 + 6], pv[8 * s2 + 7]);
                        u4v_t t4 = {w0, w1, w2, w3}; pf[s2] = __builtin_bit_cast(s5_bf16x8, t4); }
#pragma unroll
                    for (int dt = 0; dt < 2; ++dt)
#pragma unroll
                        for (int s2 = 0; s2 < 2; ++s2) oacc[qt][dt] = __builtin_amdgcn_mfma_f32_32x32x16_bf16(vf[dt][s2], pf[s2], oacc[qt][dt], 0, 0, 0);
                    MFMA_KEEP(oacc[qt][1], pf[0]); MFMA_KEEP(oacc[qt][1], pf[1]);
                }
            }
        }
#pragma unroll
        for (int qt = 0; qt < 2; ++qt) {
            const float ltot = lrun[qt] + __shfl_xor(lrun[qt], 32), inv = 1.0f / ltot;
            bf16_t* op = mix + (size_t)(qrow0 + 64 * (w & 1) + 32 * qt + r) * D + head * 64; unsigned char* op8 = (unsigned char*)mix + (size_t)(qrow0 + 64 * (w & 1) + 32 * qt + r) * D + head * 64; const float inv8 = inv * MIX8_SCALE;
#pragma unroll
            for (int dt = 0; dt < 2; ++dt)
#pragma unroll
                for (int g4 = 0; g4 < 4; ++g4) {
                    if (OUT0_FP8) { *(unsigned*)(op8 + 32 * dt + 8 * g4 + 4 * hh) = pack4_fp8(oacc[qt][dt][4 * g4] * inv8, oacc[qt][dt][4 * g4 + 1] * inv8, oacc[qt][dt][4 * g4 + 2] * inv8, oacc[qt][dt][4 * g4 + 3] * inv8); continue; }
                    u32x2_t wv2; wv2.x = pack2bf(oacc[qt][dt][4 * g4] * inv, oacc[qt][dt][4 * g4 + 1] * inv); wv2.y = pack2bf(oacc[qt][dt][4 * g4 + 2] * inv, oacc[qt][dt][4 * g4 + 3] * inv);
                    *(u32x2_t*)(op + 32 * dt + 8 * g4 + 4 * hh) = wv2; }
        }
    }
}
#endif
#ifndef CPU_EMU
__device__ __forceinline__ float wave_sum(float v) {
#pragma unroll
    for (int o = 32; o >= 1; o >>= 1) v += __shfl_xor(v, o);
    return v; }
template <int MODE> __device__ __forceinline__ void ph_norm_fast(const Params& p, int l, int rows, int gwave, int nwaves, int wv_) {
    const int lane = tid_of(wv_) & 63;
    bf16_t* h = (bf16_t*)(p.ws + WS_H); float* xres = (float*)(p.ws + WS_XRES); const bf16_t* yb = (const bf16_t*)(p.ws + WS_YBUF);
    const float* tok_w = (const float*)(p.ws + WS_TOK) + (size_t)MT * 2; const int* tok_dest = (const int*)(p.ws + WS_TOK) + (size_t)MT * 6;
    for (int r = gwave; r < rows; r += nwaves) {
        const int ar = ada_row(r);
        f32x4 xv[8];
        f32x4 cg[8], cs[8], ch[8];
        if (MODE == 2) {
#pragma unroll
            for (int i = 0; i < 8; ++i) cg[i] = *(const f32x4*)(p.norm_final + 4 * lane + 256 * i);
        } else { const float* sh = ada_ptr(p, l, ar, 0); const float* sc = ada_ptr(p, l, ar, 1); const float* g = p.norm_mix + (size_t)l * D;
#pragma unroll
            for (int i = 0; i < 8; ++i) { const int c = 4 * lane + 256 * i; cg[i] = *(const f32x4*)(g + c); cs[i] = *(const f32x4*)(sc + c); ch[i] = *(const f32x4*)(sh + c); } }
        if (MODE == 0) { const float* xr = xin_row(p, l, r);
#pragma unroll
            for (int i = 0; i < 8; ++i) xv[i] = *(const f32x4*)(xr + 4 * lane + 256 * i); }
        else { const int lm = (MODE == 1) ? l - 1 : 1; const float* g2 = ada_ptr(p, lm, ar, 5); float* xr = xres + (size_t)r * D;
            const int d0 = tok_dest[r * 2], d1 = tok_dest[r * 2 + 1]; const float w0 = tok_w[r * 2], w1 = tok_w[r * 2 + 1];
            f32x4 xo[8], gg[8]; unsigned ya8[8], yc8[8]; u32x2_t ya16[8], yc16[8];
#pragma unroll
            for (int i = 0; i < 8; ++i) { const int c = 4 * lane + 256 * i;
                if (RES_BF16) { const u32x2_t t = *(const u32x2_t*)((const bf16_t*)xres + (size_t)r * D + c); xo[i] = unpack4bf(t.x, t.y); } else xo[i] = *(const f32x4*)(xr + c);
                gg[i] = *(const f32x4*)(g2 + c);
                if (Y8) { ya8[i] = *(const unsigned*)((const unsigned char*)yb + (size_t)d0 * D + c); yc8[i] = *(const unsigned*)((const unsigned char*)yb + (size_t)d1 * D + c); }
                else { ya16[i] = *(const u32x2_t*)(yb + (size_t)d0 * D + c); yc16[i] = *(const u32x2_t*)(yb + (size_t)d1 * D + c); } }
#pragma unroll
            for (int i = 0; i < 8; ++i) { f32x4 m;
                if (Y8) { const unsigned ya = ya8[i], yc = yc8[i]; const float u0 = w0 * (1.0f / Y8_SCALE), u1 = w1 * (1.0f / Y8_SCALE);
                    m[0] = u0 * __builtin_amdgcn_cvt_f32_fp8(ya, 0) + u1 * __builtin_amdgcn_cvt_f32_fp8(yc, 0); m[1] = u0 * __builtin_amdgcn_cvt_f32_fp8(ya, 1) + u1 * __builtin_amdgcn_cvt_f32_fp8(yc, 1);
                    m[2] = u0 * __builtin_amdgcn_cvt_f32_fp8(ya, 2) + u1 * __builtin_amdgcn_cvt_f32_fp8(yc, 2); m[3] = u0 * __builtin_amdgcn_cvt_f32_fp8(ya, 3) + u1 * __builtin_amdgcn_cvt_f32_fp8(yc, 3); }
                else { const u32x2_t ya = ya16[i], yc = yc16[i];
                    m[0] = w0 * __uint_as_float(ya.x << 16) + w1 * __uint_as_float(yc.x << 16); m[1] = w0 * __uint_as_float(ya.x & 0xffff0000u) + w1 * __uint_as_float(yc.x & 0xffff0000u);
                    m[2] = w0 * __uint_as_float(ya.y << 16) + w1 * __uint_as_float(yc.y << 16); m[3] = w0 * __uint_as_float(ya.y & 0xffff0000u) + w1 * __uint_as_float(yc.y & 0xffff0000u); }
                xv[i] = xo[i] + gg[i] * m; } }
        float ss = 0.f;
#pragma unroll
        for (int i = 0; i < 8; ++i) ss += (xv[i][0] * xv[i][0] + xv[i][1] * xv[i][1]) + (xv[i][2] * xv[i][2] + xv[i][3] * xv[i][3]);
        ss = wave_sum(ss);
        const float rstd = 1.0f / sqrtf(ss * (1.0f / D) + 1e-6f);
#ifndef CPU_EMU
        asm volatile("" ::: "memory");
#endif
        if (MODE == 2) {
#pragma unroll
            for (int i = 0; i < 8; ++i) { const int c = 4 * lane + 256 * i; *(f32x4*)(p.out + (size_t)r * D + c) = xv[i] * rstd * cg[i]; }
        } else {
#pragma unroll
            for (int i = 0; i < 8; ++i) { const int c = 4 * lane + 256 * i;
                if (MODE == 1) { if (RES_BF16) { u32x2_t t; t.x = pack2bf(xv[i][0], xv[i][1]); t.y = pack2bf(xv[i][2], xv[i][3]); *(u32x2_t*)((bf16_t*)xres + (size_t)r * D + c) = t; } else *(f32x4*)(xres + (size_t)r * D + c) = xv[i]; }
                const f32x4 hv = xv[i] * rstd * cg[i] * (cs[i] + 1.0f) + ch[i];
                if ((MODE == 1 && DENSE1_FP8) || (MODE == 0 && IN0_FP8)) *(unsigned*)((unsigned char*)h + (size_t)r * D + c) = pack4_fp8(hv[0], hv[1], hv[2], hv[3]);
                else { if (MODE == 0 && IN0QKV_FP8) *(unsigned*)(p.ws + WS_H8 + (size_t)r * D + c) = pack4_fp8(hv[0], hv[1], hv[2], hv[3]);
                    u32x2_t w; w.x = pack2bf(hv[0], hv[1]); w.y = pack2bf(hv[2], hv[3]); *(u32x2_t*)(h + (size_t)r * D + c) = w; } } }
    }
}
template <bool H8> __device__ __forceinline__ void ph_router_fast(const Params& p, int l, int rows, LAS unsigned char* lds, int bid, int nblocks, int wv_) {
    const int lane = tid_of(wv_) & 63, rr = lane & 15, q = lane >> 4, w = wv_;
    bf16_t* h = (bf16_t*)(p.ws + WS_H); const float* xres = (const float*)(p.ws + WS_XRES); const s5_bf16x8* RWF = (const s5_bf16x8*)(p.ws + WS_RWF);
    int* tok_e = (int*)(p.ws + WS_TOK); float* tok_w = (float*)(p.ws + WS_TOK) + (size_t)MT * 2; int* tok_slot = (int*)(p.ws + WS_TOK) + (size_t)MT * 4;
    int* hist = (int*)(p.ws + WS_HIST) + (size_t)l * MAXG * HIST_LD;
    int run = 0;
    LAS float* ssq = (LAS float*)lds;
    LAS f32x4* red = (LAS f32x4*)(lds + 1024);
    LAS float* cfA = (LAS float*)(lds + 16384); LAS float* cfB = cfA + D;
    const int tid = w * 64 + lane, ntl = rows / 16, TPW = (ntl + nblocks - 1) / nblocks, t_lo = bid * TPW, t_hi = (t_lo + TPW < ntl) ? t_lo + TPW : ntl;
    s5_bf16x8 rwh[8], rwl[8];
#pragma unroll
    for (int st = 0; st < 8; ++st) { rwh[st] = RWF[(8 * w + st) * 64 + lane]; rwl[st] = RWF[(64 + 8 * w + st) * 64 + lane]; }
    const f32x4 rbias = *(const f32x4*)(p.router_b + 4 * q);
    int ar_cur = -1;
    u4v_t nx[8];
    if (RES_BF16 && t_lo < t_hi) { const bf16_t* xr = (const bf16_t*)xres + (size_t)(t_lo * 16 + rr) * D + 256 * w + 8 * q;
#pragma unroll
        for (int st = 0; st < 8; ++st) nx[st] = *(const u4v_t*)(xr + 32 * st); }
    for (int t16 = t_lo; t16 < t_hi; ++t16) {
        const int r = t16 * 16 + rr, ar = ada_row(t16 * 16);
        if (ar != ar_cur) { ar_cur = ar;
            const f32x4 gv = *(const f32x4*)(p.norm_ffn + (size_t)l * D + 4 * tid), sv = *(const f32x4*)(ada_ptr(p, l, ar, 4) + 4 * tid), hv = *(const f32x4*)(ada_ptr(p, l, ar, 3) + 4 * tid);
            *(LAS f32x4*)(cfA + 4 * tid) = gv * (sv + 1.0f); *(LAS f32x4*)(cfB + 4 * tid) = hv; }
        f32x4 xa[8], xb[8];
        if (RES_BF16) {
#pragma unroll
            for (int st = 0; st < 8; ++st) { xa[st] = unpack4bf(nx[st][0], nx[st][1]); xb[st] = unpack4bf(nx[st][2], nx[st][3]); }
            if (t16 + 1 < t_hi) { const bf16_t* xr = (const bf16_t*)xres + (size_t)((t16 + 1) * 16 + rr) * D + 256 * w + 8 * q;
#pragma unroll
                for (int st = 0; st < 8; ++st) nx[st] = *(const u4v_t*)(xr + 32 * st); } }
        else { const float* xr = xres + (size_t)r * D + 256 * w + 8 * q;
#pragma unroll
            for (int st = 0; st < 8; ++st) { xa[st] = *(const f32x4*)(xr + 32 * st); xb[st] = *(const f32x4*)(xr + 32 * st + 4); } }
        float ss = 0.f;
#pragma unroll
        for (int st = 0; st < 8; ++st) ss += (xa[st][0] * xa[st][0] + xa[st][1] * xa[st][1]) + (xa[st][2] * xa[st][2] + xa[st][3] * xa[st][3]) + (xb[st][0] * xb[st][0] + xb[st][1] * xb[st][1]) + (xb[st][2] * xb[st][2] + xb[st][3] * xb[st][3]);
        ss += __shfl_xor(ss, 16); ss += __shfl_xor(ss, 32);
        if (q == 0) ssq[w * 16 + rr] = ss;
        __syncthreads();
        float tot = 0.f;
#pragma unroll
        for (int ww = 0; ww < 8; ++ww) tot += ssq[ww * 16 + rr];
        const float rstd = 1.0f / sqrtf(tot * (1.0f / D) + 1e-6f);
        const LAS float* cA = cfA + 256 * w + 8 * q; const LAS float* cB = cfB + 256 * w + 8 * q;
        f32x4 lhi, llo; { const float z0 = opaque_zero(); lhi = (f32x4){z0, z0, z0, z0}; llo = lhi; }
#pragma unroll
        for (int st = 0; st < 8; ++st) {
            const f32x4 ga = *(const LAS f32x4*)(cA + 32 * st), gb = *(const LAS f32x4*)(cA + 32 * st + 4), ha = *(const LAS f32x4*)(cB + 32 * st), hb = *(const LAS f32x4*)(cB + 32 * st + 4);
            const f32x4 va = xa[st] * rstd * ga + ha, vb = xb[st] * rstd * gb + hb;
            u4v_t wv4 = {pack2bf(va[0], va[1]), pack2bf(va[2], va[3]), pack2bf(vb[0], vb[1]), pack2bf(vb[2], vb[3])};
            if (H8) { u32x2_t w8; w8.x = pack4_fp8(va[0], va[1], va[2], va[3]); w8.y = pack4_fp8(vb[0], vb[1], vb[2], vb[3]); *(u32x2_t*)((unsigned char*)h + (size_t)r * D + 256 * w + 32 * st + 8 * q) = w8; }
            else *(u4v_t*)(h + (size_t)r * D + 256 * w + 32 * st + 8 * q) = wv4;
            const s5_bf16x8 hf = __builtin_bit_cast(s5_bf16x8, wv4);
            lhi = __builtin_amdgcn_mfma_f32_16x16x32_bf16(rwh[st], hf, lhi, 0, 0, 0); MFMA_KEEP(lhi, rwh[st]);
            llo = __builtin_amdgcn_mfma_f32_16x16x32_bf16(rwl[st], hf, llo, 0, 0, 0); MFMA_KEEP(llo, rwl[st]); MFMA_KEEP(llo, hf);
        }
        red[w * 64 + lane] = lhi + llo;
        __syncthreads();
        if (w == 0) {
            f32x4 lsum = red[lane];
#pragma unroll
            for (int ww = 1; ww < 8; ++ww) lsum += red[ww * 64 + lane];
            float lg[4];
#pragma unroll
            for (int i = 0; i < 4; ++i) lg[i] = lsum[i] + rbias[i];
            float mx = fmaxf(fmaxf(lg[0], lg[1]), fmaxf(lg[2], lg[3])); mx = fmaxf(mx, __shfl_xor(mx, 16)); mx = fmaxf(mx, __shfl_xor(mx, 32));
            float pr[4], sum = 0.f;
#pragma unroll
            for (int i = 0; i < 4; ++i) { pr[i] = __expf(lg[i] - mx); sum += pr[i]; }
            sum += __shfl_xor(sum, 16); sum += __shfl_xor(sum, 32);
            float a1 = -1.f, a2 = -1.f; int j1 = 0, j2 = 0;
#pragma unroll
            for (int i = 0; i < 4; ++i) { const float v = pr[i] / sum; if (v > a1) { a2 = a1; j2 = j1; a1 = v; j1 = i; } else if (v > a2) { a2 = v; j2 = i; } }
            float best = a1 + a2; int bq = q; float w1 = a1, w2 = a2; int e1 = 4 * q + j1, e2 = 4 * q + j2;
#pragma unroll
            for (int o = 16; o <= 32; o <<= 1) {
                const float ob = __shfl_xor(best, o), ow1 = __shfl_xor(w1, o), ow2 = __shfl_xor(w2, o); const int oq = __shfl_xor(bq, o), oe1 = __shfl_xor(e1, o), oe2 = __shfl_xor(e2, o);
                if (ob > best || (ob == best && oq < bq)) { best = ob; bq = oq; w1 = ow1; w2 = ow2; e1 = oe1; e2 = oe2; } }
            int rk1 = 0, rk2 = 0, mine = 0; const unsigned long long below = (1ull << rr) - 1ull;
#pragma unroll
            for (int e = 0; e < NE; ++e) { const unsigned long long m = __ballot(q == 0 && (e1 == e || e2 == e)); const int pc = __popcll(m & below); if (e1 == e) rk1 = pc; if (e2 == e) rk2 = pc; if (rr == e) mine = __popcll(m); }
            const int b1 = __shfl(run, e1), b2 = __shfl(run, e2);
            if (q == 0) { const float ws = w1 + w2; tok_e[r * 2] = e1; tok_e[r * 2 + 1] = e2; tok_w[r * 2] = w1 / ws; tok_w[r * 2 + 1] = w2 / ws;
                tok_slot[r * 2] = b1 + rk1; tok_slot[r * 2 + 1] = b2 + rk2; }
            run += mine;
        }
    }
    if (w == 0 && lane < HIST_LD) hist[bid * HIST_LD + lane] = lane < NE ? run : 0;
}
__device__ __forceinline__ void ph_dispatch_fast(const Params& p, int l, int rows, LAS unsigned char* lds, int bid, int nblocks, int wv_) {
    const int tid = tid_of(wv_); const int* hist = (const int*)(p.ws + WS_HIST) + (size_t)l * MAXG * HIST_LD;
    const int* tok_e = (const int*)(p.ws + WS_TOK); const int* tok_slot = (const int*)(p.ws + WS_TOK) + (size_t)MT * 4; int* tok_dest = (int*)(p.ws + WS_TOK) + (size_t)MT * 6;
    int* rowidx = (int*)(p.ws + WS_ROWIDX); int* cnt = (int*)(p.ws + WS_CNT) + l * 64;
    LAS int* pre = (LAS int*)lds; LAS int* seg = pre + MAXG * NE; LAS int* tot = seg + 32 * NE; LAS int* pst = tot + NE;
    { const int e = tid & 15, sg = tid >> 4; int v[8], sum = 0;
#pragma unroll
        for (int i = 0; i < 8; ++i) { const int wg = 8 * sg + i; v[i] = wg < nblocks ? hist[wg * HIST_LD + e] : 0; sum += v[i]; }
        seg[sg * NE + e] = sum;
        __syncthreads();
        int base = 0; for (int s2 = 0; s2 < sg; ++s2) base += seg[s2 * NE + e];
#pragma unroll
        for (int i = 0; i < 8; ++i) { pre[(8 * sg + i) * NE + e] = base; base += v[i]; }
        if (sg == 31) tot[e] = base;
        __syncthreads();
        if (tid <= NE) { int acc = 0; for (int j = 0; j < tid; ++j) acc += (tot[j] + 255) / 256 * 256; pst[tid] = acc; }
        if (bid == 0 && tid < NE) cnt[tid] = tot[tid];
        __syncthreads(); }
    const long gtid = (long)bid * 512 + tid, gthreads = (long)nblocks * 512; const int tpw = (rows / 16 + nblocks - 1) / nblocks;
    for (long it = gtid; it < (long)rows * 2; it += gthreads) { const int e = tok_e[it], wg = (int)((it >> 5) / tpw), dest = pst[e] + pre[wg * NE + e] + tok_slot[it]; tok_dest[it] = dest; st_coh(rowidx + dest, (int)(it / 2)); }
    const int total = pst[NE];
    for (long it = gtid; it < total; it += gthreads) { int st = 0, ce = 0;
#pragma unroll
        for (int j = 0; j < NE; ++j) { if (it >= pst[j] && it < pst[j + 1]) { st = pst[j]; ce = tot[j]; } }
        if (it - st >= ce) st_coh(rowidx + it, 0); }
}
#endif
__device__ __forceinline__ void ph_final(const Params& p, long gtid, long gthreads) {
    const float* xres = (const float*)(p.ws + WS_XRES);
    for (long r = gtid; r < ML; r += gthreads) {
        const float* xr = xres + (size_t)r * D; float ss = 0.f; for (int k = 0; k < D; ++k) ss += xr[k] * xr[k];
        const float rstd = 1.0f / sqrtf(ss / D + 1e-6f);
        for (int k = 0; k < D; ++k) p.out[(size_t)r * D + k] = xr[k] * rstd * p.norm_final[k];
    }
}

struct CvtJob { const float* src; bf16_t* dst; int K, N, mode, fp8, ld; };
constexpr int NJOBS = 6 + 2 * NE * 3;
constexpr int IN0_NQ = QW + 2 * KVW;
__device__ __forceinline__ CvtJob cvt_job(const Params& p, int j) {
    CvtJob J; unsigned char* ws = p.ws; J.fp8 = 0;
    if (j == 0) { J.src = p.ev_w_in; J.dst = (bf16_t*)(ws + WS_WT_IN0); J.K = D; J.N = IN0_NQ; J.mode = 0; }
    else if (j == 5) { J.src = p.ev_w_in + IN0_NQ; J.dst = (bf16_t*)(ws + WS_WT_IN0) + (size_t)IN0_NQ * D; J.K = D; J.N = EVIN - IN0_NQ; J.mode = 0; }
    else if (j == 1) { J.src = p.ev_w_out; J.dst = (bf16_t*)(ws + WS_WT_OUT0); J.K = D; J.N = D; J.mode = 0; }
    else if (j == 2) { J.src = p.od_w_in; J.dst = (bf16_t*)(ws + WS_WT_IN1); J.K = D; J.N = S5W; J.mode = 0; }
    else if (j == 3) { J.src = p.s5_glu_w; J.dst = (bf16_t*)(ws + WS_WT_GLU); J.K = S5W; J.N = S5W; J.mode = 0; }
    else if (j == 4) { J.src = p.od_w_out; J.dst = (bf16_t*)(ws + WS_WT_OUT1); J.K = S5W; J.N = D; J.mode = 0; }
    else { const int q = j - 6, le = q / 3, kind = q % 3;
        if (kind == 0) { J.src = p.moe_w_gate + (size_t)le * D * FF; J.dst = (bf16_t*)(ws + WS_WT_GU) + (size_t)le * 2 * FF * D; J.K = D; J.N = FF; J.mode = 1; }
        else if (kind == 1) { J.src = p.moe_w_up + (size_t)le * D * FF; J.dst = (bf16_t*)(ws + WS_WT_GU) + (size_t)le * 2 * FF * D; J.K = D; J.N = FF; J.mode = 2; }
        else { J.src = p.moe_w_down + (size_t)le * FF * D; J.dst = (bf16_t*)(ws + WS_WT_DN) + (size_t)le * D * FF; J.K = FF; J.N = D; J.mode = 0; }
        if (le >= NE ? MOE1_FP8 : MOE0_FP8) { const int l8 = le / NE, e = le % NE; J.fp8 = 1;
            J.dst = kind == 2 ? (bf16_t*)(ws + WS_WT_DN + (size_t)l8 * NE * D * FF * 2 + (size_t)e * D * FF) : (bf16_t*)(ws + WS_WT_GU + (size_t)l8 * NE * 2 * FF * D * 2 + (size_t)e * 2 * FF * D); } }
    if (((IN0_FP8 || IN0QKV_FP8) && j == 0) || (IN0_FP8 && j == 5) || (OUT0_FP8 && j == 1)) J.fp8 = 1;
    J.ld = (j == 0 || j == 5) ? EVIN : J.N;
    if (DENSE1_FP8 && j >= 2 && j <= 4) J.fp8 = 1;
    return J;
}
__device__ __forceinline__ int cvt_rowmap(int mode, int n) { return mode == 0 ? n : (n / 128) * 256 + (mode == 2 ? 128 : 0) + n % 128; }
constexpr long cvt_tiles_of(int K, int N) { return (long)(K / 64) * (N / 256); }
constexpr long CVT_TILES = cvt_tiles_of(D, IN0_NQ) + cvt_tiles_of(D, EVIN - IN0_NQ) + cvt_tiles_of(D, D) + cvt_tiles_of(D, S5W) + cvt_tiles_of(S5W, S5W) + cvt_tiles_of(S5W, D) + (long)2 * NE * 3 * cvt_tiles_of(D, FF);
__device__ __forceinline__ void cvt_find(long tile, int& j, long& local) {
    const long t0 = cvt_tiles_of(D, IN0_NQ), t1 = t0 + cvt_tiles_of(D, D), t2 = t1 + cvt_tiles_of(D, S5W), t3 = t2 + cvt_tiles_of(S5W, S5W), t4 = t3 + cvt_tiles_of(S5W, D), t5 = t4 + cvt_tiles_of(D, EVIN - IN0_NQ);
    if (tile < t0) { j = 0; local = tile; } else if (tile < t1) { j = 1; local = tile - t0; } else if (tile < t2) { j = 2; local = tile - t1; } else if (tile < t3) { j = 3; local = tile - t2; }
    else if (tile < t4) { j = 4; local = tile - t3; } else if (tile < t5) { j = 5; local = tile - t4; } else { const long q = tile - t5, per = cvt_tiles_of(D, FF); j = 6 + (int)(q / per); local = q % per; }
}
#ifndef CPU_EMU
constexpr int CVT_PITCH = 257, CVT_LDS_BYTES = 128 * 129 * 4;
struct CvtSrc { const float* src; int N, fp8; };
__device__ __forceinline__ CvtSrc cvt_src(const Params& p, long t) { int j; long loc; cvt_find(t, j, loc); const CvtJob L = cvt_job(p, j); CvtSrc S; S.N = L.ld; S.fp8 = L.fp8;
    if (L.fp8) { const int tn8 = L.N / 128, k0 = (int)(loc / tn8) * 128, n0 = (int)(loc % tn8) * 128; S.src = L.src + (size_t)k0 * L.ld + n0; }
    else { const int tn = L.N / 256, k0 = (int)(loc / tn) * 64, n0 = (int)(loc % tn) * 256; S.src = L.src + (size_t)k0 * L.ld + n0; }
    return S; }
__device__ __forceinline__ f32x4 cvt_load(const CvtSrc& S, int tid, int i) { const int q = tid + 512 * i, kk = S.fp8 ? q >> 5 : q >> 6, n4 = S.fp8 ? (q & 31) * 4 : (q & 63) * 4; return *(const f32x4*)(S.src + (size_t)kk * S.N + n4); }
__device__ __forceinline__ void ph_convert(const Params& p, float* tile, long t_end, int max_tiles, int wv_) {
    const int tid = tid_of(wv_); int* ctr = (int*)(p.ws + WS_CNT) + 128; LAS int* tsh = (LAS int*)((LAS unsigned char*)tile + CVT_LDS_BYTES);
    (void)max_tiles;
    int pend = 0, par = 0;
    __syncthreads();
    if (tid == 0) { const int a0 = atomicAdd(ctr, 1), a1 = atomicAdd(ctr, 1); pend = atomicAdd(ctr, 1); tsh[0] = a0; tsh[1] = a1; }
    __syncthreads();
    long t = tsh[0], tn = tsh[1];
    f32x4 R[8];
    if (t < t_end) { const CvtSrc S = cvt_src(p, t);
#pragma unroll
        for (int i = 0; i < 8; ++i) R[i] = cvt_load(S, tid, i); }
    while (t < t_end) {
        int j; long local; cvt_find(t, j, local); const CvtJob J = cvt_job(p, j);
        const bool more = tn < t_end; const CvtSrc SN = cvt_src(p, more ? tn : t);
#pragma unroll
        for (int i = 0; i < 8; ++i) {
            if (J.fp8) { const int q = tid + 512 * i, kk = q >> 5, n4 = (q & 31) * 4; *(f32x4*)(tile + kk * 128 + (n4 ^ (((kk >> 4) & 3) << 4))) = R[i]; }
            else { const int q = tid + 512 * i, kk = q >> 6, n4 = (q & 63) * 4; tile[kk * CVT_PITCH + n4] = R[i][0]; tile[kk * CVT_PITCH + n4 + 1] = R[i][1]; tile[kk * CVT_PITCH + n4 + 2] = R[i][2]; tile[kk * CVT_PITCH + n4 + 3] = R[i][3]; }
        }
        if (tid == 0) { tsh[2 + par] = pend; pend = atomicAdd(ctr, 1); }
        __syncthreads();
        const long tnn = tsh[2 + par]; par ^= 1;
        if (more) {
#pragma unroll
            for (int i = 0; i < 8; ++i) R[i] = cvt_load(SN, tid, i); }
        if (J.fp8) {
            const int tn8 = J.N / 128, k0 = (int)(local / tn8) * 128, n0 = (int)(local % tn8) * 128;
            const float wsc = (OUT0_FP8 && j == 1 && k0 < QW) ? W8_SCALE / MIX8_SCALE : W8_SCALE;
#pragma unroll
            for (int i = 0; i < 2; ++i) { const int lane = tid & 63, nn = 64 * i + 8 * (tid >> 6) + (lane & 7), kg = lane >> 3, kgl = kg & 3; const float* tp = tile + (16 * kg) * 128 + (nn ^ (kgl << 4)); u4v_t w;
#pragma unroll
                for (int d4 = 0; d4 < 4; ++d4) { int pk = 0; pk = __builtin_amdgcn_cvt_pk_fp8_f32(tp[(4 * d4) * 128] * wsc, tp[(4 * d4 + 1) * 128] * wsc, pk, false);
                    pk = __builtin_amdgcn_cvt_pk_fp8_f32(tp[(4 * d4 + 2) * 128] * wsc, tp[(4 * d4 + 3) * 128] * wsc, pk, true); w[d4] = (unsigned)pk; }
                *(u4v_t*)((unsigned char*)J.dst + (size_t)cvt_rowmap(J.mode, n0 + nn) * J.K + k0 + 16 * kg) = w; }
        } else {
            const int tnn_ = J.N / 256, k0 = (int)(local / tnn_) * 64, n0 = (int)(local % tnn_) * 256;
#pragma unroll
            for (int i = 0; i < 4; ++i) { const int q = tid + 512 * i, nn = q >> 3, k8 = (q & 7) * 8; const float* tp = tile + k8 * CVT_PITCH + nn;
                u4v_t w = {pack2bf(tp[0], tp[CVT_PITCH]), pack2bf(tp[2 * CVT_PITCH], tp[3 * CVT_PITCH]), pack2bf(tp[4 * CVT_PITCH], tp[5 * CVT_PITCH]), pack2bf(tp[6 * CVT_PITCH], tp[7 * CVT_PITCH])};
                *(u4v_t*)(J.dst + (size_t)cvt_rowmap(J.mode, n0 + nn) * J.K + k0 + k8) = w; }
        }
        __syncthreads();
        t = tn; tn = tnn;
    }
}
#else
void ph_convert_emu(const Params& p) {
    for (int j = 0; j < NJOBS; ++j) { const CvtJob J = cvt_job(p, j);
        for (int n = 0; n < J.N; ++n) { bf16_t* dr = J.dst + (size_t)cvt_rowmap(J.mode, n) * J.K; for (int k = 0; k < J.K; ++k) dr[k] = f2bf(J.src[(size_t)k * J.ld + n]); } }
}
#endif

namespace pg8 {
constexpr int BM = 256, BK = 64, HALF = 128, HTB = HALF * BK * 2  , STAGE_BYTES = 8 * HTB, NXCD = 8, WGM = 8;
struct Unit { int pm, pn, e; };
struct Gemm { const bf16_t* A; const bf16_t* Bt; int M, N, K; int sc_w = 0, sc_a = 0; };
__host__ __device__ __forceinline__ int lds_byte(int r, int c) { const int st = (r >> 4) * 2 + (c >> 5), rr = r & 15, cc = c & 31, ob = rr * 64 + cc * 2; return st * 1024 + (ob ^ (((ob >> 9) & 1) << 5)); }
__host__ __device__ __forceinline__ void stage_rc(int b, int& R, int& C) { const int st = b / 1024, sb = b % 1024, swz = sb ^ (((sb >> 9) & 1) << 5); R = (st >> 1) * 16 + swz / 64; C = (st & 1) * 32 + (swz % 64) / 2; }
__host__ __device__ __forceinline__ int perm32(int rho) { const int n = rho >> 4, i = rho & 15; return 8 * (i >> 2) + 4 * n + (i & 3); }

struct StaticOrder {
    static constexpr bool GATHER = false;
    int nM, nN, nwg, G, c;
    __host__ __device__ void init(int M, int N, int G_, int c_) { nM = M / BM; nN = N / BM; nwg = nM * nN; G = G_; c = c_; }
    __host__ __device__ bool next(int i, Unit& u) const {
        const long L = (long)i * G + c; if (L >= nwg) return false;
        int wgid = (int)L; { const int q = nwg / NXCD, r = nwg % NXCD, xcd = wgid % NXCD, off = wgid / NXCD; wgid = (xcd < r ? xcd * (q + 1) : r * (q + 1) + (xcd - r) * q) + off; }
        const int nig = WGM * nN, gid = wgid / nig, fm = gid * WGM, gsz = (nM - fm) < WGM ? (nM - fm) : WGM;
        u.pm = fm + ((wgid % nig) % gsz); u.pn = (wgid % nig) / gsz; u.e = 0; return true;
    }
    __device__ __forceinline__ const char* b_base(const Gemm& g, const Unit& u) const { return (const char*)g.Bt + (size_t)u.pn * ((size_t)BM * g.K * 2); }
    __device__ __forceinline__ int a_row(const Unit& u, int rr) const { return u.pm * BM + rr; }
};
template <bool ROWS> struct MoeOrder {
    static constexpr bool GATHER = ROWS;
    int nN, nwg, G, c; const int* cnt; const int* rowidx; size_t estride;
    __device__ void init(const int* cnt_, int N, int G_, int c_, const int* rowidx_, size_t estride_) { int acc = 0; cnt = cnt_;
#pragma unroll
        for (int e = 0; e < NE; ++e) acc += (cnt[e] + 255) / 256 * 256;
        nN = N / BM; nwg = (acc / 256) * nN; G = G_; c = c_; rowidx = rowidx_; estride = estride_; }
    __device__ bool next(int i, Unit& u) const { const long L = (long)i * G + c; if (L >= nwg) return false; u.pm = (int)(L / nN); u.pn = (int)(L % nN); int e = 0, acc = 0;
#pragma unroll
        for (int j = 0; j < NE - 1; ++j) { acc += (cnt[j] + 255) / 256 * 256; e += (u.pm * 256 >= acc) ? 1 : 0; }
        u.e = e; return true; }
    __device__ __forceinline__ const char* b_base(const Gemm& g, const Unit& u) const { return (const char*)g.Bt + (size_t)u.e * estride + (size_t)u.pn * ((size_t)BM * g.K * 2); }
    __device__ __forceinline__ int a_row(const Unit& u, int rr) const { return ROWS ? ld_coh(rowidx + u.pm * BM + rr) : u.pm * BM + rr; }
    __device__ __forceinline__ const int* a_row_ptr(const Unit& u, int rr) const { return rowidx + u.pm * BM + rr; }
};

#ifdef CPU_EMU
typedef unsigned char* LdsPtr;
#else
#define PG8_LAS __attribute__((address_space(3)))
typedef PG8_LAS unsigned char* LdsPtr;
typedef short bf16x8 __attribute__((ext_vector_type(8)));
typedef unsigned u32x4 __attribute__((ext_vector_type(4)));
typedef int pg8_v4i __attribute__((ext_vector_type(4)));
typedef int pg8_v8i __attribute__((ext_vector_type(8)));
template <class Epi, class Sched, bool F8 = false>
__device__ __forceinline__ void gemm_phase(LdsPtr lds, const Gemm g, const Sched& S, const Epi& E, int wv_) {
    const int tid = tid_of(wv_), wid = wv_, lane = tid & 63, wr = wid >> 2, wc = wid & 3, fr = lane & 15, fq = lane >> 4;
    const int K = g.K, nt = K / BK;
    unsigned voffB[2]; int RA[2], CA[2];
#pragma unroll
    for (int i = 0; i < 2; ++i) { int R, C; stage_rc(tid * 16 + i * 8192, R, C); const int Rb = Epi::PERM ? ((R & ~31) + perm32(R & 31)) : R;
        RA[i] = R; CA[i] = C; voffB[i] = (unsigned)(Rb * K + C) * 2u; }
    const size_t kstep = (size_t)(BK * 2);
    const size_t hstep = (size_t)HALF * K * 2;
    const unsigned ldsw = (unsigned)wid * 1024u;
    const int aoff = F8 ? lds_byte(wr * 64 + fr, fq * 16) + ((fq & 1) << 4) : lds_byte(wr * 64 + fr, fq * 8), boff = F8 ? lds_byte(wc * 32 + fr, fq * 16) + ((fq & 1) << 4) : lds_byte(wc * 32 + fr, fq * 8);
    const int sc_both = (g.sc_w & 0xff) | ((g.sc_a & 0xff) << 8);
    const int koff = F8 ? (16 - ((fq & 1) << 5)) : 1024;
#define PG8_SA(b, h) (((b) * 2 + (h)) * HTB)
#define PG8_SB(b, h) ((4 + (b) * 2 + (h)) * HTB)
#define PG8_STAGE(bufoff, gbase, voff) do { _Pragma("unroll") for (int _i = 0; _i < 2; ++_i) \
        __builtin_amdgcn_global_load_lds((const unsigned*)((const char*)(gbase) + (voff)[_i]), (PG8_LAS unsigned*)(lds + (bufoff) + ldsw + _i * 8192), 16, 0, 0); } while (0)
#define PG8_LD8(dst, addr) do { const pg8_v4i lo_ = *(const PG8_LAS pg8_v4i*)(addr), hi_ = *(const PG8_LAS pg8_v4i*)((addr) + koff); dst = __builtin_shufflevector(lo_, hi_, 0, 1, 2, 3, 4, 5, 6, 7); } while (0)
#define PG8_LDA(dst, b, h) do { if constexpr (F8) { _Pragma("unroll") for (int m = 0; m < 4; ++m) PG8_LD8(dst##8[m], lds + PG8_SA(b, h) + aoff + m * 2048); } \
        else { _Pragma("unroll") for (int m = 0; m < 4; ++m) _Pragma("unroll") for (int k = 0; k < 2; ++k) dst[m][k] = *(const PG8_LAS bf16x8*)(lds + PG8_SA(b, h) + aoff + m * 2048 + k * koff); } } while (0)
#define PG8_LDB(dst, b, h) do { if constexpr (F8) { _Pragma("unroll") for (int n = 0; n < 2; ++n) PG8_LD8(dst##8[n], lds + PG8_SB(b, h) + boff + n * 2048); } \
        else { _Pragma("unroll") for (int n = 0; n < 2; ++n) _Pragma("unroll") for (int k = 0; k < 2; ++k) dst[n][k] = *(const PG8_LAS bf16x8*)(lds + PG8_SB(b, h) + boff + n * 2048 + k * koff); } } while (0)
#define PG8_MMA(ai, bj, At, Bt) do { __builtin_amdgcn_s_setprio(1); \
        if constexpr (F8) { _Pragma("unroll") for (int m = 0; m < 4; ++m) _Pragma("unroll") for (int n = 0; n < 2; ++n) \
            acc[ai][bj][m][n] = __builtin_amdgcn_mfma_scale_f32_16x16x128_f8f6f4(Bt##8[n], At##8[m], acc[ai][bj][m][n], 0, 0, 0, sc_both, 1, sc_both); } \
        else { _Pragma("unroll") for (int m = 0; m < 4; ++m) _Pragma("unroll") for (int n = 0; n < 2; ++n) _Pragma("unroll") for (int k = 0; k < 2; ++k) \
            acc[ai][bj][m][n] = __builtin_amdgcn_mfma_f32_16x16x32_bf16(Bt[n][k], At[m][k], acc[ai][bj][m][n], 0, 0, 0); } \
        __builtin_amdgcn_s_setprio(0); } while (0)
#define PG8_WAIT_V(n) asm volatile("s_waitcnt vmcnt(" #n ")" ::: "memory")
#define PG8_WAIT_L(n) asm volatile("s_waitcnt lgkmcnt(" #n ")" ::: "memory")
#define PG8_BAR __builtin_amdgcn_s_barrier()
#define PG8_SCHED __builtin_amdgcn_sched_barrier(0)
#define PG8_VOFFA(dst, U) do { _Pragma("unroll") for (int _h = 0; _h < 2; ++_h) _Pragma("unroll") for (int _i = 0; _i < 2; ++_i) \
        dst[_h][_i] = (unsigned)((size_t)S.a_row(U, _h * HALF + RA[_i]) * K + CA[_i]) * 2u; } while (0)
    Unit cur, nxt; int ui = 0;
    if (!S.next(0, cur)) return;
    f32x4 acc[2][2][4][2];
#pragma unroll
    for (int a = 0; a < 2; ++a)
#pragma unroll
        for (int b = 0; b < 2; ++b)
#pragma unroll
            for (int m = 0; m < 4; ++m)
#pragma unroll
                for (int n = 0; n < 2; ++n) acc[a][b][m][n] = (f32x4){0.f, 0.f, 0.f, 0.f};
    bf16x8 At[4][2], B0[2][2], B1[2][2];
    pg8_v8i At8[4], B08[2], B18[2];
    unsigned vA[2][2];
    PG8_VOFFA(vA, cur);
    const char* cA = (const char*)g.A; const char* cB = S.b_base(g, cur);
    PG8_STAGE(PG8_SB(0, 0), cB, voffB); PG8_STAGE(PG8_SB(0, 1), cB + hstep, voffB); PG8_STAGE(PG8_SA(0, 0), cA, vA[0]); PG8_STAGE(PG8_SA(0, 1), cA, vA[1]);
    if (wr == 1) PG8_BAR;
    PG8_WAIT_V(2); PG8_BAR;
    PG8_STAGE(PG8_SB(1, 0), cB + kstep, voffB); PG8_STAGE(PG8_SA(1, 0), cA + kstep, vA[0]); PG8_STAGE(PG8_SB(1, 1), cB + hstep + kstep, voffB);
    PG8_WAIT_V(6); PG8_BAR;
    for (;;) {
        const bool has_next = S.next(ui + 1, nxt);
#ifndef CPU_EMU
        if constexpr (Sched::GATHER) { if (has_next) {
#pragma unroll
            for (int _h = 0; _h < 2; ++_h)
#pragma unroll
                for (int _i = 0; _i < 2; ++_i)
                    __builtin_amdgcn_global_load_lds((const unsigned*)S.a_row_ptr(nxt, _h * HALF + RA[_i]), (PG8_LAS unsigned*)(lds + STAGE_BYTES + 2048 + (_h * 2 + _i) * 2048 + wid * 256), 4, 0, 16); } }
#endif
        const char* nB = has_next ? S.b_base(g, nxt) : cB;
        for (int t = 0; t < nt; t += 2) {
            const bool last = (t == nt - 2);
            const char* a1 = cA + (size_t)(t + 1) * kstep;
            const char* a2 = last ? cA : cA + (size_t)(t + 2) * kstep; const char* b2 = last ? nB : cB + (size_t)(t + 2) * kstep;
            const char* a3 = a2 + kstep; const char* b3 = b2 + kstep;
            PG8_LDB(B0, 0, 0); PG8_LDB(B1, 0, 1); PG8_SCHED; PG8_LDA(At, 0, 0); PG8_STAGE(PG8_SA(1, 1), a1, vA[1]);
            if (last && has_next) {
                if constexpr (Sched::GATHER) { if (nt < 4) PG8_WAIT_V(0);
#pragma unroll
                    for (int _h = 0; _h < 2; ++_h)
#pragma unroll
                        for (int _i = 0; _i < 2; ++_i) { const int row_ = *(const PG8_LAS int*)(lds + STAGE_BYTES + 2048 + (_h * 2 + _i) * 2048 + wid * 256 + lane * 4);
                            vA[_h][_i] = (unsigned)((size_t)row_ * K + CA[_i]) * 2u; } }
                else { PG8_VOFFA(vA, nxt); } }
            PG8_WAIT_V(8); PG8_WAIT_L(0); PG8_BAR; PG8_MMA(0, 0, At, B0); PG8_MMA(0, 1, At, B1); PG8_BAR; PG8_SCHED;
            PG8_LDA(At, 0, 1); PG8_STAGE(PG8_SB(0, 0), b2, voffB); PG8_STAGE(PG8_SB(0, 1), b2 + hstep, voffB); PG8_STAGE(PG8_SA(0, 0), a2, vA[0]);
            PG8_WAIT_V(8); PG8_WAIT_L(0); PG8_BAR; PG8_MMA(1, 0, At, B0); PG8_MMA(1, 1, At, B1); PG8_BAR; PG8_SCHED;
            PG8_LDB(B0, 1, 0); PG8_LDB(B1, 1, 1); PG8_SCHED; PG8_LDA(At, 1, 0); PG8_STAGE(PG8_SA(0, 1), a2, vA[1]);
            PG8_WAIT_V(8); PG8_WAIT_L(0); PG8_BAR; PG8_MMA(0, 0, At, B0); PG8_MMA(0, 1, At, B1); PG8_BAR; PG8_SCHED;
            PG8_LDA(At, 1, 1); PG8_STAGE(PG8_SB(1, 0), b3, voffB); PG8_STAGE(PG8_SB(1, 1), b3 + hstep, voffB); PG8_STAGE(PG8_SA(1, 0), a3, vA[0]);
            PG8_WAIT_V(8); PG8_WAIT_L(0); PG8_BAR; PG8_MMA(1, 0, At, B0); PG8_MMA(1, 1, At, B1); PG8_BAR; PG8_SCHED;
        }
        if (wr == 0) PG8_BAR;
        E(acc, cur, wr, wc, fr, fq);
        if (!has_next) break;
#pragma unroll
        for (int a = 0; a < 2; ++a)
#pragma unroll
            for (int b = 0; b < 2; ++b)
#pragma unroll
                for (int m = 0; m < 4; ++m)
#pragma unroll
                    for (int n = 0; n < 2; ++n) acc[a][b][m][n] = (f32x4){0.f, 0.f, 0.f, 0.f};
        cur = nxt; cB = nB; ++ui;
        if (wr == 1) PG8_BAR;
    }
    PG8_WAIT_V(0);
    PG8_BAR;
#undef PG8_SA
#undef PG8_SB
#undef PG8_STAGE
#undef PG8_LDA
#undef PG8_LDB
#undef PG8_MMA
#undef PG8_LD8
#undef PG8_WAIT_V
#undef PG8_WAIT_L
#undef PG8_BAR
#undef PG8_SCHED
#undef PG8_VOFFA
}
#endif
}

typedef f32x4 AccT[2][2][4][2];

struct EpiQKV {
    static constexpr bool PERM = false;
    bf16_t* O; const float* rope; bf16_t* VT; int pn0 = 0;
    __device__ __forceinline__ void operator()(const AccT& acc, const pg8::Unit& u, int wr, int wc, int fr, int fq) const {
        const int colt = (u.pn + pn0) * 256; const bool is_q = colt < COL_K, is_k = colt >= COL_K && colt < COL_V, is_v = colt >= COL_V && colt < COL_XR;
#pragma unroll
        for (int ai = 0; ai < 2; ++ai) {
            f32x4 rp[4][2];
            if (is_q || is_k) {
#pragma unroll
                for (int m = 0; m < 4; ++m) { const int r = u.pm * 256 + ai * 128 + wr * 64 + m * 16 + fr, t = r % NSEQ, pos = (wc & 1) ? (t % 64) : (t / 64);
                    rp[m][0] = *(const f32x4*)(rope + (pos * 16 + 4 * fq) * 2); rp[m][1] = *(const f32x4*)(rope + (pos * 16 + 4 * fq) * 2 + 4); }
#ifndef CPU_EMU
                asm volatile("" ::: "memory");
#endif
            }
#pragma unroll
            for (int m = 0; m < 4; ++m) {
                const int r = u.pm * 256 + ai * 128 + wr * 64 + m * 16 + fr; const bool lat = r < ML; const int t = r % NSEQ;
#pragma unroll
                for (int bj = 0; bj < 2; ++bj) {
                    const int cg = colt + bj * 128 + wc * 32;
                    f32x4 v0 = acc[ai][bj][m][0], v1 = acc[ai][bj][m][1];
                    if ((is_q || is_k) && lat) {
#pragma unroll
                        for (int j = 0; j < 4; ++j) { const float cs = rp[m][j >> 1][(j & 1) * 2], sn = rp[m][j >> 1][(j & 1) * 2 + 1]; const float a = v0[j], b = v1[j]; v0[j] = a * cs - b * sn; v1[j] = b * cs + a * sn; }
                    }
                    if (is_q) { v0 *= 0.125f; v1 *= 0.125f; }
                    bf16_t* rowp = O + (size_t)r * EVIN + cg + 4 * fq;
                    u32x2_t w0, w1; w0.x = pack2bf(v0[0], v0[1]); w0.y = pack2bf(v0[2], v0[3]); w1.x = pack2bf(v1[0], v1[1]); w1.y = pack2bf(v1[2], v1[3]);
                    *(u32x2_t*)rowp = w0; *(u32x2_t*)(rowp + 16) = w1;
                    if (is_v) {
                        const int bb = lat ? r / NSEQ : (r - ML) / NCTX, tt = lat ? t : (r - ML) % NCTX, k16 = tt & 15, kp = (k16 & 3) | ((k16 & 4) << 1) | ((k16 & 8) >> 1);
                        const int pos = (lat ? 128 : 128 + NSEQ + 128) + (tt & ~15) + kp, vc = cg - COL_V + 4 * fq;
                        bf16_t* vp = VT + ((size_t)bb * 256 + vc) * VT_T + pos;
#pragma unroll
                        for (int j = 0; j < 4; ++j) { vp[(size_t)j * VT_T] = f2bf(v0[j]); vp[(size_t)(16 + j) * VT_T] = f2bf(v1[j]); }
                    }
                }
            }
        }
    }
};
template <bool IN16, bool OUT16> struct EpiResidT {
    static constexpr bool PERM = false;
    const float* xin_lat; const float* xin_ctx; float* xout; const float* gate;
    __device__ __forceinline__ void operator()(const AccT& acc, const pg8::Unit& u, int wr, int wc, int fr, int fq) const {
        const int row0 = u.pm * 256, arow = row0 < ML ? row0 / NSEQ : NB; const float* gp = gate + (size_t)arow * ADA6;
        const int col0 = u.pn * 256 + wc * 32 + 4 * fq;
        f32x4 gv[2][2];
#pragma unroll
        for (int bj = 0; bj < 2; ++bj)
#pragma unroll
            for (int n = 0; n < 2; ++n) gv[bj][n] = *(const f32x4*)(gp + col0 + bj * 128 + n * 16);
#pragma unroll
        for (int ai = 0; ai < 2; ++ai) {
            f32x4 xi[4][2][2];
#pragma unroll
            for (int m = 0; m < 4; ++m) { const int r = row0 + ai * 128 + wr * 64 + m * 16 + fr;
                const size_t io = (r < ML ? (size_t)r * D : (size_t)(r - ML) * D) + col0; const float* ib = r < ML ? xin_lat : xin_ctx;
#pragma unroll
                for (int bj = 0; bj < 2; ++bj)
#pragma unroll
                    for (int n = 0; n < 2; ++n) {
                        if (IN16) { const u32x2_t t = *(const u32x2_t*)((const bf16_t*)ib + io + bj * 128 + n * 16); xi[m][bj][n] = unpack4bf(t.x, t.y); } else xi[m][bj][n] = *(const f32x4*)(ib + io + bj * 128 + n * 16); } }
#ifndef CPU_EMU
            asm volatile("" ::: "memory");
#endif
#pragma unroll
            for (int m = 0; m < 4; ++m) { const int r = row0 + ai * 128 + wr * 64 + m * 16 + fr; const size_t oo = (size_t)r * D + col0;
#pragma unroll
                for (int bj = 0; bj < 2; ++bj)
#pragma unroll
                    for (int n = 0; n < 2; ++n) { const f32x4 xo = xi[m][bj][n] + gv[bj][n] * acc[ai][bj][m][n];
                        if (OUT16) { u32x2_t t; t.x = pack2bf(xo[0], xo[1]); t.y = pack2bf(xo[2], xo[3]); *(u32x2_t*)((bf16_t*)xout + oo + bj * 128 + n * 16) = t; } else *(f32x4*)(xout + oo + bj * 128 + n * 16) = xo; } }
        }
    }
};
typedef EpiResidT<false, RES_BF16> EpiResid0;
typedef EpiResidT<RES_BF16, RES_BF16> EpiResid;
struct EpiBf16 {
    static constexpr bool PERM = true;
    bf16_t* O; int ldc;
    __device__ __forceinline__ void operator()(const AccT& acc, const pg8::Unit& u, int wr, int wc, int fr, int fq) const {
        const int col0 = u.pn * 256 + wc * 32 + 8 * fq;
#pragma unroll
        for (int ai = 0; ai < 2; ++ai)
#pragma unroll
            for (int m = 0; m < 4; ++m) { bf16_t* rowp = O + (size_t)(u.pm * 256 + ai * 128 + wr * 64 + m * 16 + fr) * ldc + col0;
#pragma unroll
                for (int bj = 0; bj < 2; ++bj) { const f32x4 v0 = acc[ai][bj][m][0], v1 = acc[ai][bj][m][1];
                    u32x4_t w; w.x = pack2bf(v0[0], v0[1]); w.y = pack2bf(v0[2], v0[3]); w.z = pack2bf(v1[0], v1[1]); w.w = pack2bf(v1[2], v1[3]);
                    *(u32x4_t*)(rowp + bj * 128) = w; } }
    }
};
#ifndef CPU_EMU
struct EpiY8 {
    static constexpr bool PERM = true;
    unsigned char* O; int ldc;
    __device__ __forceinline__ void operator()(const AccT& acc, const pg8::Unit& u, int wr, int wc, int fr, int fq) const {
        const int col0 = u.pn * 256 + wc * 32 + 8 * fq;
#pragma unroll
        for (int ai = 0; ai < 2; ++ai)
#pragma unroll
            for (int m = 0; m < 4; ++m) { unsigned char* rowp = O + (size_t)(u.pm * 256 + ai * 128 + wr * 64 + m * 16 + fr) * ldc + col0;
#pragma unroll
                for (int bj = 0; bj < 2; ++bj) { const f32x4 v0 = acc[ai][bj][m][0] * Y8_SCALE, v1 = acc[ai][bj][m][1] * Y8_SCALE;
                    u32x2_t w; w.x = pack4_fp8(v0[0], v0[1], v0[2], v0[3]); w.y = pack4_fp8(v1[0], v1[1], v1[2], v1[3]);
                    *(u32x2_t*)(rowp + bj * 128) = w; } }
    }
};
#endif
struct EpiGU {
    static constexpr bool PERM = true;
    bf16_t* O;
    __device__ __forceinline__ void operator()(const AccT& acc, const pg8::Unit& u, int wr, int wc, int fr, int fq) const {
        const int col0 = u.pn * 128 + wc * 32 + 8 * fq;
#pragma unroll
        for (int ai = 0; ai < 2; ++ai)
#pragma unroll
            for (int m = 0; m < 4; ++m) { bf16_t* rowp = O + (size_t)(u.pm * 256 + ai * 128 + wr * 64 + m * 16 + fr) * FF + col0;
                float o[8];
#pragma unroll
                for (int n = 0; n < 2; ++n)
#pragma unroll
                    for (int j = 0; j < 4; ++j) { const float gt = acc[ai][0][m][n][j], up = acc[ai][1][m][n][j]; o[n * 4 + j] = siluf_(gt) * up; }
                u32x4_t w; w.x = pack2bf(o[0], o[1]); w.y = pack2bf(o[2], o[3]); w.z = pack2bf(o[4], o[5]); w.w = pack2bf(o[6], o[7]);
                *(u32x4_t*)rowp = w; }
    }
};
#ifndef CPU_EMU
struct EpiGU8 {
    static constexpr bool PERM = true;
    unsigned char* O;
    __device__ __forceinline__ void operator()(const AccT& acc, const pg8::Unit& u, int wr, int wc, int fr, int fq) const {
        const int col0 = u.pn * 128 + wc * 32 + 8 * fq;
#pragma unroll
        for (int ai = 0; ai < 2; ++ai)
#pragma unroll
            for (int m = 0; m < 4; ++m) { unsigned char* rowp = O + (size_t)(u.pm * 256 + ai * 128 + wr * 64 + m * 16 + fr) * FF + col0;
                float o[8];
#pragma unroll
                for (int n = 0; n < 2; ++n)
#pragma unroll
                    for (int j = 0; j < 4; ++j) { const float gt = acc[ai][0][m][n][j], up = acc[ai][1][m][n][j]; o[n * 4 + j] = siluf_(gt) * up * ACT8_SCALE; }
                u32x2_t w; w.x = pack4_fp8(o[0], o[1], o[2], o[3]); w.y = pack4_fp8(o[4], o[5], o[6], o[7]);
                *(u32x2_t*)rowp = w; }
    }
};
#endif
struct EpiGLU {
    static constexpr bool PERM = true;
    const bf16_t* Z; bf16_t* O; const float* bias;
    __device__ __forceinline__ void operator()(const AccT& acc, const pg8::Unit& u, int wr, int wc, int fr, int fq) const {
        const int col0 = u.pn * 256 + wc * 32 + 8 * fq;
#pragma unroll
        for (int ai = 0; ai < 2; ++ai)
#pragma unroll
            for (int m = 0; m < 4; ++m) { const size_t ro = (size_t)(u.pm * 256 + ai * 128 + wr * 64 + m * 16 + fr) * S5W + col0;
#pragma unroll
                for (int bj = 0; bj < 2; ++bj) { const u32x4_t zz = *(const u32x4_t*)(Z + ro + bj * 128); const unsigned zw[4] = {zz.x, zz.y, zz.z, zz.w}; float o[8];
#pragma unroll
                    for (int n = 0; n < 2; ++n)
#pragma unroll
                        for (int j = 0; j < 4; ++j) { const int q = n * 4 + j; const float zv = __uint_as_float((q & 1) ? (zw[q >> 1] & 0xffff0000u) : (zw[q >> 1] << 16));
                            o[q] = zv * sigmoidf_(acc[ai][bj][m][n][j] + bias[col0 + bj * 128 + q]); }
                    u32x4_t w; w.x = pack2bf(o[0], o[1]); w.y = pack2bf(o[2], o[3]); w.z = pack2bf(o[4], o[5]); w.w = pack2bf(o[6], o[7]);
                    *(u32x4_t*)(O + ro + bj * 128) = w; } }
    }
};

#ifndef CPU_EMU
struct EpiGLU8 {
    static constexpr bool PERM = true;
    const unsigned char* Z; unsigned char* O; const float* bias;
    __device__ __forceinline__ void operator()(const AccT& acc, const pg8::Unit& u, int wr, int wc, int fr, int fq) const {
        const int col0 = u.pn * 256 + wc * 32 + 8 * fq;
        u32x2_t zall[2][4][2]; f32x4 bv[2][2];
#pragma unroll
        for (int bj = 0; bj < 2; ++bj)
#pragma unroll
            for (int n = 0; n < 2; ++n) bv[bj][n] = *(const f32x4*)(bias + col0 + bj * 128 + n * 4);
#pragma unroll
        for (int ai = 0; ai < 2; ++ai)
#pragma unroll
            for (int m = 0; m < 4; ++m) { const size_t ro = (size_t)(u.pm * 256 + ai * 128 + wr * 64 + m * 16 + fr) * S5W + col0;
#pragma unroll
                for (int bj = 0; bj < 2; ++bj) zall[ai][m][bj] = *(const u32x2_t*)(Z + ro + bj * 128); }
        asm volatile("" ::: "memory");
#pragma unroll
        for (int ai = 0; ai < 2; ++ai)
#pragma unroll
            for (int m = 0; m < 4; ++m) { const size_t ro = (size_t)(u.pm * 256 + ai * 128 + wr * 64 + m * 16 + fr) * S5W + col0;
#pragma unroll
                for (int bj = 0; bj < 2; ++bj) { const u32x2_t zz = zall[ai][m][bj]; float o[8];
#pragma unroll
                    for (int n = 0; n < 2; ++n) { const int zw = (int)(n ? zz.y : zz.x);
                        const float z0 = __builtin_amdgcn_cvt_f32_fp8(zw, 0), z1 = __builtin_amdgcn_cvt_f32_fp8(zw, 1), z2 = __builtin_amdgcn_cvt_f32_fp8(zw, 2), z3 = __builtin_amdgcn_cvt_f32_fp8(zw, 3); const float zv[4] = {z0, z1, z2, z3};
#pragma unroll
                        for (int j = 0; j < 4; ++j) { const int q = n * 4 + j; o[q] = zv[j] * (S8_SCALE / Z8_SCALE) * sigmoidf_(acc[ai][bj][m][n][j] + bv[bj][n][j]); } }
                    u32x2_t w; w.x = pack4_fp8(o[0], o[1], o[2], o[3]); w.y = pack4_fp8(o[4], o[5], o[6], o[7]);
                    *(u32x2_t*)(O + ro + bj * 128) = w; } }
    }
};
#endif

enum { G_IN0 = 0, G_OUT0, G_GU, G_DN, G_IN1, G_GLU, G_OUT1, G_GU8, G_DN8, G_IN18, G_GLU8, G_OUT18, G_IN08, G_OUT08, G_IN0SPLIT };
#ifdef CPU_EMU
namespace pg8 {
template <class Epi, class Sched> void gemm_phase(LdsPtr, const Gemm g, const Sched& S, const Epi& E, int) {
    Unit u; std::vector<float> C(256 * 256), af(g.K), bfv((size_t)256 * g.K);
    for (int i = 0; S.next(i, u); ++i) {
        const bf16_t* Bb = (const bf16_t*)S.b_base(g, u);
        for (size_t q = 0; q < (size_t)256 * g.K; ++q) bfv[q] = bf2f(Bb[q]);
        for (int r = 0; r < 256; ++r) { const bf16_t* a = g.A + (size_t)S.a_row(u, r) * g.K; for (int k = 0; k < g.K; ++k) af[k] = bf2f(a[k]);
            for (int cc = 0; cc < 256; ++cc) { const float* bp = &bfv[(size_t)cc * g.K]; float s = 0.f; for (int k = 0; k < g.K; ++k) s += af[k] * bp[k]; C[r * 256 + cc] = s; } }
        for (int tid = 0; tid < 512; ++tid) { const int wid = tid >> 6, lane = tid & 63, wr = wid >> 2, wc = wid & 3, fr = lane & 15, fq = lane >> 4;
            f32x4 acc[2][2][4][2];
            for (int ai = 0; ai < 2; ++ai) for (int bj = 0; bj < 2; ++bj) for (int m = 0; m < 4; ++m) for (int n = 0; n < 2; ++n) for (int j = 0; j < 4; ++j) {
                const int r = 128 * ai + 64 * wr + 16 * m + fr, cc = Epi::PERM ? 128 * bj + 32 * wc + 8 * fq + 4 * n + j : 128 * bj + 32 * wc + 16 * n + 4 * fq + j;
                acc[ai][bj][m][n][j] = C[r * 256 + cc]; }
            E(acc, u, wr, wc, fr, fq); }
    }
}
}
#endif
#ifndef CPU_EMU
template <class Sched> __device__ __forceinline__ void gemm_stagger(const Sched& S, int tile_us) {
    const int rem = S.nwg % S.G; if (rem == 0 || S.c < rem) return;
    const int units = (int)((long)(S.c - rem) * tile_us * 4 / (5 * (S.G - rem)));
    for (int i = 0; i < units; ++i) __builtin_amdgcn_s_sleep(32);
}
#else
template <class Sched> void gemm_stagger(const Sched&, int) {}
#endif
template <int WHICH> __device__ __forceinline__ void run_gemm(const Params& p, int l, pg8::LdsPtr lds, int G, int c, int wv_ = 0) {
    unsigned char* ws = p.ws; pg8::Gemm g;
    if constexpr (WHICH == G_IN0) { g.A = (const bf16_t*)(ws + WS_H); g.Bt = (const bf16_t*)(ws + WS_WT_IN0); g.M = MT; g.N = EVIN; g.K = D;
        pg8::StaticOrder S; S.init(g.M, g.N, G, c); EpiQKV E; E.O = (bf16_t*)(ws + WS_QKV); E.rope = (const float*)(ws + WS_ROPE); E.VT = (bf16_t*)(ws + WS_VT); pg8::gemm_phase(lds, g, S, E, wv_); }
    else if constexpr (WHICH == G_OUT0) { g.A = (const bf16_t*)(ws + WS_MIX); g.Bt = (const bf16_t*)(ws + WS_WT_OUT0); g.M = MT; g.N = D; g.K = D;
        pg8::StaticOrder S; S.init(g.M, g.N, G, c); EpiResid0 E; E.xin_lat = p.x; E.xin_ctx = p.ctx; E.xout = (float*)(ws + WS_XRES); E.gate = (const float*)(ws + WS_ADA) + 2 * D; pg8::gemm_phase(lds, g, S, E, wv_); }
    else if constexpr (WHICH == G_GU) { g.A = (const bf16_t*)(ws + WS_H); g.Bt = (const bf16_t*)(ws + WS_WT_GU) + (size_t)l * NE * 2 * FF * D; g.M = NBLK * 256; g.N = 2 * FF; g.K = D;
        pg8::MoeOrder<true> S; S.init((const int*)(ws + WS_CNT) + l * 64, g.N, G, c, (const int*)(ws + WS_ROWIDX), (size_t)2 * FF * D * 2); EpiGU E; E.O = (bf16_t*)(ws + WS_ACT); pg8::gemm_phase(lds, g, S, E, wv_); }
    else if constexpr (WHICH == G_DN) { g.A = (const bf16_t*)(ws + WS_ACT); g.Bt = (const bf16_t*)(ws + WS_WT_DN) + (size_t)l * NE * D * FF; g.M = NBLK * 256; g.N = D; g.K = FF;
        pg8::MoeOrder<false> S; S.init((const int*)(ws + WS_CNT) + l * 64, g.N, G, c, nullptr, (size_t)D * FF * 2); EpiBf16 E; E.O = (bf16_t*)(ws + WS_YBUF); E.ldc = D; pg8::gemm_phase(lds, g, S, E, wv_); }
#ifndef CPU_EMU
    else if constexpr (WHICH == G_IN0SPLIT) {
        { g.A = (const bf16_t*)(ws + WS_H); g.Bt = (const bf16_t*)(ws + WS_WT_IN0) + (size_t)IN0_NQ * D; g.M = MT; g.N = EVIN - IN0_NQ; g.K = D;
          pg8::StaticOrder S; S.init(g.M, g.N, G, c); EpiBf16 E; E.O = (bf16_t*)(ws + WS_QKV) + IN0_NQ; E.ldc = EVIN; pg8::gemm_phase(lds, g, S, E, wv_); }
        const int extra = ((MT / 256) * ((EVIN - IN0_NQ) / 256)) % G, G2 = G - extra;
        if (c >= extra) { pg8::Gemm g2; g2.A = (const bf16_t*)(ws + WS_H8); g2.Bt = (const bf16_t*)(ws + WS_WT_IN0); g2.M = MT; g2.N = IN0_NQ; g2.K = D / 2; g2.sc_w = W8_E8M0; g2.sc_a = ONE_E8M0;
          pg8::StaticOrder S; S.init(g2.M, g2.N, G2, c - extra); EpiQKV E; E.O = (bf16_t*)(ws + WS_QKV); E.rope = (const float*)(ws + WS_ROPE); E.VT = (bf16_t*)(ws + WS_VT); pg8::gemm_phase<EpiQKV, pg8::StaticOrder, true>(lds, g2, S, E, wv_); } }
    else if constexpr (WHICH == G_IN08) { g.A = (const bf16_t*)(ws + WS_H); g.Bt = (const bf16_t*)(ws + WS_WT_IN0); g.M = MT; g.N = EVIN; g.K = D / 2; g.sc_w = W8_E8M0; g.sc_a = ONE_E8M0;
        pg8::StaticOrder S; S.init(g.M, g.N, G, c); EpiQKV E; E.O = (bf16_t*)(ws + WS_QKV); E.rope = (const float*)(ws + WS_ROPE); E.VT = (bf16_t*)(ws + WS_VT); pg8::gemm_phase<EpiQKV, pg8::StaticOrder, true>(lds, g, S, E, wv_); }
    else if constexpr (WHICH == G_OUT08) { g.A = (const bf16_t*)(ws + WS_MIX); g.Bt = (const bf16_t*)(ws + WS_WT_OUT0); g.M = MT; g.N = D; g.K = D / 2; g.sc_w = W8_E8M0; g.sc_a = ONE_E8M0;
        pg8::StaticOrder S; S.init(g.M, g.N, G, c); gemm_stagger(S, 30); EpiResid0 E; E.xin_lat = p.x; E.xin_ctx = p.ctx; E.xout = (float*)(ws + WS_XRES); E.gate = (const float*)(ws + WS_ADA) + 2 * D; pg8::gemm_phase<EpiResid0, pg8::StaticOrder, true>(lds, g, S, E, wv_); }
    else if constexpr (WHICH == G_IN18) { g.A = (const bf16_t*)(ws + WS_H); g.Bt = (const bf16_t*)(ws + WS_WT_IN1); g.M = MT; g.N = S5W; g.K = D / 2; g.sc_w = W8_E8M0; g.sc_a = ONE_E8M0;
        pg8::StaticOrder S; S.init(g.M, g.N, G, c); gemm_stagger(S, 16); EpiBf16 E; E.O = (bf16_t*)(ws + WS_U1); E.ldc = S5W; pg8::gemm_phase<EpiBf16, pg8::StaticOrder, true>(lds, g, S, E, wv_); }
    else if constexpr (WHICH == G_GLU8) { g.A = (const bf16_t*)(ws + WS_Z); g.Bt = (const bf16_t*)(ws + WS_WT_GLU); g.M = ML; g.N = S5W; g.K = S5W / 2; g.sc_w = W8_E8M0; g.sc_a = Z8_E8M0;
        pg8::StaticOrder S; S.init(g.M, g.N, G, c); EpiGLU8 E; E.Z = ws + WS_Z; E.O = ws + WS_S; E.bias = p.s5_glu_b; pg8::gemm_phase<EpiGLU8, pg8::StaticOrder, true>(lds, g, S, E, wv_); }
    else if constexpr (WHICH == G_OUT18) { g.A = (const bf16_t*)(ws + WS_S); g.Bt = (const bf16_t*)(ws + WS_WT_OUT1); g.M = ML; g.N = D; g.K = S5W / 2; g.sc_w = W8_E8M0; g.sc_a = S8_E8M0;
        pg8::StaticOrder S; S.init(g.M, g.N, G, c); EpiResid E; E.xin_lat = (const float*)(ws + WS_XRES); E.xin_ctx = (const float*)(ws + WS_XRES + (size_t)ML * D * (RES_BF16 ? 2 : 4)); E.xout = (float*)(ws + WS_XRES);
        E.gate = (const float*)(ws + WS_ADA) + (size_t)NADA * ADA6 + 2 * D; pg8::gemm_phase<EpiResid, pg8::StaticOrder, true>(lds, g, S, E, wv_); }
    else if constexpr (WHICH == G_GU8) { g.A = (const bf16_t*)(ws + WS_H); g.Bt = (const bf16_t*)(ws + WS_WT_GU + (size_t)l * NE * 2 * FF * D * 2); g.M = NBLK * 256; g.N = 2 * FF; g.K = D / 2; g.sc_w = W8_E8M0; g.sc_a = ONE_E8M0;
        pg8::MoeOrder<true> S; S.init((const int*)(ws + WS_CNT) + l * 64, g.N, G, c, (const int*)(ws + WS_ROWIDX), (size_t)2 * FF * D); gemm_stagger(S, 20); EpiGU8 E; E.O = ws + WS_ACT; pg8::gemm_phase<EpiGU8, pg8::MoeOrder<true>, true>(lds, g, S, E, wv_); }
    else if constexpr (WHICH == G_DN8) { g.A = (const bf16_t*)(ws + WS_ACT); g.Bt = (const bf16_t*)(ws + WS_WT_DN + (size_t)l * NE * D * FF * 2); g.M = NBLK * 256; g.N = D; g.K = FF / 2; g.sc_w = W8_E8M0; g.sc_a = ACT8_E8M0;
        pg8::MoeOrder<false> S; S.init((const int*)(ws + WS_CNT) + l * 64, g.N, G, c, nullptr, (size_t)D * FF); gemm_stagger(S, 13);
        if constexpr (Y8) { EpiY8 E; E.O = ws + WS_YBUF; E.ldc = D; pg8::gemm_phase<EpiY8, pg8::MoeOrder<false>, true>(lds, g, S, E, wv_); }
        else { EpiBf16 E; E.O = (bf16_t*)(ws + WS_YBUF); E.ldc = D; pg8::gemm_phase<EpiBf16, pg8::MoeOrder<false>, true>(lds, g, S, E, wv_); } }
#endif
    else if constexpr (WHICH == G_IN1) { g.A = (const bf16_t*)(ws + WS_H); g.Bt = (const bf16_t*)(ws + WS_WT_IN1); g.M = MT; g.N = S5W; g.K = D;
        pg8::StaticOrder S; S.init(g.M, g.N, G, c); EpiBf16 E; E.O = (bf16_t*)(ws + WS_U1); E.ldc = S5W; pg8::gemm_phase(lds, g, S, E, wv_); }
    else if constexpr (WHICH == G_GLU) { g.A = (const bf16_t*)(ws + WS_Z); g.Bt = (const bf16_t*)(ws + WS_WT_GLU); g.M = ML; g.N = S5W; g.K = S5W;
        pg8::StaticOrder S; S.init(g.M, g.N, G, c); EpiGLU E; E.Z = (const bf16_t*)(ws + WS_Z); E.O = (bf16_t*)(ws + WS_S); E.bias = p.s5_glu_b; pg8::gemm_phase(lds, g, S, E, wv_); }
    else { g.A = (const bf16_t*)(ws + WS_S); g.Bt = (const bf16_t*)(ws + WS_WT_OUT1); g.M = ML; g.N = D; g.K = S5W;
        pg8::StaticOrder S; S.init(g.M, g.N, G, c); EpiResid E; E.xin_lat = (const float*)(ws + WS_XRES); E.xin_ctx = (const float*)(ws + WS_XRES + (size_t)ML * D * (RES_BF16 ? 2 : 4)); E.xout = (float*)(ws + WS_XRES);
        E.gate = (const float*)(ws + WS_ADA) + (size_t)NADA * ADA6 + 2 * D; pg8::gemm_phase(lds, g, S, E, wv_); }
}
#ifndef CPU_EMU

#define XB_TMO      128
#define XB_XCNT(j)  (256  + 64 * (j))
#define XB_XSUB(j)  (1280 + 64 * (j))
#define XB_XGEN(j)  (2304 + 64 * (j))
#define XB_TOP      3328
#define XB_TOPGEN   3392
#define XCD_BAR_WORDS 3456
#define XB_SPIN_CAP (1u << 24)

__device__ __forceinline__ unsigned xb_ld(unsigned* p)              { return __hip_atomic_load(p, __ATOMIC_RELAXED, __HIP_MEMORY_SCOPE_AGENT); }
__device__ __forceinline__ unsigned xb_add(unsigned* p, unsigned v) { return __hip_atomic_fetch_add(p, v, __ATOMIC_RELAXED, __HIP_MEMORY_SCOPE_AGENT); }
__device__ __forceinline__ unsigned xb_xcc_id() { return (unsigned)__builtin_amdgcn_s_getreg((3 << 11) | 20) & 0xFu; }
#define XB_SPIN(cond, bar) do { unsigned _sp = 0; while (cond) { __builtin_amdgcn_s_sleep(1); \
    if ((++_sp & 255u) == 0u) { if (xb_ld(&(bar)[XB_TMO])) break; if (_sp > XB_SPIN_CAP) { atomicAdd(&(bar)[XB_TMO], 1u); break; } } } } while (0)

struct XcdBarrier {
    unsigned* bar; unsigned x;
    volatile LAS unsigned* st;
};

__device__ __forceinline__ XcdBarrier xcd_barrier_post(unsigned* bar, volatile LAS unsigned* st, int wv_) {
    XcdBarrier b; b.bar = bar; b.x = xb_xcc_id(); b.st = st;
    if (tid_of(wv_) == 0) (void)xb_add(&bar[XB_XCNT(b.x)], 1u);
    return b;
}
__device__ __forceinline__ void xcd_barrier_complete(unsigned* bar, unsigned x, unsigned& nloc, unsigned& nx) {
    const unsigned G = gridDim.x * gridDim.y * gridDim.z;
    unsigned sum, cnt, mine, sp = 0u;
    for (;;) {
        sum = 0u; cnt = 0u; mine = 0u;
#pragma unroll
        for (unsigned j = 0; j < 16; ++j) { const unsigned c = xb_ld(&bar[XB_XCNT(j)]); sum += c; cnt += (c > 0u) ? 1u : 0u; mine = (j == x) ? c : mine; }
        if (sum == G) break;
        __builtin_amdgcn_s_sleep(1);
        if ((++sp & 255u) == 0u) { if (xb_ld(&bar[XB_TMO])) break; if (sp > XB_SPIN_CAP) { atomicAdd(&bar[XB_TMO], 1u); break; } }
    }
    nloc = mine > 0u ? mine : 1u; nx = cnt > 0u ? cnt : 1u;
}

__device__ __forceinline__ void xcd_barrier(const XcdBarrier& b, int wv_) {
    asm volatile("s_waitcnt vmcnt(0)" ::: "memory");
    __syncthreads();
    if (tid_of(wv_) == 0) {
        unsigned* bar = b.bar;
        __builtin_amdgcn_s_waitcnt(0);
        unsigned nloc = b.st[0], nx = b.st[1];
        if (nloc == 0u) { xcd_barrier_complete(bar, b.x, nloc, nx); b.st[0] = nloc; b.st[1] = nx; }
        const unsigned old = xb_add(&bar[XB_XSUB(b.x)], 1u);
        const unsigned gen = old / nloc;
        if (old + 1u == (gen + 1u) * nloc) {
            __builtin_amdgcn_fence(__ATOMIC_RELEASE, "agent");
            asm volatile("s_waitcnt vmcnt(0)" ::: "memory");
            const unsigned og = xb_add(&bar[XB_TOP], 1u);
            const unsigned tg = og / nx;
            if (og + 1u == (tg + 1u) * nx) xb_add(&bar[XB_TOPGEN], 1u);
            else XB_SPIN(xb_ld(&bar[XB_TOPGEN]) == tg, bar);
            __builtin_amdgcn_fence(__ATOMIC_ACQUIRE, "agent");
            xb_add(&bar[XB_XGEN(b.x)], 1u);
            asm volatile("s_waitcnt vmcnt(0)" ::: "memory");
        } else {
            XB_SPIN(xb_ld(&bar[XB_XGEN(b.x)]) == gen, bar);
            __builtin_amdgcn_fence(__ATOMIC_ACQUIRE, "agent");
            asm volatile("s_waitcnt vmcnt(0)" ::: "memory");
        }
    }
    __syncthreads();
}


#define GT ((long)blockIdx.x * blockDim.x + threadIdx.x)
#define GN ((long)gridDim.x * blockDim.x)
constexpr int MEGA_LDS = 147456;
__device__ __forceinline__ long gt_of(int wv) { return (long)blockIdx.x * 512 + tid_of(wv); }
__global__ void __launch_bounds__(512, 2) k_mega(Params p) {
    extern __shared__ __attribute__((aligned(16))) unsigned char shm[];
    volatile LAS unsigned* st = (volatile LAS unsigned*)(shm + MEGA_LDS - 64);
    const int WV = __builtin_amdgcn_readfirstlane((int)threadIdx.x >> 6);
    if (tid_of(WV) == 0) { st[0] = 0u; st[1] = 0u; st[2] = 0u; st[3] = 0u; }
    __syncthreads();
    const XcdBarrier bar = xcd_barrier_post((unsigned*)(p.ws + WS_BAR), st, WV);
    const long gn = (long)gridDim.x * 512; const int G = (int)gridDim.x, c = (int)blockIdx.x; const pg8::LdsPtr lds = (pg8::LdsPtr)shm;
#define gt gt_of(WV)
    ph_ada(p, (float*)shm, c, G, WV); ph_tables(p, gt, gn); ph_convert(p, (float*)shm, CVT_TILES, -1, WV);
    xcd_barrier(bar, WV);
    ph_norm_fast<0>(p, 0, MT, c * 8 + WV, G * 8, WV);
    xcd_barrier(bar, WV);
    run_gemm<IN0_FP8 ? G_IN08 : (IN0QKV_FP8 ? G_IN0SPLIT : G_IN0)>(p, 0, lds, G, c, WV);
    xcd_barrier(bar, WV);
    ph_attn_fast(p, (LAS unsigned char*)shm, c, G, WV);
    { constexpr int ATT_UNITS = NB * 4 * (NSEQ / 128 + NCTX / 128); const int extra = ATT_UNITS % G;
      if (extra * 2 < G) { if (c >= extra) ph_conv_fast(p, (long)(c - extra) * 512 + tid_of(WV), (long)(G - extra) * 512); } else ph_conv_fast(p, gt, gn); }
    xcd_barrier(bar, WV);
    ph_lru_fast<1>(p, (LAS unsigned char*)shm, c * 8 + WV, G * 8, WV);
    xcd_barrier(bar, WV);
    ph_lru_fast<2>(p, (LAS unsigned char*)shm, c * 8 + WV, G * 8, WV);
    xcd_barrier(bar, WV);
    run_gemm<OUT0_FP8 ? G_OUT08 : G_OUT0>(p, 0, lds, G, c, WV);
    xcd_barrier(bar, WV);
    ph_router_fast<MOE0_FP8>(p, 0, MT, (LAS unsigned char*)shm, c, G, WV);
    xcd_barrier(bar, WV);
    ph_dispatch_fast(p, 0, MT, (LAS unsigned char*)shm, c, G, WV);
    xcd_barrier(bar, WV);
    run_gemm<MOE0_FP8 ? G_GU8 : G_GU>(p, 0, lds, G, c, WV);
    xcd_barrier(bar, WV);
    run_gemm<MOE0_FP8 ? G_DN8 : G_DN>(p, 0, lds, G, c, WV);
    xcd_barrier(bar, WV);
    ph_norm_fast<1>(p, 1, MT, c * 8 + WV, G * 8, WV);
    xcd_barrier(bar, WV);
    run_gemm<DENSE1_FP8 ? G_IN18 : G_IN1>(p, 1, lds, G, c, WV);
    xcd_barrier(bar, WV);
    ph_s5_fast<1>(p, (LAS unsigned char*)shm, c * 8 + WV, G * 8, WV);
    xcd_barrier(bar, WV);
    ph_s5_fast<2>(p, (LAS unsigned char*)shm, c * 8 + WV, G * 8, WV);
    xcd_barrier(bar, WV);
    run_gemm<DENSE1_FP8 ? G_GLU8 : G_GLU>(p, 1, lds, G, c, WV);
    xcd_barrier(bar, WV);
    run_gemm<DENSE1_FP8 ? G_OUT18 : G_OUT1>(p, 1, lds, G, c, WV);
    xcd_barrier(bar, WV);
    ph_router_fast<MOE1_FP8>(p, 1, ML, (LAS unsigned char*)shm, c, G, WV);
    xcd_barrier(bar, WV);
    ph_dispatch_fast(p, 1, ML, (LAS unsigned char*)shm, c, G, WV);
    xcd_barrier(bar, WV);
    run_gemm<MOE1_FP8 ? G_GU8 : G_GU>(p, 1, lds, G, c, WV);
    xcd_barrier(bar, WV);
    run_gemm<MOE1_FP8 ? G_DN8 : G_DN>(p, 1, lds, G, c, WV);
    xcd_barrier(bar, WV);
    ph_norm_fast<2>(p, 1, ML, c * 8 + WV, G * 8, WV);
#undef gt
}

#ifdef MK_MULTI
__global__ void __launch_bounds__(512, 2) k_prologue(Params p) {
    extern __shared__ __attribute__((aligned(16))) unsigned char shm[];
    ph_ada(p, (float*)shm, blockIdx.x, gridDim.x, (int)threadIdx.x >> 6); ph_tables(p, GT, GN); ph_convert(p, (float*)shm, CVT_TILES, -1, (int)threadIdx.x >> 6);
}
template <int WHICH> __global__ void __launch_bounds__(512, 2) k_gemm(Params p, int l) {
    extern __shared__ __attribute__((aligned(16))) unsigned char shm[];
    run_gemm<WHICH>(p, l, (pg8::LdsPtr)shm, (int)gridDim.x, (int)blockIdx.x, __builtin_amdgcn_readfirstlane((int)threadIdx.x >> 6));
}
__global__ void __launch_bounds__(512, 2) k_norm(Params p, int l, int rows) { ph_norm(p, l, rows, GT, GN); }
__global__ void __launch_bounds__(512, 2) k_conv(Params p) { ph_conv(p, GT, GN); }
__global__ void __launch_bounds__(512, 2) k_lru(Params p) { ph_lru(p, GT, GN); }
__global__ void __launch_bounds__(512, 2) k_attn(Params p) { ph_attn(p, GT, GN); }
__global__ void __launch_bounds__(512, 2) k_router(Params p, int l, int rows) { ph_router(p, l, rows, GT, GN); }
__global__ void __launch_bounds__(512, 2) k_dispatch(Params p, int l, int rows) { ph_dispatch(p, l, rows, GT, GN); }
__global__ void __launch_bounds__(512, 2) k_combine(Params p, int l, int rows) { ph_combine(p, l, rows, GT, GN); }
__global__ void __launch_bounds__(512, 2) k_s5(Params p) { ph_s5(p, GT, GN); }
__global__ void __launch_bounds__(512, 2) k_final(Params p) { ph_final(p, GT, GN); }

#endif
static Params make_params(void* const* d_in, void* d_out, void* d_ws) {
    Params p{}; const float* const* in = (const float* const*)d_in;
    p.x = in[0]; p.c = in[1]; p.ctx = in[2]; p.c_ctx = in[3]; p.ada_w = in[4]; p.ada_b = in[5]; p.norm_mix = in[6]; p.norm_ffn = in[7]; p.norm_final = in[8];
    p.ev_w_in = in[9]; p.ev_w_out = in[10]; p.attn_sink = in[11]; p.lru_conv_w = in[12]; p.lru_conv_b = in[13]; p.lru_lam = in[14]; p.lru_wa = in[15]; p.lru_ba = in[16]; p.lru_wi = in[17]; p.lru_bi = in[18];
    p.od_w_in = in[19]; p.s5_lam_re = in[20]; p.s5_lam_im = in[21]; p.s5_log_step = in[22]; p.s5_b_re = in[23]; p.s5_b_im = in[24]; p.s5_c_re = in[25]; p.s5_c_im = in[26]; p.s5_d = in[27];
    p.s5_glu_w = in[28]; p.s5_glu_b = in[29]; p.od_w_out = in[30]; p.router_w = in[31]; p.router_b = in[32]; p.moe_w_gate = in[33]; p.moe_w_up = in[34]; p.moe_w_down = in[35];
    p.out = (float*)d_out; p.ws = (unsigned char*)d_ws; return p;
}

extern "C" void kernel_launch(void* const* d_in, const int* in_sizes, int n_in, void* d_out, int out_size, void* d_ws, size_t ws_size, hipStream_t stream) {
    if (n_in != 36 || ws_size < WS_END || out_size != ML * D) { fprintf(stderr, "kernel_launch: unexpected shapes (n_in %d, out %d, ws %zu < %zu)\n", n_in, out_size, ws_size, (size_t)WS_END); return; }
#ifdef MK_MULTI
    static bool attr_done = false;
    constexpr int GLDS = pg8::STAGE_BYTES;
    if (!attr_done) {
        (void)hipFuncSetAttribute((const void*)k_gemm<G_IN0>, hipFuncAttributeMaxDynamicSharedMemorySize, GLDS); (void)hipFuncSetAttribute((const void*)k_gemm<G_OUT0>, hipFuncAttributeMaxDynamicSharedMemorySize, GLDS);
        (void)hipFuncSetAttribute((const void*)k_gemm<G_GU>, hipFuncAttributeMaxDynamicSharedMemorySize, GLDS); (void)hipFuncSetAttribute((const void*)k_gemm<G_DN>, hipFuncAttributeMaxDynamicSharedMemorySize, GLDS);
        (void)hipFuncSetAttribute((const void*)k_gemm<G_IN1>, hipFuncAttributeMaxDynamicSharedMemorySize, GLDS); (void)hipFuncSetAttribute((const void*)k_gemm<G_GLU>, hipFuncAttributeMaxDynamicSharedMemorySize, GLDS);
        (void)hipFuncSetAttribute((const void*)k_gemm<G_OUT1>, hipFuncAttributeMaxDynamicSharedMemorySize, GLDS);
        attr_done = true;
    }
    const Params p = make_params(d_in, d_out, d_ws);
    (void)hipMemsetAsync(d_ws, 0, CTL_BYTES, stream);
    const dim3 blk(512); const int NG = 256, NW = 1024;
    k_prologue<<<NW, blk, (ADA_LDS_BYTES > CVT_LDS_BYTES + 16 ? ADA_LDS_BYTES : CVT_LDS_BYTES + 16), stream>>>(p);
    k_norm<<<NW, blk, 0, stream>>>(p, 0, MT);
    k_gemm<G_IN0><<<NG, blk, GLDS, stream>>>(p, 0);
    k_attn<<<NW, blk, 0, stream>>>(p);
    k_conv<<<NW, blk, 0, stream>>>(p);
    k_lru<<<NW, blk, 0, stream>>>(p);
    k_gemm<G_OUT0><<<NG, blk, GLDS, stream>>>(p, 0);
    k_router<<<NW, blk, 0, stream>>>(p, 0, MT);
    k_dispatch<<<NW, blk, 0, stream>>>(p, 0, MT);
    k_gemm<G_GU><<<NG, blk, GLDS, stream>>>(p, 0);
    k_gemm<G_DN><<<NG, blk, GLDS, stream>>>(p, 0);
    k_combine<<<NW, blk, 0, stream>>>(p, 0, MT);
    k_norm<<<NW, blk, 0, stream>>>(p, 1, MT);
    k_gemm<G_IN1><<<NG, blk, GLDS, stream>>>(p, 1);
    k_s5<<<NW, blk, 0, stream>>>(p);
    k_gemm<G_GLU><<<NG, blk, GLDS, stream>>>(p, 1);
    k_gemm<G_OUT1><<<NG, blk, GLDS, stream>>>(p, 1);
    k_router<<<NW, blk, 0, stream>>>(p, 1, ML);
    k_dispatch<<<NW, blk, 0, stream>>>(p, 1, ML);
    k_gemm<G_GU><<<NG, blk, GLDS, stream>>>(p, 1);
    k_gemm<G_DN><<<NG, blk, GLDS, stream>>>(p, 1);
    k_combine<<<NW, blk, 0, stream>>>(p, 1, ML);
    k_final<<<NW, blk, 0, stream>>>(p);
#else
    static int grid = 0;
    if (!grid) {
        int dev = 0, cus = 0, per_cu = 0;
        if (hipGetDevice(&dev) != hipSuccess || hipDeviceGetAttribute(&cus, hipDeviceAttributeMultiprocessorCount, dev) != hipSuccess) { fprintf(stderr, "kernel_launch: device query failed\n"); return; }
        if (hipFuncSetAttribute((const void*)k_mega, hipFuncAttributeMaxDynamicSharedMemorySize, MEGA_LDS) != hipSuccess) { fprintf(stderr, "kernel_launch: hipFuncSetAttribute failed\n"); return; }
        if (hipOccupancyMaxActiveBlocksPerMultiprocessor(&per_cu, (const void*)k_mega, 512, MEGA_LDS) != hipSuccess || per_cu < 1) { fprintf(stderr, "kernel_launch: occupancy query says %d\n", per_cu); return; }
        grid = cus < MAXG ? cus : MAXG;
    }
    const Params p = make_params(d_in, d_out, d_ws);
    (void)hipMemsetAsync(d_ws, 0, WS_ADA, stream);
    hipLaunchKernelGGL(k_mega, dim3(grid), dim3(512), MEGA_LDS, stream, p);
#endif
}
#endif
```
